# Optimizing an MI355X kernel written in HIP

```python
import jax, jax.numpy as jnp
from jax import lax
import numpy as np

D_MODEL = 4096
BATCH = 2
SEQ = 8192
DEPTH = 1

N_HEADS_A = 16
HEAD_DIM_A = 128
N_KV_A = 4
D_A = N_HEADS_A * HEAD_DIM_A
KV_DIM = N_KV_A * HEAD_DIM_A
N_HEADS_IDX = 16
HEAD_DIM_IDX = 128
D_IDX_Q = N_HEADS_IDX * HEAD_DIM_IDX
TOPK_MAX = 256
Q_BLOCK = 128
ROPE_THETA = 10000.0
HEAD_DIM_B = 64
D_B = 2048
N_HEADS_B = D_B // HEAD_DIM_B
LORA_DECAY = 96
LORA_A = 96
LORA_GATE = 256
GN_EPS = 64e-5
IN_SIZES = (D_A, KV_DIM, KV_DIM, D_IDX_Q, HEAD_DIM_IDX, N_HEADS_IDX, D_B, D_B, D_B)
D_IN = D_A + 2 * KV_DIM + D_IDX_Q + HEAD_DIM_IDX + N_HEADS_IDX + 3 * D_B
D_FF = ((8 * D_MODEL // 3 + 255) // 256) * 256
D_PLE = 256
RMS_EPS = 1e-6

kernel_name = "hybrid_dsa_rwkv7_gated_block"


def _rms(x):
    x32 = x.astype(jnp.float32)
    return (x32 * lax.rsqrt(jnp.mean(x32 * x32, axis=-1, keepdims=True) + RMS_EPS)).astype(x.dtype)


def rmsnorm(x, g):
    return _rms(x) * g


def rope(t, positions):
    d = t.shape[-1]
    inv_freq = ROPE_THETA ** (-jnp.arange(0, d, 2, dtype=jnp.float32) / d)
    ang = positions.astype(jnp.float32)[..., None] * inv_freq
    cos = jnp.cos(ang)[:, :, None, :].astype(t.dtype)
    sin = jnp.sin(ang)[:, :, None, :].astype(t.dtype)
    t1, t2 = t[..., : d // 2], t[..., d // 2:]
    return jnp.concatenate([t1 * cos - t2 * sin, t1 * sin + t2 * cos], axis=-1)


def token_shift(t):
    return jnp.pad(t, ((0, 0), (1, 0), (0, 0)))[:, :-1]


def split_in(proj):
    outs, start = [], 0
    for size in IN_SIZES:
        outs.append(proj[..., start:start + size])
        start += size
    return outs


def dsa_attention(q, k, v, q_idx, k_idx, w_idx):
    B, S = q.shape[0], q.shape[1]
    topk = min(TOPK_MAX, S // 4)
    nb = S // Q_BLOCK
    key_pos = jnp.arange(S)

    def to_blocks(t):
        return jnp.moveaxis(t.reshape((B, nb, Q_BLOCK) + t.shape[2:]), 1, 0)

    def one_block(args):
        blk, q_blk, qi_blk, wi_blk = args
        q_pos = blk * Q_BLOCK + jnp.arange(Q_BLOCK)
        causal = key_pos[None, :] <= q_pos[:, None]
        logits = jnp.einsum('bqhd,bsd->bqhs', qi_blk, k_idx) * (HEAD_DIM_IDX ** -0.5)
        score = jnp.einsum('bqh,bqhs->bqs', wi_blk, jax.nn.relu(logits)).astype(jnp.float32)
        score = jnp.where(causal[None], score, -jnp.inf)
        _, idx = lax.top_k(score, topk)
        k_sel = jax.vmap(lambda kk, ii: kk[ii])(k, idx)
        v_sel = jax.vmap(lambda vv, ii: vv[ii])(v, idx)
        qg = q_blk.reshape(B, Q_BLOCK, N_KV_A, N_HEADS_A // N_KV_A, HEAD_DIM_A)
        s = jnp.einsum('bqgnd,bqkgd->bqgnk', qg, k_sel).astype(jnp.float32) * (HEAD_DIM_A ** -0.5)
        valid = idx <= q_pos[None, :, None]
        s = jnp.where(valid[:, :, None, None, :], s, -jnp.inf)
        prob = jax.nn.softmax(s, axis=-1).astype(v.dtype)
        o = jnp.einsum('bqgnk,bqkgd->bqgnd', prob, v_sel)
        return o.reshape(B, Q_BLOCK, D_A)

    out = lax.map(one_block, (jnp.arange(nb), to_blocks(q), to_blocks(q_idx), to_blocks(w_idx)))
    return jnp.moveaxis(out, 0, 1).reshape(B, S, D_A)


def rwkv7_time_mix(xn, r, k, v, mu_rkv, mu_wag, w0, w1, w2, a0, a1, a2, g1, g2,
                   k_k, k_a, r_k, ln_w, ln_b):
    B, S, _ = xn.shape
    dt = xn.dtype
    r = r + (token_shift(r) - r) * mu_rkv[0]
    k = k + (token_shift(k) - k) * mu_rkv[1]
    v = v + (token_shift(v) - v) * mu_rkv[2]
    xx = token_shift(xn) - xn
    xw = xn + xx * mu_wag[0]
    xa = xn + xx * mu_wag[1]
    xg = xn + xx * mu_wag[2]
    w = -jax.nn.softplus(-(w0 + jnp.tanh(xw @ w1) @ w2)) - 0.5
    decay = jnp.exp(-jnp.exp(w.astype(jnp.float32)))
    a = jax.nn.sigmoid(a0 + (xa @ a1) @ a2)
    g = jax.nn.sigmoid(xg @ g1) @ g2
    kk = (k * k_k).astype(jnp.float32).reshape(B, S, N_HEADS_B, HEAD_DIM_B)
    kk = kk / jnp.maximum(jnp.linalg.norm(kk, axis=-1, keepdims=True), 1e-12)
    k = k * (1.0 + (a - 1.0) * k_a)

    def heads(t):
        return jnp.moveaxis(t.astype(jnp.float32).reshape(B, S, N_HEADS_B, HEAD_DIM_B), 1, 0)

    a_h = a.astype(jnp.float32).reshape(B, S, N_HEADS_B, HEAD_DIM_B)
    xs = (heads(r), heads(decay), heads(k), heads(v),
          jnp.moveaxis(-kk, 1, 0), jnp.moveaxis(kk * a_h, 1, 0))

    def step(state, inp):
        r_t, w_t, k_t, v_t, a_t, b_t = inp
        sa = jnp.einsum('bhij,bhj->bhi', state, a_t)
        state = (state * w_t[:, :, None, :] + sa[..., None] * b_t[:, :, None, :]
                 + v_t[..., None] * k_t[:, :, None, :])
        return state, jnp.einsum('bhij,bhj->bhi', state, r_t)

    state0 = jnp.zeros((B, N_HEADS_B, HEAD_DIM_B, HEAD_DIM_B), jnp.float32)
    _, y = lax.scan(step, state0, xs)
    y = jnp.moveaxis(y, 0, 1)
    mu = jnp.mean(y, axis=-1, keepdims=True)
    var = jnp.mean(jnp.square(y - mu), axis=-1, keepdims=True)
    y = ((y - mu) * lax.rsqrt(var + GN_EPS)).reshape(B, S, D_B).astype(dt) * ln_w + ln_b
    rh = r.reshape(B, S, N_HEADS_B, HEAD_DIM_B)
    kh = k.reshape(B, S, N_HEADS_B, HEAD_DIM_B)
    vh = v.reshape(B, S, N_HEADS_B, HEAD_DIM_B)
    bonus = jnp.sum(rh * kh * r_k, axis=-1, keepdims=True) * vh
    return (y + bonus.reshape(B, S, D_B)) * g


def setup_inputs(seed: int = 0) -> dict:
    key = jax.random.key(seed)
    ks = jax.random.split(key, 40)
    L, D = DEPTH, D_MODEL

    def nrm(k, shape, scale):
        return jax.random.normal(k, shape, jnp.float32) * scale

    def uni(k, shape):
        return jax.random.uniform(k, shape, jnp.float32)

    return {
        "x": nrm(ks[0], (BATCH, SEQ, D), 1.0),
        "p": nrm(ks[1], (L, BATCH, SEQ, D_PLE), 1.0),
        "positions": jnp.broadcast_to(jnp.arange(SEQ, dtype=jnp.int32), (BATCH, SEQ)),
        "norm_mix": 1.0 + nrm(ks[2], (L, D), 0.02),
        "w_in": nrm(ks[3], (L, D, D_IN), D ** -0.5),
        "mu_rkv": uni(ks[4], (L, 3, D_B)),
        "mu_wag": uni(ks[5], (L, 3, D)),
        "w0": nrm(ks[6], (L, D_B), 0.5),
        "w1": nrm(ks[7], (L, D, LORA_DECAY), D ** -0.5),
        "w2": nrm(ks[8], (L, LORA_DECAY, D_B), 0.1 * LORA_DECAY ** -0.5),
        "a0": nrm(ks[9], (L, D_B), 0.1),
        "a1": nrm(ks[10], (L, D, LORA_A), D ** -0.5),
        "a2": nrm(ks[11], (L, LORA_A, D_B), 0.1 * LORA_A ** -0.5),
        "g1": nrm(ks[12], (L, D, LORA_GATE), D ** -0.5),
        "g2": nrm(ks[13], (L, LORA_GATE, D_B), LORA_GATE ** -0.5),
        "k_k": 0.85 + nrm(ks[14], (L, D_B), 0.02),
        "k_a": 1.0 + nrm(ks[15], (L, D_B), 0.02),
        "r_k": nrm(ks[16], (L, N_HEADS_B, HEAD_DIM_B), 0.05),
        "ln_w": 1.0 + nrm(ks[17], (L, D_B), 0.02),
        "ln_b": nrm(ks[18], (L, D_B), 0.02),
        "w_pa": nrm(ks[19], (L, D_A, D), D_A ** -0.5),
        "w_pb": nrm(ks[20], (L, D_B, D), D_B ** -0.5),
        "w_gate": nrm(ks[21], (L, D, 2 * D), D ** -0.5),
        "b_gate": nrm(ks[22], (L, 2 * D), 0.02),
        "w_o": nrm(ks[23], (L, D, D), D ** -0.5),
        "norm_ffn": 1.0 + nrm(ks[24], (L, D), 0.02),
        "w_ffn1": nrm(ks[25], (L, D, D_FF), D ** -0.5),
        "w_ffn3": nrm(ks[26], (L, D, D_FF), D ** -0.5),
        "w_ffn2": nrm(ks[27], (L, D_FF, D), D_FF ** -0.5),
        "w_ple_gate": nrm(ks[28], (L, D, D), D ** -0.5),
        "w_ple": nrm(ks[29], (L, D_PLE, D), D_PLE ** -0.5),
        "norm_final": 1.0 + nrm(ks[30], (D,), 0.02),
    }


def reference(x, p, positions, norm_mix, w_in, mu_rkv, mu_wag, w0, w1, w2, a0, a1, a2,
              g1, g2, k_k, k_a, r_k, ln_w, ln_b, w_pa, w_pb, w_gate, b_gate, w_o,
              norm_ffn, w_ffn1, w_ffn3, w_ffn2, w_ple_gate, w_ple, norm_final):
    B, S, _ = x.shape
    h = x
    for i in range(DEPTH):
        xn = rmsnorm(h, norm_mix[i])
        q, k, v, qi, ki, wi, rb, kb, vb = split_in(xn @ w_in[i])
        q = rope(q.reshape(B, S, N_HEADS_A, HEAD_DIM_A), positions)
        k = rope(k.reshape(B, S, N_KV_A, HEAD_DIM_A), positions)
        v = v.reshape(B, S, N_KV_A, HEAD_DIM_A)
        qi = rope(qi.reshape(B, S, N_HEADS_IDX, HEAD_DIM_IDX), positions)
        ki = rope(ki[:, :, None, :], positions)[:, :, 0, :]
        wi = wi * (N_HEADS_IDX ** -0.5)
        y_a = dsa_attention(q, k, v, qi, ki, wi) @ w_pa[i]
        y_b = rwkv7_time_mix(xn, rb, kb, vb, mu_rkv[i], mu_wag[i], w0[i], w1[i], w2[i],
                             a0[i], a1[i], a2[i], g1[i], g2[i], k_k[i], k_a[i], r_k[i],
                             ln_w[i], ln_b[i]) @ w_pb[i]
        gates = jax.nn.sigmoid(xn @ w_gate[i] + b_gate[i])
        g_a, g_b = gates[..., :D_MODEL], gates[..., D_MODEL:]
        h = h + (g_a * y_a + g_b * y_b) @ w_o[i]
        xf = rmsnorm(h, norm_ffn[i])
        h = h + (jax.nn.silu(xf @ w_ffn1[i]) * (xf @ w_ffn3[i])) @ w_ffn2[i]
        h = h + jax.nn.sigmoid(_rms(h) @ w_ple_gate[i]) * (p[i] @ w_ple[i])
    return rmsnorm(h, norm_final)
```

```cpp
#include <hip/hip_runtime.h>
#include <cstdio>
#include <cstdint>
__device__ __forceinline__ int lane_opaque() { int l; asm volatile("v_mbcnt_lo_u32_b32 %0, -1, 0\n\tv_mbcnt_hi_u32_b32 %0, -1, %0" : "=v"(l)); return l; }
namespace pg8 {
#define PG8_LAS __attribute__((address_space(3)))
typedef unsigned short bf16_t;
typedef short bf16x8 __attribute__((ext_vector_type(8)));
typedef float f32x4 __attribute__((ext_vector_type(4)));
typedef unsigned u32x4 __attribute__((ext_vector_type(4)));
constexpr int BM = 256, BK = 64, HALF = 128, HTB = HALF * BK * 2  , STAGE_BYTES = 8 * HTB, NXCD = 8, WGM = 8;

__host__ __device__ __forceinline__ int lds_byte(int r, int c) { const int st = (r >> 4) * 2 + (c >> 5), rr = r & 15, cc = c & 31, ob = rr * 64 + cc * 2; return st * 1024 + (ob ^ (((ob >> 9) & 1) << 5)); }
__host__ __device__ __forceinline__ void stage_rc(int b, int& R, int& C) { const int st = b / 1024, sb = b % 1024, swz = sb ^ (((sb >> 9) & 1) << 5); R = (st >> 1) * 16 + swz / 64; C = (st & 1) * 32 + (swz % 64) / 2; }
__host__ __device__ __forceinline__ int perm32(int rho) { const int n = rho >> 4, i = rho & 15; return 8 * (i >> 2) + 4 * n + (i & 3); }

struct Unit { int pm, pn; };
struct Gemm { const bf16_t* A; const bf16_t* Bt; int M, N, K; };

struct StaticOrder {
    int nM, nN, nwg, G, c;
    __host__ __device__ void init(int M, int N, int G_, int c_) { nM = M / BM; nN = N / BM; nwg = nM * nN; G = G_; c = c_; }
    __host__ __device__ bool next(int i, Unit& u) const {
        const long L = (long)i * G + c; if (L >= nwg) return false;
        int wgid = (int)L; { const int q = nwg / NXCD, r = nwg % NXCD, xcd = wgid % NXCD, off = wgid / NXCD; wgid = (xcd < r ? xcd * (q + 1) : r * (q + 1) + (xcd - r) * q) + off; }
        const int nig = WGM * nN, gid = wgid / nig, fm = gid * WGM, gsz = (nM - fm) < WGM ? (nM - fm) : WGM;
        u.pm = fm + ((wgid % nig) % gsz); u.pn = (wgid % nig) / gsz; return true;
    }
    __device__ __forceinline__ void a_ready(const Unit&) const {}
    __device__ __forceinline__ void done(const Unit&) const {}
};
__device__ __forceinline__ unsigned cvt_pk_bf16(float lo, float hi) { unsigned r; asm volatile("v_cvt_pk_bf16_f32 %0, %1, %2" : "=v"(r) : "v"(lo), "v"(hi)); return r; }
template <class Epi, class Sched, bool ALIGN_EPI = false, bool SP2 = false>
__device__ __forceinline__ void gemm_phase(PG8_LAS unsigned char* lds, const Gemm g, const Sched& S, const Epi& E, const int wid) {
    const int lane = lane_opaque(), tid = wid * 64 + lane, wr = wid >> 2, wc = wid & 3, fr = lane & 15, fq = lane >> 4;
    const int K = g.K, nt = K / BK;
    unsigned voffA[2], voffB[2];
#pragma unroll
    for (int i = 0; i < 2; ++i) { int R, C; stage_rc(tid * 16 + i * 8192, R, C); const int Rb = Epi::PERM ? ((R & ~31) + perm32(R & 31)) : R;
        voffA[i] = (unsigned)(R * K + C) * 2u; voffB[i] = (unsigned)(Rb * K + C) * 2u; }
    const size_t kstep = (size_t)(BK * 2);
    const size_t hstep = (size_t)HALF * K * 2;
    const size_t tstep = 2 * hstep;
    const unsigned ldsw = (unsigned)wid * 1024u;
    const int aoff = lds_byte(wr * 64 + fr, fq * 8), boff = lds_byte(wc * 32 + fr, fq * 8);
#define PG8_SA(b, h) (((b) * 2 + (h)) * HTB)
#define PG8_SB(b, h) ((4 + (b) * 2 + (h)) * HTB)
#define PG8_STAGE(bufoff, gbase, voff) do { _Pragma("unroll") for (int _i = 0; _i < 2; ++_i) \
        __builtin_amdgcn_global_load_lds((const unsigned*)((const char*)(gbase) + (voff)[_i]), (PG8_LAS unsigned*)(lds + (bufoff) + ldsw + _i * 8192), 16, 0, 0); } while (0)
#define PG8_LDA(dst, b, h) do { _Pragma("unroll") for (int m = 0; m < 4; ++m) _Pragma("unroll") for (int k = 0; k < 2; ++k) dst[m][k] = *(const PG8_LAS bf16x8*)(lds + PG8_SA(b, h) + aoff + m * 2048 + k * 1024); } while (0)
#define PG8_LDB(dst, b, h) do { _Pragma("unroll") for (int n = 0; n < 2; ++n) _Pragma("unroll") for (int k = 0; k < 2; ++k) dst[n][k] = *(const PG8_LAS bf16x8*)(lds + PG8_SB(b, h) + boff + n * 2048 + k * 1024); } while (0)
#define PG8_MMA(ai, bj, At, Bt) do { __builtin_amdgcn_s_setprio(1); _Pragma("unroll") for (int m = 0; m < 4; ++m) _Pragma("unroll") for (int n = 0; n < 2; ++n) _Pragma("unroll") for (int k = 0; k < 2; ++k) \
        acc[ai][bj][m][n] = __builtin_amdgcn_mfma_f32_16x16x32_bf16(Bt[n][k], At[m][k], acc[ai][bj][m][n], 0, 0, 0); __builtin_amdgcn_s_setprio(0); } while (0)
#define PG8_WAIT_V(n) asm volatile("s_waitcnt vmcnt(" #n ")" ::: "memory")
#define PG8_WAIT_L(n) asm volatile("s_waitcnt lgkmcnt(" #n ")" ::: "memory")
#define PG8_BAR __builtin_amdgcn_s_barrier()
#define PG8_SCHED __builtin_amdgcn_sched_barrier(0)
    Unit cur, nxt; int ui = 0;
    if (!S.next(0, cur)) return;
    f32x4 acc[2][2][4][2];
#pragma unroll
    for (int a = 0; a < 2; ++a)
#pragma unroll
        for (int b = 0; b < 2; ++b)
#pragma unroll
            for (int m = 0; m < 4; ++m)
#pragma unroll
                for (int n = 0; n < 2; ++n) acc[a][b][m][n] = (f32x4){0.f, 0.f, 0.f, 0.f};
    bf16x8 At[4][2], B0[2][2], B1[2][2];
    const char* cA = (const char*)g.A + (size_t)cur.pm * tstep; const char* cB = (const char*)g.Bt + (size_t)cur.pn * tstep;
    S.a_ready(cur);
    if constexpr (SP2) {
        PG8_STAGE(PG8_SB(0, 0), cB, voffB); PG8_STAGE(PG8_SB(0, 1), cB + hstep, voffB); PG8_STAGE(PG8_SA(0, 0), cA, voffA); PG8_STAGE(PG8_SA(0, 1), cA + hstep, voffA);
        if (wr == 1) PG8_BAR;
        PG8_WAIT_V(2); PG8_BAR;
        PG8_STAGE(PG8_SB(1, 0), cB + kstep, voffB); PG8_STAGE(PG8_SA(1, 0), cA + kstep, voffA); PG8_STAGE(PG8_SB(1, 1), cB + hstep + kstep, voffB);
        PG8_WAIT_V(6); PG8_BAR;
    } else {
        PG8_STAGE(PG8_SB(0, 0), cB, voffB); PG8_STAGE(PG8_SA(0, 0), cA, voffA); PG8_STAGE(PG8_SB(0, 1), cB + hstep, voffB); PG8_STAGE(PG8_SA(0, 1), cA + hstep, voffA);
        if (wr == 1) PG8_BAR;
        PG8_WAIT_V(4); PG8_BAR;
        PG8_STAGE(PG8_SB(1, 0), cB + kstep, voffB); PG8_STAGE(PG8_SA(1, 0), cA + kstep, voffA); PG8_STAGE(PG8_SB(1, 1), cB + hstep + kstep, voffB);
        PG8_WAIT_V(6); PG8_BAR;
    }
    for (;;) {
        const bool has_next = S.next(ui + 1, nxt);
        const char* nA = has_next ? (const char*)g.A + (size_t)nxt.pm * tstep : cA; const char* nB = has_next ? (const char*)g.Bt + (size_t)nxt.pn * tstep : cB;
        for (int t = 0; t < nt; t += 2) {
            const bool last = (t == nt - 2);
            const char* a1 = cA + (size_t)(t + 1) * kstep;
            const char* a2 = last ? nA : cA + (size_t)(t + 2) * kstep; const char* b2 = last ? nB : cB + (size_t)(t + 2) * kstep;
            const char* a3 = a2 + kstep; const char* b3 = b2 + kstep;
            if (last && has_next) S.a_ready(nxt);
            if constexpr (SP2) {
            PG8_LDB(B0, 0, 0); PG8_LDB(B1, 0, 1); PG8_SCHED; PG8_LDA(At, 0, 0); PG8_STAGE(PG8_SA(1, 1), a1 + hstep, voffA);
            PG8_WAIT_V(8); PG8_WAIT_L(0); PG8_BAR; PG8_MMA(0, 0, At, B0); PG8_MMA(0, 1, At, B1); PG8_BAR; PG8_SCHED;
            PG8_LDA(At, 0, 1); PG8_STAGE(PG8_SB(0, 0), b2, voffB); PG8_STAGE(PG8_SB(0, 1), b2 + hstep, voffB); PG8_STAGE(PG8_SA(0, 0), a2, voffA);
            PG8_WAIT_V(8); PG8_WAIT_L(0); PG8_BAR; PG8_MMA(1, 0, At, B0); PG8_MMA(1, 1, At, B1); PG8_BAR; PG8_SCHED;
            PG8_LDB(B0, 1, 0); PG8_LDB(B1, 1, 1); PG8_SCHED; PG8_LDA(At, 1, 0); PG8_STAGE(PG8_SA(0, 1), a2 + hstep, voffA);
            PG8_WAIT_V(8); PG8_WAIT_L(0); PG8_BAR; PG8_MMA(0, 0, At, B0); PG8_MMA(0, 1, At, B1); PG8_BAR; PG8_SCHED;
            PG8_LDA(At, 1, 1); PG8_STAGE(PG8_SB(1, 0), b3, voffB); PG8_STAGE(PG8_SB(1, 1), b3 + hstep, voffB); PG8_STAGE(PG8_SA(1, 0), a3, voffA);
            PG8_WAIT_V(8); PG8_WAIT_L(0); PG8_BAR; PG8_MMA(1, 0, At, B0); PG8_MMA(1, 1, At, B1); PG8_BAR; PG8_SCHED;
            } else {
            PG8_LDB(B0, 0, 0); PG8_SCHED; PG8_LDA(At, 0, 0); PG8_STAGE(PG8_SA(1, 1), a1 + hstep, voffA);
            PG8_WAIT_L(8); PG8_BAR; PG8_WAIT_L(0); PG8_MMA(0, 0, At, B0); PG8_BAR; PG8_SCHED;
            PG8_LDB(B1, 0, 1); PG8_STAGE(PG8_SB(0, 0), b2, voffB);
            PG8_BAR; PG8_WAIT_L(0); PG8_MMA(0, 1, At, B1); PG8_BAR;
            PG8_LDA(At, 0, 1); PG8_STAGE(PG8_SA(0, 0), a2, voffA);
            PG8_BAR; PG8_WAIT_L(0); PG8_MMA(1, 0, At, B0); PG8_BAR; PG8_SCHED;
            PG8_STAGE(PG8_SB(0, 1), b2 + hstep, voffB);
            PG8_WAIT_V(6); PG8_BAR; PG8_MMA(1, 1, At, B1); PG8_BAR;
            PG8_LDB(B0, 1, 0); PG8_SCHED; PG8_LDA(At, 1, 0); PG8_STAGE(PG8_SA(0, 1), a2 + hstep, voffA);
            PG8_WAIT_L(8); PG8_BAR; PG8_WAIT_L(0); PG8_MMA(0, 0, At, B0); PG8_BAR; PG8_SCHED;
            PG8_LDB(B1, 1, 1); PG8_STAGE(PG8_SB(1, 0), b3, voffB);
            PG8_BAR; PG8_WAIT_L(0); PG8_MMA(0, 1, At, B1); PG8_BAR;
            PG8_LDA(At, 1, 1); PG8_STAGE(PG8_SA(1, 0), a3, voffA);
            PG8_BAR; PG8_WAIT_L(0); PG8_MMA(1, 0, At, B0); PG8_BAR; PG8_SCHED;
            PG8_STAGE(PG8_SB(1, 1), b3 + hstep, voffB);
            PG8_WAIT_V(6); PG8_BAR; PG8_MMA(1, 1, At, B1); PG8_BAR;
            }
        }
        if constexpr (ALIGN_EPI) { if (wr == 0) PG8_BAR; }
        if constexpr (!Epi::AFTER_DRAIN) { E(acc, cur, wr, wc, fr, fq); S.done(cur); }
        if (!has_next) break;
        if (!Epi::CHAIN || !E.keep(cur)) {
#pragma unroll
        for (int a = 0; a < 2; ++a)
#pragma unroll
            for (int b = 0; b < 2; ++b)
#pragma unroll
                for (int m = 0; m < 4; ++m)
#pragma unroll
                    for (int n = 0; n < 2; ++n) acc[a][b][m][n] = (f32x4){0.f, 0.f, 0.f, 0.f};
        }
        cur = nxt; cA = nA; cB = nB; ++ui;
        if constexpr (ALIGN_EPI) { if (wr == 1) PG8_BAR; }
    }
    PG8_WAIT_V(0);
    if constexpr (!ALIGN_EPI) { if (wr == 0) PG8_BAR; }
    PG8_BAR;
    if constexpr (Epi::AFTER_DRAIN) { E.fused(acc, cur, wr, wc, fr, fq, lds, wid, lane); S.done(cur); }
#undef PG8_SA
#undef PG8_SB
#undef PG8_STAGE
#undef PG8_LDA
#undef PG8_LDB
#undef PG8_MMA
#undef PG8_WAIT_V
#undef PG8_WAIT_L
#undef PG8_BAR
#undef PG8_SCHED
}
}

#define LAS __attribute__((address_space(3)))
#define XB_TMO      128
#define XB_XCNT(j)  (256  + 64 * (j))
#define XB_XSUB(j)  (1280 + 64 * (j))
#define XB_XGEN(j)  (2304 + 64 * (j))
#define XB_TOP      3328
#define XB_TOPGEN   3392
#define XCD_BAR_WORDS 3456
#define XB_SPIN_CAP (1u << 18)

__device__ __forceinline__ unsigned xb_ld(unsigned* p)              { return __hip_atomic_load(p, __ATOMIC_RELAXED, __HIP_MEMORY_SCOPE_AGENT); }
__device__ __forceinline__ unsigned xb_add(unsigned* p, unsigned v) { return __hip_atomic_fetch_add(p, v, __ATOMIC_RELAXED, __HIP_MEMORY_SCOPE_AGENT); }
__device__ __forceinline__ unsigned xb_xcc_id() { return (unsigned)__builtin_amdgcn_s_getreg((3 << 11) | 20) & 0xFu; }
#define XB_SPIN(cond, bar) do { unsigned _sp = 0; while (cond) { __builtin_amdgcn_s_sleep(1); \
    if ((++_sp & 255u) == 0u) { if (xb_ld(&(bar)[XB_TMO])) break; if (_sp > XB_SPIN_CAP) { atomicAdd(&(bar)[XB_TMO], 1u); break; } } } } while (0)

struct XcdBarrier {
    unsigned* bar; unsigned x;
    volatile LAS unsigned* st;
};

__device__ __forceinline__ XcdBarrier xcd_barrier_post(unsigned* bar, volatile LAS unsigned* st, const bool leader  ) {
    XcdBarrier b; b.bar = bar; b.x = xb_xcc_id(); b.st = st;
    if (leader) (void)xb_add(&bar[XB_XCNT(b.x)], 1u);
    return b;
}
__device__ __forceinline__ void xcd_barrier_complete(unsigned* bar, unsigned x, unsigned& nloc, unsigned& nx) {
    const unsigned G = gridDim.x * gridDim.y * gridDim.z;
    unsigned sum, cnt, mine, sp = 0u;
    for (;;) {
        sum = 0u; cnt = 0u; mine = 0u;
#pragma unroll
        for (unsigned j = 0; j < 16; ++j) { const unsigned c = xb_ld(&bar[XB_XCNT(j)]); sum += c; cnt += (c > 0u) ? 1u : 0u; mine = (j == x) ? c : mine; }
        if (sum == G) break;
        __builtin_amdgcn_s_sleep(1);
        if ((++sp & 255u) == 0u) { if (xb_ld(&bar[XB_TMO])) break; if (sp > XB_SPIN_CAP) { atomicAdd(&bar[XB_TMO], 1u); break; } }
    }
    nloc = mine > 0u ? mine : 1u; nx = cnt > 0u ? cnt : 1u;
}

__device__ __forceinline__ void xcd_barrier(const XcdBarrier& b, const bool leader  ) {
    asm volatile("s_waitcnt vmcnt(0)" ::: "memory");
    __syncthreads();
    if (leader) {
        unsigned* bar = b.bar;
        __builtin_amdgcn_s_waitcnt(0);
        unsigned nloc = b.st[0], nx = b.st[1];
        if (nloc == 0u) { xcd_barrier_complete(bar, b.x, nloc, nx); b.st[0] = nloc; b.st[1] = nx; }
        const unsigned old = xb_add(&bar[XB_XSUB(b.x)], 1u);
        const unsigned gen = old / nloc;
        if (old + 1u == (gen + 1u) * nloc) {
            __builtin_amdgcn_fence(__ATOMIC_RELEASE, "agent");
            asm volatile("s_waitcnt vmcnt(0)" ::: "memory");
            const unsigned og = xb_add(&bar[XB_TOP], 1u);
            const unsigned tg = og / nx;
            if (og + 1u == (tg + 1u) * nx) xb_add(&bar[XB_TOPGEN], 1u);
            else XB_SPIN(xb_ld(&bar[XB_TOPGEN]) == tg, bar);
            __builtin_amdgcn_fence(__ATOMIC_ACQUIRE, "agent");
            xb_add(&bar[XB_XGEN(b.x)], 1u);
            asm volatile("s_waitcnt vmcnt(0)" ::: "memory");
        } else {
            XB_SPIN(xb_ld(&bar[XB_XGEN(b.x)]) == gen, bar);
            __builtin_amdgcn_fence(__ATOMIC_ACQUIRE, "agent");
            asm volatile("s_waitcnt vmcnt(0)" ::: "memory");
        }
    }
    __syncthreads();
}

constexpr int BATCH = 2, SEQ = 8192, M = BATCH * SEQ, D = 4096;
constexpr int DA = 2048, KVD = 512, DIQ = 2048, HDI = 128, NHI = 16, DB = 2048, NHB = 32, HDB = 64;
constexpr int DIN = 11408, DFF = 11008, DPLE = 256, TOPK = 256;
constexpr int NCAT = 81 * 256;
constexpr int N13 = 2 * DFF;
constexpr int LORA_LD = 1024;
constexpr float RMS_EPS = 1e-6f, GN_EPS = 64e-5f;

#define GAS __attribute__((address_space(1)))
typedef unsigned short bf16;
typedef unsigned v4u __attribute__((ext_vector_type(4)));
typedef unsigned v2u __attribute__((ext_vector_type(2)));
typedef float f32x4 __attribute__((ext_vector_type(4)));
typedef float f32x16 __attribute__((ext_vector_type(16)));
typedef short bf16x8 __attribute__((ext_vector_type(8)));
typedef GAS unsigned gu32;
#define RLX_AGENT __ATOMIC_RELAXED, __HIP_MEMORY_SCOPE_AGENT
#define LDS_WAIT() asm volatile("s_waitcnt lgkmcnt(0)" ::: "memory")
#define VM_WAIT() asm volatile("s_waitcnt vmcnt(0)" ::: "memory")
#define DI __device__ __forceinline__

DI unsigned f2bf(float f) { unsigned u = __builtin_bit_cast(unsigned, f); return (u + 0x7fffu + ((u >> 16) & 1u)) >> 16; }
DI unsigned pk2(float lo, float hi) { return f2bf(lo) | (f2bf(hi) << 16); }
DI float bf_lo(unsigned w) { return __builtin_bit_cast(float, w << 16); }
DI float bf_hi(unsigned w) { return __builtin_bit_cast(float, w & 0xffff0000u); }
DI float bf2f(bf16 h) { return __builtin_bit_cast(float, ((unsigned)h) << 16); }
DI float sigmoidf_(float z) { return 1.0f / (1.0f + __expf(-z)); }
DI float wave_sum(float v) {
#pragma unroll
    for (int o = 1; o < 64; o <<= 1) v += __shfl_xor(v, o);
    return v;
}

namespace epi {
using pg8::Unit; using pg8::BM; using pg8::HALF; using pg8::cvt_pk_bf16;
typedef pg8::f32x4 f4;
DI v4u pack8(const f4& a, const f4& b) { v4u w; w.x = cvt_pk_bf16(a[0], a[1]); w.y = cvt_pk_bf16(a[2], a[3]); w.z = cvt_pk_bf16(b[0], b[1]); w.w = cvt_pk_bf16(b[2], b[3]); return w; }
DI void unpack8(const v4u& w, f4& a, f4& b) { a[0] = bf_lo(w.x); a[1] = bf_hi(w.x); a[2] = bf_lo(w.y); a[3] = bf_hi(w.y); b[0] = bf_lo(w.z); b[1] = bf_hi(w.z); b[2] = bf_lo(w.w); b[3] = bf_hi(w.w); }

struct InProj {
    static constexpr bool PERM = true, AFTER_DRAIN = false, CHAIN = false;
    bf16 *q, *k, *v, *qi, *ki, *rb, *kb, *vb, *lora, *gates; float* wi;
    const float *rstd, *rcos, *rsin;
    DI bool keep(const Unit&) const { return false; }
    DI void operator()(f4 (&acc)[2][2][4][2], const Unit& u, int wr, int wc, int fr, int fq) const {
        { const int ln_ = lane_opaque(); fr = ln_ & 15; fq = ln_ >> 4; }
        const int pn = u.pn, row0 = u.pm * BM + wr * 64 + fr;
        int kind = 0, ld, cb; bf16* dst;
        if (pn < 8)       { kind = 1; dst = q;  ld = DA;  cb = pn * 256; }
        else if (pn < 10) { kind = 1; dst = k;  ld = KVD; cb = (pn - 8) * 256; }
        else if (pn < 12) { dst = v;  ld = KVD; cb = (pn - 10) * 256; }
        else if (pn < 20) { kind = 1; dst = qi; ld = DIQ; cb = (pn - 12) * 256; }
        else if (pn == 20){ kind = 2; dst = ki; ld = HDI; cb = 0; }
        else if (pn < 29) { dst = rb; ld = DB; cb = (pn - 21) * 256; }
        else if (pn < 37) { dst = kb; ld = DB; cb = (pn - 29) * 256; }
        else if (pn < 45) { dst = vb; ld = DB; cb = (pn - 37) * 256; }
        else if (pn < 49) { dst = lora; ld = LORA_LD; cb = (pn - 45) * 256; }
        else              { dst = gates; ld = 2 * D; cb = (pn - 49) * 256; }
        if (kind == 0) {
#pragma unroll
            for (int ai = 0; ai < 2; ++ai)
#pragma unroll
                for (int m = 0; m < 4; ++m) { const int row = row0 + ai * HALF + m * 16; const float rs = rstd[row];
#pragma unroll
                    for (int bj = 0; bj < 2; ++bj) *(v4u*)(dst + (size_t)row * ld + cb + bj * HALF + wc * 32 + 8 * fq) = pack8(acc[ai][bj][m][0] * rs, acc[ai][bj][m][1] * rs); }
        } else if (kind == 1 || wc < 2) {
            const int hb = cb + (wc >> 1) * 128, dd0 = (wc & 1) * 32 + 8 * fq;
#pragma unroll
            for (int ai = 0; ai < 2; ++ai)
#pragma unroll
                for (int m = 0; m < 4; ++m) { const int row = row0 + ai * HALF + m * 16; const float rs = rstd[row];
                    const f4 c0 = *(const f4*)(rcos + (size_t)row * 64 + dd0), c1 = *(const f4*)(rcos + (size_t)row * 64 + dd0 + 4);
                    const f4 s0 = *(const f4*)(rsin + (size_t)row * 64 + dd0), s1 = *(const f4*)(rsin + (size_t)row * 64 + dd0 + 4);
                    const f4 a0 = acc[ai][0][m][0] * rs, a1 = acc[ai][0][m][1] * rs, b0 = acc[ai][1][m][0] * rs, b1 = acc[ai][1][m][1] * rs;
                    bf16* p = dst + (size_t)row * ld + hb + dd0;
                    *(v4u*)(p)      = pack8(a0 * c0 - b0 * s0, a1 * c1 - b1 * s1);
                    *(v4u*)(p + 64) = pack8(a0 * s0 + b0 * c0, a1 * s1 + b1 * c1); }
        } else if (wc == 2 && fq < 2) {
#pragma unroll
            for (int ai = 0; ai < 2; ++ai)
#pragma unroll
                for (int m = 0; m < 4; ++m) { const int row = row0 + ai * HALF + m * 16; const float rs = rstd[row] * 0.25f;
                    *(f4*)(wi + (size_t)row * 16 + 8 * fq) = acc[ai][0][m][0] * rs; *(f4*)(wi + (size_t)row * 16 + 8 * fq + 4) = acc[ai][0][m][1] * rs; }
        }
    }
};

struct LoraUp {
    static constexpr bool PERM = true, AFTER_DRAIN = false, CHAIN = false;
    float* decay; bf16 *aout, *gout; const float *w0, *a0;
    DI bool keep(const Unit&) const { return false; }
    DI void operator()(f4 (&acc)[2][2][4][2], const Unit& u, int wr, int wc, int fr, int fq) const {
        { const int ln_ = lane_opaque(); fr = ln_ & 15; fq = ln_ >> 4; }
        const int which = u.pm >> 6, row0 = (u.pm & 63) * BM + wr * 64 + fr, col0 = (u.pn & 7) * BM + wc * 32 + 8 * fq;
        if (which == 0) {
#pragma unroll
            for (int bj = 0; bj < 2; ++bj) { const int col = col0 + bj * HALF; const f4 z0 = *(const f4*)(w0 + col), z1 = *(const f4*)(w0 + col + 4);
#pragma unroll
                for (int ai = 0; ai < 2; ++ai)
#pragma unroll
                    for (int m = 0; m < 4; ++m) { const size_t off = (size_t)(row0 + ai * HALF + m * 16) * DB + col;
                        f4 x0 = acc[ai][bj][m][0] + z0, x1 = acc[ai][bj][m][1] + z1;
#pragma unroll
                        for (int e = 0; e < 4; ++e) { x0[e] = __expf(-0.6065306597126334f * sigmoidf_(x0[e])); x1[e] = __expf(-0.6065306597126334f * sigmoidf_(x1[e])); }
                        *(f4*)(decay + off) = x0; *(f4*)(decay + off + 4) = x1;
                        asm volatile("" ::: "memory"); } }
        } else if (which == 1) {
#pragma unroll
            for (int bj = 0; bj < 2; ++bj) { const int col = col0 + bj * HALF; const f4 z0 = *(const f4*)(a0 + col), z1 = *(const f4*)(a0 + col + 4);
#pragma unroll
                for (int ai = 0; ai < 2; ++ai)
#pragma unroll
                    for (int m = 0; m < 4; ++m) { const size_t off = (size_t)(row0 + ai * HALF + m * 16) * DB + col;
                        f4 x0 = acc[ai][bj][m][0] + z0, x1 = acc[ai][bj][m][1] + z1;
#pragma unroll
                        for (int e = 0; e < 4; ++e) { x0[e] = sigmoidf_(x0[e]); x1[e] = sigmoidf_(x1[e]); }
                        *(v4u*)(aout + off) = pack8(x0, x1);
                        asm volatile("" ::: "memory"); } }
        } else {
#pragma unroll
            for (int bj = 0; bj < 2; ++bj)
#pragma unroll
                for (int ai = 0; ai < 2; ++ai)
#pragma unroll
                    for (int m = 0; m < 4; ++m) *(v4u*)(gout + (size_t)(row0 + ai * HALF + m * 16) * DB + col0 + bj * HALF) = pack8(acc[ai][bj][m][0], acc[ai][bj][m][1]);
        }
    }
};

struct GateMix {
    static constexpr bool PERM = true, AFTER_DRAIN = false, CHAIN = true;
    const bf16* gates; const float* bgate; bf16* mout;
    DI bool keep(const Unit& u) const { return u.pm < 64; }
    DI void operator()(f4 (&acc)[2][2][4][2], const Unit& u, int wr, int wc, int fr, int fq) const {
        { const int ln_ = lane_opaque(); fr = ln_ & 15; fq = ln_ >> 4; }
        const int which = u.pm >> 6, row0 = (u.pm & 63) * BM + wr * 64 + fr, col0 = (u.pn & 15) * BM + wc * 32 + 8 * fq;
#pragma unroll
        for (int bj = 0; bj < 2; ++bj) { const int col = col0 + bj * HALF;
            const f4 ba0 = *(const f4*)(bgate + col), ba1 = *(const f4*)(bgate + col + 4), bb0 = *(const f4*)(bgate + D + col), bb1 = *(const f4*)(bgate + D + col + 4);
#pragma unroll
            for (int ai = 0; ai < 2; ++ai)
#pragma unroll
                for (int m = 0; m < 4; ++m) { const int row = row0 + ai * HALF + m * 16;
                    f4 zb0, zb1; unpack8(*(const v4u*)(gates + (size_t)row * (2 * D) + D + col), zb0, zb1); zb0 += bb0; zb1 += bb1;
                    if (which == 0) {
                        f4 za0, za1; unpack8(*(const v4u*)(gates + (size_t)row * (2 * D) + col), za0, za1); za0 += ba0; za1 += ba1;
#pragma unroll
                        for (int e = 0; e < 4; ++e) {
                            acc[ai][bj][m][0][e] *= (1.0f + __expf(-zb0[e])) / (1.0f + __expf(-za0[e]));
                            acc[ai][bj][m][1][e] *= (1.0f + __expf(-zb1[e])) / (1.0f + __expf(-za1[e])); }
                    } else {
                        f4 o0, o1;
#pragma unroll
                        for (int e = 0; e < 4; ++e) { o0[e] = acc[ai][bj][m][0][e] * sigmoidf_(zb0[e]); o1[e] = acc[ai][bj][m][1][e] * sigmoidf_(zb1[e]); }
                        *(v4u*)(mout + (size_t)row * D + col) = pack8(o0, o1);
                    } } }
    }
};

struct Resid {
    static constexpr bool PERM = true, AFTER_DRAIN = false, CHAIN = false;
    const float* base; float* out; bf16* outb; float* ss;
    DI bool keep(const Unit&) const { return false; }
    DI void operator()(f4 (&acc)[2][2][4][2], const Unit& u, int wr, int wc, int fr, int fq) const {
        { const int ln_ = lane_opaque(); fr = ln_ & 15; fq = ln_ >> 4; }
        const int row0 = u.pm * BM + wr * 64 + fr, col0 = u.pn * BM + wc * 32 + 8 * fq;
#pragma unroll
        for (int ai = 0; ai < 2; ++ai)
#pragma unroll
            for (int m = 0; m < 4; ++m) { const int row = row0 + ai * HALF + m * 16; float s = 0.f;
#pragma unroll
                for (int bj = 0; bj < 2; ++bj) { const size_t off = (size_t)row * D + col0 + bj * HALF;
                    const f4 h0 = *(const f4*)(base + off) + acc[ai][bj][m][0], h1 = *(const f4*)(base + off + 4) + acc[ai][bj][m][1];
                    *(f4*)(out + off) = h0; *(f4*)(out + off + 4) = h1; *(v4u*)(outb + off) = pack8(h0, h1);
                    s += (h0[0] * h0[0] + h0[1] * h0[1]) + (h0[2] * h0[2] + h0[3] * h0[3]) + (h1[0] * h1[0] + h1[1] * h1[1]) + (h1[2] * h1[2] + h1[3] * h1[3]); }
                s += __shfl_xor(s, 16); s += __shfl_xor(s, 32);
                if (fq == 0) atomicAdd(ss + row, s); }
    }
};

struct FfnUp {
    static constexpr bool PERM = true, AFTER_DRAIN = false, CHAIN = false;
    const float* ss; bf16* uout;
    DI bool keep(const Unit&) const { return false; }
    DI void operator()(f4 (&acc)[2][2][4][2], const Unit& u, int wr, int wc, int fr, int fq) const {
        { const int ln_ = lane_opaque(); fr = ln_ & 15; fq = ln_ >> 4; }
        const int row0 = u.pm * BM + wr * 64 + fr, col0 = u.pn * HALF + wc * 32 + 8 * fq;
#pragma unroll
        for (int ai = 0; ai < 2; ++ai)
#pragma unroll
            for (int m = 0; m < 4; ++m) { const int row = row0 + ai * HALF + m * 16; const float r = __builtin_amdgcn_rsqf(ss[row] * (1.0f / D) + RMS_EPS);
                f4 o0, o1;
#pragma unroll
                for (int e = 0; e < 4; ++e) { const float a0 = acc[ai][0][m][0][e] * r, a1 = acc[ai][0][m][1][e] * r;
                    o0[e] = a0 * sigmoidf_(a0) * (acc[ai][1][m][0][e] * r); o1[e] = a1 * sigmoidf_(a1) * (acc[ai][1][m][1][e] * r); }
                *(v4u*)(uout + (size_t)row * DFF + col0) = pack8(o0, o1); }
    }
};

struct StoreBf {
    static constexpr bool PERM = true, AFTER_DRAIN = false, CHAIN = false;
    bf16* o; int ld;
    DI bool keep(const Unit&) const { return false; }
    DI void operator()(f4 (&acc)[2][2][4][2], const Unit& u, int wr, int wc, int fr, int fq) const {
        { const int ln_ = lane_opaque(); fr = ln_ & 15; fq = ln_ >> 4; }
        const int row0 = u.pm * BM + wr * 64 + fr, col0 = u.pn * BM + wc * 32 + 8 * fq;
#pragma unroll
        for (int ai = 0; ai < 2; ++ai)
#pragma unroll
            for (int m = 0; m < 4; ++m)
#pragma unroll
                for (int bj = 0; bj < 2; ++bj) *(v4u*)(o + (size_t)(row0 + ai * HALF + m * 16) * ld + col0 + bj * HALF) = pack8(acc[ai][bj][m][0], acc[ai][bj][m][1]);
    }
};

struct PleGate {
    static constexpr bool PERM = true, AFTER_DRAIN = false, CHAIN = false;
    float* h; const bf16* pp; const float* ss_in; float* ss_out;
    DI bool keep(const Unit&) const { return false; }
    DI void operator()(f4 (&acc)[2][2][4][2], const Unit& u, int wr, int wc, int fr, int fq) const {
        { const int ln_ = lane_opaque(); fr = ln_ & 15; fq = ln_ >> 4; }
        const int row0 = u.pm * BM + wr * 64 + fr, col0 = u.pn * BM + wc * 32 + 8 * fq;
#pragma unroll
        for (int ai = 0; ai < 2; ++ai)
#pragma unroll
            for (int m = 0; m < 4; ++m) { const int row = row0 + ai * HALF + m * 16; const float r = __builtin_amdgcn_rsqf(ss_in[row] * (1.0f / D) + RMS_EPS); float s = 0.f;
#pragma unroll
                for (int bj = 0; bj < 2; ++bj) { const size_t off = (size_t)row * D + col0 + bj * HALF;
                    f4 p0, p1; unpack8(*(const v4u*)(pp + off), p0, p1);
                    f4 h0 = *(const f4*)(h + off), h1 = *(const f4*)(h + off + 4);
#pragma unroll
                    for (int e = 0; e < 4; ++e) { h0[e] += sigmoidf_(acc[ai][bj][m][0][e] * r) * p0[e]; h1[e] += sigmoidf_(acc[ai][bj][m][1][e] * r) * p1[e]; }
                    *(f4*)(h + off) = h0; *(f4*)(h + off + 4) = h1;
                    s += (h0[0] * h0[0] + h0[1] * h0[1]) + (h0[2] * h0[2] + h0[3] * h0[3]) + (h1[0] * h1[0] + h1[1] * h1[1]) + (h1[2] * h1[2] + h1[3] * h1[3]); }
                s += __shfl_xor(s, 16); s += __shfl_xor(s, 32);
                if (fq == 0) atomicAdd(ss_out + row, s); }
    }
};

struct Stack3Order {
    int G, c;
    DI bool next(int i, Unit& u) const { const int L = i * G + c; if (L >= 1536) return false; const int which = L >> 9, r = L & 511; u.pm = which * 64 + (r & 63); u.pn = which * 8 + (r >> 6); return true; }
    DI void a_ready(const Unit&) const {}
    DI void done(const Unit&) const {}
};
struct ChainOrder {
    pg8::StaticOrder so;
    DI bool next(int i, Unit& u) const { Unit t; if (!so.next(i >> 1, t)) return false; const int which = i & 1; u.pm = which * 64 + t.pm; u.pn = which * 16 + t.pn; return true; }
    DI void a_ready(const Unit&) const {}
    DI void done(const Unit&) const {}
};
}

constexpr size_t MiB = 1u << 20;
constexpr size_t WS_CTL = 0, CTL_ZERO_BYTES = 1 * MiB;
constexpr int CW_TMO = 0, CW_BAR = 4096;
constexpr size_t SS1_OFF = 256 * 1024, SS2_OFF = 320 * 1024, SS3_OFF = 384 * 1024;
constexpr size_t WS_RSTDX = 1 * MiB;
constexpr size_t WS_BONUS = 2 * MiB;
constexpr size_t WS_RCOS = 4 * MiB, WS_RSIN = 8 * MiB;
constexpr size_t WS_WI = 12 * MiB;
constexpr size_t WS_PB = 13 * MiB;
constexpr size_t WS_WPAB = 24 * MiB;
constexpr size_t WS_WO = 56 * MiB, WS_WPG = 88 * MiB;
constexpr size_t WS_WPLE = 120 * MiB;
constexpr size_t WS_WL2 = 122 * MiB;
constexpr size_t WS_R1 = 126 * MiB;
constexpr size_t WS_WCAT = 126 * MiB;
constexpr size_t WS_XB = 288 * MiB;
constexpr size_t WS_SCORE = 126 * MiB;
constexpr size_t WS_IDX = 382 * MiB;
constexpr size_t WS_DECAY = 126 * MiB;
constexpr size_t WS_AOUT = 254 * MiB;
constexpr size_t WS_ALORA = 382 * MiB;
constexpr size_t WS_W13 = 126 * MiB;
constexpr size_t WS_W2 = 298 * MiB;
constexpr size_t WS_Q = 416 * MiB, WS_K = 480 * MiB, WS_V = 496 * MiB, WS_QI = 512 * MiB, WS_KI = 576 * MiB;
constexpr size_t WS_RB = 580 * MiB, WS_KB = 644 * MiB, WS_VB = 708 * MiB, WS_LORA = 772 * MiB, WS_GATES = 804 * MiB;
constexpr size_t WS_Y = 416 * MiB;
constexpr size_t WS_MIX = 416 * MiB;
constexpr size_t WS_H1B = 544 * MiB;
constexpr size_t WS_U = 672 * MiB;
constexpr size_t WS_H2B = 416 * MiB;
constexpr size_t WS_PP = 544 * MiB;
constexpr size_t WS_AO = 1060 * MiB;
constexpr size_t WS_GOUT = 1188 * MiB;
constexpr size_t WS_END = 1252 * MiB;

constexpr int RING_OFF = 0, RING_BYTES = 131072;
constexpr int LDSCTL_OFF = RING_BYTES, MISC_OFF = LDSCTL_OFF + 320;
constexpr int LDS_BYTES = 147456;
constexpr int NWAVES = 8;

struct Args {
    const float* in[32]; float* out; unsigned char* ws; int ph_lo, ph_hi;
};
enum { I_X = 0, I_P, I_POS, I_NORM_MIX, I_W_IN, I_MU_RKV, I_MU_WAG, I_W0, I_W1, I_W2, I_A0, I_A1, I_A2, I_G1, I_G2, I_KK, I_KA, I_RK, I_LNW, I_LNB,
       I_WPA, I_WPB, I_WGATE, I_BGATE, I_WO, I_NORM_FFN, I_WFFN1, I_WFFN3, I_WFFN2, I_WPLEG, I_WPLE, I_NORM_FINAL };

struct TrSrc { const float* p; int ld, col0, nvalid, kvalid; const float* ksc; const float* mu; int mumode; };
DI void tr_item(const TrSrc& s, bf16* WT, int dK, int n0, int k0, LAS float* scr, int lane) {
    const int nn = lane & 31;
#pragma unroll 8
    for (int i = 0; i < 32; ++i) { const int kk = 2 * i + (lane >> 5), k = k0 + kk; float v = 0.f;
        if (nn < s.nvalid && k < s.kvalid) { v = s.p[(size_t)k * s.ld + s.col0 + nn]; if (s.ksc) v *= s.ksc[k];
            if (s.mumode == 1) v *= (1.0f - s.mu[k]); else if (s.mumode == 2) v *= s.mu[k]; }
        scr[kk * 33 + nn] = v; }
    LDS_WAIT(); asm volatile("" ::: "memory");
    const int c = lane & 7;
#pragma unroll
    for (int j = 0; j < 4; ++j) { const int n = (lane >> 3) + 8 * j; const LAS float* t = scr + (8 * c) * 33 + n;
        v4u o; o.x = pk2(t[0 * 33], t[1 * 33]); o.y = pk2(t[2 * 33], t[3 * 33]); o.z = pk2(t[4 * 33], t[5 * 33]); o.w = pk2(t[6 * 33], t[7 * 33]);
        *(GAS v4u*)(WT + (size_t)(n0 + n) * dK + k0 + 8 * c) = o; }
    LDS_WAIT(); asm volatile("" ::: "memory");
}
DI TrSrc src_wcat(const float* const* in, int n0) {
    TrSrc s; s.p = in[I_W_IN]; s.ld = DIN; s.col0 = 0; s.nvalid = 32; s.kvalid = D; s.ksc = in[I_NORM_MIX]; s.mu = nullptr; s.mumode = 0;
    const int tile = n0 >> 8, p = n0 & 255, bj = p >> 7, x = p & 127;
    if (tile < 8)        s.col0 = 0    + (2 * tile + (x >> 6)) * 128 + 64 * bj + (x & 63);
    else if (tile < 10)  s.col0 = 2048 + (2 * (tile - 8) + (x >> 6)) * 128 + 64 * bj + (x & 63);
    else if (tile < 12)  s.col0 = 2560 + (tile - 10) * 256 + p;
    else if (tile < 20)  s.col0 = 3072 + (2 * (tile - 12) + (x >> 6)) * 128 + 64 * bj + (x & 63);
    else if (tile == 20) { if (x < 64) s.col0 = 5120 + 64 * bj + x; else if (bj == 0 && x == 64) { s.col0 = 5248; s.nvalid = 16; } else s.nvalid = 0; }
    else if (tile < 45)  s.col0 = 5264 + (tile - 21) * 256 + p;
    else if (tile < 49)  { const int c = (tile - 45) * 256 + p;
        if (c < 96)       { s.p = in[I_W1]; s.ld = 96;  s.col0 = c;       s.mu = in[I_MU_WAG];         s.mumode = 1; }
        else if (c < 192) { s.p = in[I_A1]; s.ld = 96;  s.col0 = c - 96;  s.mu = in[I_MU_WAG] + D;     s.mumode = 1; }
        else if (c < 448) { s.p = in[I_G1]; s.ld = 256; s.col0 = c - 192; s.mu = in[I_MU_WAG] + 2 * D; s.mumode = 1; }
        else if (c < 544) { s.p = in[I_W1]; s.ld = 96;  s.col0 = c - 448; s.mu = in[I_MU_WAG];         s.mumode = 2; }
        else if (c < 640) { s.p = in[I_A1]; s.ld = 96;  s.col0 = c - 544; s.mu = in[I_MU_WAG] + D;     s.mumode = 2; }
        else if (c < 896) { s.p = in[I_G1]; s.ld = 256; s.col0 = c - 640; s.mu = in[I_MU_WAG] + 2 * D; s.mumode = 2; }
        else s.nvalid = 0; }
    else { s.p = in[I_WGATE]; s.ld = 2 * D; s.col0 = (tile - 49) * 256 + p; }
    return s;
}
DI TrSrc src_plain(const float* p, int ld, int col0, int kvalid, const float* ksc) { TrSrc s; s.p = p; s.ld = ld; s.col0 = col0; s.nvalid = 32; s.kvalid = kvalid; s.ksc = ksc; s.mu = nullptr; s.mumode = 0; return s; }

DI void convert_set_a(const float* const* in, unsigned char* ws, LAS float* scr, int gw, int NGW, int lane) {
    constexpr int I0 = (NCAT / 32) * (D / 64);
    constexpr int I1 = (D / 32) * (DA / 64);
    constexpr int I3 = (D / 32) * (D / 64);
    constexpr int I5 = (D / 32) * (DPLE / 64);
    constexpr int I6 = (DB / 32) * (256 / 64);
    constexpr int NITEMS = I0 + 2 * I1 + 2 * I3 + I5 + 3 * I6;
    for (int it = gw; it < NITEMS; it += NGW) {
        int r = it;
        if (r < I0) { const int nblk = NCAT / 32, kb = r / nblk, nb = r % nblk; tr_item(src_wcat(in, 32 * nb), (bf16*)(ws + WS_WCAT), D, 32 * nb, 64 * kb, scr, lane); continue; } r -= I0;
        if (r < 2 * I1) { const int w = r / I1; r -= w * I1; const int nblk = D / 32, kb = r / nblk, nb = r % nblk;
            tr_item(src_plain(in[w ? I_WPB : I_WPA], D, 32 * nb, DA, nullptr), (bf16*)(ws + WS_WPAB) + (size_t)w * D * DA, DA, 32 * nb, 64 * kb, scr, lane); continue; } r -= 2 * I1;
        if (r < 2 * I3) { const int w = r / I3; r -= w * I3; const int nblk = D / 32, kb = r / nblk, nb = r % nblk;
            tr_item(src_plain(in[w ? I_WPLEG : I_WO], D, 32 * nb, D, nullptr), (bf16*)(ws + (w ? WS_WPG : WS_WO)), D, 32 * nb, 64 * kb, scr, lane); continue; } r -= 2 * I3;
        if (r < I5) { const int nblk = D / 32, kb = r / nblk, nb = r % nblk; tr_item(src_plain(in[I_WPLE], D, 32 * nb, DPLE, nullptr), (bf16*)(ws + WS_WPLE), DPLE, 32 * nb, 64 * kb, scr, lane); continue; } r -= I5;
        { const int w = r / I6; r -= w * I6; const int nblk = DB / 32, kb = r / nblk, nb = r % nblk;
          tr_item(src_plain(in[w == 0 ? I_W2 : (w == 1 ? I_A2 : I_G2)], DB, 32 * nb, w == 2 ? 256 : 96, nullptr), (bf16*)(ws + WS_WL2) + (size_t)w * DB * 256, 256, 32 * nb, 64 * kb, scr, lane); }
    }
}
DI void convert_set_b(const float* const* in, unsigned char* ws, LAS float* scr, int gw, int NGW, int lane) {
    constexpr int I0 = (N13 / 32) * (D / 64), I1 = (D / 32) * (DFF / 64);
    for (int it = gw; it < I0 + I1; it += NGW) {
        int r = it;
        if (r < I0) { const int nblk = N13 / 32, kb = r / nblk, nb = r % nblk, n0 = 32 * nb, tile = n0 >> 8, p = n0 & 255;
            tr_item(src_plain(in[(p >> 7) ? I_WFFN3 : I_WFFN1], DFF, tile * 128 + (p & 127), D, in[I_NORM_FFN]), (bf16*)(ws + WS_W13), D, n0, 64 * kb, scr, lane); continue; } r -= I0;
        { const int nblk = D / 32, kb = r / nblk, nb = r % nblk; tr_item(src_plain(in[I_WFFN2], D, 32 * nb, DFF, nullptr), (bf16*)(ws + WS_W2), DFF, 32 * nb, 64 * kb, scr, lane); }
    }
}
DI void prologue_rows(const float* const* in, unsigned char* ws, int gw, int NGW, int lane) {
    const float* x = in[I_X]; bf16* xb = (bf16*)(ws + WS_XB); float* rstd = (float*)(ws + WS_RSTDX);
    for (int m = gw; m < M; m += NGW) {
        const GAS f32x4* xr = (const GAS f32x4*)(x + (size_t)m * D) + lane; GAS v2u* o = (GAS v2u*)(xb + (size_t)m * D) + lane; float s = 0.f;
#pragma unroll 4
        for (int j = 0; j < 16; ++j) { const f32x4 v = xr[64 * j]; s += (v.x * v.x + v.y * v.y) + (v.z * v.z + v.w * v.w); v2u w; w.x = pk2(v.x, v.y); w.y = pk2(v.z, v.w); o[64 * j] = w; }
        s = wave_sum(s);
        if (lane == 0) rstd[m] = 1.0f / sqrtf(s * (1.0f / D) + RMS_EPS);
    }
    const int* pos = (const int*)in[I_POS]; float* rc = (float*)(ws + WS_RCOS); float* rsn = (float*)(ws + WS_RSIN);
    for (int e = gw * 64 + lane; e < M * 64; e += NGW * 64) {
        const int m = e >> 6, i = e & 63; double inv = 1.0; for (int j = 0; j < i; ++j) inv *= 0.8659643233600653523;
        const double ang = (double)pos[m] * inv;
        const double qd = __builtin_rint(ang * 0.63661977236758134308); const int qi = (int)((long long)qd & 3);
        double r = __builtin_fma(-qd, 1.5707963267948965580, ang); r = __builtin_fma(-qd, 6.1232339957367658860e-17, r);
        const double r2 = r * r;
        const double sn = r * (1.0 + r2 * (-1.0 / 6 + r2 * (1.0 / 120 + r2 * (-1.0 / 5040 + r2 * (1.0 / 362880 + r2 * (-1.0 / 39916800 + r2 * (1.0 / 6227020800.0)))))));
        const double cs = 1.0 + r2 * (-0.5 + r2 * (1.0 / 24 + r2 * (-1.0 / 720 + r2 * (1.0 / 40320 + r2 * (-1.0 / 3628800 + r2 * (1.0 / 479001600.0 + r2 * (-1.0 / 87178291200.0)))))));
        const double c4 = (qi == 0) ? cs : (qi == 1) ? -sn : (qi == 2) ? -cs : sn;
        const double s4 = (qi == 0) ? sn : (qi == 1) ? cs : (qi == 2) ? -sn : -cs;
        rc[e] = (float)c4; rsn[e] = (float)s4;
    }
    const float* p = in[I_P]; bf16* pb = (bf16*)(ws + WS_PB);
    for (int e = gw * 64 + lane; e < M * DPLE / 4; e += NGW * 64) { const f32x4 v = ((const GAS f32x4*)p)[e]; v2u w; w.x = pk2(v.x, v.y); w.y = pk2(v.z, v.w); ((GAS v2u*)pb)[e] = w; }
}
DI void build_alora(unsigned char* ws, int gtid, int NT) {
    const bf16* L = (const bf16*)(ws + WS_LORA); bf16* A = (bf16*)(ws + WS_ALORA);
    for (int e = gtid; e < 3 * M * 32; e += NT) {
        const int which = e / (M * 32), r = e - which * (M * 32), m = r >> 5, j0 = (r & 31) * 8;
        f32x4 o0 = {0.f, 0.f, 0.f, 0.f}, o1 = o0;
        const int width = which == 2 ? 256 : 96, ca = which == 0 ? 0 : (which == 1 ? 96 : 192), cbb = which == 0 ? 448 : (which == 1 ? 544 : 640);
        if (j0 < width) {
            f32x4 c0, c1, p0 = {0.f, 0.f, 0.f, 0.f}, p1 = p0;
            epi::unpack8(*(const v4u*)(L + (size_t)m * LORA_LD + ca + j0), c0, c1);
            if ((m & (SEQ - 1)) != 0) epi::unpack8(*(const v4u*)(L + (size_t)(m - 1) * LORA_LD + cbb + j0), p0, p1);
            o0 = c0 + p0; o1 = c1 + p1;
            if (which == 0) {
#pragma unroll
                for (int t = 0; t < 4; ++t) { o0[t] = 1.0f - 2.0f / (__expf(2.0f * o0[t]) + 1.0f); o1[t] = 1.0f - 2.0f / (__expf(2.0f * o1[t]) + 1.0f); } }
            if (which == 2) {
#pragma unroll
                for (int t = 0; t < 4; ++t) { o0[t] = sigmoidf_(o0[t]); o1[t] = sigmoidf_(o1[t]); } }
        }
        *(v4u*)(A + ((size_t)which * M + m) * 256 + j0) = epi::pack8(o0, o1);
    }
}

constexpr int IDX_TS = 272;
constexpr int IDX_TILE_BYTES = 64 * IDX_TS;
constexpr int IDX_HIST_OFF = 2 * IDX_TILE_BYTES;

DI unsigned fkey(float f) { unsigned u = __builtin_bit_cast(unsigned, f); if (u == 0x80000000u) u = 0u; return (u & 0x80000000u) ? ~u : (u | 0x80000000u); }

DI void indexer_unit(unsigned char* ws, LAS unsigned char* lds, int b, int blk, float* scratch, int tid, int wave, int lane) {
    const bf16* qi = (const bf16*)(ws + WS_QI); const bf16* ki = (const bf16*)(ws + WS_KI); const float* wi = (const float*)(ws + WS_WI);
    const int t0 = blk * 32, mrow0 = b * SEQ + t0;
    const int r = lane & 31, kh = lane >> 5, aq = (r >> 2) & 1, ah = (r & 3) + 4 * (r >> 3);
    bf16x8 af[2][8]; f32x4 wg[2][4];
#pragma unroll
    for (int rt = 0; rt < 2; ++rt) {
        const bf16* src = qi + (size_t)(mrow0 + 4 * wave + 2 * rt + aq) * DIQ + ah * HDI + 8 * kh;
#pragma unroll
        for (int ks = 0; ks < 8; ++ks) af[rt][ks] = *(const bf16x8*)(src + 16 * ks);
        const float* wsrc = wi + (size_t)(mrow0 + 4 * wave + 2 * rt + kh) * NHI;
#pragma unroll
        for (int j = 0; j < 4; ++j) wg[rt][j] = *(const f32x4*)(wsrc + 4 * j) * 0.08838834764831845f;
    }
    const int nk = (t0 + 32 + 63) >> 6;
    const int lkey = tid >> 3, lpart = tid & 7;
    const bf16* kbase = ki + (size_t)(b * SEQ) * HDI;
    v4u st0, st1;
    { const v4u* g = (const v4u*)(kbase + (size_t)lkey * HDI + lpart * 16); st0 = g[0]; st1 = g[1]; }
    __syncthreads();
    { LAS v4u* d = (LAS v4u*)(lds + lkey * IDX_TS + lpart * 32); d[0] = st0; d[1] = st1; }
    __syncthreads();
    for (int kt = 0; kt < nk; ++kt) {
        if (kt + 1 < nk) { const v4u* g = (const v4u*)(kbase + (size_t)((kt + 1) * 64 + lkey) * HDI + lpart * 16); st0 = g[0]; st1 = g[1]; }
        const LAS unsigned char* tb = lds + (kt & 1) * IDX_TILE_BYTES;
#pragma unroll
        for (int ct = 0; ct < 2; ++ct) {
            bf16x8 bfr[8];
#pragma unroll
            for (int ks = 0; ks < 8; ++ks) bfr[ks] = *(const LAS bf16x8*)(tb + (32 * ct + r) * IDX_TS + (16 * ks + 8 * kh) * 2);
#pragma unroll
            for (int rt = 0; rt < 2; ++rt) {
                f32x16 c;
#pragma unroll
                for (int j = 0; j < 16; ++j) c[j] = 0.f;
#pragma unroll
                for (int ks = 0; ks < 8; ++ks) c = __builtin_amdgcn_mfma_f32_32x32x16_bf16(af[rt][ks], bfr[ks], c, 0, 0, 0);
                float s = 0.f;
#pragma unroll
                for (int j = 0; j < 16; ++j) s += wg[rt][j >> 2][j & 3] * fmaxf(c[j], 0.f);
                scratch[(size_t)(4 * wave + 2 * rt + kh) * SEQ + kt * 64 + 32 * ct + r] = s;
            }
        }
        if (kt + 1 < nk) { LAS v4u* d = (LAS v4u*)(lds + ((kt + 1) & 1) * IDX_TILE_BYTES + lkey * IDX_TS + lpart * 32); d[0] = st0; d[1] = st1; }
        __syncthreads();
    }
}

DI void select_unit(unsigned char* ws, LAS unsigned char* lds, int b, int blk, const float* scratch, int wave, int lane) {
    int* idx = (int*)(ws + WS_IDX);
    LAS unsigned* hist = (LAS unsigned*)(lds + IDX_HIST_OFF + wave * 1024);
    const unsigned long long lt_mask = (1ull << lane) - 1ull;
    for (int qq = 0; qq < 4; ++qq) {
        const int ql = wave * 4 + qq, t = blk * 32 + ql, n = t + 1;
        const float* sc = scratch + (size_t)ql * SEQ; int* out = idx + (size_t)(b * SEQ + t) * TOPK;
        if (n <= TOPK) { for (int e = lane; e < TOPK; e += 64) out[e] = (e < n) ? e : 0; continue; }
        unsigned prefix = 0u, pmask = 0u; int kk = TOPK;
        for (int pass = 0; pass < 4; ++pass) {
            const int shift = 24 - 8 * pass;
            hist[lane] = 0u; hist[lane + 64] = 0u; hist[lane + 128] = 0u; hist[lane + 192] = 0u;
            for (int e = lane; e < n; e += 64) { const unsigned u = fkey(sc[e]); if ((u & pmask) == prefix) __hip_atomic_fetch_add(hist + ((u >> shift) & 255u), 1u, __ATOMIC_RELAXED, __HIP_MEMORY_SCOPE_WORKGROUP); }
            LDS_WAIT(); asm volatile("" ::: "memory");
            const int c0 = (int)hist[4 * lane], c1 = (int)hist[4 * lane + 1], c2 = (int)hist[4 * lane + 2], c3 = (int)hist[4 * lane + 3];
            const int T = c0 + c1 + c2 + c3; int S = T;
#pragma unroll
            for (int o = 1; o < 64; o <<= 1) { const int v = __shfl_down(S, o); if (lane + o < 64) S += v; }
            const int E = S - T;
            const bool found = (E < kk) && (kk <= S);
            int d = 0, knew = 0;
            if (found) { int run = E;
                if (run + c3 >= kk) { d = 4 * lane + 3; knew = kk - run; } else { run += c3;
                if (run + c2 >= kk) { d = 4 * lane + 2; knew = kk - run; } else { run += c2;
                if (run + c1 >= kk) { d = 4 * lane + 1; knew = kk - run; } else { run += c1; d = 4 * lane; knew = kk - run; } } } }
            const unsigned long long fm = __ballot(found); const int src = fm ? (int)__builtin_ctzll(fm) : 0;
            d = __shfl(d, src); knew = __shfl(knew, src);
            prefix |= ((unsigned)d) << shift; pmask |= 0xffu << shift; kk = knew;
            asm volatile("" ::: "memory");
        }
        int pos = 0, eqt = 0;
        for (int base = 0; base < n; base += 64) { const int e = base + lane; const bool valid = e < n; const unsigned u = valid ? fkey(sc[e]) : 0u;
            const bool eq = valid && u == prefix; const unsigned long long em = __ballot(eq);
            const bool take = valid && (u > prefix || (eq && (eqt + __builtin_popcountll(em & lt_mask)) < kk));
            const unsigned long long tm = __ballot(take);
            if (take) { const int slot = pos + __builtin_popcountll(tm & lt_mask); if (slot < TOPK) out[slot] = e; }
            pos += __builtin_popcountll(tm); eqt += __builtin_popcountll(em); }
    }
}

DI void indexer_phase(unsigned char* ws, LAS unsigned char* lds, int tid, int wave, int lane) {
    float* scratch = (float*)(ws + WS_SCORE) + (size_t)blockIdx.x * 32 * SEQ;
    for (int pr = blockIdx.x; pr < 256; pr += gridDim.x) {
        const int b = pr >> 7, j = pr & 127;
        for (int half = 0; half < 2; ++half) { const int blk = half ? 255 - j : j;
            indexer_unit(ws, lds, b, blk, scratch, tid, wave, lane);
            VM_WAIT(); __syncthreads();
            select_unit(ws, lds, b, blk, scratch, wave, lane);
            VM_WAIT(); __syncthreads(); }
    }
}

DI void attn_phase(unsigned char* ws, LAS unsigned char* lds, int wave, int lane) {
    const bf16* q = (const bf16*)(ws + WS_Q); const bf16* kbuf = (const bf16*)(ws + WS_K); const bf16* vbuf = (const bf16*)(ws + WS_V);
    const int* idx = (const int*)(ws + WS_IDX); bf16* ao = (bf16*)(ws + WS_AO);
    LAS int* idl = (LAS int*)(lds + wave * 5120); LAS f32x4* pl = (LAS f32x4*)(lds + wave * 5120 + 1024);
    const int G = gridDim.x, bg = blockIdx.x & 7, b = bg >> 2, g = bg & 3;
    const int nw = ((G - bg + 7) >> 3) * NWAVES, wv = (blockIdx.x >> 3) * NWAVES + wave;
    const int kr = lane & 15, kq = lane >> 4;
    for (int t = wv; t < SEQ; t += nw) {
        const int mq = b * SEQ + t, nvalid = (t + 1 < TOPK) ? t + 1 : TOPK;
#pragma unroll
        for (int c = 0; c < 4; ++c) idl[lane + 64 * c] = idx[(size_t)mq * TOPK + lane + 64 * c];
        bf16x8 qf[4];
#pragma unroll
        for (int ks = 0; ks < 4; ++ks) { if (kr < 4) qf[ks] = *(const bf16x8*)(q + (size_t)mq * DA + (4 * g + kr) * 128 + 32 * ks + 8 * kq); else qf[ks] = (bf16x8){0, 0, 0, 0, 0, 0, 0, 0}; }
        LDS_WAIT(); asm volatile("" ::: "memory");
        f32x4 s[16];
#pragma unroll
        for (int kt = 0; kt < 16; ++kt) { const int key = idl[16 * kt + kr];
            const bf16* kp = kbuf + (size_t)(b * SEQ + key) * KVD + g * 128 + 8 * kq;
            f32x4 a = {0.f, 0.f, 0.f, 0.f};
#pragma unroll
            for (int ks = 0; ks < 4; ++ks) a = __builtin_amdgcn_mfma_f32_16x16x32_bf16(*(const bf16x8*)(kp + 32 * ks), qf[ks], a, 0, 0, 0);
            s[kt] = a; }
        float mx = -3.0e38f;
#pragma unroll
        for (int kt = 0; kt < 16; ++kt)
#pragma unroll
            for (int e = 0; e < 4; ++e) { const bool ok = (16 * kt + 4 * kq + e) < nvalid; s[kt][e] = ok ? s[kt][e] * 0.08838834764831845f : -3.0e38f; mx = fmaxf(mx, s[kt][e]); }
        mx = fmaxf(mx, __shfl_xor(mx, 16)); mx = fmaxf(mx, __shfl_xor(mx, 32));
        float sum = 0.f;
#pragma unroll
        for (int kt = 0; kt < 16; ++kt)
#pragma unroll
            for (int e = 0; e < 4; ++e) { const bool ok = (16 * kt + 4 * kq + e) < nvalid; const float p = ok ? __expf(s[kt][e] - mx) : 0.f; s[kt][e] = p; sum += p; }
        sum += __shfl_xor(sum, 16); sum += __shfl_xor(sum, 32);
        const float inv = 1.0f / sum;
        if (kr < 4) {
#pragma unroll
            for (int kt = 0; kt < 16; ++kt)
#pragma unroll
                for (int e = 0; e < 4; ++e) ((LAS float*)pl)[(16 * kt + 4 * kq + e) * 4 + kr] = s[kt][e] * inv; }
        LDS_WAIT(); asm volatile("" ::: "memory");
        float o[4][2];
#pragma unroll
        for (int h = 0; h < 4; ++h) { o[h][0] = 0.f; o[h][1] = 0.f; }
        const bf16* vb0 = vbuf + (size_t)(b * SEQ) * KVD + g * 128 + 2 * lane;
#pragma unroll 8
        for (int sl = 0; sl < TOPK; ++sl) { const int key = idl[sl]; const f32x4 p4 = pl[sl];
            const unsigned vv = *(const unsigned*)(vb0 + (size_t)key * KVD); const float v0 = bf_lo(vv), v1 = bf_hi(vv);
#pragma unroll
            for (int h = 0; h < 4; ++h) { o[h][0] += p4[h] * v0; o[h][1] += p4[h] * v1; } }
#pragma unroll
        for (int h = 0; h < 4; ++h) *(unsigned*)(ao + (size_t)mq * DA + (4 * g + h) * 128 + 2 * lane) = pk2(o[h][0], o[h][1]);
        LDS_WAIT(); asm volatile("" ::: "memory");
    }
}

constexpr int SC_STEPS = 32, SC_STEP_BYTES = 1344, SC_BUF_BYTES = SC_STEPS * SC_STEP_BYTES;
constexpr int SC_Y_OFF = 2 * SC_BUF_BYTES;

template <int CTRL> DI float dpp_add(float x) { return x + __builtin_bit_cast(float, __builtin_amdgcn_update_dpp(0, __builtin_bit_cast(int, x), CTRL, 0xf, 0xf, false)); }
DI float red8(float x) { x = dpp_add<0xB1>(x); x = dpp_add<0x4E>(x); x = dpp_add<0x141>(x); return x; }

DI void scan_load_chunk(const float* const* in, unsigned char* ws, LAS unsigned char* lds, int b, int h, int qr, int chunk, int lw, int lane) {
    const bf16* rb = (const bf16*)(ws + WS_RB); const bf16* kb = (const bf16*)(ws + WS_KB); const bf16* vb = (const bf16*)(ws + WS_VB);
    const float* decay = (const float*)(ws + WS_DECAY); const bf16* av = (const bf16*)(ws + WS_AOUT); float* bonus = (float*)(ws + WS_BONUS);
    const int col = h * HDB + lane;
    const float mu_r = in[I_MU_RKV][col], mu_k = in[I_MU_RKV][DB + col], mu_v = in[I_MU_RKV][2 * DB + col];
    const float kkw = in[I_KK][col], kaw = in[I_KA][col], rkw = in[I_RK][col];
    float rc[6], rp[6], kc[6], kp[6], vc[6], vp[6], dc[6], ac[6];
#pragma unroll
    for (int i = 0; i < 6; ++i) { const int s = lw + 6 * i;
        if (s < SC_STEPS) { const int t = chunk * SC_STEPS + s; const size_t o = (size_t)(b * SEQ + t) * DB + col;
            rc[i] = bf2f(rb[o]); kc[i] = bf2f(kb[o]); vc[i] = bf2f(vb[o]); dc[i] = decay[o]; ac[i] = bf2f(av[o]);
            if (t > 0) { rp[i] = bf2f(rb[o - DB]); kp[i] = bf2f(kb[o - DB]); vp[i] = bf2f(vb[o - DB]); } else { rp[i] = 0.f; kp[i] = 0.f; vp[i] = 0.f; } }
        else { rc[i] = rp[i] = kc[i] = kp[i] = vc[i] = vp[i] = dc[i] = ac[i] = 0.f; } }
#pragma unroll
    for (int i = 0; i < 6; ++i) { const int s = lw + 6 * i;
        if (s < SC_STEPS) { const int t = chunk * SC_STEPS + s;
            const float r1 = rc[i] + (rp[i] - rc[i]) * mu_r, k0 = kc[i] + (kp[i] - kc[i]) * mu_k, v1 = vc[i] + (vp[i] - vc[i]) * mu_v;
            const float kkv = k0 * kkw, nrm = sqrtf(wave_sum(kkv * kkv)), kkn = kkv / fmaxf(nrm, 1e-12f);
            const float a = ac[i], k1 = k0 * (1.0f + (a - 1.0f) * kaw);
            const float bc = wave_sum(r1 * k1 * rkw);
            LAS float* sb = (LAS float*)(lds + (chunk & 1) * SC_BUF_BYTES + s * SC_STEP_BYTES);
            sb[lane] = dc[i]; sb[64 + lane] = -kkn; sb[128 + lane] = kkn * a; sb[192 + lane] = k1; sb[256 + lane] = r1;
            if ((lane >> 4) == qr) sb[320 + (lane & 15)] = v1;
            if (qr == 0 && lane == 0) bonus[(size_t)(b * SEQ + t) * NHB + h] = bc; } }
}

DI void scan_phase(const float* const* in, unsigned char* ws, LAS unsigned char* lds, int wave, int lane) {
    float* y = (float*)(ws + WS_Y);
    constexpr int NCHUNK = SEQ / SC_STEPS;
    for (int task = blockIdx.x; task < BATCH * NHB * 4; task += gridDim.x) {
        const int bh = task >> 2, qr = task & 3, b = bh >> 5, h = bh & 31;
        const int rl = lane >> 3, cg = lane & 7;
        float st[8];
#pragma unroll
        for (int j = 0; j < 8; ++j) st[j] = 0.f;
        __syncthreads();
        if (wave >= 2) scan_load_chunk(in, ws, lds, b, h, qr, 0, wave - 2, lane);
        __syncthreads();
        for (int c = 0; c < NCHUNK; ++c) {
            if (wave < 2) {
                const LAS unsigned char* buf = lds + (c & 1) * SC_BUF_BYTES; LAS float* yb = (LAS float*)(lds + SC_Y_OFF + (c & 1) * 2048);
#pragma unroll 2
                for (int s = 0; s < SC_STEPS; ++s) { const LAS float* sb = (const LAS float*)(buf + s * SC_STEP_BYTES);
                    const f32x4 w0 = *(const LAS f32x4*)(sb + 8 * cg), w1 = *(const LAS f32x4*)(sb + 8 * cg + 4);
                    const f32x4 a0 = *(const LAS f32x4*)(sb + 64 + 8 * cg), a1 = *(const LAS f32x4*)(sb + 64 + 8 * cg + 4);
                    const f32x4 b0 = *(const LAS f32x4*)(sb + 128 + 8 * cg), b1 = *(const LAS f32x4*)(sb + 128 + 8 * cg + 4);
                    const f32x4 k0 = *(const LAS f32x4*)(sb + 192 + 8 * cg), k1 = *(const LAS f32x4*)(sb + 192 + 8 * cg + 4);
                    const f32x4 r0 = *(const LAS f32x4*)(sb + 256 + 8 * cg), r1 = *(const LAS f32x4*)(sb + 256 + 8 * cg + 4);
                    const float vi = sb[320 + 8 * wave + rl];
                    float sa = (st[0] * a0[0] + st[1] * a0[1]) + (st[2] * a0[2] + st[3] * a0[3]) + ((st[4] * a1[0] + st[5] * a1[1]) + (st[6] * a1[2] + st[7] * a1[3]));
                    sa = red8(sa);
#pragma unroll
                    for (int j = 0; j < 4; ++j) { st[j] = st[j] * w0[j] + (sa * b0[j] + vi * k0[j]); st[4 + j] = st[4 + j] * w1[j] + (sa * b1[j] + vi * k1[j]); }
                    float yv = (st[0] * r0[0] + st[1] * r0[1]) + (st[2] * r0[2] + st[3] * r0[3]) + ((st[4] * r1[0] + st[5] * r1[1]) + (st[6] * r1[2] + st[7] * r1[3]));
                    yv = red8(yv);
                    if (cg == 0) yb[s * 16 + 8 * wave + rl] = yv; }
            } else {
                if (c + 1 < NCHUNK) scan_load_chunk(in, ws, lds, b, h, qr, c + 1, wave - 2, lane);
                if (c >= 1 && wave == 2) { const LAS float* yb = (const LAS float*)(lds + SC_Y_OFF + ((c - 1) & 1) * 2048);
                    const int s = lane >> 1, hf = lane & 1, t = (c - 1) * SC_STEPS + s; float* dst = y + (size_t)(b * SEQ + t) * DB + h * HDB + 16 * qr + 8 * hf;
                    *(f32x4*)dst = *(const LAS f32x4*)(yb + s * 16 + 8 * hf); *(f32x4*)(dst + 4) = *(const LAS f32x4*)(yb + s * 16 + 8 * hf + 4); }
            }
            __syncthreads();
        }
        if (wave == 2) { const LAS float* yb = (const LAS float*)(lds + SC_Y_OFF + ((NCHUNK - 1) & 1) * 2048);
            const int s = lane >> 1, hf = lane & 1, t = (NCHUNK - 1) * SC_STEPS + s; float* dst = y + (size_t)(b * SEQ + t) * DB + h * HDB + 16 * qr + 8 * hf;
            *(f32x4*)dst = *(const LAS f32x4*)(yb + s * 16 + 8 * hf); *(f32x4*)(dst + 4) = *(const LAS f32x4*)(yb + s * 16 + 8 * hf + 4); }
    }
}

DI void gn_phase(const float* const* in, unsigned char* ws, int gw, int NGW, int lane) {
    const float* y = (const float*)(ws + WS_Y); const bf16* vb = (const bf16*)(ws + WS_VB); const bf16* gout = (const bf16*)(ws + WS_GOUT);
    const float* bonus = (const float*)(ws + WS_BONUS); bf16* ro = (bf16*)(ws + WS_AO) + (size_t)M * DB;
    for (int task = gw; task < M * NHB; task += NGW) {
        const int m = task >> 5, h = task & 31, col = h * HDB + lane; const size_t o = (size_t)m * DB + col;
        const float yv = y[o]; const float mean = wave_sum(yv) * (1.0f / 64.0f); const float d = yv - mean;
        const float var = wave_sum(d * d) * (1.0f / 64.0f);
        const float yn = d * (1.0f / sqrtf(var + GN_EPS)) * in[I_LNW][col] + in[I_LNB][col];
        const float vc = bf2f(vb[o]), vp = (m & (SEQ - 1)) ? bf2f(vb[o - DB]) : 0.f; const float v1 = vc + (vp - vc) * in[I_MU_RKV][2 * DB + col];
        const float res = (yn + bonus[(size_t)m * NHB + h] * v1) * bf2f(gout[o]);
        ro[o] = (bf16)f2bf(res);
    }
}

DI void final_phase(const float* const* in, unsigned char* ws, float* out, int gw, int NGW, int lane) {
    const float* ss3 = (const float*)(ws + SS3_OFF); const float* nf = in[I_NORM_FINAL];
    for (int m = gw; m < M; m += NGW) { const float r = 1.0f / sqrtf(ss3[m] * (1.0f / D) + RMS_EPS);
        GAS f32x4* o = (GAS f32x4*)(out + (size_t)m * D) + lane; const GAS f32x4* g = (const GAS f32x4*)nf + lane;
#pragma unroll 4
        for (int j = 0; j < 16; ++j) { f32x4 v = o[64 * j]; const f32x4 gg = g[64 * j]; v = v * r * gg; o[64 * j] = v; } }
}

#ifndef MK_N_LAUNCHES
#define MK_N_LAUNCHES 1
#endif
constexpr int N_PHASES = 13;
#ifndef PG8_SP2
#define PG8_SP2 true
#endif
#ifndef PG8_ALIGN
#define PG8_ALIGN true
#endif

__global__ void __launch_bounds__(NWAVES * 64, 2) hybrid_fwd(Args args) {
    extern __shared__ __attribute__((aligned(16))) unsigned char lds_raw[];
    LAS unsigned char* lds = (LAS unsigned char*)lds_raw;
    volatile LAS unsigned* MISC = (volatile LAS unsigned*)(lds + MISC_OFF);
    const int wave = __builtin_amdgcn_readfirstlane(threadIdx.x >> 6);
    const int G = gridDim.x, gw = blockIdx.x * NWAVES + wave, NGW = G * NWAVES;
    unsigned char* ws = args.ws; const float* const* in = args.in;
    { const int tid0 = wave * 64 + lane_opaque(); for (int u = tid0; u < (LDS_BYTES - LDSCTL_OFF) / 4; u += NWAVES * 64) ((LAS unsigned*)(lds + LDSCTL_OFF))[u] = 0u; }
    __syncthreads();
    unsigned* ctl = (unsigned*)(ws + WS_CTL);
    XcdBarrier bar; bar.bar = ctl + CW_BAR; bar.x = 0; bar.st = nullptr;
    const bool multi = (args.ph_hi - args.ph_lo) > 1;
    if (multi) bar = xcd_barrier_post(ctl + CW_BAR, MISC + 8, wave == 0 && lane_opaque() == 0);
    const int lo = args.ph_lo, hi = args.ph_hi;
#ifndef PHASE_MASK
#define PHASE_MASK 0x3fff
#endif
#define IN(k) ((((PHASE_MASK) >> (k)) & 1) && lo <= (k) && (k) < hi)
#define SEAM(k) do { if (IN(k) && IN((k) + 1)) xcd_barrier(bar, wave == 0 && lane_opaque() == 0); } while (0)
#define LANE lane_opaque()
    LAS float* scr = (LAS float*)(lds + RING_OFF + wave * 16384);

    if (IN(0)) { const int lane = LANE; convert_set_a(in, ws, scr, gw, NGW, lane); prologue_rows(in, ws, gw, NGW, lane); }
    SEAM(0);
    if (IN(1)) {
        pg8::Gemm g{(const bf16*)(ws + WS_XB), (const bf16*)(ws + WS_WCAT), M, NCAT, D}; pg8::StaticOrder S; S.init(M, NCAT, G, (int)blockIdx.x);
        epi::InProj E{(bf16*)(ws + WS_Q), (bf16*)(ws + WS_K), (bf16*)(ws + WS_V), (bf16*)(ws + WS_QI), (bf16*)(ws + WS_KI), (bf16*)(ws + WS_RB), (bf16*)(ws + WS_KB), (bf16*)(ws + WS_VB),
                      (bf16*)(ws + WS_LORA), (bf16*)(ws + WS_GATES), (float*)(ws + WS_WI), (const float*)(ws + WS_RSTDX), (const float*)(ws + WS_RCOS), (const float*)(ws + WS_RSIN)};
        pg8::gemm_phase<epi::InProj, pg8::StaticOrder, PG8_ALIGN, PG8_SP2>(lds + RING_OFF, g, S, E, wave);
    }
    SEAM(1);
    if (IN(2)) { const int lane = LANE; indexer_phase(ws, lds + RING_OFF, wave * 64 + lane, wave, lane); }
    SEAM(2);
    if (IN(3)) attn_phase(ws, lds + RING_OFF, wave, LANE);
    SEAM(3);
    if (IN(4)) build_alora(ws, blockIdx.x * (NWAVES * 64) + wave * 64 + LANE, G * NWAVES * 64);
    SEAM(4);
    if (IN(5)) {
        int k256 = 256; asm volatile("" : "+s"(k256));
        pg8::Gemm g{(const bf16*)(ws + WS_ALORA), (const bf16*)(ws + WS_WL2), 3 * M, 3 * DB, k256}; epi::Stack3Order S{G, (int)blockIdx.x};
        epi::LoraUp E{(float*)(ws + WS_DECAY), (bf16*)(ws + WS_AOUT), (bf16*)(ws + WS_GOUT), in[I_W0], in[I_A0]};
        pg8::gemm_phase<epi::LoraUp, epi::Stack3Order, PG8_ALIGN, PG8_SP2>(lds + RING_OFF, g, S, E, wave);
    }
    SEAM(5);
    if (IN(6)) scan_phase(in, ws, lds + RING_OFF, wave, LANE);
    SEAM(6);
    if (IN(7)) { const int lane = LANE; gn_phase(in, ws, gw, NGW, lane); __syncthreads(); convert_set_b(in, ws, scr, gw, NGW, lane); }
    SEAM(7);
    if (IN(8)) {
        pg8::Gemm g{(const bf16*)(ws + WS_AO), (const bf16*)(ws + WS_WPAB), 2 * M, 2 * D, DA}; epi::ChainOrder S; S.so.init(M, D, G, (int)blockIdx.x);
        epi::GateMix E{(const bf16*)(ws + WS_GATES), in[I_BGATE], (bf16*)(ws + WS_MIX)};
        pg8::gemm_phase<epi::GateMix, epi::ChainOrder, PG8_ALIGN, PG8_SP2>(lds + RING_OFF, g, S, E, wave);
    }
    SEAM(8);
    if (IN(9)) {
        pg8::Gemm g{(const bf16*)(ws + WS_MIX), (const bf16*)(ws + WS_WO), M, D, D}; pg8::StaticOrder S; S.init(M, D, G, (int)blockIdx.x);
        epi::Resid E{in[I_X], args.out, (bf16*)(ws + WS_H1B), (float*)(ws + SS1_OFF)};
        pg8::gemm_phase<epi::Resid, pg8::StaticOrder, PG8_ALIGN, PG8_SP2>(lds + RING_OFF, g, S, E, wave);
    }
    SEAM(9);
    if (IN(10)) {
        pg8::Gemm g{(const bf16*)(ws + WS_H1B), (const bf16*)(ws + WS_W13), M, N13, D}; pg8::StaticOrder S; S.init(M, N13, G, (int)blockIdx.x);
        epi::FfnUp E{(const float*)(ws + SS1_OFF), (bf16*)(ws + WS_U)};
        pg8::gemm_phase<epi::FfnUp, pg8::StaticOrder, PG8_ALIGN, PG8_SP2>(lds + RING_OFF, g, S, E, wave);
    }
    SEAM(10);
    if (IN(11)) {
        { pg8::Gemm g{(const bf16*)(ws + WS_U), (const bf16*)(ws + WS_W2), M, D, DFF}; pg8::StaticOrder S; S.init(M, D, G, (int)blockIdx.x);
          epi::Resid E{args.out, args.out, (bf16*)(ws + WS_H2B), (float*)(ws + SS2_OFF)};
          pg8::gemm_phase<epi::Resid, pg8::StaticOrder, PG8_ALIGN, PG8_SP2>(lds + RING_OFF, g, S, E, wave); }
        { int k256 = 256; asm volatile("" : "+s"(k256));
          pg8::Gemm g{(const bf16*)(ws + WS_PB), (const bf16*)(ws + WS_WPLE), M, D, k256}; pg8::StaticOrder S; S.init(M, D, G, (int)blockIdx.x);
          epi::StoreBf E{(bf16*)(ws + WS_PP), D};
          pg8::gemm_phase<epi::StoreBf, pg8::StaticOrder, PG8_ALIGN, PG8_SP2>(lds + RING_OFF, g, S, E, wave); }
    }
    SEAM(11);
    if (IN(12)) {
        pg8::Gemm g{(const bf16*)(ws + WS_H2B), (const bf16*)(ws + WS_WPG), M, D, D}; pg8::StaticOrder S; S.init(M, D, G, (int)blockIdx.x);
        epi::PleGate E{args.out, (const bf16*)(ws + WS_PP), (const float*)(ws + SS2_OFF), (float*)(ws + SS3_OFF)};
        pg8::gemm_phase<epi::PleGate, pg8::StaticOrder, PG8_ALIGN, PG8_SP2>(lds + RING_OFF, g, S, E, wave);
    }
    SEAM(12);
    if (IN(13)) final_phase(in, ws, args.out, gw, NGW, LANE);
#undef IN
#undef SEAM
#undef LANE
}

extern "C" void kernel_launch(void* const* d_in, const int* in_sizes, int n_in, void* d_out, int out_size, void* d_ws, size_t ws_size, hipStream_t stream) {
    static int grid = 0;
    if (grid == 0) {
        if (n_in != 32 || in_sizes[0] != M * D || out_size != M * D || ws_size < WS_END) { fprintf(stderr, "kernel_launch: unexpected shapes: n_in %d in0 %d out %d ws %zu (need %zu)\n", n_in, n_in > 0 ? in_sizes[0] : -1, out_size, ws_size, (size_t)WS_END); grid = -1; return; }
        int dev = 0, cus = 0, per_cu = 0;
        if (hipGetDevice(&dev) != hipSuccess || hipDeviceGetAttribute(&cus, hipDeviceAttributeMultiprocessorCount, dev) != hipSuccess) { grid = -1; return; }
        if (hipFuncSetAttribute((const void*)hybrid_fwd, hipFuncAttributeMaxDynamicSharedMemorySize, LDS_BYTES) != hipSuccess) { fprintf(stderr, "kernel_launch: hipFuncSetAttribute failed\n"); grid = -1; return; }
        if (hipOccupancyMaxActiveBlocksPerMultiprocessor(&per_cu, (const void*)hybrid_fwd, NWAVES * 64, LDS_BYTES) != hipSuccess || per_cu < 1) fprintf(stderr, "kernel_launch: occupancy query says %d\n", per_cu);
        (void)hipGetLastError();
        grid = cus;
    }
    if (grid < 0) return;
    if (hipMemsetAsync((char*)d_ws + WS_CTL, 0, CTL_ZERO_BYTES, stream) != hipSuccess) return;
    Args a{};
    for (int i = 0; i < 32; ++i) a.in[i] = (const float*)d_in[i];
    a.out = (float*)d_out; a.ws = (unsigned char*)d_ws;
#if MK_N_LAUNCHES == 1
    a.ph_lo = 0; a.ph_hi = N_PHASES + 1;
    hipLaunchKernelGGL(hybrid_fwd, dim3(grid), dim3(NWAVES * 64), LDS_BYTES, stream, a);
#else
    for (int p = 0; p <= N_PHASES; ++p) { a.ph_lo = p; a.ph_hi = p + 1; hipLaunchKernelGGL(hybrid_fwd, dim3(grid), dim3(NWAVES * 64), LDS_BYTES, stream, a); }
#endif
}
```

```cpp
#include <hip/hip_runtime.h>
#include <cstdio>
#include <cstdint>
__device__ __forceinline__ int lane_opaque() { int l; asm volatile("v_mbcnt_lo_u32_b32 %0, -1, 0\n\tv_mbcnt_hi_u32_b32 %0, -1, %0" : "=v"(l)); return l; }

namespace pg8 {
#define PG8_LAS __attribute__((address_space(3)))
typedef unsigned short bf16_t;
typedef short bf16x8 __attribute__((ext_vector_type(8)));
typedef float f32x4 __attribute__((ext_vector_type(4)));
typedef unsigned u32x4 __attribute__((ext_vector_type(4)));
constexpr int BM = 256, BK = 64, HALF = 128, HTB = HALF * BK * 2  , STAGE_BYTES = 8 * HTB, NXCD = 8, WGM = 8;

__host__ __device__ __forceinline__ int lds_byte(int r, int c) { const int st = (r >> 4) * 2 + (c >> 5), rr = r & 15, cc = c & 31, ob = rr * 64 + cc * 2; return st * 1024 + (ob ^ (((ob >> 9) & 1) << 5)); }
__host__ __device__ __forceinline__ void stage_rc(int b, int& R, int& C) { const int st = b / 1024, sb = b % 1024, swz = sb ^ (((sb >> 9) & 1) << 5); R = (st >> 1) * 16 + swz / 64; C = (st & 1) * 32 + (swz % 64) / 2; }
__host__ __device__ __forceinline__ int perm32(int rho) { const int n = rho >> 4, i = rho & 15; return 8 * (i >> 2) + 4 * n + (i & 3); }

struct Unit { int pm, pn; };
struct Gemm { const bf16_t* A; const bf16_t* Bt; int M, N, K; };

struct StaticOrder {
    int nM, nN, nwg, G, c;
    __host__ __device__ void init(int M, int N, int G_, int c_) { nM = M / BM; nN = N / BM; nwg = nM * nN; G = G_; c = c_; }
    __host__ __device__ bool next(int i, Unit& u) const {
        const long L = (long)i * G + c; if (L >= nwg) return false;
        int wgid = (int)L; { const int q = nwg / NXCD, r = nwg % NXCD, xcd = wgid % NXCD, off = wgid / NXCD; wgid = (xcd < r ? xcd * (q + 1) : r * (q + 1) + (xcd - r) * q) + off; }
        const int nig = WGM * nN, gid = wgid / nig, fm = gid * WGM, gsz = (nM - fm) < WGM ? (nM - fm) : WGM;
        u.pm = fm + ((wgid % nig) % gsz); u.pn = (wgid % nig) / gsz; return true;
    }
    __device__ __forceinline__ void a_ready(const Unit&) const {}
    __device__ __forceinline__ void done(const Unit&) const {}
};
__device__ __forceinline__ unsigned cvt_pk_bf16(float lo, float hi) { unsigned r; asm volatile("v_cvt_pk_bf16_f32 %0, %1, %2" : "=v"(r) : "v"(lo), "v"(hi)); return r; }
template <class Epi, class Sched, bool ALIGN_EPI = false, bool SP2 = false>
__device__ __forceinline__ void gemm_phase(PG8_LAS unsigned char* lds, const Gemm g, const Sched& S, const Epi& E, const int wid) {
    const int lane = lane_opaque(), tid = wid * 64 + lane, wr = wid >> 2, wc = wid & 3, fr = lane & 15, fq = lane >> 4;
    const int K = g.K, nt = K / BK;
    unsigned voffA[2], voffB[2];
#pragma unroll
    for (int i = 0; i < 2; ++i) { int R, C; stage_rc(tid * 16 + i * 8192, R, C); const int Rb = Epi::PERM ? ((R & ~31) + perm32(R & 31)) : R;
        voffA[i] = (unsigned)(R * K + C) * 2u; voffB[i] = (unsigned)(Rb * K + C) * 2u; }
    const size_t kstep = (size_t)(BK * 2);
    const size_t hstep = (size_t)HALF * K * 2;
    const size_t tstep = 2 * hstep;
    const unsigned ldsw = (unsigned)wid * 1024u;
    const int aoff = lds_byte(wr * 64 + fr, fq * 8), boff = lds_byte(wc * 32 + fr, fq * 8);
#define PG8_SA(b, h) (((b) * 2 + (h)) * HTB)
#define PG8_SB(b, h) ((4 + (b) * 2 + (h)) * HTB)
#define PG8_STAGE(bufoff, gbase, voff) do { _Pragma("unroll") for (int _i = 0; _i < 2; ++_i) \
        __builtin_amdgcn_global_load_lds((const unsigned*)((const char*)(gbase) + (voff)[_i]), (PG8_LAS unsigned*)(lds + (bufoff) + ldsw + _i * 8192), 16, 0, 0); } while (0)
#define PG8_LDA(dst, b, h) do { _Pragma("unroll") for (int m = 0; m < 4; ++m) _Pragma("unroll") for (int k = 0; k < 2; ++k) dst[m][k] = *(const PG8_LAS bf16x8*)(lds + PG8_SA(b, h) + aoff + m * 2048 + k * 1024); } while (0)
#define PG8_LDB(dst, b, h) do { _Pragma("unroll") for (int n = 0; n < 2; ++n) _Pragma("unroll") for (int k = 0; k < 2; ++k) dst[n][k] = *(const PG8_LAS bf16x8*)(lds + PG8_SB(b, h) + boff + n * 2048 + k * 1024); } while (0)
#define PG8_MMA(ai, bj, At, Bt) do { __builtin_amdgcn_s_setprio(1); _Pragma("unroll") for (int m = 0; m < 4; ++m) _Pragma("unroll") for (int n = 0; n < 2; ++n) _Pragma("unroll") for (int k = 0; k < 2; ++k) \
        acc[ai][bj][m][n] = __builtin_amdgcn_mfma_f32_16x16x32_bf16(Bt[n][k], At[m][k], acc[ai][bj][m][n], 0, 0, 0); __builtin_amdgcn_s_setprio(0); } while (0)
#define PG8_WAIT_V(n) asm volatile("s_waitcnt vmcnt(" #n ")" ::: "memory")
#define PG8_WAIT_L(n) asm volatile("s_waitcnt lgkmcnt(" #n ")" ::: "memory")
#define PG8_BAR __builtin_amdgcn_s_barrier()
#define PG8_SCHED __builtin_amdgcn_sched_barrier(0)
    Unit cur, nxt; int ui = 0;
    if (!S.next(0, cur)) return;
    f32x4 acc[2][2][4][2];
#pragma unroll
    for (int a = 0; a < 2; ++a)
#pragma unroll
        for (int b = 0; b < 2; ++b)
#pragma unroll
            for (int m = 0; m < 4; ++m)
#pragma unroll
                for (int n = 0; n < 2; ++n) acc[a][b][m][n] = (f32x4){0.f, 0.f, 0.f, 0.f};
    bf16x8 At[4][2], B0[2][2], B1[2][2];
    const char* cA = (const char*)g.A + (size_t)cur.pm * tstep; const char* cB = (const char*)g.Bt + (size_t)cur.pn * tstep;
    S.a_ready(cur);
    if constexpr (SP2) {
        PG8_STAGE(PG8_SB(0, 0), cB, voffB); PG8_STAGE(PG8_SB(0, 1), cB + hstep, voffB); PG8_STAGE(PG8_SA(0, 0), cA, voffA); PG8_STAGE(PG8_SA(0, 1), cA + hstep, voffA);
        if (wr == 1) PG8_BAR;
        PG8_WAIT_V(2); PG8_BAR;
        PG8_STAGE(PG8_SB(1, 0), cB + kstep, voffB); PG8_STAGE(PG8_SA(1, 0), cA + kstep, voffA); PG8_STAGE(PG8_SB(1, 1), cB + hstep + kstep, voffB);
        PG8_WAIT_V(6); PG8_BAR;
    } else {
        PG8_STAGE(PG8_SB(0, 0), cB, voffB); PG8_STAGE(PG8_SA(0, 0), cA, voffA); PG8_STAGE(PG8_SB(0, 1), cB + hstep, voffB); PG8_STAGE(PG8_SA(0, 1), cA + hstep, voffA);
        if (wr == 1) PG8_BAR;
        PG8_WAIT_V(4); PG8_BAR;
        PG8_STAGE(PG8_SB(1, 0), cB + kstep, voffB); PG8_STAGE(PG8_SA(1, 0), cA + kstep, voffA); PG8_STAGE(PG8_SB(1, 1), cB + hstep + kstep, voffB);
        PG8_WAIT_V(6); PG8_BAR;
    }
    for (;;) {
        const bool has_next = S.next(ui + 1, nxt);
        const char* nA = has_next ? (const char*)g.A + (size_t)nxt.pm * tstep : cA; const char* nB = has_next ? (const char*)g.Bt + (size_t)nxt.pn * tstep : cB;
        for (int t = 0; t < nt; t += 2) {
            const bool last = (t == nt - 2);
            const char* a1 = cA + (size_t)(t + 1) * kstep;
            const char* a2 = last ? nA : cA + (size_t)(t + 2) * kstep; const char* b2 = last ? nB : cB + (size_t)(t + 2) * kstep;
            const char* a3 = a2 + kstep; const char* b3 = b2 + kstep;
            if (last && has_next) S.a_ready(nxt);
            if constexpr (SP2) {
            PG8_LDB(B0, 0, 0); PG8_LDB(B1, 0, 1); PG8_SCHED; PG8_LDA(At, 0, 0); PG8_STAGE(PG8_SA(1, 1), a1 + hstep, voffA);
            PG8_WAIT_V(8); PG8_WAIT_L(0); PG8_BAR; PG8_MMA(0, 0, At, B0); PG8_MMA(0, 1, At, B1); PG8_BAR; PG8_SCHED;
            PG8_LDA(At, 0, 1); PG8_STAGE(PG8_SB(0, 0), b2, voffB); PG8_STAGE(PG8_SB(0, 1), b2 + hstep, voffB); PG8_STAGE(PG8_SA(0, 0), a2, voffA);
            PG8_WAIT_V(8); PG8_WAIT_L(0); PG8_BAR; PG8_MMA(1, 0, At, B0); PG8_MMA(1, 1, At, B1); PG8_BAR; PG8_SCHED;
            PG8_LDB(B0, 1, 0); PG8_LDB(B1, 1, 1); PG8_SCHED; PG8_LDA(At, 1, 0); PG8_STAGE(PG8_SA(0, 1), a2 + hstep, voffA);
            PG8_WAIT_V(8); PG8_WAIT_L(0); PG8_BAR; PG8_MMA(0, 0, At, B0); PG8_MMA(0, 1, At, B1); PG8_BAR; PG8_SCHED;
            PG8_LDA(At, 1, 1); PG8_STAGE(PG8_SB(1, 0), b3, voffB); PG8_STAGE(PG8_SB(1, 1), b3 + hstep, voffB); PG8_STAGE(PG8_SA(1, 0), a3, voffA);
            PG8_WAIT_V(8); PG8_WAIT_L(0); PG8_BAR; PG8_MMA(1, 0, At, B0); PG8_MMA(1, 1, At, B1); PG8_BAR; PG8_SCHED;
            } else {
            PG8_LDB(B0, 0, 0); PG8_SCHED; PG8_LDA(At, 0, 0); PG8_STAGE(PG8_SA(1, 1), a1 + hstep, voffA);
            PG8_WAIT_L(8); PG8_BAR; PG8_WAIT_L(0); PG8_MMA(0, 0, At, B0); PG8_BAR; PG8_SCHED;
            PG8_LDB(B1, 0, 1); PG8_STAGE(PG8_SB(0, 0), b2, voffB);
            PG8_BAR; PG8_WAIT_L(0); PG8_MMA(0, 1, At, B1); PG8_BAR;
            PG8_LDA(At, 0, 1); PG8_STAGE(PG8_SA(0, 0), a2, voffA);
            PG8_BAR; PG8_WAIT_L(0); PG8_MMA(1, 0, At, B0); PG8_BAR; PG8_SCHED;
            PG8_STAGE(PG8_SB(0, 1), b2 + hstep, voffB);
            PG8_WAIT_V(6); PG8_BAR; PG8_MMA(1, 1, At, B1); PG8_BAR;
            PG8_LDB(B0, 1, 0); PG8_SCHED; PG8_LDA(At, 1, 0); PG8_STAGE(PG8_SA(0, 1), a2 + hstep, voffA);
            PG8_WAIT_L(8); PG8_BAR; PG8_WAIT_L(0); PG8_MMA(0, 0, At, B0); PG8_BAR; PG8_SCHED;
            PG8_LDB(B1, 1, 1); PG8_STAGE(PG8_SB(1, 0), b3, voffB);
            PG8_BAR; PG8_WAIT_L(0); PG8_MMA(0, 1, At, B1); PG8_BAR;
            PG8_LDA(At, 1, 1); PG8_STAGE(PG8_SA(1, 0), a3, voffA);
            PG8_BAR; PG8_WAIT_L(0); PG8_MMA(1, 0, At, B0); PG8_BAR; PG8_SCHED;
            PG8_STAGE(PG8_SB(1, 1), b3 + hstep, voffB);
            PG8_WAIT_V(6); PG8_BAR; PG8_MMA(1, 1, At, B1); PG8_BAR;
            }
        }
        if constexpr (ALIGN_EPI) { if (wr == 0) PG8_BAR; }
        if constexpr (!Epi::AFTER_DRAIN) { E(acc, cur, wr, wc, fr, fq); S.done(cur); }
        if (!has_next) break;
        if (!Epi::CHAIN || !E.keep(cur)) {
#pragma unroll
        for (int a = 0; a < 2; ++a)
#pragma unroll
            for (int b = 0; b < 2; ++b)
#pragma unroll
                for (int m = 0; m < 4; ++m)
#pragma unroll
                    for (int n = 0; n < 2; ++n) acc[a][b][m][n] = (f32x4){0.f, 0.f, 0.f, 0.f};
        }
        cur = nxt; cA = nA; cB = nB; ++ui;
        if constexpr (ALIGN_EPI) { if (wr == 1) PG8_BAR; }
    }
    PG8_WAIT_V(0);
    if constexpr (!ALIGN_EPI) { if (wr == 0) PG8_BAR; }
    PG8_BAR;
    if constexpr (Epi::AFTER_DRAIN) { E.fused(acc, cur, wr, wc, fr, fq, lds, wid, lane); S.done(cur); }
#undef PG8_SA
#undef PG8_SB
#undef PG8_STAGE
#undef PG8_LDA
#undef PG8_LDB
#undef PG8_MMA
#undef PG8_WAIT_V
#undef PG8_WAIT_L
#undef PG8_BAR
#undef PG8_SCHED
}
}

#define LAS __attribute__((address_space(3)))
#define XB_TMO      128
#define XB_XCNT(j)  (256  + 64 * (j))
#define XB_XSUB(j)  (1280 + 64 * (j))
#define XB_XGEN(j)  (2304 + 64 * (j))
#define XB_TOP      3328
#define XB_TOPGEN   3392
#define XCD_BAR_WORDS 3456
#define XB_SPIN_CAP (1u << 18)

__device__ __forceinline__ unsigned xb_ld(unsigned* p)              { return __hip_atomic_load(p, __ATOMIC_RELAXED, __HIP_MEMORY_SCOPE_AGENT); }
__device__ __forceinline__ unsigned xb_add(unsigned* p, unsigned v) { return __hip_atomic_fetch_add(p, v, __ATOMIC_RELAXED, __HIP_MEMORY_SCOPE_AGENT); }
__device__ __forceinline__ unsigned xb_xcc_id() { return (unsigned)__builtin_amdgcn_s_getreg((3 << 11) | 20) & 0xFu; }
#define XB_SPIN(cond, bar) do { unsigned _sp = 0; while (cond) { __builtin_amdgcn_s_sleep(1); \
    if ((++_sp & 255u) == 0u) { if (xb_ld(&(bar)[XB_TMO])) break; if (_sp > XB_SPIN_CAP) { atomicAdd(&(bar)[XB_TMO], 1u); break; } } } } while (0)

struct XcdBarrier {
    unsigned* bar; unsigned x;
    volatile LAS unsigned* st;
};

__device__ __forceinline__ XcdBarrier xcd_barrier_post(unsigned* bar, volatile LAS unsigned* st, const bool leader  ) {
    XcdBarrier b; b.bar = bar; b.x = xb_xcc_id(); b.st = st;
    if (leader) (void)xb_add(&bar[XB_XCNT(b.x)], 1u);
    return b;
}
__device__ __forceinline__ void xcd_barrier_complete(unsigned* bar, unsigned x, unsigned& nloc, unsigned& nx) {
    const unsigned G = gridDim.x * gridDim.y * gridDim.z;
    unsigned sum, cnt, mine, sp = 0u;
    for (;;) {
        sum = 0u; cnt = 0u; mine = 0u;
#pragma unroll
        for (unsigned j = 0; j < 16; ++j) { const unsigned c = xb_ld(&bar[XB_XCNT(j)]); sum += c; cnt += (c > 0u) ? 1u : 0u; mine = (j == x) ? c : mine; }
        if (sum == G) break;
        __builtin_amdgcn_s_sleep(1);
        if ((++sp & 255u) == 0u) { if (xb_ld(&bar[XB_TMO])) break; if (sp > XB_SPIN_CAP) { atomicAdd(&bar[XB_TMO], 1u); break; } }
    }
    nloc = mine > 0u ? mine : 1u; nx = cnt > 0u ? cnt : 1u;
}

__device__ __forceinline__ void xcd_barrier(const XcdBarrier& b, const bool leader  ) {
    asm volatile("s_waitcnt vmcnt(0)" ::: "memory");
    __syncthreads();
    if (leader) {
        unsigned* bar = b.bar;
        __builtin_amdgcn_s_waitcnt(0);
        unsigned nloc = b.st[0], nx = b.st[1];
        if (nloc == 0u) { xcd_barrier_complete(bar, b.x, nloc, nx); b.st[0] = nloc; b.st[1] = nx; }
        const unsigned old = xb_add(&bar[XB_XSUB(b.x)], 1u);
        const unsigned gen = old / nloc;
        if (old + 1u == (gen + 1u) * nloc) {
            __builtin_amdgcn_fence(__ATOMIC_RELEASE, "agent");
            asm volatile("s_waitcnt vmcnt(0)" ::: "memory");
            const unsigned og = xb_add(&bar[XB_TOP], 1u);
            const unsigned tg = og / nx;
            if (og + 1u == (tg + 1u) * nx) xb_add(&bar[XB_TOPGEN], 1u);
            else XB_SPIN(xb_ld(&bar[XB_TOPGEN]) == tg, bar);
            __builtin_amdgcn_fence(__ATOMIC_ACQUIRE, "agent");
            xb_add(&bar[XB_XGEN(b.x)], 1u);
            asm volatile("s_waitcnt vmcnt(0)" ::: "memory");
        } else {
            XB_SPIN(xb_ld(&bar[XB_XGEN(b.x)]) == gen, bar);
            __builtin_amdgcn_fence(__ATOMIC_ACQUIRE, "agent");
            asm volatile("s_waitcnt vmcnt(0)" ::: "memory");
        }
    }
    __syncthreads();
}

constexpr int BATCH = 2, SEQ = 8192, M = BATCH * SEQ, D = 4096;
constexpr int DA = 2048, KVD = 512, DIQ = 2048, HDI = 128, NHI = 16, DB = 2048, NHB = 32, HDB = 64;
constexpr int DIN = 11408, DFF = 11008, DPLE = 256, TOPK = 256;
constexpr int NCAT = 81 * 256;
constexpr int N13 = 2 * DFF;
constexpr int LORA_LD = 1024;
constexpr float RMS_EPS = 1e-6f, GN_EPS = 64e-5f;

#define GAS __attribute__((address_space(1)))
typedef unsigned short bf16;
typedef unsigned v4u __attribute__((ext_vector_type(4)));
typedef unsigned v2u __attribute__((ext_vector_type(2)));
typedef float f32x4 __attribute__((ext_vector_type(4)));
typedef float f32x16 __attribute__((ext_vector_type(16)));
typedef float f32x2 __attribute__((ext_vector_type(2)));
typedef short bf16x8 __attribute__((ext_vector_type(8)));
typedef GAS unsigned gu32;
#define RLX_AGENT __ATOMIC_RELAXED, __HIP_MEMORY_SCOPE_AGENT
#define LDS_WAIT() asm volatile("s_waitcnt lgkmcnt(0)" ::: "memory")
#define VM_WAIT() asm volatile("s_waitcnt vmcnt(0)" ::: "memory")
#define DI __device__ __forceinline__

DI unsigned f2bf(float f) { unsigned u = __builtin_bit_cast(unsigned, f); return (u + 0x7fffu + ((u >> 16) & 1u)) >> 16; }
DI unsigned pk2(float lo, float hi) { return f2bf(lo) | (f2bf(hi) << 16); }
DI float bf_lo(unsigned w) { return __builtin_bit_cast(float, w << 16); }
DI float bf_hi(unsigned w) { return __builtin_bit_cast(float, w & 0xffff0000u); }
DI float bf2f(bf16 h) { return __builtin_bit_cast(float, ((unsigned)h) << 16); }
DI float sigmoidf_(float z) { return 1.0f / (1.0f + __expf(-z)); }
DI float wave_sum(float v) {
#pragma unroll
    for (int o = 1; o < 64; o <<= 1) v += __shfl_xor(v, o);
    return v;
}

namespace epi {
using pg8::Unit; using pg8::BM; using pg8::HALF; using pg8::cvt_pk_bf16;
typedef pg8::f32x4 f4;
DI v4u pack8(const f4& a, const f4& b) { v4u w; w.x = cvt_pk_bf16(a[0], a[1]); w.y = cvt_pk_bf16(a[2], a[3]); w.z = cvt_pk_bf16(b[0], b[1]); w.w = cvt_pk_bf16(b[2], b[3]); return w; }
DI void unpack8(const v4u& w, f4& a, f4& b) { a[0] = bf_lo(w.x); a[1] = bf_hi(w.x); a[2] = bf_lo(w.y); a[3] = bf_hi(w.y); b[0] = bf_lo(w.z); b[1] = bf_hi(w.z); b[2] = bf_lo(w.w); b[3] = bf_hi(w.w); }

struct InProj {
    static constexpr bool PERM = true, AFTER_DRAIN = false, CHAIN = false;
    bf16 *q, *k, *v, *qi, *ki, *rb, *kb, *vb, *lora, *gates; float* wi;
    const float *rstd, *rcos, *rsin;
    DI bool keep(const Unit&) const { return false; }
    DI void operator()(f4 (&acc)[2][2][4][2], const Unit& u, int wr, int wc, int fr, int fq) const {
        { const int ln_ = lane_opaque(); fr = ln_ & 15; fq = ln_ >> 4; }
        const int pn = u.pn, row0 = u.pm * BM + wr * 64 + fr;
        int kind = 0, ld, cb; bf16* dst;
        if (pn < 8)       { kind = 1; dst = q;  ld = DA;  cb = pn * 256; }
        else if (pn < 10) { kind = 1; dst = k;  ld = KVD; cb = (pn - 8) * 256; }
        else if (pn < 12) { dst = v;  ld = KVD; cb = (pn - 10) * 256; }
        else if (pn < 20) { kind = 1; dst = qi; ld = DIQ; cb = (pn - 12) * 256; }
        else if (pn == 20){ kind = 2; dst = ki; ld = HDI; cb = 0; }
        else if (pn < 29) { dst = rb; ld = DB; cb = (pn - 21) * 256; }
        else if (pn < 37) { dst = kb; ld = DB; cb = (pn - 29) * 256; }
        else if (pn < 45) { dst = vb; ld = DB; cb = (pn - 37) * 256; }
        else if (pn < 49) { dst = lora; ld = LORA_LD; cb = (pn - 45) * 256; }
        else              { dst = gates; ld = 2 * D; cb = (pn - 49) * 256; }
        if (kind == 0) {
#pragma unroll
            for (int ai = 0; ai < 2; ++ai)
#pragma unroll
                for (int m = 0; m < 4; ++m) { const int row = row0 + ai * HALF + m * 16; const float rs = rstd[row];
#pragma unroll
                    for (int bj = 0; bj < 2; ++bj) *(v4u*)(dst + (size_t)row * ld + cb + bj * HALF + wc * 32 + 8 * fq) = pack8(acc[ai][bj][m][0] * rs, acc[ai][bj][m][1] * rs); }
        } else if (kind == 1 || wc < 2) {
            const int hb = cb + (wc >> 1) * 128, dd0 = (wc & 1) * 32 + 8 * fq;
#pragma unroll
            for (int ai = 0; ai < 2; ++ai)
#pragma unroll
                for (int m = 0; m < 4; ++m) { const int row = row0 + ai * HALF + m * 16; const float rs = rstd[row];
                    const f4 c0 = *(const f4*)(rcos + (size_t)row * 64 + dd0), c1 = *(const f4*)(rcos + (size_t)row * 64 + dd0 + 4);
                    const f4 s0 = *(const f4*)(rsin + (size_t)row * 64 + dd0), s1 = *(const f4*)(rsin + (size_t)row * 64 + dd0 + 4);
                    const f4 a0 = acc[ai][0][m][0] * rs, a1 = acc[ai][0][m][1] * rs, b0 = acc[ai][1][m][0] * rs, b1 = acc[ai][1][m][1] * rs;
                    bf16* p = dst + (size_t)row * ld + hb + dd0;
                    *(v4u*)(p)      = pack8(a0 * c0 - b0 * s0, a1 * c1 - b1 * s1);
                    *(v4u*)(p + 64) = pack8(a0 * s0 + b0 * c0, a1 * s1 + b1 * c1); }
        } else if (wc == 2 && fq < 2) {
#pragma unroll
            for (int ai = 0; ai < 2; ++ai)
#pragma unroll
                for (int m = 0; m < 4; ++m) { const int row = row0 + ai * HALF + m * 16; const float rs = rstd[row] * 0.25f;
                    *(f4*)(wi + (size_t)row * 16 + 8 * fq) = acc[ai][0][m][0] * rs; *(f4*)(wi + (size_t)row * 16 + 8 * fq + 4) = acc[ai][0][m][1] * rs; }
        }
    }
};

struct LoraUp {
    static constexpr bool PERM = true, AFTER_DRAIN = false, CHAIN = false;
    float* decay; bf16 *aout, *gout; const float *w0, *a0;
    DI bool keep(const Unit&) const { return false; }
    DI void operator()(f4 (&acc)[2][2][4][2], const Unit& u, int wr, int wc, int fr, int fq) const {
        { const int ln_ = lane_opaque(); fr = ln_ & 15; fq = ln_ >> 4; }
        const int which = u.pm >> 6, row0 = (u.pm & 63) * BM + wr * 64 + fr, col0 = (u.pn & 7) * BM + wc * 32 + 8 * fq;
        if (which == 0) {
#pragma unroll
            for (int bj = 0; bj < 2; ++bj) { const int col = col0 + bj * HALF; const f4 z0 = *(const f4*)(w0 + col), z1 = *(const f4*)(w0 + col + 4);
#pragma unroll
                for (int ai = 0; ai < 2; ++ai)
#pragma unroll
                    for (int m = 0; m < 4; ++m) { const size_t off = (size_t)(row0 + ai * HALF + m * 16) * DB + col;
                        f4 x0 = acc[ai][bj][m][0] + z0, x1 = acc[ai][bj][m][1] + z1;
#pragma unroll
                        for (int e = 0; e < 4; ++e) { x0[e] = __expf(-0.6065306597126334f * sigmoidf_(x0[e])); x1[e] = __expf(-0.6065306597126334f * sigmoidf_(x1[e])); }
                        *(f4*)(decay + off) = x0; *(f4*)(decay + off + 4) = x1;
                        asm volatile("" ::: "memory"); } }
        } else if (which == 1) {
#pragma unroll
            for (int bj = 0; bj < 2; ++bj) { const int col = col0 + bj * HALF; const f4 z0 = *(const f4*)(a0 + col), z1 = *(const f4*)(a0 + col + 4);
#pragma unroll
                for (int ai = 0; ai < 2; ++ai)
#pragma unroll
                    for (int m = 0; m < 4; ++m) { const size_t off = (size_t)(row0 + ai * HALF + m * 16) * DB + col;
                        f4 x0 = acc[ai][bj][m][0] + z0, x1 = acc[ai][bj][m][1] + z1;
#pragma unroll
                        for (int e = 0; e < 4; ++e) { x0[e] = sigmoidf_(x0[e]); x1[e] = sigmoidf_(x1[e]); }
                        *(v4u*)(aout + off) = pack8(x0, x1);
                        asm volatile("" ::: "memory"); } }
        } else {
#pragma unroll
            for (int bj = 0; bj < 2; ++bj)
#pragma unroll
                for (int ai = 0; ai < 2; ++ai)
#pragma unroll
                    for (int m = 0; m < 4; ++m) *(v4u*)(gout + (size_t)(row0 + ai * HALF + m * 16) * DB + col0 + bj * HALF) = pack8(acc[ai][bj][m][0], acc[ai][bj][m][1]);
        }
    }
};

struct GateMix {
    static constexpr bool PERM = true, AFTER_DRAIN = false, CHAIN = true;
    const bf16* gates; const float* bgate; bf16* mout;
    DI bool keep(const Unit& u) const { return u.pm < 64; }
    DI void operator()(f4 (&acc)[2][2][4][2], const Unit& u, int wr, int wc, int fr, int fq) const {
        { const int ln_ = lane_opaque(); fr = ln_ & 15; fq = ln_ >> 4; }
        const int which = u.pm >> 6, row0 = (u.pm & 63) * BM + wr * 64 + fr, col0 = (u.pn & 15) * BM + wc * 32 + 8 * fq;
#pragma unroll
        for (int bj = 0; bj < 2; ++bj) { const int col = col0 + bj * HALF;
            const f4 ba0 = *(const f4*)(bgate + col), ba1 = *(const f4*)(bgate + col + 4), bb0 = *(const f4*)(bgate + D + col), bb1 = *(const f4*)(bgate + D + col + 4);
#pragma unroll
            for (int ai = 0; ai < 2; ++ai)
#pragma unroll
                for (int m = 0; m < 4; ++m) { const int row = row0 + ai * HALF + m * 16;
                    f4 zb0, zb1; unpack8(*(const v4u*)(gates + (size_t)row * (2 * D) + D + col), zb0, zb1); zb0 += bb0; zb1 += bb1;
                    if (which == 0) {
                        f4 za0, za1; unpack8(*(const v4u*)(gates + (size_t)row * (2 * D) + col), za0, za1); za0 += ba0; za1 += ba1;
#pragma unroll
                        for (int e = 0; e < 4; ++e) {
                            acc[ai][bj][m][0][e] *= (1.0f + __expf(-zb0[e])) / (1.0f + __expf(-za0[e]));
                            acc[ai][bj][m][1][e] *= (1.0f + __expf(-zb1[e])) / (1.0f + __expf(-za1[e])); }
                    } else {
                        f4 o0, o1;
#pragma unroll
                        for (int e = 0; e < 4; ++e) { o0[e] = acc[ai][bj][m][0][e] * sigmoidf_(zb0[e]); o1[e] = acc[ai][bj][m][1][e] * sigmoidf_(zb1[e]); }
                        *(v4u*)(mout + (size_t)row * D + col) = pack8(o0, o1);
                    } } }
    }
};

struct Resid {
    static constexpr bool PERM = true, AFTER_DRAIN = false, CHAIN = false;
    const float* base; float* out; bf16* outb; float* ss;
    DI bool keep(const Unit&) const { return false; }
    DI void operator()(f4 (&acc)[2][2][4][2], const Unit& u, int wr, int wc, int fr, int fq) const {
        { const int ln_ = lane_opaque(); fr = ln_ & 15; fq = ln_ >> 4; }
        const int row0 = u.pm * BM + wr * 64 + fr, col0 = u.pn * BM + wc * 32 + 8 * fq;
#pragma unroll
        for (int ai = 0; ai < 2; ++ai)
#pragma unroll
            for (int m = 0; m < 4; ++m) { const int row = row0 + ai * HALF + m * 16; float s = 0.f;
#pragma unroll
                for (int bj = 0; bj < 2; ++bj) { const size_t off = (size_t)row * D + col0 + bj * HALF;
                    const f4 h0 = *(const f4*)(base + off) + acc[ai][bj][m][0], h1 = *(const f4*)(base + off + 4) + acc[ai][bj][m][1];
                    *(f4*)(out + off) = h0; *(f4*)(out + off + 4) = h1; *(v4u*)(outb + off) = pack8(h0, h1);
                    s += (h0[0] * h0[0] + h0[1] * h0[1]) + (h0[2] * h0[2] + h0[3] * h0[3]) + (h1[0] * h1[0] + h1[1] * h1[1]) + (h1[2] * h1[2] + h1[3] * h1[3]); }
                s += __shfl_xor(s, 16); s += __shfl_xor(s, 32);
                if (fq == 0) atomicAdd(ss + row, s); }
    }
};

struct FfnUp {
    static constexpr bool PERM = true, AFTER_DRAIN = false, CHAIN = false;
    const float* ss; bf16* uout;
    DI bool keep(const Unit&) const { return false; }
    DI void operator()(f4 (&acc)[2][2][4][2], const Unit& u, int wr, int wc, int fr, int fq) const {
        { const int ln_ = lane_opaque(); fr = ln_ & 15; fq = ln_ >> 4; }
        const int row0 = u.pm * BM + wr * 64 + fr, col0 = u.pn * HALF + wc * 32 + 8 * fq;
#pragma unroll
        for (int ai = 0; ai < 2; ++ai)
#pragma unroll
            for (int m = 0; m < 4; ++m) { const int row = row0 + ai * HALF + m * 16; const float r = __builtin_amdgcn_rsqf(ss[row] * (1.0f / D) + RMS_EPS);
                f4 o0, o1;
#pragma unroll
                for (int e = 0; e < 4; ++e) { const float a0 = acc[ai][0][m][0][e] * r, a1 = acc[ai][0][m][1][e] * r;
                    o0[e] = a0 * sigmoidf_(a0) * (acc[ai][1][m][0][e] * r); o1[e] = a1 * sigmoidf_(a1) * (acc[ai][1][m][1][e] * r); }
                *(v4u*)(uout + (size_t)row * DFF + col0) = pack8(o0, o1); }
    }
};

struct StoreBf {
    static constexpr bool PERM = true, AFTER_DRAIN = false, CHAIN = false;
    bf16* o; int ld;
    DI bool keep(const Unit&) const { return false; }
    DI void operator()(f4 (&acc)[2][2][4][2], const Unit& u, int wr, int wc, int fr, int fq) const {
        { const int ln_ = lane_opaque(); fr = ln_ & 15; fq = ln_ >> 4; }
        const int row0 = u.pm * BM + wr * 64 + fr, col0 = u.pn * BM + wc * 32 + 8 * fq;
#pragma unroll
        for (int ai = 0; ai < 2; ++ai)
#pragma unroll
            for (int m = 0; m < 4; ++m)
#pragma unroll
                for (int bj = 0; bj < 2; ++bj) *(v4u*)(o + (size_t)(row0 + ai * HALF + m * 16) * ld + col0 + bj * HALF) = pack8(acc[ai][bj][m][0], acc[ai][bj][m][1]);
    }
};

struct PleGate {
    static constexpr bool PERM = true, AFTER_DRAIN = false, CHAIN = false;
    float* h; const bf16* pp; const float* ss_in; float* ss_out;
    DI bool keep(const Unit&) const { return false; }
    DI void operator()(f4 (&acc)[2][2][4][2], const Unit& u, int wr, int wc, int fr, int fq) const {
        { const int ln_ = lane_opaque(); fr = ln_ & 15; fq = ln_ >> 4; }
        const int row0 = u.pm * BM + wr * 64 + fr, col0 = u.pn * BM + wc * 32 + 8 * fq;
#pragma unroll
        for (int ai = 0; ai < 2; ++ai)
#pragma unroll
            for (int m = 0; m < 4; ++m) { const int row = row0 + ai * HALF + m * 16; const float r = __builtin_amdgcn_rsqf(ss_in[row] * (1.0f / D) + RMS_EPS); float s = 0.f;
#pragma unroll
                for (int bj = 0; bj < 2; ++bj) { const size_t off = (size_t)row * D + col0 + bj * HALF;
                    f4 p0, p1; unpack8(*(const v4u*)(pp + off), p0, p1);
                    f4 h0 = *(const f4*)(h + off), h1 = *(const f4*)(h + off + 4);
#pragma unroll
                    for (int e = 0; e < 4; ++e) { h0[e] += sigmoidf_(acc[ai][bj][m][0][e] * r) * p0[e]; h1[e] += sigmoidf_(acc[ai][bj][m][1][e] * r) * p1[e]; }
                    *(f4*)(h + off) = h0; *(f4*)(h + off + 4) = h1;
                    s += (h0[0] * h0[0] + h0[1] * h0[1]) + (h0[2] * h0[2] + h0[3] * h0[3]) + (h1[0] * h1[0] + h1[1] * h1[1]) + (h1[2] * h1[2] + h1[3] * h1[3]); }
                s += __shfl_xor(s, 16); s += __shfl_xor(s, 32);
                if (fq == 0) atomicAdd(ss_out + row, s); }
    }
};

struct Stack3Order {
    int G, c;
    DI bool next(int i, Unit& u) const { const int L = i * G + c; if (L >= 1536) return false; const int which = L >> 9, r = L & 511; u.pm = which * 64 + (r & 63); u.pn = which * 8 + (r >> 6); return true; }
    DI void a_ready(const Unit&) const {}
    DI void done(const Unit&) const {}
};
struct ChainOrder {
    pg8::StaticOrder so;
    DI bool next(int i, Unit& u) const { Unit t; if (!so.next(i >> 1, t)) return false; const int which = i & 1; u.pm = which * 64 + t.pm; u.pn = which * 16 + t.pn; return true; }
    DI void a_ready(const Unit&) const {}
    DI void done(const Unit&) const {}
};
}

constexpr size_t MiB = 1u << 20;
constexpr size_t WS_CTL = 0, CTL_ZERO_BYTES = 1 * MiB;
constexpr int CW_TMO = 0, CW_BAR = 4096;
constexpr size_t SS1_OFF = 256 * 1024, SS2_OFF = 320 * 1024, SS3_OFF = 384 * 1024;
constexpr size_t WS_RSTDX = 1 * MiB;
constexpr size_t WS_BONUS = 2 * MiB;
constexpr size_t WS_RCOS = 4 * MiB, WS_RSIN = 8 * MiB;
constexpr size_t WS_WI = 12 * MiB;
constexpr size_t WS_PB = 13 * MiB;
constexpr size_t WS_WPAB = 24 * MiB;
constexpr size_t WS_WO = 56 * MiB, WS_WPG = 88 * MiB;
constexpr size_t WS_WPLE = 120 * MiB;
constexpr size_t WS_WL2 = 122 * MiB;
constexpr size_t WS_R1 = 126 * MiB;
constexpr size_t WS_WCAT = 126 * MiB;
constexpr size_t WS_XB = 288 * MiB;
constexpr size_t WS_SCORE = 126 * MiB;
constexpr size_t WS_IDX = 382 * MiB;
constexpr size_t WS_DECAY = 126 * MiB;
constexpr size_t WS_AOUT = 254 * MiB;
constexpr size_t WS_ALORA = 382 * MiB;
constexpr size_t WS_W13 = 126 * MiB;
constexpr size_t WS_W2 = 298 * MiB;
constexpr size_t WS_Q = 416 * MiB, WS_K = 480 * MiB, WS_V = 496 * MiB, WS_QI = 512 * MiB, WS_KI = 576 * MiB;
constexpr size_t WS_RB = 580 * MiB, WS_KB = 644 * MiB, WS_VB = 708 * MiB, WS_LORA = 772 * MiB, WS_GATES = 804 * MiB;
constexpr size_t WS_Y = 416 * MiB;
constexpr size_t WS_MIX = 416 * MiB;
constexpr size_t WS_H1B = 544 * MiB;
constexpr size_t WS_U = 672 * MiB;
constexpr size_t WS_H2B = 416 * MiB;
constexpr size_t WS_PP = 544 * MiB;
constexpr size_t WS_AO = 1060 * MiB;
constexpr size_t WS_GOUT = 1188 * MiB;
constexpr size_t WS_END = 1252 * MiB;

constexpr int RING_OFF = 0, RING_BYTES = 131072;
constexpr int LDSCTL_OFF = RING_BYTES, MISC_OFF = LDSCTL_OFF + 320;
constexpr int LDS_BYTES = 147456;
constexpr int NWAVES = 8;

struct Args {
    const float* in[32]; float* out; unsigned char* ws; int ph_lo, ph_hi;
};
enum { I_X = 0, I_P, I_POS, I_NORM_MIX, I_W_IN, I_MU_RKV, I_MU_WAG, I_W0, I_W1, I_W2, I_A0, I_A1, I_A2, I_G1, I_G2, I_KK, I_KA, I_RK, I_LNW, I_LNB,
       I_WPA, I_WPB, I_WGATE, I_BGATE, I_WO, I_NORM_FFN, I_WFFN1, I_WFFN3, I_WFFN2, I_WPLEG, I_WPLE, I_NORM_FINAL };

struct TrSrc { const float* p; int ld, col0, nvalid, kvalid; const float* ksc; const float* mu; int mumode; };
DI void tr_item(const TrSrc& s, bf16* WT, int dK, int n0, int k0, LAS float* scr, int lane) {
    const int nn = lane & 31;
#pragma unroll 8
    for (int i = 0; i < 32; ++i) { const int kk = 2 * i + (lane >> 5), k = k0 + kk; float v = 0.f;
        if (nn < s.nvalid && k < s.kvalid) { v = s.p[(size_t)k * s.ld + s.col0 + nn]; if (s.ksc) v *= s.ksc[k];
            if (s.mumode == 1) v *= (1.0f - s.mu[k]); else if (s.mumode == 2) v *= s.mu[k]; }
        scr[kk * 33 + nn] = v; }
    LDS_WAIT(); asm volatile("" ::: "memory");
    const int c = lane & 7;
#pragma unroll
    for (int j = 0; j < 4; ++j) { const int n = (lane >> 3) + 8 * j; const LAS float* t = scr + (8 * c) * 33 + n;
        v4u o; o.x = pk2(t[0 * 33], t[1 * 33]); o.y = pk2(t[2 * 33], t[3 * 33]); o.z = pk2(t[4 * 33], t[5 * 33]); o.w = pk2(t[6 * 33], t[7 * 33]);
        *(GAS v4u*)(WT + (size_t)(n0 + n) * dK + k0 + 8 * c) = o; }
    LDS_WAIT(); asm volatile("" ::: "memory");
}
DI TrSrc src_wcat(const float* const* in, int n0) {
    TrSrc s; s.p = in[I_W_IN]; s.ld = DIN; s.col0 = 0; s.nvalid = 32; s.kvalid = D; s.ksc = in[I_NORM_MIX]; s.mu = nullptr; s.mumode = 0;
    const int tile = n0 >> 8, p = n0 & 255, bj = p >> 7, x = p & 127;
    if (tile < 8)        s.col0 = 0    + (2 * tile + (x >> 6)) * 128 + 64 * bj + (x & 63);
    else if (tile < 10)  s.col0 = 2048 + (2 * (tile - 8) + (x >> 6)) * 128 + 64 * bj + (x & 63);
    else if (tile < 12)  s.col0 = 2560 + (tile - 10) * 256 + p;
    else if (tile < 20)  s.col0 = 3072 + (2 * (tile - 12) + (x >> 6)) * 128 + 64 * bj + (x & 63);
    else if (tile == 20) { if (x < 64) s.col0 = 5120 + 64 * bj + x; else if (bj == 0 && x == 64) { s.col0 = 5248; s.nvalid = 16; } else s.nvalid = 0; }
    else if (tile < 45)  s.col0 = 5264 + (tile - 21) * 256 + p;
    else if (tile < 49)  { const int c = (tile - 45) * 256 + p;
        if (c < 96)       { s.p = in[I_W1]; s.ld = 96;  s.col0 = c;       s.mu = in[I_MU_WAG];         s.mumode = 1; }
        else if (c < 192) { s.p = in[I_A1]; s.ld = 96;  s.col0 = c - 96;  s.mu = in[I_MU_WAG] + D;     s.mumode = 1; }
        else if (c < 448) { s.p = in[I_G1]; s.ld = 256; s.col0 = c - 192; s.mu = in[I_MU_WAG] + 2 * D; s.mumode = 1; }
        else if (c < 544) { s.p = in[I_W1]; s.ld = 96;  s.col0 = c - 448; s.mu = in[I_MU_WAG];         s.mumode = 2; }
        else if (c < 640) { s.p = in[I_A1]; s.ld = 96;  s.col0 = c - 544; s.mu = in[I_MU_WAG] + D;     s.mumode = 2; }
        else if (c < 896) { s.p = in[I_G1]; s.ld = 256; s.col0 = c - 640; s.mu = in[I_MU_WAG] + 2 * D; s.mumode = 2; }
        else s.nvalid = 0; }
    else { s.p = in[I_WGATE]; s.ld = 2 * D; s.col0 = (tile - 49) * 256 + p; }
    return s;
}
DI TrSrc src_plain(const float* p, int ld, int col0, int kvalid, const float* ksc) { TrSrc s; s.p = p; s.ld = ld; s.col0 = col0; s.nvalid = 32; s.kvalid = kvalid; s.ksc = ksc; s.mu = nullptr; s.mumode = 0; return s; }

DI void convert_set_a(const float* const* in, unsigned char* ws, LAS float* scr, int gw, int NGW, int lane) {
    constexpr int I0 = (NCAT / 32) * (D / 64);
    constexpr int I1 = (D / 32) * (DA / 64);
    constexpr int I3 = (D / 32) * (D / 64);
    constexpr int I5 = (D / 32) * (DPLE / 64);
    constexpr int I6 = (DB / 32) * (256 / 64);
    constexpr int NITEMS = I0 + 2 * I1 + 2 * I3 + I5 + 3 * I6;
    for (int it = gw; it < NITEMS; it += NGW) {
        int r = it;
        if (r < I0) { const int nblk = NCAT / 32, kb = r / nblk, nb = r % nblk; tr_item(src_wcat(in, 32 * nb), (bf16*)(ws + WS_WCAT), D, 32 * nb, 64 * kb, scr, lane); continue; } r -= I0;
        if (r < 2 * I1) { const int w = r / I1; r -= w * I1; const int nblk = D / 32, kb = r / nblk, nb = r % nblk;
            tr_item(src_plain(in[w ? I_WPB : I_WPA], D, 32 * nb, DA, nullptr), (bf16*)(ws + WS_WPAB) + (size_t)w * D * DA, DA, 32 * nb, 64 * kb, scr, lane); continue; } r -= 2 * I1;
        if (r < 2 * I3) { const int w = r / I3; r -= w * I3; const int nblk = D / 32, kb = r / nblk, nb = r % nblk;
            tr_item(src_plain(in[w ? I_WPLEG : I_WO], D, 32 * nb, D, nullptr), (bf16*)(ws + (w ? WS_WPG : WS_WO)), D, 32 * nb, 64 * kb, scr, lane); continue; } r -= 2 * I3;
        if (r < I5) { const int nblk = D / 32, kb = r / nblk, nb = r % nblk; tr_item(src_plain(in[I_WPLE], D, 32 * nb, DPLE, nullptr), (bf16*)(ws + WS_WPLE), DPLE, 32 * nb, 64 * kb, scr, lane); continue; } r -= I5;
        { const int w = r / I6; r -= w * I6; const int nblk = DB / 32, kb = r / nblk, nb = r % nblk;
          tr_item(src_plain(in[w == 0 ? I_W2 : (w == 1 ? I_A2 : I_G2)], DB, 32 * nb, w == 2 ? 256 : 96, nullptr), (bf16*)(ws + WS_WL2) + (size_t)w * DB * 256, 256, 32 * nb, 64 * kb, scr, lane); }
    }
}
DI void convert_set_b(const float* const* in, unsigned char* ws, LAS float* scr, int gw, int NGW, int lane) {
    constexpr int I0 = (N13 / 32) * (D / 64), I1 = (D / 32) * (DFF / 64);
    for (int it = gw; it < I0 + I1; it += NGW) {
        int r = it;
        if (r < I0) { const int nblk = N13 / 32, kb = r / nblk, nb = r % nblk, n0 = 32 * nb, tile = n0 >> 8, p = n0 & 255;
            tr_item(src_plain(in[(p >> 7) ? I_WFFN3 : I_WFFN1], DFF, tile * 128 + (p & 127), D, in[I_NORM_FFN]), (bf16*)(ws + WS_W13), D, n0, 64 * kb, scr, lane); continue; } r -= I0;
        { const int nblk = D / 32, kb = r / nblk, nb = r % nblk; tr_item(src_plain(in[I_WFFN2], D, 32 * nb, DFF, nullptr), (bf16*)(ws + WS_W2), DFF, 32 * nb, 64 * kb, scr, lane); }
    }
}
DI void prologue_rows(const float* const* in, unsigned char* ws, int gw, int NGW, int lane) {
    const float* x = in[I_X]; bf16* xb = (bf16*)(ws + WS_XB); float* rstd = (float*)(ws + WS_RSTDX);
    for (int m = gw; m < M; m += NGW) {
        const GAS f32x4* xr = (const GAS f32x4*)(x + (size_t)m * D) + lane; GAS v2u* o = (GAS v2u*)(xb + (size_t)m * D) + lane; float s = 0.f;
#pragma unroll 4
        for (int j = 0; j < 16; ++j) { const f32x4 v = xr[64 * j]; s += (v.x * v.x + v.y * v.y) + (v.z * v.z + v.w * v.w); v2u w; w.x = pk2(v.x, v.y); w.y = pk2(v.z, v.w); o[64 * j] = w; }
        s = wave_sum(s);
        if (lane == 0) rstd[m] = 1.0f / sqrtf(s * (1.0f / D) + RMS_EPS);
    }
    const int* pos = (const int*)in[I_POS]; float* rc = (float*)(ws + WS_RCOS); float* rsn = (float*)(ws + WS_RSIN);
    for (int e = gw * 64 + lane; e < M * 64; e += NGW * 64) {
        const int m = e >> 6, i = e & 63; double inv = 1.0; for (int j = 0; j < i; ++j) inv *= 0.8659643233600653523;
        const double ang = (double)pos[m] * inv;
        const double qd = __builtin_rint(ang * 0.63661977236758134308); const int qi = (int)((long long)qd & 3);
        double r = __builtin_fma(-qd, 1.5707963267948965580, ang); r = __builtin_fma(-qd, 6.1232339957367658860e-17, r);
        const double r2 = r * r;
        const double sn = r * (1.0 + r2 * (-1.0 / 6 + r2 * (1.0 / 120 + r2 * (-1.0 / 5040 + r2 * (1.0 / 362880 + r2 * (-1.0 / 39916800 + r2 * (1.0 / 6227020800.0)))))));
        const double cs = 1.0 + r2 * (-0.5 + r2 * (1.0 / 24 + r2 * (-1.0 / 720 + r2 * (1.0 / 40320 + r2 * (-1.0 / 3628800 + r2 * (1.0 / 479001600.0 + r2 * (-1.0 / 87178291200.0)))))));
        const double c4 = (qi == 0) ? cs : (qi == 1) ? -sn : (qi == 2) ? -cs : sn;
        const double s4 = (qi == 0) ? sn : (qi == 1) ? cs : (qi == 2) ? -sn : -cs;
        rc[e] = (float)c4; rsn[e] = (float)s4;
    }
    const float* p = in[I_P]; bf16* pb = (bf16*)(ws + WS_PB);
    for (int e = gw * 64 + lane; e < M * DPLE / 4; e += NGW * 64) { const f32x4 v = ((const GAS f32x4*)p)[e]; v2u w; w.x = pk2(v.x, v.y); w.y = pk2(v.z, v.w); ((GAS v2u*)pb)[e] = w; }
}
DI void build_alora(unsigned char* ws, int gtid, int NT) {
    const bf16* L = (const bf16*)(ws + WS_LORA); bf16* A = (bf16*)(ws + WS_ALORA);
    for (int e = gtid; e < 3 * M * 32; e += NT) {
        const int which = e / (M * 32), r = e - which * (M * 32), m = r >> 5, j0 = (r & 31) * 8;
        f32x4 o0 = {0.f, 0.f, 0.f, 0.f}, o1 = o0;
        const int width = which == 2 ? 256 : 96, ca = which == 0 ? 0 : (which == 1 ? 96 : 192), cbb = which == 0 ? 448 : (which == 1 ? 544 : 640);
        if (j0 < width) {
            f32x4 c0, c1, p0 = {0.f, 0.f, 0.f, 0.f}, p1 = p0;
            epi::unpack8(*(const v4u*)(L + (size_t)m * LORA_LD + ca + j0), c0, c1);
            if ((m & (SEQ - 1)) != 0) epi::unpack8(*(const v4u*)(L + (size_t)(m - 1) * LORA_LD + cbb + j0), p0, p1);
            o0 = c0 + p0; o1 = c1 + p1;
            if (which == 0) {
#pragma unroll
                for (int t = 0; t < 4; ++t) { o0[t] = 1.0f - 2.0f / (__expf(2.0f * o0[t]) + 1.0f); o1[t] = 1.0f - 2.0f / (__expf(2.0f * o1[t]) + 1.0f); } }
            if (which == 2) {
#pragma unroll
                for (int t = 0; t < 4; ++t) { o0[t] = sigmoidf_(o0[t]); o1[t] = sigmoidf_(o1[t]); } }
        }
        *(v4u*)(A + ((size_t)which * M + m) * 256 + j0) = epi::pack8(o0, o1);
    }
}

constexpr int IDX_TS = 272;
constexpr int IDX_TILE_BYTES = 64 * IDX_TS;
constexpr int IDX_HIST_OFF = 2 * IDX_TILE_BYTES;

DI unsigned fkey(float f) { unsigned u = __builtin_bit_cast(unsigned, f); if (u == 0x80000000u) u = 0u; return (u & 0x80000000u) ? ~u : (u | 0x80000000u); }

DI void indexer_unit(unsigned char* ws, LAS unsigned char* lds, int b, int blk, float* scratch, int wave) {
    const int lane = lane_opaque(), tid = wave * 64 + lane;
    const bf16* qi = (const bf16*)(ws + WS_QI); const bf16* ki = (const bf16*)(ws + WS_KI); const float* wi = (const float*)(ws + WS_WI);
    const int t0 = blk * 32, mrow0 = b * SEQ + t0;
    const int r = lane & 31, kh = lane >> 5, aq = (r >> 2) & 1, ah = (r & 3) + 4 * (r >> 3);
    bf16x8 af[2][8]; f32x4 wg[2][4];
#pragma unroll
    for (int rt = 0; rt < 2; ++rt) {
        const bf16* src = qi + (size_t)(mrow0 + 4 * wave + 2 * rt + aq) * DIQ + ah * HDI + 8 * kh;
#pragma unroll
        for (int ks = 0; ks < 8; ++ks) af[rt][ks] = *(const bf16x8*)(src + 16 * ks);
        const float* wsrc = wi + (size_t)(mrow0 + 4 * wave + 2 * rt + kh) * NHI;
#pragma unroll
        for (int j = 0; j < 4; ++j) wg[rt][j] = *(const f32x4*)(wsrc + 4 * j) * 0.08838834764831845f;
    }
    const int nk = (t0 + 32 + 63) >> 6;
    const int lkey = tid >> 3, lpart = tid & 7;
    const bf16* kbase = ki + (size_t)(b * SEQ) * HDI;
    v4u st0, st1;
    { const v4u* g = (const v4u*)(kbase + (size_t)lkey * HDI + lpart * 16); st0 = g[0]; st1 = g[1]; }
    __syncthreads();
    { LAS v4u* d = (LAS v4u*)(lds + lkey * IDX_TS + lpart * 32); d[0] = st0; d[1] = st1; }
    __syncthreads();
    for (int kt = 0; kt < nk; ++kt) {
        if (kt + 1 < nk) { const v4u* g = (const v4u*)(kbase + (size_t)((kt + 1) * 64 + lkey) * HDI + lpart * 16); st0 = g[0]; st1 = g[1]; }
        const LAS unsigned char* tb = lds + (kt & 1) * IDX_TILE_BYTES;
#pragma unroll
        for (int ct = 0; ct < 2; ++ct) {
            bf16x8 bfr[8];
#pragma unroll
            for (int ks = 0; ks < 8; ++ks) bfr[ks] = *(const LAS bf16x8*)(tb + (32 * ct + r) * IDX_TS + (16 * ks + 8 * kh) * 2);
#pragma unroll
            for (int rt = 0; rt < 2; ++rt) {
                f32x16 c;
#pragma unroll
                for (int j = 0; j < 16; ++j) c[j] = 0.f;
#pragma unroll
                for (int ks = 0; ks < 8; ++ks) c = __builtin_amdgcn_mfma_f32_32x32x16_bf16(af[rt][ks], bfr[ks], c, 0, 0, 0);
                float s = 0.f;
#pragma unroll
                for (int j = 0; j < 16; ++j) s += wg[rt][j >> 2][j & 3] * fmaxf(c[j], 0.f);
                scratch[(size_t)(4 * wave + 2 * rt + kh) * SEQ + kt * 64 + 32 * ct + r] = s;
            }
        }
        if (kt + 1 < nk) { LAS v4u* d = (LAS v4u*)(lds + ((kt + 1) & 1) * IDX_TILE_BYTES + lkey * IDX_TS + lpart * 32); d[0] = st0; d[1] = st1; }
        __syncthreads();
    }
}

DI void select_unit(unsigned char* ws, LAS unsigned char* lds, int b, int blk, const float* scratch, int wave) {
    int* idx = (int*)(ws + WS_IDX);
    LAS unsigned* hist = (LAS unsigned*)(lds + IDX_HIST_OFF + wave * 1024);
    for (int qq = 0; qq < 4; ++qq) {
        const int lane = lane_opaque(); const unsigned long long lt_mask = (1ull << lane) - 1ull;
        const int ql = wave * 4 + qq, t = blk * 32 + ql, n = t + 1;
        const float* sc = scratch + (size_t)ql * SEQ; int* out = idx + (size_t)(b * SEQ + t) * TOPK;
        if (n <= TOPK) { for (int e = lane; e < TOPK; e += 64) out[e] = (e < n) ? e : 0; continue; }
        const int n4 = (n + 3) >> 2;
        v4u key[32];
#pragma unroll
        for (int j = 0; j < 32; ++j) { key[j] = (v4u){0u, 0u, 0u, 0u};
            if (64 * j < n4) { const int gi = 64 * j + lane; if (gi < n4) { const f32x4 v = *(const f32x4*)(sc + 4 * gi); const int e0 = 4 * gi;
                key[j].x = fkey(v[0]); key[j].y = (e0 + 1 < n) ? fkey(v[1]) : 0u; key[j].z = (e0 + 2 < n) ? fkey(v[2]) : 0u; key[j].w = (e0 + 3 < n) ? fkey(v[3]) : 0u; } } }
        unsigned prefix = 0u, pmask = 0u; int kk = TOPK;
        for (int pass = 0; pass < 4; ++pass) {
            const int shift = 24 - 8 * pass;
            hist[lane] = 0u; hist[lane + 64] = 0u; hist[lane + 128] = 0u; hist[lane + 192] = 0u;
#pragma unroll
            for (int j = 0; j < 32; ++j) if (64 * j < n4) {
#pragma unroll
                for (int c = 0; c < 4; ++c) { const unsigned u = key[j][c]; if ((u & pmask) == prefix) __hip_atomic_fetch_add(hist + ((u >> shift) & 255u), 1u, __ATOMIC_RELAXED, __HIP_MEMORY_SCOPE_WORKGROUP); } }
            LDS_WAIT(); asm volatile("" ::: "memory");
            const int c0 = (int)hist[4 * lane], c1 = (int)hist[4 * lane + 1], c2 = (int)hist[4 * lane + 2], c3 = (int)hist[4 * lane + 3];
            const int T = c0 + c1 + c2 + c3; int S = T;
#pragma unroll
            for (int o = 1; o < 64; o <<= 1) { const int v = __shfl_down(S, o); if (lane + o < 64) S += v; }
            const int E = S - T;
            const bool found = (E < kk) && (kk <= S);
            int d = 0, knew = 0;
            if (found) { int run = E;
                if (run + c3 >= kk) { d = 4 * lane + 3; knew = kk - run; } else { run += c3;
                if (run + c2 >= kk) { d = 4 * lane + 2; knew = kk - run; } else { run += c2;
                if (run + c1 >= kk) { d = 4 * lane + 1; knew = kk - run; } else { run += c1; d = 4 * lane; knew = kk - run; } } } }
            const unsigned long long fm = __ballot(found); const int src = fm ? (int)__builtin_ctzll(fm) : 0;
            d = __shfl(d, src); knew = __shfl(knew, src);
            prefix |= ((unsigned)d) << shift; pmask |= 0xffu << shift; kk = knew;
            asm volatile("" ::: "memory");
        }
        int pos = 0, eqt = 0;
#pragma unroll
        for (int j = 0; j < 32; ++j) if (64 * j < n4) {
            bool eq[4], gt[4]; unsigned long long em[4]; int eq_before = eqt;
#pragma unroll
            for (int c = 0; c < 4; ++c) { const unsigned u = key[j][c]; eq[c] = (u == prefix); gt[c] = (u > prefix); em[c] = __ballot(eq[c]); eq_before += __builtin_popcountll(em[c] & lt_mask); }
            bool take[4]; unsigned long long tm[4]; int tk_before = pos, run_eq = eq_before;
#pragma unroll
            for (int c = 0; c < 4; ++c) { take[c] = gt[c] || (eq[c] && run_eq < kk); run_eq += eq[c] ? 1 : 0; tm[c] = __ballot(take[c]); tk_before += __builtin_popcountll(tm[c] & lt_mask); }
            int slot = tk_before;
#pragma unroll
            for (int c = 0; c < 4; ++c) { if (take[c]) { if (slot < TOPK) out[slot] = 256 * j + 4 * lane + c; ++slot; } }
#pragma unroll
            for (int c = 0; c < 4; ++c) { pos += __builtin_popcountll(tm[c]); eqt += __builtin_popcountll(em[c]); }
        }
    }
}

DI void indexer_phase(unsigned char* ws, LAS unsigned char* lds, int wave) {
    float* scratch = (float*)(ws + WS_SCORE) + (size_t)blockIdx.x * 32 * SEQ;
    for (int pr = blockIdx.x; pr < 256; pr += gridDim.x) {
        const int b = pr >> 7, j = pr & 127;
        for (int half = 0; half < 2; ++half) { const int blk = half ? 255 - j : j;
            indexer_unit(ws, lds, b, blk, scratch, wave);
            VM_WAIT(); __syncthreads();
            select_unit(ws, lds, b, blk, scratch, wave);
            VM_WAIT(); __syncthreads(); }
    }
}

typedef int v4i __attribute__((ext_vector_type(4)));
DI void attn_phase(unsigned char* ws, LAS unsigned char* lds, int wave, int lane) {
    const bf16* q = (const bf16*)(ws + WS_Q); const bf16* kbuf = (const bf16*)(ws + WS_K); const bf16* vbuf = (const bf16*)(ws + WS_V);
    const int* idx = (const int*)(ws + WS_IDX); bf16* ao = (bf16*)(ws + WS_AO);
    LAS int* idl = (LAS int*)(lds + wave * 5120); LAS float* pl = (LAS float*)(lds + wave * 5120 + 1024);
    const int G = gridDim.x, bg = blockIdx.x & 7, b = bg >> 2, g = bg & 3;
    const int nw = ((G - bg + 7) >> 3) * NWAVES, wv = (blockIdx.x >> 3) * NWAVES + wave;
    const int kr = lane & 15, kq = lane >> 4;
    const int kg = lane >> 4, dg = lane & 15;
    const bf16* kbase = kbuf + (size_t)(b * SEQ) * KVD + g * 128 + 8 * kq;
    const bf16* vbase = vbuf + (size_t)(b * SEQ) * KVD + g * 128 + 8 * dg;
    for (int t = wv; t < SEQ; t += nw) {
        const int mq = b * SEQ + t, nvalid = (t + 1 < TOPK) ? t + 1 : TOPK;
#pragma unroll
        for (int c = 0; c < 4; ++c) idl[lane + 64 * c] = idx[(size_t)mq * TOPK + lane + 64 * c];
        bf16x8 qf[4];
#pragma unroll
        for (int ks = 0; ks < 4; ++ks) { if (kr < 4) qf[ks] = *(const bf16x8*)(q + (size_t)mq * DA + (4 * g + kr) * 128 + 32 * ks + 8 * kq); else qf[ks] = (bf16x8){0, 0, 0, 0, 0, 0, 0, 0}; }
        LDS_WAIT(); asm volatile("" ::: "memory");
        int kidx[16];
#pragma unroll
        for (int kt = 0; kt < 16; ++kt) kidx[kt] = idl[64 * (kr >> 2) + 4 * kt + (kr & 3)];
        f32x4 s[16];
#pragma unroll
        for (int grp = 0; grp < 4; ++grp) {
            bf16x8 kf[4][4];
#pragma unroll
            for (int j = 0; j < 4; ++j) { const bf16* kp = kbase + (size_t)kidx[4 * grp + j] * KVD;
#pragma unroll
                for (int ks = 0; ks < 4; ++ks) kf[j][ks] = *(const bf16x8*)(kp + 32 * ks); }
#pragma unroll
            for (int j = 0; j < 4; ++j) { f32x4 a = {0.f, 0.f, 0.f, 0.f};
#pragma unroll
                for (int ks = 0; ks < 4; ++ks) a = __builtin_amdgcn_mfma_f32_16x16x32_bf16(kf[j][ks], qf[ks], a, 0, 0, 0);
                s[4 * grp + j] = a; }
        }
        float mx = -3.0e38f;
#pragma unroll
        for (int kt = 0; kt < 16; ++kt)
#pragma unroll
            for (int e = 0; e < 4; ++e) { const bool ok = (64 * kq + 4 * kt + e) < nvalid; s[kt][e] = ok ? s[kt][e] * 0.08838834764831845f : -3.0e38f; mx = fmaxf(mx, s[kt][e]); }
        mx = fmaxf(mx, __shfl_xor(mx, 16)); mx = fmaxf(mx, __shfl_xor(mx, 32));
        float sum = 0.f;
#pragma unroll
        for (int kt = 0; kt < 16; ++kt)
#pragma unroll
            for (int e = 0; e < 4; ++e) { const bool ok = (64 * kq + 4 * kt + e) < nvalid; const float p = ok ? __expf(s[kt][e] - mx) : 0.f; s[kt][e] = p; sum += p; }
        sum += __shfl_xor(sum, 16); sum += __shfl_xor(sum, 32);
        const float inv = 1.0f / sum;
        if (kr < 4) {
#pragma unroll
            for (int kt = 0; kt < 16; ++kt) *(LAS f32x4*)(pl + kr * 256 + 64 * kq + 4 * kt) = s[kt] * inv; }
        LDS_WAIT(); asm volatile("" ::: "memory");
        f32x2 acc[4][4];
#pragma unroll
        for (int h = 0; h < 4; ++h)
#pragma unroll
            for (int d = 0; d < 4; ++d) acc[h][d] = (f32x2){0.f, 0.f};
#pragma unroll
        for (int ch = 0; ch < 4; ++ch) {
            v4i ix[4];
#pragma unroll
            for (int j = 0; j < 4; ++j) ix[j] = *(const LAS v4i*)(idl + 64 * kg + 16 * ch + 4 * j);
            v4u vv[16];
#pragma unroll
            for (int j = 0; j < 16; ++j) vv[j] = *(const v4u*)(vbase + (size_t)ix[j >> 2][j & 3] * KVD);
            f32x4 pp[4][4];
#pragma unroll
            for (int h = 0; h < 4; ++h)
#pragma unroll
                for (int j = 0; j < 4; ++j) pp[h][j] = *(const LAS f32x4*)(pl + h * 256 + 64 * kg + 16 * ch + 4 * j);
#pragma unroll
            for (int j = 0; j < 16; ++j) {
                const f32x2 v0 = {bf_lo(vv[j].x), bf_hi(vv[j].x)}, v1 = {bf_lo(vv[j].y), bf_hi(vv[j].y)}, v2 = {bf_lo(vv[j].z), bf_hi(vv[j].z)}, v3 = {bf_lo(vv[j].w), bf_hi(vv[j].w)};
#pragma unroll
                for (int h = 0; h < 4; ++h) { const float p = pp[h][j >> 2][j & 3]; const f32x2 p2 = {p, p};
                    acc[h][0] += p2 * v0; acc[h][1] += p2 * v1; acc[h][2] += p2 * v2; acc[h][3] += p2 * v3; }
            }
        }
#pragma unroll
        for (int h = 0; h < 4; ++h)
#pragma unroll
            for (int d = 0; d < 4; ++d) {
                acc[h][d][0] += __shfl_xor(acc[h][d][0], 16); acc[h][d][1] += __shfl_xor(acc[h][d][1], 16);
                acc[h][d][0] += __shfl_xor(acc[h][d][0], 32); acc[h][d][1] += __shfl_xor(acc[h][d][1], 32); }
        if (kg == 0) {
#pragma unroll
            for (int h = 0; h < 4; ++h) { v4u w; w.x = pk2(acc[h][0][0], acc[h][0][1]); w.y = pk2(acc[h][1][0], acc[h][1][1]); w.z = pk2(acc[h][2][0], acc[h][2][1]); w.w = pk2(acc[h][3][0], acc[h][3][1]);
                *(v4u*)(ao + (size_t)mq * DA + (4 * g + h) * 128 + 8 * dg) = w; } }
        LDS_WAIT(); asm volatile("" ::: "memory");
    }
}

constexpr int SC_STEPS = 32, SC_STEP_BYTES = 1344, SC_BUF_BYTES = SC_STEPS * SC_STEP_BYTES;
constexpr int SC_Y_OFF = 2 * SC_BUF_BYTES;

template <int CTRL> DI float dpp_add(float x) { return x + __builtin_bit_cast(float, __builtin_amdgcn_update_dpp(0, __builtin_bit_cast(int, x), CTRL, 0xf, 0xf, false)); }
DI float red16(float x) { x = dpp_add<0xB1>(x); x = dpp_add<0x4E>(x); x = dpp_add<0x141>(x); x = dpp_add<0x140>(x); return x; }

struct ScanRaw { v2u rc, rp, kc, kp, vc, vp, ac; f32x4 dc; };
struct ScanConst { f32x4 mu_r, mu_k, mu_v, kkw, kaw, rkw; };
DI f32x4 bf4(const v2u& w) { f32x4 r; r[0] = bf_lo(w.x); r[1] = bf_hi(w.x); r[2] = bf_lo(w.y); r[3] = bf_hi(w.y); return r; }

DI void scan_issue(ScanRaw& R, const unsigned char* ws, int b, int h, int t, int cg) {
    const bf16* rb = (const bf16*)(ws + WS_RB); const bf16* kb = (const bf16*)(ws + WS_KB); const bf16* vb = (const bf16*)(ws + WS_VB);
    const float* decay = (const float*)(ws + WS_DECAY); const bf16* av = (const bf16*)(ws + WS_AOUT);
    const size_t o = (size_t)(b * SEQ + t) * DB + h * HDB + 4 * cg;
    R.rc = *(const v2u*)(rb + o); R.kc = *(const v2u*)(kb + o); R.vc = *(const v2u*)(vb + o); R.dc = *(const f32x4*)(decay + o); R.ac = *(const v2u*)(av + o);
    if (t > 0) { R.rp = *(const v2u*)(rb + o - DB); R.kp = *(const v2u*)(kb + o - DB); R.vp = *(const v2u*)(vb + o - DB); }
    else { R.rp = (v2u){0u, 0u}; R.kp = (v2u){0u, 0u}; R.vp = (v2u){0u, 0u}; }
}
DI void scan_emit(const ScanRaw& R, const ScanConst& C, LAS float* sb, int cg, int qr, float* bonus_dst) {
    const f32x4 rc = bf4(R.rc), rp = bf4(R.rp), kc = bf4(R.kc), kp = bf4(R.kp), vc = bf4(R.vc), vp = bf4(R.vp), a = bf4(R.ac);
    const f32x4 r1 = rc + (rp - rc) * C.mu_r, k0 = kc + (kp - kc) * C.mu_k, v1 = vc + (vp - vc) * C.mu_v;
    const f32x4 kkv = k0 * C.kkw;
    const float nrm = sqrtf(red16((kkv[0] * kkv[0] + kkv[1] * kkv[1]) + (kkv[2] * kkv[2] + kkv[3] * kkv[3])));
    const f32x4 kkn = kkv * (1.0f / fmaxf(nrm, 1e-12f));
    const f32x4 k1 = k0 * (1.0f + (a - 1.0f) * C.kaw);
    const f32x4 rk = r1 * k1 * C.rkw;
    const float bc = red16((rk[0] + rk[1]) + (rk[2] + rk[3]));
    *(LAS f32x4*)(sb + 4 * cg) = R.dc; *(LAS f32x4*)(sb + 64 + 4 * cg) = -kkn; *(LAS f32x4*)(sb + 128 + 4 * cg) = kkn * a;
    *(LAS f32x4*)(sb + 192 + 4 * cg) = k1; *(LAS f32x4*)(sb + 256 + 4 * cg) = r1;
    if ((cg >> 2) == qr) *(LAS f32x4*)(sb + 320 + 4 * (cg & 3)) = v1;
    if (bonus_dst != nullptr && cg == 0) *bonus_dst = bc;
}
struct ScanVec { f32x4 w, a, b, k, r; float v; };
DI void scan_ld(ScanVec& V, const LAS float* sb, int cg, int vrow) {
    V.w = *(const LAS f32x4*)(sb + 4 * cg); V.a = *(const LAS f32x4*)(sb + 64 + 4 * cg); V.b = *(const LAS f32x4*)(sb + 128 + 4 * cg);
    V.k = *(const LAS f32x4*)(sb + 192 + 4 * cg); V.r = *(const LAS f32x4*)(sb + 256 + 4 * cg); V.v = sb[320 + vrow];
}
DI float scan_step(f32x4& st, const ScanVec& V) {
    const f32x4 t = st * V.w + V.k * V.v;
    const float sa = red16((st[0] * V.a[0] + st[1] * V.a[1]) + (st[2] * V.a[2] + st[3] * V.a[3]));
    st = t + V.b * sa;
    return red16((st[0] * V.r[0] + st[1] * V.r[1]) + (st[2] * V.r[2] + st[3] * V.r[3]));
}
#define SC_BAR() do { asm volatile("s_waitcnt lgkmcnt(0)" ::: "memory"); __builtin_amdgcn_s_barrier(); asm volatile("" ::: "memory"); } while (0)

DI void scan_phase(const float* const* in, unsigned char* ws, LAS unsigned char* lds, int wave, int lane) {
    float* y = (float*)(ws + WS_Y); float* bonus = (float*)(ws + WS_BONUS);
    constexpr int NCHUNK = SEQ / SC_STEPS;
    for (int task = blockIdx.x; task < BATCH * NHB * 4; task += gridDim.x) {
        const int bh = task >> 2, qr = task & 3, b = bh >> 5, h = bh & 31;
        const int rl = lane >> 4, cg = lane & 15;
        __syncthreads();
        if (wave < 4) {
            f32x4 st = {0.f, 0.f, 0.f, 0.f}; const int vrow = 4 * wave + rl;
            SC_BAR();
            for (int c = 0; c < NCHUNK; ++c) {
                const LAS unsigned char* buf = lds + (c & 1) * SC_BUF_BYTES; LAS float* yb = (LAS float*)(lds + SC_Y_OFF + (c & 1) * 2048);
                ScanVec A, B; scan_ld(A, (const LAS float*)buf, cg, vrow);
#pragma unroll 2
                for (int s = 0; s < SC_STEPS; s += 2) {
                    scan_ld(B, (const LAS float*)(buf + (s + 1) * SC_STEP_BYTES), cg, vrow);
                    const float y0 = scan_step(st, A);
                    if (s + 2 < SC_STEPS) scan_ld(A, (const LAS float*)(buf + (s + 2) * SC_STEP_BYTES), cg, vrow);
                    const float y1 = scan_step(st, B);
                    if (cg == 0) { yb[s * 16 + vrow] = y0; yb[(s + 1) * 16 + vrow] = y1; }
                }
                SC_BAR();
            }
        } else {
            const int lw = wave - 4, col0 = h * HDB + 4 * cg;
            ScanConst C; C.mu_r = *(const f32x4*)(in[I_MU_RKV] + col0); C.mu_k = *(const f32x4*)(in[I_MU_RKV] + DB + col0); C.mu_v = *(const f32x4*)(in[I_MU_RKV] + 2 * DB + col0);
            C.kkw = *(const f32x4*)(in[I_KK] + col0); C.kaw = *(const f32x4*)(in[I_KA] + col0); C.rkw = *(const f32x4*)(in[I_RK] + col0);
            ScanRaw R0, R1;
            const int s0 = 4 * lw + rl, s1 = 4 * (lw + 4) + rl;
            scan_issue(R0, ws, b, h, s0, cg); scan_issue(R1, ws, b, h, s1, cg);
            { LAS float* base = (LAS float*)(lds);
              scan_emit(R0, C, base + s0 * (SC_STEP_BYTES / 4), cg, qr, qr == 0 ? bonus + (size_t)(b * SEQ + s0) * NHB + h : nullptr);
              scan_emit(R1, C, base + s1 * (SC_STEP_BYTES / 4), cg, qr, qr == 0 ? bonus + (size_t)(b * SEQ + s1) * NHB + h : nullptr); }
            scan_issue(R0, ws, b, h, SC_STEPS + s0, cg); scan_issue(R1, ws, b, h, SC_STEPS + s1, cg);
            SC_BAR();
            for (int c = 0; c < NCHUNK; ++c) {
                if (c + 1 < NCHUNK) { LAS float* base = (LAS float*)(lds + ((c + 1) & 1) * SC_BUF_BYTES); const int t0 = (c + 1) * SC_STEPS;
                    scan_emit(R0, C, base + s0 * (SC_STEP_BYTES / 4), cg, qr, qr == 0 ? bonus + (size_t)(b * SEQ + t0 + s0) * NHB + h : nullptr);
                    scan_emit(R1, C, base + s1 * (SC_STEP_BYTES / 4), cg, qr, qr == 0 ? bonus + (size_t)(b * SEQ + t0 + s1) * NHB + h : nullptr); }
                if (c + 2 < NCHUNK) { const int t0 = (c + 2) * SC_STEPS; scan_issue(R0, ws, b, h, t0 + s0, cg); scan_issue(R1, ws, b, h, t0 + s1, cg); }
                if (c >= 1 && lw == 0) { const LAS float* yb = (const LAS float*)(lds + SC_Y_OFF + ((c - 1) & 1) * 2048);
                    const int s = lane >> 1, hf = lane & 1, t = (c - 1) * SC_STEPS + s; float* dst = y + (size_t)(b * SEQ + t) * DB + h * HDB + 16 * qr + 8 * hf;
                    *(f32x4*)dst = *(const LAS f32x4*)(yb + s * 16 + 8 * hf); *(f32x4*)(dst + 4) = *(const LAS f32x4*)(yb + s * 16 + 8 * hf + 4); }
                SC_BAR();
            }
            if (lw == 0) { const LAS float* yb = (const LAS float*)(lds + SC_Y_OFF + ((NCHUNK - 1) & 1) * 2048);
                const int s = lane >> 1, hf = lane & 1, t = (NCHUNK - 1) * SC_STEPS + s; float* dst = y + (size_t)(b * SEQ + t) * DB + h * HDB + 16 * qr + 8 * hf;
                *(f32x4*)dst = *(const LAS f32x4*)(yb + s * 16 + 8 * hf); *(f32x4*)(dst + 4) = *(const LAS f32x4*)(yb + s * 16 + 8 * hf + 4); }
        }
    }
}

DI void gn_phase(const float* const* in, unsigned char* ws, int gw, int NGW, int lane) {
    const float* y = (const float*)(ws + WS_Y); const bf16* vb = (const bf16*)(ws + WS_VB); const bf16* gout = (const bf16*)(ws + WS_GOUT);
    const float* bonus = (const float*)(ws + WS_BONUS); bf16* ro = (bf16*)(ws + WS_AO) + (size_t)M * DB;
    const int per = (M * 8 + NGW - 1) / NGW, it0 = gw * per, it1 = (it0 + per < M * 8) ? it0 + per : M * 8;
    const int hh = lane >> 4, cg = lane & 15;
#pragma unroll 2
    for (int it = it0; it < it1; ++it) {
        const int m = it >> 3, h = (it & 7) * 4 + hh, col = h * HDB + 4 * cg; const size_t o = (size_t)m * DB + col;
        const f32x4 yv = *(const f32x4*)(y + o);
        const f32x4 vc = bf4(*(const v2u*)(vb + o)), g4 = bf4(*(const v2u*)(gout + o));
        f32x4 vp = {0.f, 0.f, 0.f, 0.f}; if (m & (SEQ - 1)) vp = bf4(*(const v2u*)(vb + o - DB));
        const float bc = bonus[(size_t)m * NHB + h];
        const f32x4 lw = *(const f32x4*)(in[I_LNW] + col), lb = *(const f32x4*)(in[I_LNB] + col), muv = *(const f32x4*)(in[I_MU_RKV] + 2 * DB + col);
        const float mean = red16((yv[0] + yv[1]) + (yv[2] + yv[3])) * (1.0f / 64.0f); const f32x4 d = yv - mean;
        const float var = red16((d[0] * d[0] + d[1] * d[1]) + (d[2] * d[2] + d[3] * d[3])) * (1.0f / 64.0f);
        const f32x4 yn = d * (1.0f / sqrtf(var + GN_EPS)) * lw + lb;
        const f32x4 v1 = vc + (vp - vc) * muv;
        const f32x4 res = (yn + v1 * bc) * g4;
        v2u w; w.x = pk2(res[0], res[1]); w.y = pk2(res[2], res[3]);
        *(v2u*)(ro + o) = w;
    }
}

DI void final_phase(const float* const* in, unsigned char* ws, float* out, int gw, int NGW, int lane) {
    const float* ss3 = (const float*)(ws + SS3_OFF); const float* nf = in[I_NORM_FINAL];
    for (int m = gw; m < M; m += NGW) { const float r = 1.0f / sqrtf(ss3[m] * (1.0f / D) + RMS_EPS);
        GAS f32x4* o = (GAS f32x4*)(out + (size_t)m * D) + lane; const GAS f32x4* g = (const GAS f32x4*)nf + lane;
#pragma unroll 4
        for (int j = 0; j < 16; ++j) { f32x4 v = o[64 * j]; const f32x4 gg = g[64 * j]; v = v * r * gg; o[64 * j] = v; } }
}

#ifndef MK_N_LAUNCHES
#define MK_N_LAUNCHES 1
#endif
constexpr int N_PHASES = 13;
#ifndef REP_P2
#define REP_P2 1
#endif
#ifndef REP_P3
#define REP_P3 1
#endif
#ifndef REP_P6
#define REP_P6 1
#endif
#ifndef REP_P7
#define REP_P7 1
#endif
#ifndef REP_C
#define REP_C 1
#endif
#ifndef PG8_SP2
#define PG8_SP2 true
#endif
#ifndef PG8_ALIGN
#define PG8_ALIGN true
#endif

__global__ void __launch_bounds__(NWAVES * 64, 2) hybrid_fwd(Args args) {
    extern __shared__ __attribute__((aligned(16))) unsigned char lds_raw[];
    LAS unsigned char* lds = (LAS unsigned char*)lds_raw;
    volatile LAS unsigned* MISC = (volatile LAS unsigned*)(lds + MISC_OFF);
    const int wave = __builtin_amdgcn_readfirstlane(threadIdx.x >> 6);
    const int G = gridDim.x, gw = blockIdx.x * NWAVES + wave, NGW = G * NWAVES;
    unsigned char* ws = args.ws; const float* const* in = args.in;
    { const int tid0 = wave * 64 + lane_opaque(); for (int u = tid0; u < (LDS_BYTES - LDSCTL_OFF) / 4; u += NWAVES * 64) ((LAS unsigned*)(lds + LDSCTL_OFF))[u] = 0u; }
    __syncthreads();
    unsigned* ctl = (unsigned*)(ws + WS_CTL);
    XcdBarrier bar; bar.bar = ctl + CW_BAR; bar.x = 0; bar.st = nullptr;
    const bool multi = (args.ph_hi - args.ph_lo) > 1;
    if (multi) bar = xcd_barrier_post(ctl + CW_BAR, MISC + 8, wave == 0 && lane_opaque() == 0);
    const int lo = args.ph_lo, hi = args.ph_hi;
#ifndef PHASE_MASK
#define PHASE_MASK 0x3fff
#endif
#define IN(k) ((((PHASE_MASK) >> (k)) & 1) && lo <= (k) && (k) < hi)
#define SEAM(k) do { if (IN(k) && IN((k) + 1)) xcd_barrier(bar, wave == 0 && lane_opaque() == 0); } while (0)
#define LANE lane_opaque()
    LAS float* scr = (LAS float*)(lds + RING_OFF + wave * 16384);

    if (IN(0)) { const int lane = LANE; for (int rep = 0; rep < REP_C; ++rep) { convert_set_a(in, ws, scr, gw, NGW, lane); prologue_rows(in, ws, gw, NGW, lane); } }
    SEAM(0);
    if (IN(1)) {
        pg8::Gemm g{(const bf16*)(ws + WS_XB), (const bf16*)(ws + WS_WCAT), M, NCAT, D}; pg8::StaticOrder S; S.init(M, NCAT, G, (int)blockIdx.x);
        epi::InProj E{(bf16*)(ws + WS_Q), (bf16*)(ws + WS_K), (bf16*)(ws + WS_V), (bf16*)(ws + WS_QI), (bf16*)(ws + WS_KI), (bf16*)(ws + WS_RB), (bf16*)(ws + WS_KB), (bf16*)(ws + WS_VB),
                      (bf16*)(ws + WS_LORA), (bf16*)(ws + WS_GATES), (float*)(ws + WS_WI), (const float*)(ws + WS_RSTDX), (const float*)(ws + WS_RCOS), (const float*)(ws + WS_RSIN)};
        pg8::gemm_phase<epi::InProj, pg8::StaticOrder, PG8_ALIGN, PG8_SP2>(lds + RING_OFF, g, S, E, wave);
    }
    SEAM(1);
    if (IN(2)) { for (int rep = 0; rep < REP_P2; ++rep) indexer_phase(ws, lds + RING_OFF, wave); }
    SEAM(2);
    if (IN(3)) { for (int rep = 0; rep < REP_P3; ++rep) attn_phase(ws, lds + RING_OFF, wave, LANE); }
    SEAM(3);
    if (IN(4)) build_alora(ws, blockIdx.x * (NWAVES * 64) + wave * 64 + LANE, G * NWAVES * 64);
    SEAM(4);
    if (IN(5)) {
        int k256 = 256; asm volatile("" : "+s"(k256));
        pg8::Gemm g{(const bf16*)(ws + WS_ALORA), (const bf16*)(ws + WS_WL2), 3 * M, 3 * DB, k256}; epi::Stack3Order S{G, (int)blockIdx.x};
        epi::LoraUp E{(float*)(ws + WS_DECAY), (bf16*)(ws + WS_AOUT), (bf16*)(ws + WS_GOUT), in[I_W0], in[I_A0]};
        pg8::gemm_phase<epi::LoraUp, epi::Stack3Order, PG8_ALIGN, PG8_SP2>(lds + RING_OFF, g, S, E, wave);
    }
    SEAM(5);
    if (IN(6)) { for (int rep = 0; rep < REP_P6; ++rep) scan_phase(in, ws, lds + RING_OFF, wave, LANE); }
    SEAM(6);
    if (IN(7)) { for (int rep = 0; rep < REP_P7; ++rep) gn_phase(in, ws, gw, NGW, LANE); }
    if (IN(7)) { const int lane = LANE; __syncthreads(); for (int rep = 0; rep < REP_C; ++rep) convert_set_b(in, ws, scr, gw, NGW, lane); }
    SEAM(7);
    if (IN(8)) {
        pg8::Gemm g{(const bf16*)(ws + WS_AO), (const bf16*)(ws + WS_WPAB), 2 * M, 2 * D, DA}; epi::ChainOrder S; S.so.init(M, D, G, (int)blockIdx.x);
        epi::GateMix E{(const bf16*)(ws + WS_GATES), in[I_BGATE], (bf16*)(ws + WS_MIX)};
        pg8::gemm_phase<epi::GateMix, epi::ChainOrder, PG8_ALIGN, PG8_SP2>(lds + RING_OFF, g, S, E, wave);
    }
    SEAM(8);
    if (IN(9)) {
        pg8::Gemm g{(const bf16*)(ws + WS_MIX), (const bf16*)(ws + WS_WO), M, D, D}; pg8::StaticOrder S; S.init(M, D, G, (int)blockIdx.x);
        epi::Resid E{in[I_X], args.out, (bf16*)(ws + WS_H1B), (float*)(ws + SS1_OFF)};
        pg8::gemm_phase<epi::Resid, pg8::StaticOrder, PG8_ALIGN, PG8_SP2>(lds + RING_OFF, g, S, E, wave);
    }
    SEAM(9);
    if (IN(10)) {
        pg8::Gemm g{(const bf16*)(ws + WS_H1B), (const bf16*)(ws + WS_W13), M, N13, D}; pg8::StaticOrder S; S.init(M, N13, G, (int)blockIdx.x);
        epi::FfnUp E{(const float*)(ws + SS1_OFF), (bf16*)(ws + WS_U)};
        pg8::gemm_phase<epi::FfnUp, pg8::StaticOrder, PG8_ALIGN, PG8_SP2>(lds + RING_OFF, g, S, E, wave);
    }
    SEAM(10);
    if (IN(11)) {
        { pg8::Gemm g{(const bf16*)(ws + WS_U), (const bf16*)(ws + WS_W2), M, D, DFF}; pg8::StaticOrder S; S.init(M, D, G, (int)blockIdx.x);
          epi::Resid E{args.out, args.out, (bf16*)(ws + WS_H2B), (float*)(ws + SS2_OFF)};
          pg8::gemm_phase<epi::Resid, pg8::StaticOrder, PG8_ALIGN, PG8_SP2>(lds + RING_OFF, g, S, E, wave); }
        { int k256 = 256; asm volatile("" : "+s"(k256));
          pg8::Gemm g{(const bf16*)(ws + WS_PB), (const bf16*)(ws + WS_WPLE), M, D, k256}; pg8::StaticOrder S; S.init(M, D, G, (int)blockIdx.x);
          epi::StoreBf E{(bf16*)(ws + WS_PP), D};
          pg8::gemm_phase<epi::StoreBf, pg8::StaticOrder, PG8_ALIGN, PG8_SP2>(lds + RING_OFF, g, S, E, wave); }
    }
    SEAM(11);
    if (IN(12)) {
        pg8::Gemm g{(const bf16*)(ws + WS_H2B), (const bf16*)(ws + WS_WPG), M, D, D}; pg8::StaticOrder S; S.init(M, D, G, (int)blockIdx.x);
        epi::PleGate E{args.out, (const bf16*)(ws + WS_PP), (const float*)(ws + SS2_OFF), (float*)(ws + SS3_OFF)};
        pg8::gemm_phase<epi::PleGate, pg8::StaticOrder, PG8_ALIGN, PG8_SP2>(lds + RING_OFF, g, S, E, wave);
    }
    SEAM(12);
    if (IN(13)) final_phase(in, ws, args.out, gw, NGW, LANE);
#undef IN
#undef SEAM
#undef LANE
}

extern "C" void kernel_launch(void* const* d_in, const int* in_sizes, int n_in, void* d_out, int out_size, void* d_ws, size_t ws_size, hipStream_t stream) {
    static int grid = 0;
    if (grid == 0) {
        if (n_in != 32 || in_sizes[0] != M * D || out_size != M * D || ws_size < WS_END) { fprintf(stderr, "kernel_launch: unexpected shapes: n_in %d in0 %d out %d ws %zu (need %zu)\n", n_in, n_in > 0 ? in_sizes[0] : -1, out_size, ws_size, (size_t)WS_END); grid = -1; return; }
        int dev = 0, cus = 0, per_cu = 0;
        if (hipGetDevice(&dev) != hipSuccess || hipDeviceGetAttribute(&cus, hipDeviceAttributeMultiprocessorCount, dev) != hipSuccess) { grid = -1; return; }
        if (hipFuncSetAttribute((const void*)hybrid_fwd, hipFuncAttributeMaxDynamicSharedMemorySize, LDS_BYTES) != hipSuccess) { fprintf(stderr, "kernel_launch: hipFuncSetAttribute failed\n"); grid = -1; return; }
        if (hipOccupancyMaxActiveBlocksPerMultiprocessor(&per_cu, (const void*)hybrid_fwd, NWAVES * 64, LDS_BYTES) != hipSuccess || per_cu < 1) fprintf(stderr, "kernel_launch: occupancy query says %d\n", per_cu);
        (void)hipGetLastError();
        grid = cus;
    }
    if (grid < 0) return;
    if (hipMemsetAsync((char*)d_ws + WS_CTL, 0, CTL_ZERO_BYTES, stream) != hipSuccess) return;
    Args a{};
    for (int i = 0; i < 32; ++i) a.in[i] = (const float*)d_in[i];
    a.out = (float*)d_out; a.ws = (unsigned char*)d_ws;
#if MK_N_LAUNCHES == 1
    a.ph_lo = 0; a.ph_hi = N_PHASES + 1;
    hipLaunchKernelGGL(hybrid_fwd, dim3(grid), dim3(NWAVES * 64), LDS_BYTES, stream, a);
#else
    for (int p = 0; p <= N_PHASES; ++p) { a.ph_lo = p; a.ph_hi = p + 1; hipLaunchKernelGGL(hybrid_fwd, dim3(grid), dim3(NWAVES * 64), LDS_BYTES, stream, a); }
#endif
}
```

```cpp
#include <hip/hip_runtime.h>
#include <cstdio>
#include <cstdint>
__device__ __forceinline__ int lane_opaque() { int l; asm volatile("v_mbcnt_lo_u32_b32 %0, -1, 0\n\tv_mbcnt_hi_u32_b32 %0, -1, %0" : "=v"(l)); return l; }

namespace pg8 {
#define PG8_LAS __attribute__((address_space(3)))
typedef unsigned short bf16_t;
typedef short bf16x8 __attribute__((ext_vector_type(8)));
typedef float f32x4 __attribute__((ext_vector_type(4)));
typedef unsigned u32x4 __attribute__((ext_vector_type(4)));
constexpr int BM = 256, BK = 64, HALF = 128, HTB = HALF * BK * 2  , STAGE_BYTES = 8 * HTB, NXCD = 8, WGM = 8;

__host__ __device__ __forceinline__ int lds_byte(int r, int c) { const int st = (r >> 4) * 2 + (c >> 5), rr = r & 15, cc = c & 31, ob = rr * 64 + cc * 2; return st * 1024 + (ob ^ (((ob >> 9) & 1) << 5)); }
__host__ __device__ __forceinline__ void stage_rc(int b, int& R, int& C) { const int st = b / 1024, sb = b % 1024, swz = sb ^ (((sb >> 9) & 1) << 5); R = (st >> 1) * 16 + swz / 64; C = (st & 1) * 32 + (swz % 64) / 2; }
__host__ __device__ __forceinline__ int perm32(int rho) { const int n = rho >> 4, i = rho & 15; return 8 * (i >> 2) + 4 * n + (i & 3); }

struct Unit { int pm, pn; };
struct Gemm { const bf16_t* A; const bf16_t* Bt; int M, N, K; };

struct StaticOrder {
    int nM, nN, nwg, G, c;
    __host__ __device__ void init(int M, int N, int G_, int c_) { nM = M / BM; nN = N / BM; nwg = nM * nN; G = G_; c = c_; }
    __host__ __device__ bool next(int i, Unit& u) const {
        const long L = (long)i * G + c; if (L >= nwg) return false;
        int wgid = (int)L; { const int q = nwg / NXCD, r = nwg % NXCD, xcd = wgid % NXCD, off = wgid / NXCD; wgid = (xcd < r ? xcd * (q + 1) : r * (q + 1) + (xcd - r) * q) + off; }
        const int nig = WGM * nN, gid = wgid / nig, fm = gid * WGM, gsz = (nM - fm) < WGM ? (nM - fm) : WGM;
        u.pm = fm + ((wgid % nig) % gsz); u.pn = (wgid % nig) / gsz; return true;
    }
    __device__ __forceinline__ void a_ready(const Unit&) const {}
    __device__ __forceinline__ void done(const Unit&) const {}
};
__device__ __forceinline__ unsigned cvt_pk_bf16(float lo, float hi) { unsigned r; asm volatile("v_cvt_pk_bf16_f32 %0, %1, %2" : "=v"(r) : "v"(lo), "v"(hi)); return r; }
template <class Epi, class Sched, bool ALIGN_EPI = false, bool SP2 = false>
__device__ __forceinline__ void gemm_phase(PG8_LAS unsigned char* lds, const Gemm g, const Sched& S, const Epi& E, const int wid) {
    const int lane = lane_opaque(), tid = wid * 64 + lane, wr = wid >> 2, wc = wid & 3, fr = lane & 15, fq = lane >> 4;
    const int K = g.K, nt = K / BK;
    unsigned voffA[2], voffB[2];
#pragma unroll
    for (int i = 0; i < 2; ++i) { int R, C; stage_rc(tid * 16 + i * 8192, R, C); const int Rb = Epi::PERM ? ((R & ~31) + perm32(R & 31)) : R;
        voffA[i] = (unsigned)(R * K + C) * 2u; voffB[i] = (unsigned)(Rb * K + C) * 2u; }
    const size_t kstep = (size_t)(BK * 2);
    const size_t hstep = (size_t)HALF * K * 2;
    const size_t tstep = 2 * hstep;
    const unsigned ldsw = (unsigned)wid * 1024u;
    const int aoff = lds_byte(wr * 64 + fr, fq * 8), boff = lds_byte(wc * 32 + fr, fq * 8);
#define PG8_SA(b, h) (((b) * 2 + (h)) * HTB)
#define PG8_SB(b, h) ((4 + (b) * 2 + (h)) * HTB)
#define PG8_STAGE(bufoff, gbase, voff) do { _Pragma("unroll") for (int _i = 0; _i < 2; ++_i) \
        __builtin_amdgcn_global_load_lds((const unsigned*)((const char*)(gbase) + (voff)[_i]), (PG8_LAS unsigned*)(lds + (bufoff) + ldsw + _i * 8192), 16, 0, 0); } while (0)
#define PG8_LDA(dst, b, h) do { _Pragma("unroll") for (int m = 0; m < 4; ++m) _Pragma("unroll") for (int k = 0; k < 2; ++k) dst[m][k] = *(const PG8_LAS bf16x8*)(lds + PG8_SA(b, h) + aoff + m * 2048 + k * 1024); } while (0)
#define PG8_LDB(dst, b, h) do { _Pragma("unroll") for (int n = 0; n < 2; ++n) _Pragma("unroll") for (int k = 0; k < 2; ++k) dst[n][k] = *(const PG8_LAS bf16x8*)(lds + PG8_SB(b, h) + boff + n * 2048 + k * 1024); } while (0)
#define PG8_MMA(ai, bj, At, Bt) do { __builtin_amdgcn_s_setprio(1); _Pragma("unroll") for (int m = 0; m < 4; ++m) _Pragma("unroll") for (int n = 0; n < 2; ++n) _Pragma("unroll") for (int k = 0; k < 2; ++k) \
        acc[ai][bj][m][n] = __builtin_amdgcn_mfma_f32_16x16x32_bf16(Bt[n][k], At[m][k], acc[ai][bj][m][n], 0, 0, 0); __builtin_amdgcn_s_setprio(0); } while (0)
#define PG8_WAIT_V(n) asm volatile("s_waitcnt vmcnt(" #n ")" ::: "memory")
#define PG8_WAIT_L(n) asm volatile("s_waitcnt lgkmcnt(" #n ")" ::: "memory")
#define PG8_BAR __builtin_amdgcn_s_barrier()
#define PG8_SCHED __builtin_amdgcn_sched_barrier(0)
    Unit cur, nxt; int ui = 0;
    if (!S.next(0, cur)) return;
    f32x4 acc[2][2][4][2];
#pragma unroll
    for (int a = 0; a < 2; ++a)
#pragma unroll
        for (int b = 0; b < 2; ++b)
#pragma unroll
            for (int m = 0; m < 4; ++m)
#pragma unroll
                for (int n = 0; n < 2; ++n) acc[a][b][m][n] = (f32x4){0.f, 0.f, 0.f, 0.f};
    bf16x8 At[4][2], B0[2][2], B1[2][2];
    const char* cA = (const char*)g.A + (size_t)cur.pm * tstep; const char* cB = (const char*)g.Bt + (size_t)cur.pn * tstep;
    S.a_ready(cur);
    if constexpr (SP2) {
        PG8_STAGE(PG8_SB(0, 0), cB, voffB); PG8_STAGE(PG8_SB(0, 1), cB + hstep, voffB); PG8_STAGE(PG8_SA(0, 0), cA, voffA); PG8_STAGE(PG8_SA(0, 1), cA + hstep, voffA);
        if (wr == 1) PG8_BAR;
        PG8_WAIT_V(2); PG8_BAR;
        PG8_STAGE(PG8_SB(1, 0), cB + kstep, voffB); PG8_STAGE(PG8_SA(1, 0), cA + kstep, voffA); PG8_STAGE(PG8_SB(1, 1), cB + hstep + kstep, voffB);
        PG8_WAIT_V(6); PG8_BAR;
    } else {
        PG8_STAGE(PG8_SB(0, 0), cB, voffB); PG8_STAGE(PG8_SA(0, 0), cA, voffA); PG8_STAGE(PG8_SB(0, 1), cB + hstep, voffB); PG8_STAGE(PG8_SA(0, 1), cA + hstep, voffA);
        if (wr == 1) PG8_BAR;
        PG8_WAIT_V(4); PG8_BAR;
        PG8_STAGE(PG8_SB(1, 0), cB + kstep, voffB); PG8_STAGE(PG8_SA(1, 0), cA + kstep, voffA); PG8_STAGE(PG8_SB(1, 1), cB + hstep + kstep, voffB);
        PG8_WAIT_V(6); PG8_BAR;
    }
    for (;;) {
        const bool has_next = S.next(ui + 1, nxt);
        const char* nA = has_next ? (const char*)g.A + (size_t)nxt.pm * tstep : cA; const char* nB = has_next ? (const char*)g.Bt + (size_t)nxt.pn * tstep : cB;
        for (int t = 0; t < nt; t += 2) {
            const bool last = (t == nt - 2);
            const char* a1 = cA + (size_t)(t + 1) * kstep;
            const char* a2 = last ? nA : cA + (size_t)(t + 2) * kstep; const char* b2 = last ? nB : cB + (size_t)(t + 2) * kstep;
            const char* a3 = a2 + kstep; const char* b3 = b2 + kstep;
            if (last && has_next) S.a_ready(nxt);
            if constexpr (SP2) {
            PG8_LDB(B0, 0, 0); PG8_LDB(B1, 0, 1); PG8_SCHED; PG8_LDA(At, 0, 0); PG8_STAGE(PG8_SA(1, 1), a1 + hstep, voffA);
            PG8_WAIT_V(8); PG8_WAIT_L(0); PG8_BAR; PG8_MMA(0, 0, At, B0); PG8_MMA(0, 1, At, B1); PG8_BAR; PG8_SCHED;
            PG8_LDA(At, 0, 1); PG8_STAGE(PG8_SB(0, 0), b2, voffB); PG8_STAGE(PG8_SB(0, 1), b2 + hstep, voffB); PG8_STAGE(PG8_SA(0, 0), a2, voffA);
            PG8_WAIT_V(8); PG8_WAIT_L(0); PG8_BAR; PG8_MMA(1, 0, At, B0); PG8_MMA(1, 1, At, B1); PG8_BAR; PG8_SCHED;
            PG8_LDB(B0, 1, 0); PG8_LDB(B1, 1, 1); PG8_SCHED; PG8_LDA(At, 1, 0); PG8_STAGE(PG8_SA(0, 1), a2 + hstep, voffA);
            PG8_WAIT_V(8); PG8_WAIT_L(0); PG8_BAR; PG8_MMA(0, 0, At, B0); PG8_MMA(0, 1, At, B1); PG8_BAR; PG8_SCHED;
            PG8_LDA(At, 1, 1); PG8_STAGE(PG8_SB(1, 0), b3, voffB); PG8_STAGE(PG8_SB(1, 1), b3 + hstep, voffB); PG8_STAGE(PG8_SA(1, 0), a3, voffA);
            PG8_WAIT_V(8); PG8_WAIT_L(0); PG8_BAR; PG8_MMA(1, 0, At, B0); PG8_MMA(1, 1, At, B1); PG8_BAR; PG8_SCHED;
            } else {
            PG8_LDB(B0, 0, 0); PG8_SCHED; PG8_LDA(At, 0, 0); PG8_STAGE(PG8_SA(1, 1), a1 + hstep, voffA);
            PG8_WAIT_L(8); PG8_BAR; PG8_WAIT_L(0); PG8_MMA(0, 0, At, B0); PG8_BAR; PG8_SCHED;
            PG8_LDB(B1, 0, 1); PG8_STAGE(PG8_SB(0, 0), b2, voffB);
            PG8_BAR; PG8_WAIT_L(0); PG8_MMA(0, 1, At, B1); PG8_BAR;
            PG8_LDA(At, 0, 1); PG8_STAGE(PG8_SA(0, 0), a2, voffA);
            PG8_BAR; PG8_WAIT_L(0); PG8_MMA(1, 0, At, B0); PG8_BAR; PG8_SCHED;
            PG8_STAGE(PG8_SB(0, 1), b2 + hstep, voffB);
            PG8_WAIT_V(6); PG8_BAR; PG8_MMA(1, 1, At, B1); PG8_BAR;
            PG8_LDB(B0, 1, 0); PG8_SCHED; PG8_LDA(At, 1, 0); PG8_STAGE(PG8_SA(0, 1), a2 + hstep, voffA);
            PG8_WAIT_L(8); PG8_BAR; PG8_WAIT_L(0); PG8_MMA(0, 0, At, B0); PG8_BAR; PG8_SCHED;
            PG8_LDB(B1, 1, 1); PG8_STAGE(PG8_SB(1, 0), b3, voffB);
            PG8_BAR; PG8_WAIT_L(0); PG8_MMA(0, 1, At, B1); PG8_BAR;
            PG8_LDA(At, 1, 1); PG8_STAGE(PG8_SA(1, 0), a3, voffA);
            PG8_BAR; PG8_WAIT_L(0); PG8_MMA(1, 0, At, B0); PG8_BAR; PG8_SCHED;
            PG8_STAGE(PG8_SB(1, 1), b3 + hstep, voffB);
            PG8_WAIT_V(6); PG8_BAR; PG8_MMA(1, 1, At, B1); PG8_BAR;
            }
        }
        if constexpr (ALIGN_EPI) { if (wr == 0) PG8_BAR; }
        if constexpr (!Epi::AFTER_DRAIN) { E(acc, cur, wr, wc, fr, fq); S.done(cur); }
        if (!has_next) break;
        if (!Epi::CHAIN || !E.keep(cur)) {
#pragma unroll
        for (int a = 0; a < 2; ++a)
#pragma unroll
            for (int b = 0; b < 2; ++b)
#pragma unroll
                for (int m = 0; m < 4; ++m)
#pragma unroll
                    for (int n = 0; n < 2; ++n) acc[a][b][m][n] = (f32x4){0.f, 0.f, 0.f, 0.f};
        }
        cur = nxt; cA = nA; cB = nB; ++ui;
        if constexpr (ALIGN_EPI) { if (wr == 1) PG8_BAR; }
    }
    PG8_WAIT_V(0);
    if constexpr (!ALIGN_EPI) { if (wr == 0) PG8_BAR; }
    PG8_BAR;
    if constexpr (Epi::AFTER_DRAIN) { E.fused(acc, cur, wr, wc, fr, fq, lds, wid, lane); S.done(cur); }
#undef PG8_SA
#undef PG8_SB
#undef PG8_STAGE
#undef PG8_LDA
#undef PG8_LDB
#undef PG8_MMA
#undef PG8_WAIT_V
#undef PG8_WAIT_L
#undef PG8_BAR
#undef PG8_SCHED
}
}

#define LAS __attribute__((address_space(3)))
#define XB_TMO      128
#define XB_XCNT(j)  (256  + 64 * (j))
#define XB_XSUB(j)  (1280 + 64 * (j))
#define XB_XGEN(j)  (2304 + 64 * (j))
#define XB_TOP      3328
#define XB_TOPGEN   3392
#define XCD_BAR_WORDS 3456
#define XB_SPIN_CAP (1u << 18)

__device__ __forceinline__ unsigned xb_ld(unsigned* p)              { return __hip_atomic_load(p, __ATOMIC_RELAXED, __HIP_MEMORY_SCOPE_AGENT); }
__device__ __forceinline__ unsigned xb_add(unsigned* p, unsigned v) { return __hip_atomic_fetch_add(p, v, __ATOMIC_RELAXED, __HIP_MEMORY_SCOPE_AGENT); }
__device__ __forceinline__ unsigned xb_xcc_id() { return (unsigned)__builtin_amdgcn_s_getreg((3 << 11) | 20) & 0xFu; }
#define XB_SPIN(cond, bar) do { unsigned _sp = 0; while (cond) { __builtin_amdgcn_s_sleep(1); \
    if ((++_sp & 255u) == 0u) { if (xb_ld(&(bar)[XB_TMO])) break; if (_sp > XB_SPIN_CAP) { atomicAdd(&(bar)[XB_TMO], 1u); break; } } } } while (0)

struct XcdBarrier {
    unsigned* bar; unsigned x;
    volatile LAS unsigned* st;
};

__device__ __forceinline__ XcdBarrier xcd_barrier_post(unsigned* bar, volatile LAS unsigned* st, const bool leader  ) {
    XcdBarrier b; b.bar = bar; b.x = xb_xcc_id(); b.st = st;
    if (leader) (void)xb_add(&bar[XB_XCNT(b.x)], 1u);
    return b;
}
__device__ __forceinline__ void xcd_barrier_complete(unsigned* bar, unsigned x, unsigned& nloc, unsigned& nx) {
    const unsigned G = gridDim.x * gridDim.y * gridDim.z;
    unsigned sum, cnt, mine, sp = 0u;
    for (;;) {
        sum = 0u; cnt = 0u; mine = 0u;
#pragma unroll
        for (unsigned j = 0; j < 16; ++j) { const unsigned c = xb_ld(&bar[XB_XCNT(j)]); sum += c; cnt += (c > 0u) ? 1u : 0u; mine = (j == x) ? c : mine; }
        if (sum == G) break;
        __builtin_amdgcn_s_sleep(1);
        if ((++sp & 255u) == 0u) { if (xb_ld(&bar[XB_TMO])) break; if (sp > XB_SPIN_CAP) { atomicAdd(&bar[XB_TMO], 1u); break; } }
    }
    nloc = mine > 0u ? mine : 1u; nx = cnt > 0u ? cnt : 1u;
}

__device__ __forceinline__ void xcd_barrier(const XcdBarrier& b, const bool leader  ) {
    asm volatile("s_waitcnt vmcnt(0)" ::: "memory");
    __syncthreads();
    if (leader) {
        unsigned* bar = b.bar;
        __builtin_amdgcn_s_waitcnt(0);
        unsigned nloc = b.st[0], nx = b.st[1];
        if (nloc == 0u) { xcd_barrier_complete(bar, b.x, nloc, nx); b.st[0] = nloc; b.st[1] = nx; }
        const unsigned old = xb_add(&bar[XB_XSUB(b.x)], 1u);
        const unsigned gen = old / nloc;
        if (old + 1u == (gen + 1u) * nloc) {
            __builtin_amdgcn_fence(__ATOMIC_RELEASE, "agent");
            asm volatile("s_waitcnt vmcnt(0)" ::: "memory");
            const unsigned og = xb_add(&bar[XB_TOP], 1u);
            const unsigned tg = og / nx;
            if (og + 1u == (tg + 1u) * nx) xb_add(&bar[XB_TOPGEN], 1u);
            else XB_SPIN(xb_ld(&bar[XB_TOPGEN]) == tg, bar);
            __builtin_amdgcn_fence(__ATOMIC_ACQUIRE, "agent");
            xb_add(&bar[XB_XGEN(b.x)], 1u);
            asm volatile("s_waitcnt vmcnt(0)" ::: "memory");
        } else {
            XB_SPIN(xb_ld(&bar[XB_XGEN(b.x)]) == gen, bar);
            __builtin_amdgcn_fence(__ATOMIC_ACQUIRE, "agent");
            asm volatile("s_waitcnt vmcnt(0)" ::: "memory");
        }
    }
    __syncthreads();
}

constexpr int BATCH = 2, SEQ = 8192, M = BATCH * SEQ, D = 4096;
constexpr int DA = 2048, KVD = 512, DIQ = 2048, HDI = 128, NHI = 16, DB = 2048, NHB = 32, HDB = 64;
constexpr int DIN = 11408, DFF = 11008, DPLE = 256, TOPK = 256;
constexpr int NCAT = 81 * 256;
constexpr int N13 = 2 * DFF;
constexpr int LORA_LD = 1024;
constexpr float RMS_EPS = 1e-6f, GN_EPS = 64e-5f;

#define GAS __attribute__((address_space(1)))
typedef unsigned short bf16;
typedef unsigned v4u __attribute__((ext_vector_type(4)));
typedef unsigned v2u __attribute__((ext_vector_type(2)));
typedef float f32x4 __attribute__((ext_vector_type(4)));
typedef float f32x16 __attribute__((ext_vector_type(16)));
typedef float f32x2 __attribute__((ext_vector_type(2)));
typedef short bf16x8 __attribute__((ext_vector_type(8)));
typedef GAS unsigned gu32;
#define RLX_AGENT __ATOMIC_RELAXED, __HIP_MEMORY_SCOPE_AGENT
#define LDS_WAIT() asm volatile("s_waitcnt lgkmcnt(0)" ::: "memory")
#define VM_WAIT() asm volatile("s_waitcnt vmcnt(0)" ::: "memory")
#define DI __device__ __forceinline__

DI unsigned f2bf(float f) { unsigned u = __builtin_bit_cast(unsigned, f); return (u + 0x7fffu + ((u >> 16) & 1u)) >> 16; }
DI unsigned pk2(float lo, float hi) { return f2bf(lo) | (f2bf(hi) << 16); }
DI float bf_lo(unsigned w) { return __builtin_bit_cast(float, w << 16); }
DI float bf_hi(unsigned w) { return __builtin_bit_cast(float, w & 0xffff0000u); }
DI float bf2f(bf16 h) { return __builtin_bit_cast(float, ((unsigned)h) << 16); }
DI float sigmoidf_(float z) { return 1.0f / (1.0f + __expf(-z)); }
DI float wave_sum(float v) {
#pragma unroll
    for (int o = 1; o < 64; o <<= 1) v += __shfl_xor(v, o);
    return v;
}

namespace epi {
using pg8::Unit; using pg8::BM; using pg8::HALF; using pg8::cvt_pk_bf16;
typedef pg8::f32x4 f4;
DI v4u pack8(const f4& a, const f4& b) { v4u w; w.x = cvt_pk_bf16(a[0], a[1]); w.y = cvt_pk_bf16(a[2], a[3]); w.z = cvt_pk_bf16(b[0], b[1]); w.w = cvt_pk_bf16(b[2], b[3]); return w; }
DI void unpack8(const v4u& w, f4& a, f4& b) { a[0] = bf_lo(w.x); a[1] = bf_hi(w.x); a[2] = bf_lo(w.y); a[3] = bf_hi(w.y); b[0] = bf_lo(w.z); b[1] = bf_hi(w.z); b[2] = bf_lo(w.w); b[3] = bf_hi(w.w); }

struct InProj {
    static constexpr bool PERM = true, AFTER_DRAIN = false, CHAIN = false;
    bf16 *q, *k, *v, *qi, *ki, *rb, *kb, *vb, *lora, *gates; float* wi;
    const float *rstd, *rcos, *rsin;
    DI bool keep(const Unit&) const { return false; }
    DI void operator()(f4 (&acc)[2][2][4][2], const Unit& u, int wr, int wc, int fr, int fq) const {
        { const int ln_ = lane_opaque(); fr = ln_ & 15; fq = ln_ >> 4; }
        const int pn = u.pn, row0 = u.pm * BM + wr * 64 + fr;
        int kind = 0, ld, cb; bf16* dst;
        float rsv[2][4];
#pragma unroll
        for (int ai = 0; ai < 2; ++ai)
#pragma unroll
            for (int m = 0; m < 4; ++m) rsv[ai][m] = rstd[row0 + ai * HALF + m * 16];
        if (pn < 8)       { kind = 1; dst = q;  ld = DA;  cb = pn * 256; }
        else if (pn < 10) { kind = 1; dst = k;  ld = KVD; cb = (pn - 8) * 256; }
        else if (pn < 12) { dst = v;  ld = KVD; cb = (pn - 10) * 256; }
        else if (pn < 20) { kind = 1; dst = qi; ld = DIQ; cb = (pn - 12) * 256; }
        else if (pn == 20){ kind = 2; dst = ki; ld = HDI; cb = 0; }
        else if (pn < 29) { dst = rb; ld = DB; cb = (pn - 21) * 256; }
        else if (pn < 37) { dst = kb; ld = DB; cb = (pn - 29) * 256; }
        else if (pn < 45) { dst = vb; ld = DB; cb = (pn - 37) * 256; }
        else if (pn < 49) { dst = lora; ld = LORA_LD; cb = (pn - 45) * 256; }
        else              { dst = gates; ld = 2 * D; cb = (pn - 49) * 256; }
        if (kind == 0) {
#pragma unroll
            for (int ai = 0; ai < 2; ++ai)
#pragma unroll
                for (int m = 0; m < 4; ++m) { const int row = row0 + ai * HALF + m * 16; const float rs = rsv[ai][m];
#pragma unroll
                    for (int bj = 0; bj < 2; ++bj) *(v4u*)(dst + (size_t)row * ld + cb + bj * HALF + wc * 32 + 8 * fq) = pack8(acc[ai][bj][m][0] * rs, acc[ai][bj][m][1] * rs); }
        } else if (kind == 1 || wc < 2) {
            const int hb = cb + (wc >> 1) * 128, dd0 = (wc & 1) * 32 + 8 * fq;
#pragma unroll
            for (int ai = 0; ai < 2; ++ai)
#pragma unroll
                for (int m = 0; m < 4; ++m) { const int row = row0 + ai * HALF + m * 16; const float rs = rsv[ai][m];
                    const f4 c0 = *(const f4*)(rcos + (size_t)row * 64 + dd0), c1 = *(const f4*)(rcos + (size_t)row * 64 + dd0 + 4);
                    const f4 s0 = *(const f4*)(rsin + (size_t)row * 64 + dd0), s1 = *(const f4*)(rsin + (size_t)row * 64 + dd0 + 4);
                    const f4 a0 = acc[ai][0][m][0] * rs, a1 = acc[ai][0][m][1] * rs, b0 = acc[ai][1][m][0] * rs, b1 = acc[ai][1][m][1] * rs;
                    bf16* p = dst + (size_t)row * ld + hb + dd0;
                    *(v4u*)(p)      = pack8(a0 * c0 - b0 * s0, a1 * c1 - b1 * s1);
                    *(v4u*)(p + 64) = pack8(a0 * s0 + b0 * c0, a1 * s1 + b1 * c1); }
        } else if (wc == 2 && fq < 2) {
#pragma unroll
            for (int ai = 0; ai < 2; ++ai)
#pragma unroll
                for (int m = 0; m < 4; ++m) { const int row = row0 + ai * HALF + m * 16; const float rs = rsv[ai][m] * 0.25f;
                    *(f4*)(wi + (size_t)row * 16 + 8 * fq) = acc[ai][0][m][0] * rs; *(f4*)(wi + (size_t)row * 16 + 8 * fq + 4) = acc[ai][0][m][1] * rs; }
        }
    }
};

struct LoraUp {
    static constexpr bool PERM = true, AFTER_DRAIN = false, CHAIN = false;
    float* decay; bf16 *aout, *gout; const float *w0, *a0;
    DI bool keep(const Unit&) const { return false; }
    DI void operator()(f4 (&acc)[2][2][4][2], const Unit& u, int wr, int wc, int fr, int fq) const {
        { const int ln_ = lane_opaque(); fr = ln_ & 15; fq = ln_ >> 4; }
        const int which = u.pm >> 6, row0 = (u.pm & 63) * BM + wr * 64 + fr, col0 = (u.pn & 7) * BM + wc * 32 + 8 * fq;
        if (which == 0) {
#pragma unroll
            for (int bj = 0; bj < 2; ++bj) { const int col = col0 + bj * HALF; const f4 z0 = *(const f4*)(w0 + col), z1 = *(const f4*)(w0 + col + 4);
#pragma unroll
                for (int ai = 0; ai < 2; ++ai)
#pragma unroll
                    for (int m = 0; m < 4; ++m) { const size_t off = (size_t)(row0 + ai * HALF + m * 16) * DB + col;
                        f4 x0 = acc[ai][bj][m][0] + z0, x1 = acc[ai][bj][m][1] + z1;
#pragma unroll
                        for (int e = 0; e < 4; ++e) { x0[e] = __expf(-0.6065306597126334f * sigmoidf_(x0[e])); x1[e] = __expf(-0.6065306597126334f * sigmoidf_(x1[e])); }
                        *(f4*)(decay + off) = x0; *(f4*)(decay + off + 4) = x1;
                        asm volatile("" ::: "memory"); } }
        } else if (which == 1) {
#pragma unroll
            for (int bj = 0; bj < 2; ++bj) { const int col = col0 + bj * HALF; const f4 z0 = *(const f4*)(a0 + col), z1 = *(const f4*)(a0 + col + 4);
#pragma unroll
                for (int ai = 0; ai < 2; ++ai)
#pragma unroll
                    for (int m = 0; m < 4; ++m) { const size_t off = (size_t)(row0 + ai * HALF + m * 16) * DB + col;
                        f4 x0 = acc[ai][bj][m][0] + z0, x1 = acc[ai][bj][m][1] + z1;
#pragma unroll
                        for (int e = 0; e < 4; ++e) { x0[e] = sigmoidf_(x0[e]); x1[e] = sigmoidf_(x1[e]); }
                        *(v4u*)(aout + off) = pack8(x0, x1);
                        asm volatile("" ::: "memory"); } }
        } else {
#pragma unroll
            for (int bj = 0; bj < 2; ++bj)
#pragma unroll
                for (int ai = 0; ai < 2; ++ai)
#pragma unroll
                    for (int m = 0; m < 4; ++m) *(v4u*)(gout + (size_t)(row0 + ai * HALF + m * 16) * DB + col0 + bj * HALF) = pack8(acc[ai][bj][m][0], acc[ai][bj][m][1]);
        }
    }
};

struct GateMix {
    static constexpr bool PERM = true, AFTER_DRAIN = false, CHAIN = true;
    const bf16* gates; const float* bgate; bf16* mout;
    DI bool keep(const Unit& u) const { return u.pm < 64; }
    DI void operator()(f4 (&acc)[2][2][4][2], const Unit& u, int wr, int wc, int fr, int fq) const {
        { const int ln_ = lane_opaque(); fr = ln_ & 15; fq = ln_ >> 4; }
        const int which = u.pm >> 6, row0 = (u.pm & 63) * BM + wr * 64 + fr, col0 = (u.pn & 15) * BM + wc * 32 + 8 * fq;
#pragma unroll
        for (int bj = 0; bj < 2; ++bj) { const int col = col0 + bj * HALF;
            const f4 ba0 = *(const f4*)(bgate + col), ba1 = *(const f4*)(bgate + col + 4), bb0 = *(const f4*)(bgate + D + col), bb1 = *(const f4*)(bgate + D + col + 4);
#pragma unroll
            for (int ai = 0; ai < 2; ++ai)
#pragma unroll
                for (int m = 0; m < 4; ++m) { const int row = row0 + ai * HALF + m * 16;
                    f4 zb0, zb1; unpack8(*(const v4u*)(gates + (size_t)row * (2 * D) + D + col), zb0, zb1); zb0 += bb0; zb1 += bb1;
                    if (which == 0) {
                        f4 za0, za1; unpack8(*(const v4u*)(gates + (size_t)row * (2 * D) + col), za0, za1); za0 += ba0; za1 += ba1;
#pragma unroll
                        for (int e = 0; e < 4; ++e) {
                            acc[ai][bj][m][0][e] *= (1.0f + __expf(-zb0[e])) / (1.0f + __expf(-za0[e]));
                            acc[ai][bj][m][1][e] *= (1.0f + __expf(-zb1[e])) / (1.0f + __expf(-za1[e])); }
                    } else {
                        f4 o0, o1;
#pragma unroll
                        for (int e = 0; e < 4; ++e) { o0[e] = acc[ai][bj][m][0][e] * sigmoidf_(zb0[e]); o1[e] = acc[ai][bj][m][1][e] * sigmoidf_(zb1[e]); }
                        *(v4u*)(mout + (size_t)row * D + col) = pack8(o0, o1);
                    } } }
    }
};

struct Resid {
    static constexpr bool PERM = true, AFTER_DRAIN = false, CHAIN = false;
    const float* base; float* out; bf16* outb; float* ss;
    DI bool keep(const Unit&) const { return false; }
    DI void operator()(f4 (&acc)[2][2][4][2], const Unit& u, int wr, int wc, int fr, int fq) const {
        { const int ln_ = lane_opaque(); fr = ln_ & 15; fq = ln_ >> 4; }
        const int row0 = u.pm * BM + wr * 64 + fr, col0 = u.pn * BM + wc * 32 + 8 * fq;
#pragma unroll
        for (int ai = 0; ai < 2; ++ai)
#pragma unroll
            for (int m = 0; m < 4; ++m) { const int row = row0 + ai * HALF + m * 16; float s = 0.f;
#pragma unroll
                for (int bj = 0; bj < 2; ++bj) { const size_t off = (size_t)row * D + col0 + bj * HALF;
                    const f4 h0 = *(const f4*)(base + off) + acc[ai][bj][m][0], h1 = *(const f4*)(base + off + 4) + acc[ai][bj][m][1];
                    *(f4*)(out + off) = h0; *(f4*)(out + off + 4) = h1; *(v4u*)(outb + off) = pack8(h0, h1);
                    s += (h0[0] * h0[0] + h0[1] * h0[1]) + (h0[2] * h0[2] + h0[3] * h0[3]) + (h1[0] * h1[0] + h1[1] * h1[1]) + (h1[2] * h1[2] + h1[3] * h1[3]); }
                s += __shfl_xor(s, 16); s += __shfl_xor(s, 32);
                if (fq == 0) atomicAdd(ss + row, s); }
    }
};

struct FfnUp {
    static constexpr bool PERM = true, AFTER_DRAIN = false, CHAIN = false;
    const float* ss; bf16* uout;
    DI bool keep(const Unit&) const { return false; }
    DI void operator()(f4 (&acc)[2][2][4][2], const Unit& u, int wr, int wc, int fr, int fq) const {
        { const int ln_ = lane_opaque(); fr = ln_ & 15; fq = ln_ >> 4; }
        const int row0 = u.pm * BM + wr * 64 + fr, col0 = u.pn * HALF + wc * 32 + 8 * fq;
        float rr[2][4];
#pragma unroll
        for (int ai = 0; ai < 2; ++ai)
#pragma unroll
            for (int m = 0; m < 4; ++m) rr[ai][m] = ss[row0 + ai * HALF + m * 16];
#pragma unroll
        for (int ai = 0; ai < 2; ++ai)
#pragma unroll
            for (int m = 0; m < 4; ++m) { const int row = row0 + ai * HALF + m * 16; const float r = __builtin_amdgcn_rsqf(rr[ai][m] * (1.0f / D) + RMS_EPS);
                f4 o0, o1;
#pragma unroll
                for (int e = 0; e < 4; ++e) { const float a0 = acc[ai][0][m][0][e] * r, a1 = acc[ai][0][m][1][e] * r;
                    o0[e] = a0 * sigmoidf_(a0) * (acc[ai][1][m][0][e] * r); o1[e] = a1 * sigmoidf_(a1) * (acc[ai][1][m][1][e] * r); }
                *(v4u*)(uout + (size_t)row * DFF + col0) = pack8(o0, o1); }
    }
};

struct StoreBf {
    static constexpr bool PERM = true, AFTER_DRAIN = false, CHAIN = false;
    bf16* o; int ld;
    DI bool keep(const Unit&) const { return false; }
    DI void operator()(f4 (&acc)[2][2][4][2], const Unit& u, int wr, int wc, int fr, int fq) const {
        { const int ln_ = lane_opaque(); fr = ln_ & 15; fq = ln_ >> 4; }
        const int row0 = u.pm * BM + wr * 64 + fr, col0 = u.pn * BM + wc * 32 + 8 * fq;
#pragma unroll
        for (int ai = 0; ai < 2; ++ai)
#pragma unroll
            for (int m = 0; m < 4; ++m)
#pragma unroll
                for (int bj = 0; bj < 2; ++bj) *(v4u*)(o + (size_t)(row0 + ai * HALF + m * 16) * ld + col0 + bj * HALF) = pack8(acc[ai][bj][m][0], acc[ai][bj][m][1]);
    }
};

struct PleGate {
    static constexpr bool PERM = true, AFTER_DRAIN = false, CHAIN = false;
    float* h; const bf16* pp; const float* ss_in; float* ss_out;
    DI bool keep(const Unit&) const { return false; }
    DI void operator()(f4 (&acc)[2][2][4][2], const Unit& u, int wr, int wc, int fr, int fq) const {
        { const int ln_ = lane_opaque(); fr = ln_ & 15; fq = ln_ >> 4; }
        const int row0 = u.pm * BM + wr * 64 + fr, col0 = u.pn * BM + wc * 32 + 8 * fq;
#pragma unroll
        for (int ai = 0; ai < 2; ++ai)
#pragma unroll
            for (int m = 0; m < 4; ++m) { const int row = row0 + ai * HALF + m * 16; const float r = __builtin_amdgcn_rsqf(ss_in[row] * (1.0f / D) + RMS_EPS); float s = 0.f;
#pragma unroll
                for (int bj = 0; bj < 2; ++bj) { const size_t off = (size_t)row * D + col0 + bj * HALF;
                    f4 p0, p1; unpack8(*(const v4u*)(pp + off), p0, p1);
                    f4 h0 = *(const f4*)(h + off), h1 = *(const f4*)(h + off + 4);
#pragma unroll
                    for (int e = 0; e < 4; ++e) { h0[e] += sigmoidf_(acc[ai][bj][m][0][e] * r) * p0[e]; h1[e] += sigmoidf_(acc[ai][bj][m][1][e] * r) * p1[e]; }
                    *(f4*)(h + off) = h0; *(f4*)(h + off + 4) = h1;
                    s += (h0[0] * h0[0] + h0[1] * h0[1]) + (h0[2] * h0[2] + h0[3] * h0[3]) + (h1[0] * h1[0] + h1[1] * h1[1]) + (h1[2] * h1[2] + h1[3] * h1[3]); }
                s += __shfl_xor(s, 16); s += __shfl_xor(s, 32);
                if (fq == 0) atomicAdd(ss_out + row, s); }
    }
};

struct Stack3Order {
    int G, c;
    DI bool next(int i, Unit& u) const { const int L = i * G + c; if (L >= 1536) return false; const int which = L >> 9, r = L & 511; u.pm = which * 64 + (r & 63); u.pn = which * 8 + (r >> 6); return true; }
    DI void a_ready(const Unit&) const {}
    DI void done(const Unit&) const {}
};
struct ChainOrder {
    pg8::StaticOrder so;
    DI bool next(int i, Unit& u) const { Unit t; if (!so.next(i >> 1, t)) return false; const int which = i & 1; u.pm = which * 64 + t.pm; u.pn = which * 16 + t.pn; return true; }
    DI void a_ready(const Unit&) const {}
    DI void done(const Unit&) const {}
};
}

constexpr size_t MiB = 1u << 20;
constexpr size_t WS_CTL = 0, CTL_ZERO_BYTES = 1 * MiB;
constexpr int CW_TMO = 0, CW_BAR = 4096;
constexpr size_t SS1_OFF = 256 * 1024, SS2_OFF = 320 * 1024, SS3_OFF = 384 * 1024;
constexpr size_t WS_RSTDX = 1 * MiB;
constexpr size_t WS_BONUS = 2 * MiB;
constexpr size_t WS_RCOS = 4 * MiB, WS_RSIN = 8 * MiB;
constexpr size_t WS_WI = 12 * MiB;
constexpr size_t WS_PB = 13 * MiB;
constexpr size_t WS_WPAB = 24 * MiB;
constexpr size_t WS_WO = 56 * MiB, WS_WPG = 88 * MiB;
constexpr size_t WS_WPLE = 120 * MiB;
constexpr size_t WS_WL2 = 122 * MiB;
constexpr size_t WS_R1 = 126 * MiB;
constexpr size_t WS_WCAT = 126 * MiB;
constexpr size_t WS_XB = 288 * MiB;
constexpr size_t WS_SCORE = 126 * MiB;
constexpr size_t WS_IDX = 382 * MiB;
constexpr size_t WS_DECAY = 126 * MiB;
constexpr size_t WS_AOUT = 254 * MiB;
constexpr size_t WS_ALORA = 318 * MiB;
constexpr size_t WS_W13 = 126 * MiB;
constexpr size_t WS_W2 = 298 * MiB;
constexpr size_t WS_Q = 416 * MiB, WS_K = 480 * MiB, WS_V = 496 * MiB, WS_QI = 512 * MiB, WS_KI = 576 * MiB;
constexpr size_t WS_RB = 580 * MiB, WS_KB = 644 * MiB, WS_VB = 708 * MiB, WS_LORA = 772 * MiB, WS_GATES = 804 * MiB;
constexpr size_t WS_Y = 416 * MiB;
constexpr size_t WS_MIX = 416 * MiB;
constexpr size_t WS_H1B = 544 * MiB;
constexpr size_t WS_U = 672 * MiB;
constexpr size_t WS_H2B = 416 * MiB;
constexpr size_t WS_PP = 544 * MiB;
constexpr size_t WS_AO = 1060 * MiB;
constexpr size_t WS_GOUT = 1188 * MiB;
constexpr size_t WS_END = 1252 * MiB;

constexpr int RING_OFF = 0, RING_BYTES = 131072;
constexpr int LDSCTL_OFF = RING_BYTES, MISC_OFF = LDSCTL_OFF + 320;
constexpr int LDS_BYTES = 147456;
constexpr int NWAVES = 8;

struct Args {
    const float* in[32]; float* out; unsigned char* ws; int ph_lo, ph_hi;
};
enum { I_X = 0, I_P, I_POS, I_NORM_MIX, I_W_IN, I_MU_RKV, I_MU_WAG, I_W0, I_W1, I_W2, I_A0, I_A1, I_A2, I_G1, I_G2, I_KK, I_KA, I_RK, I_LNW, I_LNB,
       I_WPA, I_WPB, I_WGATE, I_BGATE, I_WO, I_NORM_FFN, I_WFFN1, I_WFFN3, I_WFFN2, I_WPLEG, I_WPLE, I_NORM_FINAL };

struct TrSrc { const float* p; int ld, col0, nvalid, kvalid; const float* ksc; const float* mu; int mumode; };
DI void tr_item(const TrSrc& s, bf16* WT, int dK, int n0, int k0, LAS unsigned* T, int lane) {
    const int ng = lane & 15, kq = lane >> 4;
    f32x4 v[8][2]; f32x2 sc[8];
    const bool nok = 4 * ng < s.nvalid;
#pragma unroll
    for (int st = 0; st < 8; ++st) { const int k = k0 + 8 * st + 2 * kq;
#pragma unroll
        for (int j = 0; j < 2; ++j) v[st][j] = (nok && k + j < s.kvalid) ? *(const f32x4*)(s.p + (size_t)(k + j) * s.ld + s.col0 + 4 * ng) : (f32x4){0.f, 0.f, 0.f, 0.f};
        f32x2 c = {1.f, 1.f};
        if (s.ksc) c = *(const f32x2*)(s.ksc + k);
        if (s.mumode == 1) { const f32x2 m = *(const f32x2*)(s.mu + k); c = c * (1.0f - m); } else if (s.mumode == 2) { const f32x2 m = *(const f32x2*)(s.mu + k); c = c * m; }
        sc[st] = c; }
#pragma unroll
    for (int st = 0; st < 8; ++st) { const int kp = 4 * st + kq;
#pragma unroll
        for (int i = 0; i < 4; ++i) T[(4 * ng + i) * 32 + (kp ^ (4 * (ng & 7)))] = pk2(v[st][0][i] * sc[st][0], v[st][1][i] * sc[st][1]); }
    LDS_WAIT(); asm volatile("" ::: "memory");
#pragma unroll
    for (int j = 0; j < 8; ++j) { const int n = (lane >> 3) + 8 * j, c = lane & 7;
        *(GAS v4u*)(WT + (size_t)(n0 + n) * dK + k0 + 8 * c) = *(const LAS v4u*)(T + n * 32 + 4 * (c ^ ((n >> 2) & 7))); }
    LDS_WAIT(); asm volatile("" ::: "memory");
}
DI TrSrc src_wcat(const float* const* in, int n0) {
    TrSrc s; s.p = in[I_W_IN]; s.ld = DIN; s.col0 = 0; s.nvalid = 64; s.kvalid = D; s.ksc = in[I_NORM_MIX]; s.mu = nullptr; s.mumode = 0;
    const int tile = n0 >> 8, p = n0 & 255, bj = p >> 7, hh = (p >> 6) & 1;
    if (tile < 8)        s.col0 = 0    + (2 * tile + hh) * 128 + 64 * bj;
    else if (tile < 10)  s.col0 = 2048 + (2 * (tile - 8) + hh) * 128 + 64 * bj;
    else if (tile < 12)  s.col0 = 2560 + (tile - 10) * 256 + p;
    else if (tile < 20)  s.col0 = 3072 + (2 * (tile - 12) + hh) * 128 + 64 * bj;
    else if (tile == 20) { if (hh == 0) s.col0 = 5120 + 64 * bj; else if (bj == 0) { s.col0 = 5248; s.nvalid = 16; } else s.nvalid = 0; }
    else if (tile < 45)  s.col0 = 5264 + (tile - 21) * 256 + p;
    else if (tile < 49)  { const int c = (tile - 45) * 256 + p;
        const int seg = c < 128 ? 0 : c < 256 ? 1 : c < 512 ? 2 : c < 640 ? 3 : c < 768 ? 4 : 5, sbeg = seg == 0 ? 0 : seg == 1 ? 128 : seg == 2 ? 256 : seg == 3 ? 512 : seg == 4 ? 640 : 768;
        const int kind = seg % 3;
        s.p = in[kind == 0 ? I_W1 : (kind == 1 ? I_A1 : I_G1)]; s.ld = kind == 2 ? 256 : 96; s.col0 = c - sbeg; s.mu = in[I_MU_WAG] + kind * D; s.mumode = seg < 3 ? 1 : 2;
        if (kind != 2) s.nvalid = (s.col0 == 0) ? 64 : 32; }
    else { s.p = in[I_WGATE]; s.ld = 2 * D; s.col0 = (tile - 49) * 256 + p; }
    return s;
}
DI TrSrc src_plain(const float* p, int ld, int col0, int kvalid, const float* ksc) { TrSrc s; s.p = p; s.ld = ld; s.col0 = col0; s.nvalid = 64; s.kvalid = kvalid; s.ksc = ksc; s.mu = nullptr; s.mumode = 0; return s; }

DI void convert_set_a(const float* const* in, unsigned char* ws, LAS unsigned* scr, int gw, int NGW, int lane) {
    constexpr int I0 = (NCAT / 64) * (D / 64);
    constexpr int I1 = (D / 64) * (DA / 64);
    constexpr int I3 = (D / 64) * (D / 64);
    constexpr int I5 = (D / 64) * (DPLE / 64);
    constexpr int I6 = (DB / 64) * (256 / 64);
    constexpr int NITEMS = I0 + 2 * I1 + 2 * I3 + I5 + 3 * I6;
    for (int it = gw; it < NITEMS; it += NGW) {
        int r = it;
        if (r < I0) { const int nblk = NCAT / 64, kb = r / nblk, nb = r % nblk; tr_item(src_wcat(in, 64 * nb), (bf16*)(ws + WS_WCAT), D, 64 * nb, 64 * kb, scr, lane); continue; } r -= I0;
        if (r < 2 * I1) { const int w = r / I1; r -= w * I1; const int nblk = D / 64, kb = r / nblk, nb = r % nblk;
            tr_item(src_plain(in[w ? I_WPB : I_WPA], D, 64 * nb, DA, nullptr), (bf16*)(ws + WS_WPAB) + (size_t)w * D * DA, DA, 64 * nb, 64 * kb, scr, lane); continue; } r -= 2 * I1;
        if (r < 2 * I3) { const int w = r / I3; r -= w * I3; const int nblk = D / 64, kb = r / nblk, nb = r % nblk;
            tr_item(src_plain(in[w ? I_WPLEG : I_WO], D, 64 * nb, D, nullptr), (bf16*)(ws + (w ? WS_WPG : WS_WO)), D, 64 * nb, 64 * kb, scr, lane); continue; } r -= 2 * I3;
        if (r < I5) { const int nblk = D / 64, kb = r / nblk, nb = r % nblk; tr_item(src_plain(in[I_WPLE], D, 64 * nb, DPLE, nullptr), (bf16*)(ws + WS_WPLE), DPLE, 64 * nb, 64 * kb, scr, lane); continue; } r -= I5;
        { const int w = r / I6; r -= w * I6; const int nblk = DB / 64, kb = r / nblk, nb = r % nblk;
          tr_item(src_plain(in[w == 0 ? I_W2 : (w == 1 ? I_A2 : I_G2)], DB, 64 * nb, w == 2 ? 256 : 96, nullptr), (bf16*)(ws + WS_WL2) + (size_t)w * DB * 256, 256, 64 * nb, 64 * kb, scr, lane); }
    }
}
DI void convert_set_b(const float* const* in, unsigned char* ws, LAS unsigned* scr, int gw, int NGW, int lane) {
    constexpr int I0 = (N13 / 64) * (D / 64), I1 = (D / 64) * (DFF / 64);
    for (int it = gw; it < I0 + I1; it += NGW) {
        int r = it;
        if (r < I0) { const int nblk = N13 / 64, kb = r / nblk, nb = r % nblk, n0 = 64 * nb, tile = n0 >> 8, p = n0 & 255;
            tr_item(src_plain(in[(p >> 7) ? I_WFFN3 : I_WFFN1], DFF, tile * 128 + (p & 127), D, in[I_NORM_FFN]), (bf16*)(ws + WS_W13), D, n0, 64 * kb, scr, lane); continue; } r -= I0;
        { const int nblk = D / 64, kb = r / nblk, nb = r % nblk; tr_item(src_plain(in[I_WFFN2], D, 64 * nb, DFF, nullptr), (bf16*)(ws + WS_W2), DFF, 64 * nb, 64 * kb, scr, lane); }
    }
}
DI void prologue_rows(const float* const* in, unsigned char* ws, int gw, int NGW, int lane) {
    const float* x = in[I_X]; bf16* xb = (bf16*)(ws + WS_XB); float* rstd = (float*)(ws + WS_RSTDX);
    for (int m = gw; m < M; m += NGW) {
        const GAS f32x4* xr = (const GAS f32x4*)(x + (size_t)m * D) + lane; GAS v2u* o = (GAS v2u*)(xb + (size_t)m * D) + lane; float s = 0.f;
f32x4 xv[16];
#pragma unroll
        for (int j = 0; j < 16; ++j) xv[j] = xr[64 * j];
#pragma unroll
        for (int j = 0; j < 16; ++j) { const f32x4 v = xv[j]; s += (v.x * v.x + v.y * v.y) + (v.z * v.z + v.w * v.w); v2u w; w.x = pk2(v.x, v.y); w.y = pk2(v.z, v.w); o[64 * j] = w; }
        s = wave_sum(s);
        if (lane == 0) rstd[m] = 1.0f / sqrtf(s * (1.0f / D) + RMS_EPS);
    }
    const int* pos = (const int*)in[I_POS]; float* rc = (float*)(ws + WS_RCOS); float* rsn = (float*)(ws + WS_RSIN);
    for (int e = gw * 64 + lane; e < M * 64; e += NGW * 64) {
        const int m = e >> 6, i = e & 63; double inv = 1.0; for (int j = 0; j < i; ++j) inv *= 0.8659643233600653523;
        const double ang = (double)pos[m] * inv;
        const double qd = __builtin_rint(ang * 0.63661977236758134308); const int qi = (int)((long long)qd & 3);
        double r = __builtin_fma(-qd, 1.5707963267948965580, ang); r = __builtin_fma(-qd, 6.1232339957367658860e-17, r);
        const double r2 = r * r;
        const double sn = r * (1.0 + r2 * (-1.0 / 6 + r2 * (1.0 / 120 + r2 * (-1.0 / 5040 + r2 * (1.0 / 362880 + r2 * (-1.0 / 39916800 + r2 * (1.0 / 6227020800.0)))))));
        const double cs = 1.0 + r2 * (-0.5 + r2 * (1.0 / 24 + r2 * (-1.0 / 720 + r2 * (1.0 / 40320 + r2 * (-1.0 / 3628800 + r2 * (1.0 / 479001600.0 + r2 * (-1.0 / 87178291200.0)))))));
        const double c4 = (qi == 0) ? cs : (qi == 1) ? -sn : (qi == 2) ? -cs : sn;
        const double s4 = (qi == 0) ? sn : (qi == 1) ? cs : (qi == 2) ? -sn : -cs;
        rc[e] = (float)c4; rsn[e] = (float)s4;
    }
    const float* p = in[I_P]; bf16* pb = (bf16*)(ws + WS_PB);
    for (int e = gw * 64 + lane; e < M * DPLE / 4; e += NGW * 64) { const f32x4 v = ((const GAS f32x4*)p)[e]; v2u w; w.x = pk2(v.x, v.y); w.y = pk2(v.z, v.w); ((GAS v2u*)pb)[e] = w; }
}
DI void build_alora(unsigned char* ws, int gtid, int NT) {
    const bf16* L = (const bf16*)(ws + WS_LORA); bf16* A = (bf16*)(ws + WS_ALORA);
    for (int e = gtid; e < 3 * M * 32; e += NT) {
        const int which = e / (M * 32), r = e - which * (M * 32), m = r >> 5, j0 = (r & 31) * 8;
        f32x4 o0 = {0.f, 0.f, 0.f, 0.f}, o1 = o0;
        const int width = which == 2 ? 256 : 96, ca = which == 0 ? 0 : (which == 1 ? 128 : 256), cbb = which == 0 ? 512 : (which == 1 ? 640 : 768);
        if (j0 < width) {
            f32x4 c0, c1, p0 = {0.f, 0.f, 0.f, 0.f}, p1 = p0;
            epi::unpack8(*(const v4u*)(L + (size_t)m * LORA_LD + ca + j0), c0, c1);
            if ((m & (SEQ - 1)) != 0) epi::unpack8(*(const v4u*)(L + (size_t)(m - 1) * LORA_LD + cbb + j0), p0, p1);
            o0 = c0 + p0; o1 = c1 + p1;
            if (which == 0) {
#pragma unroll
                for (int t = 0; t < 4; ++t) { o0[t] = 1.0f - 2.0f / (__expf(2.0f * o0[t]) + 1.0f); o1[t] = 1.0f - 2.0f / (__expf(2.0f * o1[t]) + 1.0f); } }
            if (which == 2) {
#pragma unroll
                for (int t = 0; t < 4; ++t) { o0[t] = sigmoidf_(o0[t]); o1[t] = sigmoidf_(o1[t]); } }
        }
        *(v4u*)(A + ((size_t)which * M + m) * 256 + j0) = epi::pack8(o0, o1);
    }
}

constexpr int IDX_TS = 272;
constexpr int IDX_TILE_BYTES = 64 * IDX_TS;
constexpr int IDX_HIST_OFF = 2 * IDX_TILE_BYTES;

DI unsigned fkey(float f) { unsigned u = __builtin_bit_cast(unsigned, f); if (u == 0x80000000u) u = 0u; return (u & 0x80000000u) ? ~u : (u | 0x80000000u); }

DI void indexer_unit(unsigned char* ws, LAS unsigned char* lds, int b, int blk, float* scratch, int wave) {
    const int lane = lane_opaque(), tid = wave * 64 + lane;
    const bf16* qi = (const bf16*)(ws + WS_QI); const bf16* ki = (const bf16*)(ws + WS_KI); const float* wi = (const float*)(ws + WS_WI);
    const int t0 = blk * 32, mrow0 = b * SEQ + t0;
    const int r = lane & 31, kh = lane >> 5, aq = (r >> 2) & 1, ah = (r & 3) + 4 * (r >> 3);
    bf16x8 af[2][8]; f32x4 wg[2][4];
#pragma unroll
    for (int rt = 0; rt < 2; ++rt) {
        const bf16* src = qi + (size_t)(mrow0 + 4 * wave + 2 * rt + aq) * DIQ + ah * HDI + 8 * kh;
#pragma unroll
        for (int ks = 0; ks < 8; ++ks) af[rt][ks] = *(const bf16x8*)(src + 16 * ks);
        const float* wsrc = wi + (size_t)(mrow0 + 4 * wave + 2 * rt + kh) * NHI;
#pragma unroll
        for (int j = 0; j < 4; ++j) wg[rt][j] = *(const f32x4*)(wsrc + 4 * j) * 0.08838834764831845f;
    }
    const int nk = (t0 + 32 + 63) >> 6;
    const int lkey = tid >> 3, lpart = tid & 7;
    const bf16* kbase = ki + (size_t)(b * SEQ) * HDI;
    v4u st0, st1;
    { const v4u* g = (const v4u*)(kbase + (size_t)lkey * HDI + lpart * 16); st0 = g[0]; st1 = g[1]; }
    __syncthreads();
    { LAS v4u* d = (LAS v4u*)(lds + lkey * IDX_TS + lpart * 32); d[0] = st0; d[1] = st1; }
    __syncthreads();
#pragma unroll
    for (int rt = 0; rt < 2; ++rt) {
#pragma unroll
        for (int ks = 0; ks < 8; ++ks) asm volatile("; pin %0" : "+v"(af[rt][ks]));
#pragma unroll
        for (int j = 0; j < 4; ++j) asm volatile("; pin %0" : "+v"(wg[rt][j])); }
    for (int kt = 0; kt < nk; ++kt) {
        if (kt + 1 < nk) { const v4u* g = (const v4u*)(kbase + (size_t)((kt + 1) * 64 + lkey) * HDI + lpart * 16); st0 = g[0]; st1 = g[1]; }
        const LAS unsigned char* tb = lds + (kt & 1) * IDX_TILE_BYTES;
#pragma unroll
        for (int ct = 0; ct < 2; ++ct) {
            bf16x8 bfr[8];
#pragma unroll
            for (int ks = 0; ks < 8; ++ks) bfr[ks] = *(const LAS bf16x8*)(tb + (32 * ct + r) * IDX_TS + (16 * ks + 8 * kh) * 2);
#pragma unroll
            for (int rt = 0; rt < 2; ++rt) {
                f32x16 c;
#pragma unroll
                for (int j = 0; j < 16; ++j) c[j] = 0.f;
#pragma unroll
                for (int ks = 0; ks < 8; ++ks) c = __builtin_amdgcn_mfma_f32_32x32x16_bf16(af[rt][ks], bfr[ks], c, 0, 0, 0);
                float s = 0.f;
#pragma unroll
                for (int j = 0; j < 16; ++j) s += wg[rt][j >> 2][j & 3] * __builtin_amdgcn_fmed3f(c[j], 0.f, 3.0e38f);
                scratch[(size_t)(4 * wave + 2 * rt + kh) * SEQ + kt * 64 + 32 * ct + r] = s;
            }
        }
        if (kt + 1 < nk) { LAS v4u* d = (LAS v4u*)(lds + ((kt + 1) & 1) * IDX_TILE_BYTES + lkey * IDX_TS + lpart * 32); d[0] = st0; d[1] = st1; }
        asm volatile("s_waitcnt lgkmcnt(0)" ::: "memory"); __builtin_amdgcn_s_barrier(); asm volatile("" ::: "memory");
    }
}

DI void select_unit(unsigned char* ws, LAS unsigned char* lds, int b, int blk, const float* scratch, int wave) {
    int* idx = (int*)(ws + WS_IDX);
    LAS unsigned* hist = (LAS unsigned*)(lds + IDX_HIST_OFF + wave * 8192);
    for (int qq = 0; qq < 4; ++qq) {
        const int lane = lane_opaque(); const unsigned long long lt_mask = (1ull << lane) - 1ull;
        const int ql = wave * 4 + qq, t = blk * 32 + ql, n = t + 1;
        const float* sc = scratch + (size_t)ql * SEQ; int* out = idx + (size_t)(b * SEQ + t) * TOPK;
        if (n <= TOPK) { for (int e = lane; e < TOPK; e += 64) out[e] = (e < n) ? e : 0; continue; }
        const int n4 = (n + 3) >> 2;
        v4u key[32];
#pragma unroll
        for (int j = 0; j < 32; ++j) { key[j] = (v4u){0u, 0u, 0u, 0u};
            if (64 * j < n4) { const int gi = 64 * j + lane; if (gi < n4) { const f32x4 v = *(const f32x4*)(sc + 4 * gi); const int e0 = 4 * gi;
                key[j].x = fkey(v[0]); key[j].y = (e0 + 1 < n) ? fkey(v[1]) : 0u; key[j].z = (e0 + 2 < n) ? fkey(v[2]) : 0u; key[j].w = (e0 + 3 < n) ? fkey(v[3]) : 0u; } } }
        unsigned prefix = 0u, pmask = 0u; int kk = TOPK;
        for (int pass = 0; pass < 4; ++pass) {
            const int shift = 24 - 8 * pass;
#pragma unroll
            for (int z = 0; z < 8; ++z) *(LAS v4u*)(hist + 4 * (lane + 64 * z)) = (v4u){0u, 0u, 0u, 0u};
            LAS unsigned* hc = hist + 256 * (lane & 7);
#pragma unroll
            for (int j = 0; j < 32; ++j) if (64 * j < n4) {
#pragma unroll
                for (int c = 0; c < 4; ++c) { const unsigned u = key[j][c]; if ((u & pmask) == prefix) __hip_atomic_fetch_add(hc + ((u >> shift) & 255u), 1u, __ATOMIC_RELAXED, __HIP_MEMORY_SCOPE_WORKGROUP); } }
            LDS_WAIT(); asm volatile("" ::: "memory");
            v4u hs = {0u, 0u, 0u, 0u};
#pragma unroll
            for (int z = 0; z < 8; ++z) hs += *(const LAS v4u*)(hist + 256 * z + 4 * lane);
            const int c0 = (int)hs.x, c1 = (int)hs.y, c2 = (int)hs.z, c3 = (int)hs.w;
            const int T = c0 + c1 + c2 + c3; int S = T;
#pragma unroll
            for (int o = 1; o < 64; o <<= 1) { const int v = __shfl_down(S, o); if (lane + o < 64) S += v; }
            const int E = S - T;
            const bool found = (E < kk) && (kk <= S);
            int d = 0, knew = 0;
            if (found) { int run = E;
                if (run + c3 >= kk) { d = 4 * lane + 3; knew = kk - run; } else { run += c3;
                if (run + c2 >= kk) { d = 4 * lane + 2; knew = kk - run; } else { run += c2;
                if (run + c1 >= kk) { d = 4 * lane + 1; knew = kk - run; } else { run += c1; d = 4 * lane; knew = kk - run; } } } }
            const unsigned long long fm = __ballot(found); const int src = fm ? (int)__builtin_ctzll(fm) : 0;
            d = __shfl(d, src); knew = __shfl(knew, src);
            prefix |= ((unsigned)d) << shift; pmask |= 0xffu << shift; kk = knew;
            asm volatile("" ::: "memory");
        }
        int pos = 0, eqt = 0;
#pragma unroll
        for (int j = 0; j < 32; ++j) if (64 * j < n4) {
            bool eq[4], gt[4]; unsigned long long em[4]; int eq_before = eqt;
#pragma unroll
            for (int c = 0; c < 4; ++c) { const unsigned u = key[j][c]; eq[c] = (u == prefix); gt[c] = (u > prefix); em[c] = __ballot(eq[c]); eq_before += __builtin_popcountll(em[c] & lt_mask); }
            bool take[4]; unsigned long long tm[4]; int tk_before = pos, run_eq = eq_before;
#pragma unroll
            for (int c = 0; c < 4; ++c) { take[c] = gt[c] || (eq[c] && run_eq < kk); run_eq += eq[c] ? 1 : 0; tm[c] = __ballot(take[c]); tk_before += __builtin_popcountll(tm[c] & lt_mask); }
            int slot = tk_before;
#pragma unroll
            for (int c = 0; c < 4; ++c) { if (take[c]) { if (slot < TOPK) out[slot] = 256 * j + 4 * lane + c; ++slot; } }
#pragma unroll
            for (int c = 0; c < 4; ++c) { pos += __builtin_popcountll(tm[c]); eqt += __builtin_popcountll(em[c]); }
        }
    }
}

DI void indexer_phase(unsigned char* ws, LAS unsigned char* lds, int wave) {
    float* scratch = (float*)(ws + WS_SCORE) + (size_t)blockIdx.x * 32 * SEQ;
    for (int pr = blockIdx.x; pr < 256; pr += gridDim.x) {
        const int b = pr >> 7, j = pr & 127;
        for (int half = 0; half < 2; ++half) { const int blk = half ? 255 - j : j;
            indexer_unit(ws, lds, b, blk, scratch, wave);
            VM_WAIT(); __syncthreads();
#ifndef REP_SEL
#define REP_SEL 1
#endif
            for (int rs_ = 0; rs_ < REP_SEL; ++rs_) select_unit(ws, lds, b, blk, scratch, wave);
            VM_WAIT(); __syncthreads(); }
    }
}

typedef int v4i __attribute__((ext_vector_type(4)));
DI void attn_worker(unsigned char* ws, LAS unsigned char* lds, LAS unsigned* qctr, int wave, int lane) {
    const bf16* q = (const bf16*)(ws + WS_Q); const bf16* kbuf = (const bf16*)(ws + WS_K); const bf16* vbuf = (const bf16*)(ws + WS_V);
    const int* idx = (const int*)(ws + WS_IDX); bf16* ao = (bf16*)(ws + WS_AO);
    LAS int* idl = (LAS int*)(lds + wave * 5120); LAS float* pl = (LAS float*)(lds + wave * 5120 + 1024);
    const int G = gridDim.x, bg = blockIdx.x & 7, b = bg >> 2, g = bg & 3;
    const int nbk = (G - bg + 7) >> 3, rank = blockIdx.x >> 3, nq = (SEQ - rank + nbk - 1) / nbk;
    const int kr = lane & 15, kq = lane >> 4;
    const int kg = lane >> 4, dg = lane & 15;
    const bf16* kbase = kbuf + (size_t)(b * SEQ) * KVD + g * 128 + 8 * kq;
    const bf16* vbase = vbuf + (size_t)(b * SEQ) * KVD + g * 128 + 8 * dg;
    for (;;) {
        unsigned qi_ = 0u; if (lane == 0) qi_ = __hip_atomic_fetch_add(qctr, 1u, __ATOMIC_RELAXED, __HIP_MEMORY_SCOPE_WORKGROUP);
        const int qn = __builtin_amdgcn_readfirstlane((int)qi_); if (qn >= nq) break;
        const int t = rank + nbk * qn;
        const int mq = b * SEQ + t, nvalid = (t + 1 < TOPK) ? t + 1 : TOPK;
#pragma unroll
        for (int c = 0; c < 4; ++c) idl[lane + 64 * c] = idx[(size_t)mq * TOPK + lane + 64 * c];
        bf16x8 qf[4];
#pragma unroll
        for (int ks = 0; ks < 4; ++ks) { if (kr < 4) qf[ks] = *(const bf16x8*)(q + (size_t)mq * DA + (4 * g + kr) * 128 + 32 * ks + 8 * kq); else qf[ks] = (bf16x8){0, 0, 0, 0, 0, 0, 0, 0}; }
        LDS_WAIT(); asm volatile("" ::: "memory");
        int kidx[16];
#pragma unroll
        for (int kt = 0; kt < 16; ++kt) kidx[kt] = idl[64 * (kr >> 2) + 4 * kt + (kr & 3)];
        f32x4 s[16];
#pragma unroll
        for (int grp = 0; grp < 4; ++grp) {
            bf16x8 kf[4][4];
#pragma unroll
            for (int j = 0; j < 4; ++j) { const bf16* kp = kbase + (size_t)kidx[4 * grp + j] * KVD;
#pragma unroll
                for (int ks = 0; ks < 4; ++ks) kf[j][ks] = *(const bf16x8*)(kp + 32 * ks); }
#pragma unroll
            for (int j = 0; j < 4; ++j) { f32x4 a = {0.f, 0.f, 0.f, 0.f};
#pragma unroll
                for (int ks = 0; ks < 4; ++ks) a = __builtin_amdgcn_mfma_f32_16x16x32_bf16(kf[j][ks], qf[ks], a, 0, 0, 0);
                s[4 * grp + j] = a; }
        }
        float mx = -3.0e38f;
#pragma unroll
        for (int kt = 0; kt < 16; ++kt)
#pragma unroll
            for (int e = 0; e < 4; ++e) { const bool ok = (64 * kq + 4 * kt + e) < nvalid; s[kt][e] = ok ? s[kt][e] * 0.08838834764831845f : -3.0e38f; mx = fmaxf(mx, s[kt][e]); }
        mx = fmaxf(mx, __shfl_xor(mx, 16)); mx = fmaxf(mx, __shfl_xor(mx, 32));
        float sum = 0.f;
#pragma unroll
        for (int kt = 0; kt < 16; ++kt)
#pragma unroll
            for (int e = 0; e < 4; ++e) { const bool ok = (64 * kq + 4 * kt + e) < nvalid; const float p = ok ? __expf(s[kt][e] - mx) : 0.f; s[kt][e] = p; sum += p; }
        sum += __shfl_xor(sum, 16); sum += __shfl_xor(sum, 32);
        const float inv = 1.0f / sum;
        if (kr < 4) {
#pragma unroll
            for (int kt = 0; kt < 16; ++kt) *(LAS f32x4*)(pl + kr * 256 + 64 * kq + 4 * kt) = s[kt] * inv; }
        LDS_WAIT(); asm volatile("" ::: "memory");
        f32x2 acc[4][4];
#pragma unroll
        for (int h = 0; h < 4; ++h)
#pragma unroll
            for (int d = 0; d < 4; ++d) acc[h][d] = (f32x2){0.f, 0.f};
#pragma unroll
        for (int ch = 0; ch < 4; ++ch) {
            v4i ix[4];
#pragma unroll
            for (int j = 0; j < 4; ++j) ix[j] = *(const LAS v4i*)(idl + 64 * kg + 16 * ch + 4 * j);
            v4u vv[16];
#pragma unroll
            for (int j = 0; j < 16; ++j) vv[j] = *(const v4u*)(vbase + (size_t)ix[j >> 2][j & 3] * KVD);
            f32x4 pp[4][4];
#pragma unroll
            for (int h = 0; h < 4; ++h)
#pragma unroll
                for (int j = 0; j < 4; ++j) pp[h][j] = *(const LAS f32x4*)(pl + h * 256 + 64 * kg + 16 * ch + 4 * j);
#pragma unroll
            for (int j = 0; j < 16; ++j) {
                const f32x2 v0 = {bf_lo(vv[j].x), bf_hi(vv[j].x)}, v1 = {bf_lo(vv[j].y), bf_hi(vv[j].y)}, v2 = {bf_lo(vv[j].z), bf_hi(vv[j].z)}, v3 = {bf_lo(vv[j].w), bf_hi(vv[j].w)};
#pragma unroll
                for (int h = 0; h < 4; ++h) { const float p = pp[h][j >> 2][j & 3]; const f32x2 p2 = {p, p};
                    acc[h][0] += p2 * v0; acc[h][1] += p2 * v1; acc[h][2] += p2 * v2; acc[h][3] += p2 * v3; }
            }
        }
#pragma unroll
        for (int h = 0; h < 4; ++h)
#pragma unroll
            for (int d = 0; d < 4; ++d) {
                acc[h][d][0] += __shfl_xor(acc[h][d][0], 16); acc[h][d][1] += __shfl_xor(acc[h][d][1], 16);
                acc[h][d][0] += __shfl_xor(acc[h][d][0], 32); acc[h][d][1] += __shfl_xor(acc[h][d][1], 32); }
        if (kg == 0) {
#pragma unroll
            for (int h = 0; h < 4; ++h) { v4u w; w.x = pk2(acc[h][0][0], acc[h][0][1]); w.y = pk2(acc[h][1][0], acc[h][1][1]); w.z = pk2(acc[h][2][0], acc[h][2][1]); w.w = pk2(acc[h][3][0], acc[h][3][1]);
                *(v4u*)(ao + (size_t)mq * DA + (4 * g + h) * 128 + 8 * dg) = w; } }
        LDS_WAIT(); asm volatile("" ::: "memory");
    }
}

constexpr int SC_STEPS = 32, SC_STEP_BYTES = 1344, SC_BUF_BYTES = SC_STEPS * SC_STEP_BYTES;
constexpr int SC_Y_OFF = 2 * SC_BUF_BYTES;

template <int CTRL> DI float dpp_add(float x) { return x + __builtin_bit_cast(float, __builtin_amdgcn_update_dpp(0, __builtin_bit_cast(int, x), CTRL, 0xf, 0xf, false)); }
DI float red16(float x) { x = dpp_add<0xB1>(x); x = dpp_add<0x4E>(x); x = dpp_add<0x141>(x); x = dpp_add<0x140>(x); return x; }

struct ScanRaw { v2u rc, rp, kc, kp, vc, vp, ac; f32x4 dc; };
struct ScanConst { f32x4 mu_r, mu_k, mu_v, kkw, kaw, rkw; };
DI f32x4 bf4(const v2u& w) { f32x4 r; r[0] = bf_lo(w.x); r[1] = bf_hi(w.x); r[2] = bf_lo(w.y); r[3] = bf_hi(w.y); return r; }

DI void scan_issue(ScanRaw& R, const unsigned char* ws, int b, int h, int t, int cg) {
    const bf16* rb = (const bf16*)(ws + WS_RB); const bf16* kb = (const bf16*)(ws + WS_KB); const bf16* vb = (const bf16*)(ws + WS_VB);
    const float* decay = (const float*)(ws + WS_DECAY); const bf16* av = (const bf16*)(ws + WS_AOUT);
    const size_t o = (size_t)(b * SEQ + t) * DB + h * HDB + 4 * cg;
    R.rc = *(const v2u*)(rb + o); R.kc = *(const v2u*)(kb + o); R.vc = *(const v2u*)(vb + o); R.dc = *(const f32x4*)(decay + o); R.ac = *(const v2u*)(av + o);
    if (t > 0) { R.rp = *(const v2u*)(rb + o - DB); R.kp = *(const v2u*)(kb + o - DB); R.vp = *(const v2u*)(vb + o - DB); }
    else { R.rp = (v2u){0u, 0u}; R.kp = (v2u){0u, 0u}; R.vp = (v2u){0u, 0u}; }
}
DI void scan_emit(const ScanRaw& R, const ScanConst& C, LAS float* sb, int cg, int qr, float* bonus_dst) {
    const f32x4 rc = bf4(R.rc), rp = bf4(R.rp), kc = bf4(R.kc), kp = bf4(R.kp), vc = bf4(R.vc), vp = bf4(R.vp), a = bf4(R.ac);
    const f32x4 r1 = rc + (rp - rc) * C.mu_r, k0 = kc + (kp - kc) * C.mu_k, v1 = vc + (vp - vc) * C.mu_v;
    const f32x4 kkv = k0 * C.kkw;
    const float nrm = sqrtf(red16((kkv[0] * kkv[0] + kkv[1] * kkv[1]) + (kkv[2] * kkv[2] + kkv[3] * kkv[3])));
    const f32x4 kkn = kkv * (1.0f / fmaxf(nrm, 1e-12f));
    const f32x4 k1 = k0 * (1.0f + (a - 1.0f) * C.kaw);
    const f32x4 rk = r1 * k1 * C.rkw;
    const float bc = red16((rk[0] + rk[1]) + (rk[2] + rk[3]));
    *(LAS f32x4*)(sb + 4 * cg) = R.dc; *(LAS f32x4*)(sb + 64 + 4 * cg) = -kkn; *(LAS f32x4*)(sb + 128 + 4 * cg) = kkn * a;
    *(LAS f32x4*)(sb + 192 + 4 * cg) = k1; *(LAS f32x4*)(sb + 256 + 4 * cg) = r1;
    if ((cg >> 2) == qr) *(LAS f32x4*)(sb + 320 + 4 * (cg & 3)) = v1;
    if (bonus_dst != nullptr && cg == 0) *bonus_dst = bc;
}
DI float red8(float x) { x = dpp_add<0xB1>(x); x = dpp_add<0x4E>(x); x = dpp_add<0x141>(x); return x; }
struct ScanVec { f32x4 w0, w1, a0, a1, b0, b1, k0, k1, r0, r1; float v; };
DI void scan_ld(ScanVec& V, const LAS float* sb, int cg, int vrow) {
    V.w0 = *(const LAS f32x4*)(sb + 8 * cg); V.w1 = *(const LAS f32x4*)(sb + 8 * cg + 4); V.a0 = *(const LAS f32x4*)(sb + 64 + 8 * cg); V.a1 = *(const LAS f32x4*)(sb + 64 + 8 * cg + 4);
    V.b0 = *(const LAS f32x4*)(sb + 128 + 8 * cg); V.b1 = *(const LAS f32x4*)(sb + 128 + 8 * cg + 4); V.k0 = *(const LAS f32x4*)(sb + 192 + 8 * cg); V.k1 = *(const LAS f32x4*)(sb + 192 + 8 * cg + 4);
    V.r0 = *(const LAS f32x4*)(sb + 256 + 8 * cg); V.r1 = *(const LAS f32x4*)(sb + 256 + 8 * cg + 4); V.v = sb[320 + vrow];
}
DI float scan_step(f32x4& s0, f32x4& s1, const ScanVec& V) {
    const f32x4 t0 = s0 * V.w0 + V.k0 * V.v, t1 = s1 * V.w1 + V.k1 * V.v;
    const f32x4 p = s0 * V.a0 + s1 * V.a1;
    const float sa = red8((p[0] + p[1]) + (p[2] + p[3]));
    s0 = t0 + V.b0 * sa; s1 = t1 + V.b1 * sa;
    const f32x4 q = s0 * V.r0 + s1 * V.r1;
    return red8((q[0] + q[1]) + (q[2] + q[3]));
}
DI void lds_signal(LAS unsigned* p, int lane) { asm volatile("s_waitcnt lgkmcnt(0)" ::: "memory"); if (lane == 0) __hip_atomic_fetch_add(p, 1u, __ATOMIC_RELAXED, __HIP_MEMORY_SCOPE_WORKGROUP); }
DI void lds_wait_ge(LAS unsigned* p, unsigned v) {
    unsigned spins = 0;
    while ((unsigned)__builtin_amdgcn_readfirstlane(__hip_atomic_load(p, __ATOMIC_RELAXED, __HIP_MEMORY_SCOPE_WORKGROUP)) < v) { __builtin_amdgcn_s_sleep(1); if (++spins > (1u << 24)) break; }
    asm volatile("" ::: "memory");
}
constexpr int SC_YW_OFF = 2 * SC_BUF_BYTES;
constexpr int SC_NSCAN = 2, SC_NLOAD = 2;

DI void scan_task(const float* const* in, unsigned char* ws, float* y, LAS unsigned char* lds, LAS unsigned* ctr, int task, int wave, int lane) {
    float* bonus = (float*)(ws + WS_BONUS);
    constexpr int NCHUNK = SEQ / SC_STEPS;
    const int bh = task >> 2, qr = task & 3, b = bh >> 5, h = bh & 31;
    if (wave < SC_NSCAN) {
        const int rl = lane >> 3, cg = lane & 7, vrow = 8 * wave + rl;
        f32x4 s0 = {0.f, 0.f, 0.f, 0.f}, s1 = s0;
        LAS float* yb = (LAS float*)(lds + SC_YW_OFF + wave * 1024);
        for (int c = 0; c < NCHUNK; ++c) {
            lds_wait_ge(ctr, (unsigned)(c + 1)); lds_wait_ge(ctr + 1, (unsigned)(c + 1));
            const LAS unsigned char* buf = lds + (c & 1) * SC_BUF_BYTES;
            ScanVec A, B; scan_ld(A, (const LAS float*)buf, cg, vrow);
#pragma unroll 2
            for (int s = 0; s < SC_STEPS; s += 2) {
                scan_ld(B, (const LAS float*)(buf + (s + 1) * SC_STEP_BYTES), cg, vrow);
                const float y0 = scan_step(s0, s1, A);
                if (s + 2 < SC_STEPS) scan_ld(A, (const LAS float*)(buf + (s + 2) * SC_STEP_BYTES), cg, vrow);
                const float y1 = scan_step(s0, s1, B);
                if (cg == 0) { yb[s * 8 + rl] = y0; yb[(s + 1) * 8 + rl] = y1; }
            }
            lds_signal(ctr + 2 + wave, lane);
            { const int s = lane >> 1, hf = lane & 1, t = c * SC_STEPS + s;
              *(f32x4*)(y + (size_t)(b * SEQ + t) * DB + h * HDB + 16 * qr + 8 * wave + 4 * hf) = *(const LAS f32x4*)(yb + s * 8 + 4 * hf); }
            asm volatile("s_waitcnt lgkmcnt(0)" ::: "memory");
        }
    } else if (wave < SC_NSCAN + SC_NLOAD) {
        const int lw = wave - SC_NSCAN, rl = lane >> 4, cg = lane & 15, col0 = h * HDB + 4 * cg;
        ScanConst C; C.mu_r = *(const f32x4*)(in[I_MU_RKV] + col0); C.mu_k = *(const f32x4*)(in[I_MU_RKV] + DB + col0); C.mu_v = *(const f32x4*)(in[I_MU_RKV] + 2 * DB + col0);
        C.kkw = *(const f32x4*)(in[I_KK] + col0); C.kaw = *(const f32x4*)(in[I_KA] + col0); C.rkw = *(const f32x4*)(in[I_RK] + col0);
        ScanRaw R[4];
#pragma unroll
        for (int p = 0; p < 4; ++p) scan_issue(R[p], ws, b, h, 4 * (lw + 2 * p) + rl, cg);
        for (int c = 0; c < NCHUNK; ++c) {
            if (c >= 2) { lds_wait_ge(ctr + 2, (unsigned)(c - 1)); lds_wait_ge(ctr + 3, (unsigned)(c - 1)); }
            LAS float* base = (LAS float*)(lds + (c & 1) * SC_BUF_BYTES); const int t0 = c * SC_STEPS;
#pragma unroll
            for (int p = 0; p < 4; ++p) { const int st = 4 * (lw + 2 * p) + rl;
                scan_emit(R[p], C, base + st * (SC_STEP_BYTES / 4), cg, qr, qr == 0 ? bonus + (size_t)(b * SEQ + t0 + st) * NHB + h : nullptr);
                if (c + 1 < NCHUNK) scan_issue(R[p], ws, b, h, t0 + SC_STEPS + st, cg); }
            lds_signal(ctr + lw, lane);
        }
    }
}

constexpr int ATT_LDS_OFF = 90112;
DI void scan_attn_phase(const float* const* in, unsigned char* ws, float* y, LAS unsigned char* lds, LAS unsigned* ctr, int wave, int lane) {
    bool first = true;
    for (int task = blockIdx.x; task < BATCH * NHB * 4 || first; task += gridDim.x) {
        __syncthreads();
        if (wave == 0 && lane < 8) ctr[lane] = 0u;
        __syncthreads();
        if (task < BATCH * NHB * 4) scan_task(in, ws, y, lds, ctr, task, wave, lane);
        if (first) attn_worker(ws, lds + ATT_LDS_OFF, ctr + 4, wave, lane);
        first = false;
    }
}

DI void gn_phase(const float* const* in, unsigned char* ws, const float* y, int gw, int NGW, int lane) {
    const bf16* vb = (const bf16*)(ws + WS_VB); const bf16* gout = (const bf16*)(ws + WS_GOUT);
    const float* bonus = (const float*)(ws + WS_BONUS); bf16* ro = (bf16*)(ws + WS_AO) + (size_t)M * DB;
    const int per = (M * 8 + NGW - 1) / NGW, it0 = gw * per, it1 = (it0 + per < M * 8) ? it0 + per : M * 8;
    const int hh = lane >> 4, cg = lane & 15;
#pragma unroll 2
    for (int it = it0; it < it1; ++it) {
        const int m = it >> 3, h = (it & 7) * 4 + hh, col = h * HDB + 4 * cg; const size_t o = (size_t)m * DB + col;
        const f32x4 yv = *(const f32x4*)(y + o);
        const f32x4 vc = bf4(*(const v2u*)(vb + o)), g4 = bf4(*(const v2u*)(gout + o));
        f32x4 vp = {0.f, 0.f, 0.f, 0.f}; if (m & (SEQ - 1)) vp = bf4(*(const v2u*)(vb + o - DB));
        const float bc = bonus[(size_t)m * NHB + h];
        const f32x4 lw = *(const f32x4*)(in[I_LNW] + col), lb = *(const f32x4*)(in[I_LNB] + col), muv = *(const f32x4*)(in[I_MU_RKV] + 2 * DB + col);
        const float mean = red16((yv[0] + yv[1]) + (yv[2] + yv[3])) * (1.0f / 64.0f); const f32x4 d = yv - mean;
        const float var = red16((d[0] * d[0] + d[1] * d[1]) + (d[2] * d[2] + d[3] * d[3])) * (1.0f / 64.0f);
        const f32x4 yn = d * (1.0f / sqrtf(var + GN_EPS)) * lw + lb;
        const f32x4 v1 = vc + (vp - vc) * muv;
        const f32x4 res = (yn + v1 * bc) * g4;
        v2u w; w.x = pk2(res[0], res[1]); w.y = pk2(res[2], res[3]);
        *(v2u*)(ro + o) = w;
    }
}

DI void final_phase(const float* const* in, unsigned char* ws, float* out, int gw, int NGW, int lane) {
    const float* ss3 = (const float*)(ws + SS3_OFF); const float* nf = in[I_NORM_FINAL];
    for (int m = gw; m < M; m += NGW) { const float r = 1.0f / sqrtf(ss3[m] * (1.0f / D) + RMS_EPS);
        GAS f32x4* o = (GAS f32x4*)(out + (size_t)m * D) + lane; const GAS f32x4* g = (const GAS f32x4*)nf + lane;
#pragma unroll 4
        for (int j = 0; j < 16; ++j) { f32x4 v = o[64 * j]; const f32x4 gg = g[64 * j]; v = v * r * gg; o[64 * j] = v; } }
}

#ifndef MK_N_LAUNCHES
#define MK_N_LAUNCHES 1
#endif
constexpr int N_PHASES = 13;
#ifndef REP_P2
#define REP_P2 1
#endif
#ifndef REP_P3
#define REP_P3 1
#endif
#ifndef REP_P6
#define REP_P6 1
#endif
#ifndef REP_P7
#define REP_P7 1
#endif
#ifndef REP_P10
#define REP_P10 1
#endif
#ifndef REP_C
#define REP_C 1
#endif
#ifndef PG8_SP2
#define PG8_SP2 true
#endif
#ifndef PG8_ALIGN
#define PG8_ALIGN true
#endif

__global__ void __launch_bounds__(NWAVES * 64, 2) hybrid_fwd(Args args) {
    extern __shared__ __attribute__((aligned(16))) unsigned char lds_raw[];
    LAS unsigned char* lds = (LAS unsigned char*)lds_raw;
    volatile LAS unsigned* MISC = (volatile LAS unsigned*)(lds + MISC_OFF);
    const int wave = __builtin_amdgcn_readfirstlane(threadIdx.x >> 6);
    const int G = gridDim.x, gw = blockIdx.x * NWAVES + wave, NGW = G * NWAVES;
    unsigned char* ws = args.ws; const float* const* in = args.in;
    { const int tid0 = wave * 64 + lane_opaque(); for (int u = tid0; u < (LDS_BYTES - LDSCTL_OFF) / 4; u += NWAVES * 64) ((LAS unsigned*)(lds + LDSCTL_OFF))[u] = 0u; }
    __syncthreads();
    unsigned* ctl = (unsigned*)(ws + WS_CTL);
    XcdBarrier bar; bar.bar = ctl + CW_BAR; bar.x = 0; bar.st = nullptr;
    const bool multi = (args.ph_hi - args.ph_lo) > 1;
    if (multi) bar = xcd_barrier_post(ctl + CW_BAR, MISC + 8, wave == 0 && lane_opaque() == 0);
    const int lo = args.ph_lo, hi = args.ph_hi;
#ifndef PHASE_MASK
#define PHASE_MASK 0x3fff
#endif
#define IN(k) ((((PHASE_MASK) >> (k)) & 1) && lo <= (k) && (k) < hi)
#define SEAM(k) do { if (IN(k) && IN((k) + 1)) xcd_barrier(bar, wave == 0 && lane_opaque() == 0); } while (0)
#define LANE lane_opaque()
    LAS unsigned* scr = (LAS unsigned*)(lds + RING_OFF + wave * 16384);

    if (IN(0)) { const int lane = LANE; for (int rep = 0; rep < REP_C; ++rep) { convert_set_a(in, ws, scr, gw, NGW, lane); prologue_rows(in, ws, gw, NGW, lane); } }
    SEAM(0);
    if (IN(1)) {
        pg8::Gemm g{(const bf16*)(ws + WS_XB), (const bf16*)(ws + WS_WCAT), M, NCAT, D}; pg8::StaticOrder S; S.init(M, NCAT, G, (int)blockIdx.x);
        epi::InProj E{(bf16*)(ws + WS_Q), (bf16*)(ws + WS_K), (bf16*)(ws + WS_V), (bf16*)(ws + WS_QI), (bf16*)(ws + WS_KI), (bf16*)(ws + WS_RB), (bf16*)(ws + WS_KB), (bf16*)(ws + WS_VB),
                      (bf16*)(ws + WS_LORA), (bf16*)(ws + WS_GATES), (float*)(ws + WS_WI), (const float*)(ws + WS_RSTDX), (const float*)(ws + WS_RCOS), (const float*)(ws + WS_RSIN)};
        pg8::gemm_phase<epi::InProj, pg8::StaticOrder, PG8_ALIGN, PG8_SP2>(lds + RING_OFF, g, S, E, wave);
    }
    SEAM(1);
    if (IN(2)) { for (int rep = 0; rep < REP_P2; ++rep) indexer_phase(ws, lds + RING_OFF, wave); }
    SEAM(2);
    if (IN(4)) build_alora(ws, blockIdx.x * (NWAVES * 64) + wave * 64 + LANE, G * NWAVES * 64);
    SEAM(4);
    if (IN(5)) {
        int k256 = 256; asm volatile("" : "+s"(k256));
        pg8::Gemm g{(const bf16*)(ws + WS_ALORA), (const bf16*)(ws + WS_WL2), 3 * M, 3 * DB, k256}; epi::Stack3Order S{G, (int)blockIdx.x};
        epi::LoraUp E{(float*)(ws + WS_DECAY), (bf16*)(ws + WS_AOUT), (bf16*)(ws + WS_GOUT), in[I_W0], in[I_A0]};
        pg8::gemm_phase<epi::LoraUp, epi::Stack3Order, PG8_ALIGN, PG8_SP2>(lds + RING_OFF, g, S, E, wave);
    }
    SEAM(5);
    if (IN(6)) { for (int rep = 0; rep < REP_P6; ++rep) scan_attn_phase(in, ws, args.out, lds + RING_OFF, (LAS unsigned*)(lds + MISC_OFF + 64), wave, LANE); }
    SEAM(6);
    if (IN(7)) { for (int rep = 0; rep < REP_P7; ++rep) gn_phase(in, ws, args.out, gw, NGW, LANE); }
    if (IN(7)) { const int lane = LANE; __syncthreads(); for (int rep = 0; rep < REP_C; ++rep) convert_set_b(in, ws, scr, gw, NGW, lane); }
    SEAM(7);
    if (IN(8)) {
        pg8::Gemm g{(const bf16*)(ws + WS_AO), (const bf16*)(ws + WS_WPAB), 2 * M, 2 * D, DA}; epi::ChainOrder S; S.so.init(M, D, G, (int)blockIdx.x);
        epi::GateMix E{(const bf16*)(ws + WS_GATES), in[I_BGATE], (bf16*)(ws + WS_MIX)};
        pg8::gemm_phase<epi::GateMix, epi::ChainOrder, PG8_ALIGN, PG8_SP2>(lds + RING_OFF, g, S, E, wave);
    }
    SEAM(8);
    if (IN(9)) {
        pg8::Gemm g{(const bf16*)(ws + WS_MIX), (const bf16*)(ws + WS_WO), M, D, D}; pg8::StaticOrder S; S.init(M, D, G, (int)blockIdx.x);
        epi::Resid E{in[I_X], args.out, (bf16*)(ws + WS_H1B), (float*)(ws + SS1_OFF)};
        pg8::gemm_phase<epi::Resid, pg8::StaticOrder, PG8_ALIGN, PG8_SP2>(lds + RING_OFF, g, S, E, wave);
    }
    SEAM(9);
    if (IN(10)) {
        pg8::Gemm g{(const bf16*)(ws + WS_H1B), (const bf16*)(ws + WS_W13), M, N13, D}; pg8::StaticOrder S; S.init(M, N13, G, (int)blockIdx.x);
        epi::FfnUp E{(const float*)(ws + SS1_OFF), (bf16*)(ws + WS_U)};
        pg8::gemm_phase<epi::FfnUp, pg8::StaticOrder, PG8_ALIGN, PG8_SP2>(lds + RING_OFF, g, S, E, wave);
#if REP_P10 > 1
        pg8::gemm_phase<epi::FfnUp, pg8::StaticOrder, PG8_ALIGN, PG8_SP2>(lds + RING_OFF, g, S, E, wave);
#endif
    }
    SEAM(10);
    if (IN(11)) {
        { pg8::Gemm g{(const bf16*)(ws + WS_U), (const bf16*)(ws + WS_W2), M, D, DFF}; pg8::StaticOrder S; S.init(M, D, G, (int)blockIdx.x);
          epi::Resid E{args.out, args.out, (bf16*)(ws + WS_H2B), (float*)(ws + SS2_OFF)};
          pg8::gemm_phase<epi::Resid, pg8::StaticOrder, PG8_ALIGN, PG8_SP2>(lds + RING_OFF, g, S, E, wave); }
        { int k256 = 256; asm volatile("" : "+s"(k256));
          pg8::Gemm g{(const bf16*)(ws + WS_PB), (const bf16*)(ws + WS_WPLE), M, D, k256}; pg8::StaticOrder S; S.init(M, D, G, (int)blockIdx.x);
          epi::StoreBf E{(bf16*)(ws + WS_PP), D};
          pg8::gemm_phase<epi::StoreBf, pg8::StaticOrder, PG8_ALIGN, PG8_SP2>(lds + RING_OFF, g, S, E, wave); }
    }
    SEAM(11);
    if (IN(12)) {
        pg8::Gemm g{(const bf16*)(ws + WS_H2B), (const bf16*)(ws + WS_WPG), M, D, D}; pg8::StaticOrder S; S.init(M, D, G, (int)blockIdx.x);
        epi::PleGate E{args.out, (const bf16*)(ws + WS_PP), (const float*)(ws + SS2_OFF), (float*)(ws + SS3_OFF)};
        pg8::gemm_phase<epi::PleGate, pg8::StaticOrder, PG8_ALIGN, PG8_SP2>(lds + RING_OFF, g, S, E, wave);
    }
    SEAM(12);
    if (IN(13)) final_phase(in, ws, args.out, gw, NGW, LANE);
#undef IN
#undef SEAM
#undef LANE
}

extern "C" void kernel_launch(void* const* d_in, const int* in_sizes, int n_in, void* d_out, int out_size, void* d_ws, size_t ws_size, hipStream_t stream) {
    static int grid = 0;
    if (grid == 0) {
        if (n_in != 32 || in_sizes[0] != M * D || out_size != M * D || ws_size < WS_END) { fprintf(stderr, "kernel_launch: unexpected shapes: n_in %d in0 %d out %d ws %zu (need %zu)\n", n_in, n_in > 0 ? in_sizes[0] : -1, out_size, ws_size, (size_t)WS_END); grid = -1; return; }
        int dev = 0, cus = 0, per_cu = 0;
        if (hipGetDevice(&dev) != hipSuccess || hipDeviceGetAttribute(&cus, hipDeviceAttributeMultiprocessorCount, dev) != hipSuccess) { grid = -1; return; }
        if (hipFuncSetAttribute((const void*)hybrid_fwd, hipFuncAttributeMaxDynamicSharedMemorySize, LDS_BYTES) != hipSuccess) { fprintf(stderr, "kernel_launch: hipFuncSetAttribute failed\n"); grid = -1; return; }
        if (hipOccupancyMaxActiveBlocksPerMultiprocessor(&per_cu, (const void*)hybrid_fwd, NWAVES * 64, LDS_BYTES) != hipSuccess || per_cu < 1) fprintf(stderr, "kernel_launch: occupancy query says %d\n", per_cu);
        (void)hipGetLastError();
        grid = cus;
    }
    if (grid < 0) return;
    if (hipMemsetAsync((char*)d_ws + WS_CTL, 0, CTL_ZERO_BYTES, stream) != hipSuccess) return;
    Args a{};
    for (int i = 0; i < 32; ++i) a.in[i] = (const float*)d_in[i];
    a.out = (float*)d_out; a.ws = (unsigned char*)d_ws;
#if MK_N_LAUNCHES == 1
    a.ph_lo = 0; a.ph_hi = N_PHASES + 1;
    hipLaunchKernelGGL(hybrid_fwd, dim3(grid), dim3(NWAVES * 64), LDS_BYTES, stream, a);
#else
    for (int p = 0; p <= N_PHASES; ++p) { a.ph_lo = p; a.ph_hi = p + 1; hipLaunchKernelGGL(hybrid_fwd, dim3(grid), dim3(NWAVES * 64), LDS_BYTES, stream, a); }
#endif
}
```

```cpp
#include <hip/hip_runtime.h>
#include <cstdio>
#include <cstdint>
__device__ __forceinline__ int lane_opaque() { int l; asm volatile("v_mbcnt_lo_u32_b32 %0, -1, 0\n\tv_mbcnt_hi_u32_b32 %0, -1, %0" : "=v"(l)); return l; }

namespace pg8 {
#define PG8_LAS __attribute__((address_space(3)))
typedef unsigned short bf16_t;
typedef short bf16x8 __attribute__((ext_vector_type(8)));
typedef float f32x4 __attribute__((ext_vector_type(4)));
typedef unsigned u32x4 __attribute__((ext_vector_type(4)));
constexpr int BM = 256, BK = 64, HALF = 128, HTB = HALF * BK * 2  , STAGE_BYTES = 8 * HTB, NXCD = 8, WGM = 8;

__host__ __device__ __forceinline__ int lds_byte(int r, int c) { const int st = (r >> 4) * 2 + (c >> 5), rr = r & 15, cc = c & 31, ob = rr * 64 + cc * 2; return st * 1024 + (ob ^ (((ob >> 9) & 1) << 5)); }
__host__ __device__ __forceinline__ void stage_rc(int b, int& R, int& C) { const int st = b / 1024, sb = b % 1024, swz = sb ^ (((sb >> 9) & 1) << 5); R = (st >> 1) * 16 + swz / 64; C = (st & 1) * 32 + (swz % 64) / 2; }
__host__ __device__ __forceinline__ int perm32(int rho) { const int n = rho >> 4, i = rho & 15; return 8 * (i >> 2) + 4 * n + (i & 3); }

struct Unit { int pm, pn; };
struct Gemm { const bf16_t* A; const bf16_t* Bt; int M, N, K; };

struct StaticOrder {
    int nM, nN, nwg, G, c;
    __host__ __device__ void init(int M, int N, int G_, int c_) { nM = M / BM; nN = N / BM; nwg = nM * nN; G = G_; c = c_; }
    __host__ __device__ bool next(int i, Unit& u) const {
        const long L = (long)i * G + c; if (L >= nwg) return false;
        int wgid = (int)L; { const int q = nwg / NXCD, r = nwg % NXCD, xcd = wgid % NXCD, off = wgid / NXCD; wgid = (xcd < r ? xcd * (q + 1) : r * (q + 1) + (xcd - r) * q) + off; }
        const int nig = WGM * nN, gid = wgid / nig, fm = gid * WGM, gsz = (nM - fm) < WGM ? (nM - fm) : WGM;
        u.pm = fm + ((wgid % nig) % gsz); u.pn = (wgid % nig) / gsz; return true;
    }
    __device__ __forceinline__ void a_ready(const Unit&) const {}
    __device__ __forceinline__ void done(const Unit&) const {}
};
__device__ __forceinline__ unsigned cvt_pk_bf16(float lo, float hi) { unsigned r; asm volatile("v_cvt_pk_bf16_f32 %0, %1, %2" : "=v"(r) : "v"(lo), "v"(hi)); return r; }
template <class Epi, class Sched, bool ALIGN_EPI = false, bool SP2 = false>
__device__ __forceinline__ void gemm_phase(PG8_LAS unsigned char* lds, const Gemm g, const Sched& S, const Epi& E, const int wid) {
    const int lane = lane_opaque(), tid = wid * 64 + lane, wr = wid >> 2, wc = wid & 3, fr = lane & 15, fq = lane >> 4;
    const int K = g.K, nt = K / BK;
    unsigned voffA[2], voffB[2];
#pragma unroll
    for (int i = 0; i < 2; ++i) { int R, C; stage_rc(tid * 16 + i * 8192, R, C); const int Rb = Epi::PERM ? ((R & ~31) + perm32(R & 31)) : R;
        voffA[i] = (unsigned)(R * K + C) * 2u; voffB[i] = (unsigned)(Rb * K + C) * 2u; }
    const size_t kstep = (size_t)(BK * 2);
    const size_t hstep = (size_t)HALF * K * 2;
    const size_t tstep = 2 * hstep;
    const unsigned ldsw = (unsigned)wid * 1024u;
    const int aoff = lds_byte(wr * 64 + fr, fq * 8), boff = lds_byte(wc * 32 + fr, fq * 8);
#define PG8_SA(b, h) (((b) * 2 + (h)) * HTB)
#define PG8_SB(b, h) ((4 + (b) * 2 + (h)) * HTB)
#define PG8_STAGE(bufoff, gbase, voff) do { _Pragma("unroll") for (int _i = 0; _i < 2; ++_i) \
        __builtin_amdgcn_global_load_lds((const unsigned*)((const char*)(gbase) + (voff)[_i]), (PG8_LAS unsigned*)(lds + (bufoff) + ldsw + _i * 8192), 16, 0, 0); } while (0)
#define PG8_LDA(dst, b, h) do { _Pragma("unroll") for (int m = 0; m < 4; ++m) _Pragma("unroll") for (int k = 0; k < 2; ++k) dst[m][k] = *(const PG8_LAS bf16x8*)(lds + PG8_SA(b, h) + aoff + m * 2048 + k * 1024); } while (0)
#define PG8_LDB(dst, b, h) do { _Pragma("unroll") for (int n = 0; n < 2; ++n) _Pragma("unroll") for (int k = 0; k < 2; ++k) dst[n][k] = *(const PG8_LAS bf16x8*)(lds + PG8_SB(b, h) + boff + n * 2048 + k * 1024); } while (0)
#define PG8_MMA(ai, bj, At, Bt) do { __builtin_amdgcn_s_setprio(1); _Pragma("unroll") for (int m = 0; m < 4; ++m) _Pragma("unroll") for (int n = 0; n < 2; ++n) _Pragma("unroll") for (int k = 0; k < 2; ++k) \
        acc[ai][bj][m][n] = __builtin_amdgcn_mfma_f32_16x16x32_bf16(Bt[n][k], At[m][k], acc[ai][bj][m][n], 0, 0, 0); __builtin_amdgcn_s_setprio(0); } while (0)
#define PG8_WAIT_V(n) asm volatile("s_waitcnt vmcnt(" #n ")" ::: "memory")
#define PG8_WAIT_L(n) asm volatile("s_waitcnt lgkmcnt(" #n ")" ::: "memory")
#define PG8_BAR __builtin_amdgcn_s_barrier()
#define PG8_SCHED __builtin_amdgcn_sched_barrier(0)
    Unit cur, nxt; int ui = 0;
    if (!S.next(0, cur)) return;
    f32x4 acc[2][2][4][2];
#pragma unroll
    for (int a = 0; a < 2; ++a)
#pragma unroll
        for (int b = 0; b < 2; ++b)
#pragma unroll
            for (int m = 0; m < 4; ++m)
#pragma unroll
                for (int n = 0; n < 2; ++n) acc[a][b][m][n] = (f32x4){0.f, 0.f, 0.f, 0.f};
    bf16x8 At[4][2], B0[2][2], B1[2][2];
    const char* cA = (const char*)g.A + (size_t)cur.pm * tstep; const char* cB = (const char*)g.Bt + (size_t)cur.pn * tstep;
    S.a_ready(cur);
    if constexpr (SP2) {
        PG8_STAGE(PG8_SB(0, 0), cB, voffB); PG8_STAGE(PG8_SB(0, 1), cB + hstep, voffB); PG8_STAGE(PG8_SA(0, 0), cA, voffA); PG8_STAGE(PG8_SA(0, 1), cA + hstep, voffA);
        if (wr == 1) PG8_BAR;
        PG8_WAIT_V(2); PG8_BAR;
        PG8_STAGE(PG8_SB(1, 0), cB + kstep, voffB); PG8_STAGE(PG8_SA(1, 0), cA + kstep, voffA); PG8_STAGE(PG8_SB(1, 1), cB + hstep + kstep, voffB);
        PG8_WAIT_V(6); PG8_BAR;
    } else {
        PG8_STAGE(PG8_SB(0, 0), cB, voffB); PG8_STAGE(PG8_SA(0, 0), cA, voffA); PG8_STAGE(PG8_SB(0, 1), cB + hstep, voffB); PG8_STAGE(PG8_SA(0, 1), cA + hstep, voffA);
        if (wr == 1) PG8_BAR;
        PG8_WAIT_V(4); PG8_BAR;
        PG8_STAGE(PG8_SB(1, 0), cB + kstep, voffB); PG8_STAGE(PG8_SA(1, 0), cA + kstep, voffA); PG8_STAGE(PG8_SB(1, 1), cB + hstep + kstep, voffB);
        PG8_WAIT_V(6); PG8_BAR;
    }
    for (;;) {
        const bool has_next = S.next(ui + 1, nxt);
        const char* nA = has_next ? (const char*)g.A + (size_t)nxt.pm * tstep : cA; const char* nB = has_next ? (const char*)g.Bt + (size_t)nxt.pn * tstep : cB;
        for (int t = 0; t < nt; t += 2) {
            const bool last = (t == nt - 2);
            const char* a1 = cA + (size_t)(t + 1) * kstep;
            const char* a2 = last ? nA : cA + (size_t)(t + 2) * kstep; const char* b2 = last ? nB : cB + (size_t)(t + 2) * kstep;
            const char* a3 = a2 + kstep; const char* b3 = b2 + kstep;
            if (last && has_next) S.a_ready(nxt);
            if constexpr (SP2) {
            PG8_LDB(B0, 0, 0); PG8_LDB(B1, 0, 1); PG8_SCHED; PG8_LDA(At, 0, 0); PG8_STAGE(PG8_SA(1, 1), a1 + hstep, voffA);
            PG8_WAIT_V(8); PG8_WAIT_L(0); PG8_BAR; PG8_MMA(0, 0, At, B0); PG8_MMA(0, 1, At, B1); PG8_BAR; PG8_SCHED;
            PG8_LDA(At, 0, 1); PG8_STAGE(PG8_SB(0, 0), b2, voffB); PG8_STAGE(PG8_SB(0, 1), b2 + hstep, voffB); PG8_STAGE(PG8_SA(0, 0), a2, voffA);
            PG8_WAIT_V(8); PG8_WAIT_L(0); PG8_BAR; PG8_MMA(1, 0, At, B0); PG8_MMA(1, 1, At, B1); PG8_BAR; PG8_SCHED;
            PG8_LDB(B0, 1, 0); PG8_LDB(B1, 1, 1); PG8_SCHED; PG8_LDA(At, 1, 0); PG8_STAGE(PG8_SA(0, 1), a2 + hstep, voffA);
            PG8_WAIT_V(8); PG8_WAIT_L(0); PG8_BAR; PG8_MMA(0, 0, At, B0); PG8_MMA(0, 1, At, B1); PG8_BAR; PG8_SCHED;
            PG8_LDA(At, 1, 1); PG8_STAGE(PG8_SB(1, 0), b3, voffB); PG8_STAGE(PG8_SB(1, 1), b3 + hstep, voffB); PG8_STAGE(PG8_SA(1, 0), a3, voffA);
            PG8_WAIT_V(8); PG8_WAIT_L(0); PG8_BAR; PG8_MMA(1, 0, At, B0); PG8_MMA(1, 1, At, B1); PG8_BAR; PG8_SCHED;
            } else {
            PG8_LDB(B0, 0, 0); PG8_SCHED; PG8_LDA(At, 0, 0); PG8_STAGE(PG8_SA(1, 1), a1 + hstep, voffA);
            PG8_WAIT_L(8); PG8_BAR; PG8_WAIT_L(0); PG8_MMA(0, 0, At, B0); PG8_BAR; PG8_SCHED;
            PG8_LDB(B1, 0, 1); PG8_STAGE(PG8_SB(0, 0), b2, voffB);
            PG8_BAR; PG8_WAIT_L(0); PG8_MMA(0, 1, At, B1); PG8_BAR;
            PG8_LDA(At, 0, 1); PG8_STAGE(PG8_SA(0, 0), a2, voffA);
            PG8_BAR; PG8_WAIT_L(0); PG8_MMA(1, 0, At, B0); PG8_BAR; PG8_SCHED;
            PG8_STAGE(PG8_SB(0, 1), b2 + hstep, voffB);
            PG8_WAIT_V(6); PG8_BAR; PG8_MMA(1, 1, At, B1); PG8_BAR;
            PG8_LDB(B0, 1, 0); PG8_SCHED; PG8_LDA(At, 1, 0); PG8_STAGE(PG8_SA(0, 1), a2 + hstep, voffA);
            PG8_WAIT_L(8); PG8_BAR; PG8_WAIT_L(0); PG8_MMA(0, 0, At, B0); PG8_BAR; PG8_SCHED;
            PG8_LDB(B1, 1, 1); PG8_STAGE(PG8_SB(1, 0), b3, voffB);
            PG8_BAR; PG8_WAIT_L(0); PG8_MMA(0, 1, At, B1); PG8_BAR;
            PG8_LDA(At, 1, 1); PG8_STAGE(PG8_SA(1, 0), a3, voffA);
            PG8_BAR; PG8_WAIT_L(0); PG8_MMA(1, 0, At, B0); PG8_BAR; PG8_SCHED;
            PG8_STAGE(PG8_SB(1, 1), b3 + hstep, voffB);
            PG8_WAIT_V(6); PG8_BAR; PG8_MMA(1, 1, At, B1); PG8_BAR;
            }
        }
        if constexpr (ALIGN_EPI) { if (wr == 0) PG8_BAR; }
        if constexpr (!Epi::AFTER_DRAIN) { E(acc, cur, wr, wc, fr, fq); S.done(cur); }
        if (!has_next) break;
        if (!Epi::CHAIN || !E.keep(cur)) {
#pragma unroll
        for (int a = 0; a < 2; ++a)
#pragma unroll
            for (int b = 0; b < 2; ++b)
#pragma unroll
                for (int m = 0; m < 4; ++m)
#pragma unroll
                    for (int n = 0; n < 2; ++n) acc[a][b][m][n] = (f32x4){0.f, 0.f, 0.f, 0.f};
        }
        cur = nxt; cA = nA; cB = nB; ++ui;
        if constexpr (ALIGN_EPI) { if (wr == 1) PG8_BAR; }
    }
    PG8_WAIT_V(0);
    if constexpr (!ALIGN_EPI) { if (wr == 0) PG8_BAR; }
    PG8_BAR;
    if constexpr (Epi::AFTER_DRAIN) { E.fused(acc, cur, wr, wc, fr, fq, lds, wid, lane); S.done(cur); }
#undef PG8_SA
#undef PG8_SB
#undef PG8_STAGE
#undef PG8_LDA
#undef PG8_LDB
#undef PG8_MMA
#undef PG8_WAIT_V
#undef PG8_WAIT_L
#undef PG8_BAR
#undef PG8_SCHED
}
}

#define LAS __attribute__((address_space(3)))
#define XB_TMO      128
#define XB_XCNT(j)  (256  + 64 * (j))
#define XB_XSUB(j)  (1280 + 64 * (j))
#define XB_XGEN(j)  (2304 + 64 * (j))
#define XB_TOP      3328
#define XB_TOPGEN   3392
#define XCD_BAR_WORDS 3456
#define XB_SPIN_CAP (1u << 18)

__device__ __forceinline__ unsigned xb_ld(unsigned* p)              { return __hip_atomic_load(p, __ATOMIC_RELAXED, __HIP_MEMORY_SCOPE_AGENT); }
__device__ __forceinline__ unsigned xb_add(unsigned* p, unsigned v) { return __hip_atomic_fetch_add(p, v, __ATOMIC_RELAXED, __HIP_MEMORY_SCOPE_AGENT); }
__device__ __forceinline__ unsigned xb_xcc_id() { return (unsigned)__builtin_amdgcn_s_getreg((3 << 11) | 20) & 0xFu; }
#define XB_SPIN(cond, bar) do { unsigned _sp = 0; while (cond) { __builtin_amdgcn_s_sleep(1); \
    if ((++_sp & 255u) == 0u) { if (xb_ld(&(bar)[XB_TMO])) break; if (_sp > XB_SPIN_CAP) { atomicAdd(&(bar)[XB_TMO], 1u); break; } } } } while (0)

struct XcdBarrier {
    unsigned* bar; unsigned x;
    volatile LAS unsigned* st;
};

__device__ __forceinline__ XcdBarrier xcd_barrier_post(unsigned* bar, volatile LAS unsigned* st, const bool leader  ) {
    XcdBarrier b; b.bar = bar; b.x = xb_xcc_id(); b.st = st;
    if (leader) (void)xb_add(&bar[XB_XCNT(b.x)], 1u);
    return b;
}
__device__ __forceinline__ void xcd_barrier_complete(unsigned* bar, unsigned x, unsigned& nloc, unsigned& nx) {
    const unsigned G = gridDim.x * gridDim.y * gridDim.z;
    unsigned sum, cnt, mine, sp = 0u;
    for (;;) {
        sum = 0u; cnt = 0u; mine = 0u;
#pragma unroll
        for (unsigned j = 0; j < 16; ++j) { const unsigned c = xb_ld(&bar[XB_XCNT(j)]); sum += c; cnt += (c > 0u) ? 1u : 0u; mine = (j == x) ? c : mine; }
        if (sum == G) break;
        __builtin_amdgcn_s_sleep(1);
        if ((++sp & 255u) == 0u) { if (xb_ld(&bar[XB_TMO])) break; if (sp > XB_SPIN_CAP) { atomicAdd(&bar[XB_TMO], 1u); break; } }
    }
    nloc = mine > 0u ? mine : 1u; nx = cnt > 0u ? cnt : 1u;
}

__device__ __forceinline__ void xcd_barrier(const XcdBarrier& b, const bool leader  ) {
    asm volatile("s_waitcnt vmcnt(0)" ::: "memory");
    __syncthreads();
    if (leader) {
        unsigned* bar = b.bar;
        __builtin_amdgcn_s_waitcnt(0);
        unsigned nloc = b.st[0], nx = b.st[1];
        if (nloc == 0u) { xcd_barrier_complete(bar, b.x, nloc, nx); b.st[0] = nloc; b.st[1] = nx; }
        const unsigned old = xb_add(&bar[XB_XSUB(b.x)], 1u);
        const unsigned gen = old / nloc;
        if (old + 1u == (gen + 1u) * nloc) {
            __builtin_amdgcn_fence(__ATOMIC_RELEASE, "agent");
            asm volatile("s_waitcnt vmcnt(0)" ::: "memory");
            const unsigned og = xb_add(&bar[XB_TOP], 1u);
            const unsigned tg = og / nx;
            if (og + 1u == (tg + 1u) * nx) xb_add(&bar[XB_TOPGEN], 1u);
            else XB_SPIN(xb_ld(&bar[XB_TOPGEN]) == tg, bar);
            __builtin_amdgcn_fence(__ATOMIC_ACQUIRE, "agent");
            xb_add(&bar[XB_XGEN(b.x)], 1u);
            asm volatile("s_waitcnt vmcnt(0)" ::: "memory");
        } else {
            XB_SPIN(xb_ld(&bar[XB_XGEN(b.x)]) == gen, bar);
            __builtin_amdgcn_fence(__ATOMIC_ACQUIRE, "agent");
            asm volatile("s_waitcnt vmcnt(0)" ::: "memory");
        }
    }
    __syncthreads();
}

constexpr int BATCH = 2, SEQ = 8192, M = BATCH * SEQ, D = 4096;
constexpr int DA = 2048, KVD = 512, DIQ = 2048, HDI = 128, NHI = 16, DB = 2048, NHB = 32, HDB = 64;
constexpr int DIN = 11408, DFF = 11008, DPLE = 256, TOPK = 256;
constexpr int NCAT = 81 * 256;
constexpr int N13 = 2 * DFF;
constexpr int LORA_LD = 1024;
constexpr float RMS_EPS = 1e-6f, GN_EPS = 64e-5f;

#define GAS __attribute__((address_space(1)))
typedef unsigned short bf16;
typedef unsigned v4u __attribute__((ext_vector_type(4)));
typedef unsigned v2u __attribute__((ext_vector_type(2)));
typedef float f32x4 __attribute__((ext_vector_type(4)));
typedef float f32x16 __attribute__((ext_vector_type(16)));
typedef float f32x2 __attribute__((ext_vector_type(2)));
typedef short bf16x8 __attribute__((ext_vector_type(8)));
typedef GAS unsigned gu32;
#define RLX_AGENT __ATOMIC_RELAXED, __HIP_MEMORY_SCOPE_AGENT
#define LDS_WAIT() asm volatile("s_waitcnt lgkmcnt(0)" ::: "memory")
#define VM_WAIT() asm volatile("s_waitcnt vmcnt(0)" ::: "memory")
#define DI __device__ __forceinline__

DI unsigned f2bf(float f) { unsigned u = __builtin_bit_cast(unsigned, f); return (u + 0x7fffu + ((u >> 16) & 1u)) >> 16; }
DI unsigned pk2(float lo, float hi) { return f2bf(lo) | (f2bf(hi) << 16); }
DI float bf_lo(unsigned w) { return __builtin_bit_cast(float, w << 16); }
DI float bf_hi(unsigned w) { return __builtin_bit_cast(float, w & 0xffff0000u); }
DI float bf2f(bf16 h) { return __builtin_bit_cast(float, ((unsigned)h) << 16); }
DI float sigmoidf_(float z) { return 1.0f / (1.0f + __expf(-z)); }
DI float wave_sum(float v) {
#pragma unroll
    for (int o = 1; o < 64; o <<= 1) v += __shfl_xor(v, o);
    return v;
}

namespace epi {
using pg8::Unit; using pg8::BM; using pg8::HALF; using pg8::cvt_pk_bf16;
typedef pg8::f32x4 f4;
DI v4u pack8(const f4& a, const f4& b) { v4u w; w.x = cvt_pk_bf16(a[0], a[1]); w.y = cvt_pk_bf16(a[2], a[3]); w.z = cvt_pk_bf16(b[0], b[1]); w.w = cvt_pk_bf16(b[2], b[3]); return w; }
DI void unpack8(const v4u& w, f4& a, f4& b) { a[0] = bf_lo(w.x); a[1] = bf_hi(w.x); a[2] = bf_lo(w.y); a[3] = bf_hi(w.y); b[0] = bf_lo(w.z); b[1] = bf_hi(w.z); b[2] = bf_lo(w.w); b[3] = bf_hi(w.w); }

struct InProj {
    static constexpr bool PERM = true, AFTER_DRAIN = false, CHAIN = false;
    bf16 *q, *k, *v, *qi, *ki, *rb, *kb, *vb, *lora, *gates; float* wi;
    const float *rstd, *rcos, *rsin;
    DI bool keep(const Unit&) const { return false; }
    DI void operator()(f4 (&acc)[2][2][4][2], const Unit& u, int wr, int wc, int fr, int fq) const {
        { const int ln_ = lane_opaque(); fr = ln_ & 15; fq = ln_ >> 4; }
        const int pn = u.pn, row0 = u.pm * BM + wr * 64 + fr;
        int kind = 0, ld, cb; bf16* dst;
        float rsv[2][4];
#pragma unroll
        for (int ai = 0; ai < 2; ++ai)
#pragma unroll
            for (int m = 0; m < 4; ++m) rsv[ai][m] = rstd[row0 + ai * HALF + m * 16];
        if (pn < 8)       { kind = 1; dst = q;  ld = DA;  cb = pn * 256; }
        else if (pn < 10) { kind = 1; dst = k;  ld = KVD; cb = (pn - 8) * 256; }
        else if (pn < 12) { dst = v;  ld = KVD; cb = (pn - 10) * 256; }
        else if (pn < 20) { kind = 1; dst = qi; ld = DIQ; cb = (pn - 12) * 256; }
        else if (pn == 20){ kind = 2; dst = ki; ld = HDI; cb = 0; }
        else if (pn < 29) { dst = rb; ld = DB; cb = (pn - 21) * 256; }
        else if (pn < 37) { dst = kb; ld = DB; cb = (pn - 29) * 256; }
        else if (pn < 45) { dst = vb; ld = DB; cb = (pn - 37) * 256; }
        else if (pn < 49) { dst = lora; ld = LORA_LD; cb = (pn - 45) * 256; }
        else              { dst = gates; ld = 2 * D; cb = (pn - 49) * 256; }
        if (kind == 0) {
#pragma unroll
            for (int ai = 0; ai < 2; ++ai)
#pragma unroll
                for (int m = 0; m < 4; ++m) { const int row = row0 + ai * HALF + m * 16; const float rs = rsv[ai][m];
#pragma unroll
                    for (int bj = 0; bj < 2; ++bj) *(v4u*)(dst + (size_t)row * ld + cb + bj * HALF + wc * 32 + 8 * fq) = pack8(acc[ai][bj][m][0] * rs, acc[ai][bj][m][1] * rs); }
        } else if (kind == 1 || wc < 2) {
            const int hb = cb + (wc >> 1) * 128, dd0 = (wc & 1) * 32 + 8 * fq;
#pragma unroll
            for (int ai = 0; ai < 2; ++ai)
#pragma unroll
                for (int m = 0; m < 4; ++m) { const int row = row0 + ai * HALF + m * 16; const float rs = rsv[ai][m];
                    const f4 c0 = *(const f4*)(rcos + (size_t)row * 64 + dd0), c1 = *(const f4*)(rcos + (size_t)row * 64 + dd0 + 4);
                    const f4 s0 = *(const f4*)(rsin + (size_t)row * 64 + dd0), s1 = *(const f4*)(rsin + (size_t)row * 64 + dd0 + 4);
                    const f4 a0 = acc[ai][0][m][0] * rs, a1 = acc[ai][0][m][1] * rs, b0 = acc[ai][1][m][0] * rs, b1 = acc[ai][1][m][1] * rs;
                    bf16* p = dst + (size_t)row * ld + hb + dd0;
                    *(v4u*)(p)      = pack8(a0 * c0 - b0 * s0, a1 * c1 - b1 * s1);
                    *(v4u*)(p + 64) = pack8(a0 * s0 + b0 * c0, a1 * s1 + b1 * c1); }
        } else if (wc == 2 && fq < 2) {
#pragma unroll
            for (int ai = 0; ai < 2; ++ai)
#pragma unroll
                for (int m = 0; m < 4; ++m) { const int row = row0 + ai * HALF + m * 16; const float rs = rsv[ai][m] * 0.25f;
                    *(f4*)(wi + (size_t)row * 16 + 8 * fq) = acc[ai][0][m][0] * rs; *(f4*)(wi + (size_t)row * 16 + 8 * fq + 4) = acc[ai][0][m][1] * rs; }
        }
    }
};

struct LoraUp {
    static constexpr bool PERM = true, AFTER_DRAIN = false, CHAIN = false;
    float* decay; bf16 *aout, *gout; const float *w0, *a0;
    DI bool keep(const Unit&) const { return false; }
    DI void operator()(f4 (&acc)[2][2][4][2], const Unit& u, int wr, int wc, int fr, int fq) const {
        { const int ln_ = lane_opaque(); fr = ln_ & 15; fq = ln_ >> 4; }
        const int which = u.pm >> 6, row0 = (u.pm & 63) * BM + wr * 64 + fr, col0 = (u.pn & 7) * BM + wc * 32 + 8 * fq;
        if (which == 0) {
#pragma unroll
            for (int bj = 0; bj < 2; ++bj) { const int col = col0 + bj * HALF; const f4 z0 = *(const f4*)(w0 + col), z1 = *(const f4*)(w0 + col + 4);
#pragma unroll
                for (int ai = 0; ai < 2; ++ai)
#pragma unroll
                    for (int m = 0; m < 4; ++m) { const size_t off = (size_t)(row0 + ai * HALF + m * 16) * DB + col;
                        f4 x0 = acc[ai][bj][m][0] + z0, x1 = acc[ai][bj][m][1] + z1;
#pragma unroll
                        for (int e = 0; e < 4; ++e) { x0[e] = __expf(-0.6065306597126334f * sigmoidf_(x0[e])); x1[e] = __expf(-0.6065306597126334f * sigmoidf_(x1[e])); }
                        *(f4*)(decay + off) = x0; *(f4*)(decay + off + 4) = x1;
                        asm volatile("" ::: "memory"); } }
        } else if (which == 1) {
#pragma unroll
            for (int bj = 0; bj < 2; ++bj) { const int col = col0 + bj * HALF; const f4 z0 = *(const f4*)(a0 + col), z1 = *(const f4*)(a0 + col + 4);
#pragma unroll
                for (int ai = 0; ai < 2; ++ai)
#pragma unroll
                    for (int m = 0; m < 4; ++m) { const size_t off = (size_t)(row0 + ai * HALF + m * 16) * DB + col;
                        f4 x0 = acc[ai][bj][m][0] + z0, x1 = acc[ai][bj][m][1] + z1;
#pragma unroll
                        for (int e = 0; e < 4; ++e) { x0[e] = sigmoidf_(x0[e]); x1[e] = sigmoidf_(x1[e]); }
                        *(v4u*)(aout + off) = pack8(x0, x1);
                        asm volatile("" ::: "memory"); } }
        } else {
#pragma unroll
            for (int bj = 0; bj < 2; ++bj)
#pragma unroll
                for (int ai = 0; ai < 2; ++ai)
#pragma unroll
                    for (int m = 0; m < 4; ++m) *(v4u*)(gout + (size_t)(row0 + ai * HALF + m * 16) * DB + col0 + bj * HALF) = pack8(acc[ai][bj][m][0], acc[ai][bj][m][1]);
        }
    }
};

struct GateMix {
    static constexpr bool PERM = true, AFTER_DRAIN = false, CHAIN = true;
    const bf16* gates; const float* bgate; bf16* mout;
    DI bool keep(const Unit& u) const { return u.pm < 64; }
    DI void operator()(f4 (&acc)[2][2][4][2], const Unit& u, int wr, int wc, int fr, int fq) const {
        { const int ln_ = lane_opaque(); fr = ln_ & 15; fq = ln_ >> 4; }
        const int which = u.pm >> 6, row0 = (u.pm & 63) * BM + wr * 64 + fr, col0 = (u.pn & 15) * BM + wc * 32 + 8 * fq;
#pragma unroll
        for (int bj = 0; bj < 2; ++bj) { const int col = col0 + bj * HALF;
            const f4 ba0 = *(const f4*)(bgate + col), ba1 = *(const f4*)(bgate + col + 4), bb0 = *(const f4*)(bgate + D + col), bb1 = *(const f4*)(bgate + D + col + 4);
#pragma unroll
            for (int ai = 0; ai < 2; ++ai)
#pragma unroll
                for (int m = 0; m < 4; ++m) { const int row = row0 + ai * HALF + m * 16;
                    f4 zb0, zb1; unpack8(*(const v4u*)(gates + (size_t)row * (2 * D) + D + col), zb0, zb1); zb0 += bb0; zb1 += bb1;
                    if (which == 0) {
                        f4 za0, za1; unpack8(*(const v4u*)(gates + (size_t)row * (2 * D) + col), za0, za1); za0 += ba0; za1 += ba1;
#pragma unroll
                        for (int e = 0; e < 4; ++e) {
                            acc[ai][bj][m][0][e] *= (1.0f + __expf(-zb0[e])) / (1.0f + __expf(-za0[e]));
                            acc[ai][bj][m][1][e] *= (1.0f + __expf(-zb1[e])) / (1.0f + __expf(-za1[e])); }
                    } else {
                        f4 o0, o1;
#pragma unroll
                        for (int e = 0; e < 4; ++e) { o0[e] = acc[ai][bj][m][0][e] * sigmoidf_(zb0[e]); o1[e] = acc[ai][bj][m][1][e] * sigmoidf_(zb1[e]); }
                        *(v4u*)(mout + (size_t)row * D + col) = pack8(o0, o1);
                    } } }
    }
};

struct Resid {
    static constexpr bool PERM = true, AFTER_DRAIN = false, CHAIN = false;
    const float* base; float* out; bf16* outb; float* ss;
    DI bool keep(const Unit&) const { return false; }
    DI void operator()(f4 (&acc)[2][2][4][2], const Unit& u, int wr, int wc, int fr, int fq) const {
        { const int ln_ = lane_opaque(); fr = ln_ & 15; fq = ln_ >> 4; }
        const int row0 = u.pm * BM + wr * 64 + fr, col0 = u.pn * BM + wc * 32 + 8 * fq;
#pragma unroll
        for (int ai = 0; ai < 2; ++ai)
#pragma unroll
            for (int m = 0; m < 4; ++m) { const int row = row0 + ai * HALF + m * 16; float s = 0.f;
#pragma unroll
                for (int bj = 0; bj < 2; ++bj) { const size_t off = (size_t)row * D + col0 + bj * HALF;
                    const f4 h0 = *(const f4*)(base + off) + acc[ai][bj][m][0], h1 = *(const f4*)(base + off + 4) + acc[ai][bj][m][1];
                    *(f4*)(out + off) = h0; *(f4*)(out + off + 4) = h1; *(v4u*)(outb + off) = pack8(h0, h1);
                    s += (h0[0] * h0[0] + h0[1] * h0[1]) + (h0[2] * h0[2] + h0[3] * h0[3]) + (h1[0] * h1[0] + h1[1] * h1[1]) + (h1[2] * h1[2] + h1[3] * h1[3]); }
                s += __shfl_xor(s, 16); s += __shfl_xor(s, 32);
                if (fq == 0) atomicAdd(ss + row, s); }
    }
};

struct FfnUp {
    static constexpr bool PERM = true, AFTER_DRAIN = false, CHAIN = false;
    const float* ss; bf16* uout;
    DI bool keep(const Unit&) const { return false; }
    DI void operator()(f4 (&acc)[2][2][4][2], const Unit& u, int wr, int wc, int fr, int fq) const {
        { const int ln_ = lane_opaque(); fr = ln_ & 15; fq = ln_ >> 4; }
        const int row0 = u.pm * BM + wr * 64 + fr, col0 = u.pn * HALF + wc * 32 + 8 * fq;
        float rr[2][4];
#pragma unroll
        for (int ai = 0; ai < 2; ++ai)
#pragma unroll
            for (int m = 0; m < 4; ++m) rr[ai][m] = ss[row0 + ai * HALF + m * 16];
#pragma unroll
        for (int ai = 0; ai < 2; ++ai)
#pragma unroll
            for (int m = 0; m < 4; ++m) { const int row = row0 + ai * HALF + m * 16; const float r = __builtin_amdgcn_rsqf(rr[ai][m] * (1.0f / D) + RMS_EPS);
                f4 o0, o1;
#pragma unroll
                for (int e = 0; e < 4; ++e) { const float a0 = acc[ai][0][m][0][e] * r, a1 = acc[ai][0][m][1][e] * r;
                    o0[e] = a0 * sigmoidf_(a0) * (acc[ai][1][m][0][e] * r); o1[e] = a1 * sigmoidf_(a1) * (acc[ai][1][m][1][e] * r); }
                *(v4u*)(uout + (size_t)row * DFF + col0) = pack8(o0, o1); }
    }
};

struct StoreBf {
    static constexpr bool PERM = true, AFTER_DRAIN = false, CHAIN = false;
    bf16* o; int ld;
    DI bool keep(const Unit&) const { return false; }
    DI void operator()(f4 (&acc)[2][2][4][2], const Unit& u, int wr, int wc, int fr, int fq) const {
        { const int ln_ = lane_opaque(); fr = ln_ & 15; fq = ln_ >> 4; }
        const int row0 = u.pm * BM + wr * 64 + fr, col0 = u.pn * BM + wc * 32 + 8 * fq;
#pragma unroll
        for (int ai = 0; ai < 2; ++ai)
#pragma unroll
            for (int m = 0; m < 4; ++m)
#pragma unroll
                for (int bj = 0; bj < 2; ++bj) *(v4u*)(o + (size_t)(row0 + ai * HALF + m * 16) * ld + col0 + bj * HALF) = pack8(acc[ai][bj][m][0], acc[ai][bj][m][1]);
    }
};

struct PleGate {
    static constexpr bool PERM = true, AFTER_DRAIN = false, CHAIN = false;
    float* h; const bf16* pp; const float* ss_in; float* ss_out;
    DI bool keep(const Unit&) const { return false; }
    DI void operator()(f4 (&acc)[2][2][4][2], const Unit& u, int wr, int wc, int fr, int fq) const {
        { const int ln_ = lane_opaque(); fr = ln_ & 15; fq = ln_ >> 4; }
        const int row0 = u.pm * BM + wr * 64 + fr, col0 = u.pn * BM + wc * 32 + 8 * fq;
#pragma unroll
        for (int ai = 0; ai < 2; ++ai)
#pragma unroll
            for (int m = 0; m < 4; ++m) { const int row = row0 + ai * HALF + m * 16; const float r = __builtin_amdgcn_rsqf(ss_in[row] * (1.0f / D) + RMS_EPS); float s = 0.f;
#pragma unroll
                for (int bj = 0; bj < 2; ++bj) { const size_t off = (size_t)row * D + col0 + bj * HALF;
                    f4 p0, p1; unpack8(*(const v4u*)(pp + off), p0, p1);
                    f4 h0 = *(const f4*)(h + off), h1 = *(const f4*)(h + off + 4);
#pragma unroll
                    for (int e = 0; e < 4; ++e) { h0[e] += sigmoidf_(acc[ai][bj][m][0][e] * r) * p0[e]; h1[e] += sigmoidf_(acc[ai][bj][m][1][e] * r) * p1[e]; }
                    *(f4*)(h + off) = h0; *(f4*)(h + off + 4) = h1;
                    s += (h0[0] * h0[0] + h0[1] * h0[1]) + (h0[2] * h0[2] + h0[3] * h0[3]) + (h1[0] * h1[0] + h1[1] * h1[1]) + (h1[2] * h1[2] + h1[3] * h1[3]); }
                s += __shfl_xor(s, 16); s += __shfl_xor(s, 32);
                if (fq == 0) atomicAdd(ss_out + row, s); }
    }
};

struct Stack3Order {
    int G, c;
    DI bool next(int i, Unit& u) const { const int L = i * G + c; if (L >= 1536) return false; const int which = L >> 9, r = L & 511; u.pm = which * 64 + (r & 63); u.pn = which * 8 + (r >> 6); return true; }
    DI void a_ready(const Unit&) const {}
    DI void done(const Unit&) const {}
};
struct ChainOrder {
    pg8::StaticOrder so;
    DI bool next(int i, Unit& u) const { Unit t; if (!so.next(i >> 1, t)) return false; const int which = i & 1; u.pm = which * 64 + t.pm; u.pn = which * 16 + t.pn; return true; }
    DI void a_ready(const Unit&) const {}
    DI void done(const Unit&) const {}
};
}

constexpr size_t MiB = 1u << 20;
constexpr size_t WS_CTL = 0, CTL_ZERO_BYTES = 1 * MiB;
constexpr int CW_TMO = 0, CW_BAR = 4096;
constexpr size_t SS1_OFF = 256 * 1024, SS2_OFF = 320 * 1024, SS3_OFF = 384 * 1024;
constexpr size_t WS_RSTDX = 1 * MiB;
constexpr size_t WS_BONUS = 2 * MiB;
constexpr size_t WS_RCOS = 4 * MiB, WS_RSIN = 8 * MiB;
constexpr size_t WS_WI = 12 * MiB;
constexpr size_t WS_PB = 13 * MiB;
constexpr size_t WS_WPAB = 24 * MiB;
constexpr size_t WS_WO = 56 * MiB, WS_WPG = 88 * MiB;
constexpr size_t WS_WPLE = 120 * MiB;
constexpr size_t WS_WL2 = 122 * MiB;
constexpr size_t WS_R1 = 126 * MiB;
constexpr size_t WS_WCAT = 126 * MiB;
constexpr size_t WS_XB = 288 * MiB;
constexpr size_t WS_SCORE = 126 * MiB;
constexpr size_t WS_IDX = 382 * MiB;
constexpr size_t WS_DECAY = 126 * MiB;
constexpr size_t WS_AOUT = 254 * MiB;
constexpr size_t WS_ALORA = 318 * MiB;
constexpr size_t WS_W13 = 126 * MiB;
constexpr size_t WS_W2 = 298 * MiB;
constexpr size_t WS_Q = 416 * MiB, WS_K = 480 * MiB, WS_V = 496 * MiB, WS_QI = 512 * MiB, WS_KI = 576 * MiB;
constexpr size_t WS_RB = 580 * MiB, WS_KB = 644 * MiB, WS_VB = 708 * MiB, WS_LORA = 772 * MiB, WS_GATES = 804 * MiB;
constexpr size_t WS_Y = 416 * MiB;
constexpr size_t WS_MIX = 416 * MiB;
constexpr size_t WS_H1B = 544 * MiB;
constexpr size_t WS_U = 672 * MiB;
constexpr size_t WS_H2B = 416 * MiB;
constexpr size_t WS_PP = 544 * MiB;
constexpr size_t WS_AO = 1060 * MiB;
constexpr size_t WS_GOUT = 1188 * MiB;
constexpr size_t WS_END = 1252 * MiB;

constexpr int RING_OFF = 0, RING_BYTES = 131072;
constexpr int LDSCTL_OFF = RING_BYTES, MISC_OFF = LDSCTL_OFF + 320;
constexpr int LDS_BYTES = 147456;
constexpr int NWAVES = 8;

struct Args {
    const float* in[32]; float* out; unsigned char* ws; int ph_lo, ph_hi;
};
enum { I_X = 0, I_P, I_POS, I_NORM_MIX, I_W_IN, I_MU_RKV, I_MU_WAG, I_W0, I_W1, I_W2, I_A0, I_A1, I_A2, I_G1, I_G2, I_KK, I_KA, I_RK, I_LNW, I_LNB,
       I_WPA, I_WPB, I_WGATE, I_BGATE, I_WO, I_NORM_FFN, I_WFFN1, I_WFFN3, I_WFFN2, I_WPLEG, I_WPLE, I_NORM_FINAL };

struct TrSrc { const float* p; int ld, col0, nvalid, kvalid; const float* ksc; const float* mu; int mumode; };
DI void tr_item(const TrSrc& s, bf16* WT, int dK, int n0, int k0, LAS unsigned* T, int lane) {
    const int ng = lane & 15, kq = lane >> 4;
    f32x4 v[8][2]; f32x2 sc[8];
    const bool nok = 4 * ng < s.nvalid;
#pragma unroll
    for (int st = 0; st < 8; ++st) { const int k = k0 + 8 * st + 2 * kq;
#pragma unroll
        for (int j = 0; j < 2; ++j) v[st][j] = (nok && k + j < s.kvalid) ? *(const f32x4*)(s.p + (size_t)(k + j) * s.ld + s.col0 + 4 * ng) : (f32x4){0.f, 0.f, 0.f, 0.f};
        f32x2 c = {1.f, 1.f};
        if (s.ksc) c = *(const f32x2*)(s.ksc + k);
        if (s.mumode == 1) { const f32x2 m = *(const f32x2*)(s.mu + k); c = c * (1.0f - m); } else if (s.mumode == 2) { const f32x2 m = *(const f32x2*)(s.mu + k); c = c * m; }
        sc[st] = c; }
#pragma unroll
    for (int st = 0; st < 8; ++st) { const int kp = 4 * st + kq;
#pragma unroll
        for (int i = 0; i < 4; ++i) T[(4 * ng + i) * 32 + (kp ^ (4 * (ng & 7)))] = pk2(v[st][0][i] * sc[st][0], v[st][1][i] * sc[st][1]); }
    LDS_WAIT(); asm volatile("" ::: "memory");
#pragma unroll
    for (int j = 0; j < 8; ++j) { const int n = (lane >> 3) + 8 * j, c = lane & 7;
        *(GAS v4u*)(WT + (size_t)(n0 + n) * dK + k0 + 8 * c) = *(const LAS v4u*)(T + n * 32 + 4 * (c ^ ((n >> 2) & 7))); }
    LDS_WAIT(); asm volatile("" ::: "memory");
}
DI TrSrc src_wcat(const float* const* in, int n0) {
    TrSrc s; s.p = in[I_W_IN]; s.ld = DIN; s.col0 = 0; s.nvalid = 64; s.kvalid = D; s.ksc = in[I_NORM_MIX]; s.mu = nullptr; s.mumode = 0;
    const int tile = n0 >> 8, p = n0 & 255, bj = p >> 7, hh = (p >> 6) & 1;
    if (tile < 8)        s.col0 = 0    + (2 * tile + hh) * 128 + 64 * bj;
    else if (tile < 10)  s.col0 = 2048 + (2 * (tile - 8) + hh) * 128 + 64 * bj;
    else if (tile < 12)  s.col0 = 2560 + (tile - 10) * 256 + p;
    else if (tile < 20)  s.col0 = 3072 + (2 * (tile - 12) + hh) * 128 + 64 * bj;
    else if (tile == 20) { if (hh == 0) s.col0 = 5120 + 64 * bj; else if (bj == 0) { s.col0 = 5248; s.nvalid = 16; } else s.nvalid = 0; }
    else if (tile < 45)  s.col0 = 5264 + (tile - 21) * 256 + p;
    else if (tile < 49)  { const int c = (tile - 45) * 256 + p;
        const int seg = c < 128 ? 0 : c < 256 ? 1 : c < 512 ? 2 : c < 640 ? 3 : c < 768 ? 4 : 5, sbeg = seg == 0 ? 0 : seg == 1 ? 128 : seg == 2 ? 256 : seg == 3 ? 512 : seg == 4 ? 640 : 768;
        const int kind = seg % 3;
        s.p = in[kind == 0 ? I_W1 : (kind == 1 ? I_A1 : I_G1)]; s.ld = kind == 2 ? 256 : 96; s.col0 = c - sbeg; s.mu = in[I_MU_WAG] + kind * D; s.mumode = seg < 3 ? 1 : 2;
        if (kind != 2) s.nvalid = (s.col0 == 0) ? 64 : 32; }
    else { s.p = in[I_WGATE]; s.ld = 2 * D; s.col0 = (tile - 49) * 256 + p; }
    return s;
}
DI TrSrc src_plain(const float* p, int ld, int col0, int kvalid, const float* ksc) { TrSrc s; s.p = p; s.ld = ld; s.col0 = col0; s.nvalid = 64; s.kvalid = kvalid; s.ksc = ksc; s.mu = nullptr; s.mumode = 0; return s; }

DI void convert_set_a(const float* const* in, unsigned char* ws, LAS unsigned* scr, int gw, int NGW, int lane) {
    constexpr int I0 = (NCAT / 64) * (D / 64);
    constexpr int I1 = (D / 64) * (DA / 64);
    constexpr int I3 = (D / 64) * (D / 64);
    constexpr int I5 = (D / 64) * (DPLE / 64);
    constexpr int I6 = (DB / 64) * (256 / 64);
    constexpr int NITEMS = I0 + 2 * I1 + 2 * I3 + I5 + 3 * I6;
    for (int it = gw; it < NITEMS; it += NGW) {
        int r = it;
        if (r < I0) { const int nblk = NCAT / 64, kb = r / nblk, nb = r % nblk; tr_item(src_wcat(in, 64 * nb), (bf16*)(ws + WS_WCAT), D, 64 * nb, 64 * kb, scr, lane); continue; } r -= I0;
        if (r < 2 * I1) { const int w = r / I1; r -= w * I1; const int nblk = D / 64, kb = r / nblk, nb = r % nblk;
            tr_item(src_plain(in[w ? I_WPB : I_WPA], D, 64 * nb, DA, nullptr), (bf16*)(ws + WS_WPAB) + (size_t)w * D * DA, DA, 64 * nb, 64 * kb, scr, lane); continue; } r -= 2 * I1;
        if (r < 2 * I3) { const int w = r / I3; r -= w * I3; const int nblk = D / 64, kb = r / nblk, nb = r % nblk;
            tr_item(src_plain(in[w ? I_WPLEG : I_WO], D, 64 * nb, D, nullptr), (bf16*)(ws + (w ? WS_WPG : WS_WO)), D, 64 * nb, 64 * kb, scr, lane); continue; } r -= 2 * I3;
        if (r < I5) { const int nblk = D / 64, kb = r / nblk, nb = r % nblk; tr_item(src_plain(in[I_WPLE], D, 64 * nb, DPLE, nullptr), (bf16*)(ws + WS_WPLE), DPLE, 64 * nb, 64 * kb, scr, lane); continue; } r -= I5;
        { const int w = r / I6; r -= w * I6; const int nblk = DB / 64, kb = r / nblk, nb = r % nblk;
          tr_item(src_plain(in[w == 0 ? I_W2 : (w == 1 ? I_A2 : I_G2)], DB, 64 * nb, w == 2 ? 256 : 96, nullptr), (bf16*)(ws + WS_WL2) + (size_t)w * DB * 256, 256, 64 * nb, 64 * kb, scr, lane); }
    }
}
DI void convert_set_b(const float* const* in, unsigned char* ws, LAS unsigned* scr, int gw, int NGW, int lane) {
    constexpr int I0 = (N13 / 64) * (D / 64), I1 = (D / 64) * (DFF / 64);
    for (int it = gw; it < I0 + I1; it += NGW) {
        int r = it;
        if (r < I0) { const int nblk = N13 / 64, kb = r / nblk, nb = r % nblk, n0 = 64 * nb, tile = n0 >> 8, p = n0 & 255;
            tr_item(src_plain(in[(p >> 7) ? I_WFFN3 : I_WFFN1], DFF, tile * 128 + (p & 127), D, in[I_NORM_FFN]), (bf16*)(ws + WS_W13), D, n0, 64 * kb, scr, lane); continue; } r -= I0;
        { const int nblk = D / 64, kb = r / nblk, nb = r % nblk; tr_item(src_plain(in[I_WFFN2], D, 64 * nb, DFF, nullptr), (bf16*)(ws + WS_W2), DFF, 64 * nb, 64 * kb, scr, lane); }
    }
}
DI void prologue_rows(const float* const* in, unsigned char* ws, int gw, int NGW, int lane) {
    const float* x = in[I_X]; bf16* xb = (bf16*)(ws + WS_XB); float* rstd = (float*)(ws + WS_RSTDX);
    for (int m = gw; m < M; m += NGW) {
        const GAS f32x4* xr = (const GAS f32x4*)(x + (size_t)m * D) + lane; GAS v2u* o = (GAS v2u*)(xb + (size_t)m * D) + lane; float s = 0.f;
f32x4 xv[16];
#pragma unroll
        for (int j = 0; j < 16; ++j) xv[j] = xr[64 * j];
#pragma unroll
        for (int j = 0; j < 16; ++j) { const f32x4 v = xv[j]; s += (v.x * v.x + v.y * v.y) + (v.z * v.z + v.w * v.w); v2u w; w.x = pk2(v.x, v.y); w.y = pk2(v.z, v.w); o[64 * j] = w; }
        s = wave_sum(s);
        if (lane == 0) rstd[m] = 1.0f / sqrtf(s * (1.0f / D) + RMS_EPS);
    }
    const int* pos = (const int*)in[I_POS]; float* rc = (float*)(ws + WS_RCOS); float* rsn = (float*)(ws + WS_RSIN);
    for (int e = gw * 64 + lane; e < M * 64; e += NGW * 64) {
        const int m = e >> 6, i = e & 63; double inv = 1.0; for (int j = 0; j < i; ++j) inv *= 0.8659643233600653523;
        const double ang = (double)pos[m] * inv;
        const double qd = __builtin_rint(ang * 0.63661977236758134308); const int qi = (int)((long long)qd & 3);
        double r = __builtin_fma(-qd, 1.5707963267948965580, ang); r = __builtin_fma(-qd, 6.1232339957367658860e-17, r);
        const double r2 = r * r;
        const double sn = r * (1.0 + r2 * (-1.0 / 6 + r2 * (1.0 / 120 + r2 * (-1.0 / 5040 + r2 * (1.0 / 362880 + r2 * (-1.0 / 39916800 + r2 * (1.0 / 6227020800.0)))))));
        const double cs = 1.0 + r2 * (-0.5 + r2 * (1.0 / 24 + r2 * (-1.0 / 720 + r2 * (1.0 / 40320 + r2 * (-1.0 / 3628800 + r2 * (1.0 / 479001600.0 + r2 * (-1.0 / 87178291200.0)))))));
        const double c4 = (qi == 0) ? cs : (qi == 1) ? -sn : (qi == 2) ? -cs : sn;
        const double s4 = (qi == 0) ? sn : (qi == 1) ? cs : (qi == 2) ? -sn : -cs;
        rc[e] = (float)c4; rsn[e] = (float)s4;
    }
    const float* p = in[I_P]; bf16* pb = (bf16*)(ws + WS_PB);
    for (int e = gw * 64 + lane; e < M * DPLE / 4; e += NGW * 64) { const f32x4 v = ((const GAS f32x4*)p)[e]; v2u w; w.x = pk2(v.x, v.y); w.y = pk2(v.z, v.w); ((GAS v2u*)pb)[e] = w; }
}
DI void build_alora(unsigned char* ws, int gtid, int NT) {
    const bf16* L = (const bf16*)(ws + WS_LORA); bf16* A = (bf16*)(ws + WS_ALORA);
    for (int e = gtid; e < 3 * M * 32; e += NT) {
        const int which = e / (M * 32), r = e - which * (M * 32), m = r >> 5, j0 = (r & 31) * 8;
        f32x4 o0 = {0.f, 0.f, 0.f, 0.f}, o1 = o0;
        const int width = which == 2 ? 256 : 96, ca = which == 0 ? 0 : (which == 1 ? 128 : 256), cbb = which == 0 ? 512 : (which == 1 ? 640 : 768);
        if (j0 < width) {
            f32x4 c0, c1, p0 = {0.f, 0.f, 0.f, 0.f}, p1 = p0;
            epi::unpack8(*(const v4u*)(L + (size_t)m * LORA_LD + ca + j0), c0, c1);
            if ((m & (SEQ - 1)) != 0) epi::unpack8(*(const v4u*)(L + (size_t)(m - 1) * LORA_LD + cbb + j0), p0, p1);
            o0 = c0 + p0; o1 = c1 + p1;
            if (which == 0) {
#pragma unroll
                for (int t = 0; t < 4; ++t) { o0[t] = 1.0f - 2.0f / (__expf(2.0f * o0[t]) + 1.0f); o1[t] = 1.0f - 2.0f / (__expf(2.0f * o1[t]) + 1.0f); } }
            if (which == 2) {
#pragma unroll
                for (int t = 0; t < 4; ++t) { o0[t] = sigmoidf_(o0[t]); o1[t] = sigmoidf_(o1[t]); } }
        }
        *(v4u*)(A + ((size_t)which * M + m) * 256 + j0) = epi::pack8(o0, o1);
    }
}

constexpr int IDX_TS = 272;
constexpr int IDX_TILE_BYTES = 64 * IDX_TS;
constexpr int IDX_HIST_OFF = 2 * IDX_TILE_BYTES;

DI unsigned fkey(float f) { unsigned u = __builtin_bit_cast(unsigned, f); if (u == 0x80000000u) u = 0u; return (u & 0x80000000u) ? ~u : (u | 0x80000000u); }

DI void indexer_unit(unsigned char* ws, LAS unsigned char* lds, int b, int blk, float* scratch, int wave) {
    const int lane = lane_opaque(), tid = wave * 64 + lane;
    const bf16* qi = (const bf16*)(ws + WS_QI); const bf16* ki = (const bf16*)(ws + WS_KI); const float* wi = (const float*)(ws + WS_WI);
    const int t0 = blk * 32, mrow0 = b * SEQ + t0;
    const int r = lane & 31, kh = lane >> 5, aq = (r >> 2) & 1, ah = (r & 3) + 4 * (r >> 3);
    bf16x8 af[2][8]; f32x4 wg[2][4];
#pragma unroll
    for (int rt = 0; rt < 2; ++rt) {
        const bf16* src = qi + (size_t)(mrow0 + 4 * wave + 2 * rt + aq) * DIQ + ah * HDI + 8 * kh;
#pragma unroll
        for (int ks = 0; ks < 8; ++ks) af[rt][ks] = *(const bf16x8*)(src + 16 * ks);
        const float* wsrc = wi + (size_t)(mrow0 + 4 * wave + 2 * rt + kh) * NHI;
#pragma unroll
        for (int j = 0; j < 4; ++j) wg[rt][j] = *(const f32x4*)(wsrc + 4 * j) * 0.08838834764831845f;
    }
    const int nk = (t0 + 32 + 63) >> 6;
    const int lkey = tid >> 3, lpart = tid & 7;
    const bf16* kbase = ki + (size_t)(b * SEQ) * HDI;
    v4u st0, st1;
    { const v4u* g = (const v4u*)(kbase + (size_t)lkey * HDI + lpart * 16); st0 = g[0]; st1 = g[1]; }
    __syncthreads();
    { LAS v4u* d = (LAS v4u*)(lds + lkey * IDX_TS + lpart * 32); d[0] = st0; d[1] = st1; }
    __syncthreads();
#pragma unroll
    for (int rt = 0; rt < 2; ++rt) {
#pragma unroll
        for (int ks = 0; ks < 8; ++ks) asm volatile("; pin %0" : "+v"(af[rt][ks]));
#pragma unroll
        for (int j = 0; j < 4; ++j) asm volatile("; pin %0" : "+v"(wg[rt][j])); }
    for (int kt = 0; kt < nk; ++kt) {
        if (kt + 1 < nk) { const v4u* g = (const v4u*)(kbase + (size_t)((kt + 1) * 64 + lkey) * HDI + lpart * 16); st0 = g[0]; st1 = g[1]; }
        const LAS unsigned char* tb = lds + (kt & 1) * IDX_TILE_BYTES;
#pragma unroll
        for (int ct = 0; ct < 2; ++ct) {
            bf16x8 bfr[8];
#pragma unroll
            for (int ks = 0; ks < 8; ++ks) bfr[ks] = *(const LAS bf16x8*)(tb + (32 * ct + r) * IDX_TS + (16 * ks + 8 * kh) * 2);
#pragma unroll
            for (int rt = 0; rt < 2; ++rt) {
                f32x16 c;
#pragma unroll
                for (int j = 0; j < 16; ++j) c[j] = 0.f;
#pragma unroll
                for (int ks = 0; ks < 8; ++ks) c = __builtin_amdgcn_mfma_f32_32x32x16_bf16(af[rt][ks], bfr[ks], c, 0, 0, 0);
                float s = 0.f;
#pragma unroll
                for (int j = 0; j < 16; ++j) s += wg[rt][j >> 2][j & 3] * __builtin_amdgcn_fmed3f(c[j], 0.f, 3.0e38f);
                scratch[(size_t)(4 * wave + 2 * rt + kh) * SEQ + kt * 64 + 32 * ct + r] = s;
            }
        }
        if (kt + 1 < nk) { LAS v4u* d = (LAS v4u*)(lds + ((kt + 1) & 1) * IDX_TILE_BYTES + lkey * IDX_TS + lpart * 32); d[0] = st0; d[1] = st1; }
        asm volatile("s_waitcnt lgkmcnt(0)" ::: "memory"); __builtin_amdgcn_s_barrier(); asm volatile("" ::: "memory");
    }
}

DI void select_unit(unsigned char* ws, LAS unsigned char* lds, int b, int blk, const float* scratch, int wave) {
    int* idx = (int*)(ws + WS_IDX);
    LAS unsigned* hist = (LAS unsigned*)(lds + IDX_HIST_OFF + wave * 8192);
    for (int qq = 0; qq < 4; ++qq) {
        const int lane = lane_opaque(); const unsigned long long lt_mask = (1ull << lane) - 1ull;
        const int ql = wave * 4 + qq, t = blk * 32 + ql, n = t + 1;
        const float* sc = scratch + (size_t)ql * SEQ; int* out = idx + (size_t)(b * SEQ + t) * TOPK;
        if (n <= TOPK) { for (int e = lane; e < TOPK; e += 64) out[e] = (e < n) ? e : 0; continue; }
        const int n4 = (n + 3) >> 2;
        v4u key[32];
#pragma unroll
        for (int j = 0; j < 32; ++j) { key[j] = (v4u){0u, 0u, 0u, 0u};
            if (64 * j < n4) { const int gi = 64 * j + lane; if (gi < n4) { const f32x4 v = *(const f32x4*)(sc + 4 * gi); const int e0 = 4 * gi;
                key[j].x = fkey(v[0]); key[j].y = (e0 + 1 < n) ? fkey(v[1]) : 0u; key[j].z = (e0 + 2 < n) ? fkey(v[2]) : 0u; key[j].w = (e0 + 3 < n) ? fkey(v[3]) : 0u; } } }
        unsigned prefix = 0u, pmask = 0u; int kk = TOPK;
        for (int pass = 0; pass < 4; ++pass) {
            const int shift = 24 - 8 * pass;
#pragma unroll
            for (int z = 0; z < 8; ++z) *(LAS v4u*)(hist + 4 * (lane + 64 * z)) = (v4u){0u, 0u, 0u, 0u};
            LAS unsigned* hc = hist + 256 * (lane & 7);
#pragma unroll
            for (int j = 0; j < 32; ++j) if (64 * j < n4) {
#pragma unroll
                for (int c = 0; c < 4; ++c) { const unsigned u = key[j][c]; if ((u & pmask) == prefix) __hip_atomic_fetch_add(hc + ((u >> shift) & 255u), 1u, __ATOMIC_RELAXED, __HIP_MEMORY_SCOPE_WORKGROUP); } }
            LDS_WAIT(); asm volatile("" ::: "memory");
            v4u hs = {0u, 0u, 0u, 0u};
#pragma unroll
            for (int z = 0; z < 8; ++z) hs += *(const LAS v4u*)(hist + 256 * z + 4 * lane);
            const int c0 = (int)hs.x, c1 = (int)hs.y, c2 = (int)hs.z, c3 = (int)hs.w;
            const int T = c0 + c1 + c2 + c3; int S = T;
#pragma unroll
            for (int o = 1; o < 64; o <<= 1) { const int v = __shfl_down(S, o); if (lane + o < 64) S += v; }
            const int E = S - T;
            const bool found = (E < kk) && (kk <= S);
            int d = 0, knew = 0;
            if (found) { int run = E;
                if (run + c3 >= kk) { d = 4 * lane + 3; knew = kk - run; } else { run += c3;
                if (run + c2 >= kk) { d = 4 * lane + 2; knew = kk - run; } else { run += c2;
                if (run + c1 >= kk) { d = 4 * lane + 1; knew = kk - run; } else { run += c1; d = 4 * lane; knew = kk - run; } } } }
            const unsigned long long fm = __ballot(found); const int src = fm ? (int)__builtin_ctzll(fm) : 0;
            d = __shfl(d, src); knew = __shfl(knew, src);
            prefix |= ((unsigned)d) << shift; pmask |= 0xffu << shift; kk = knew;
            asm volatile("" ::: "memory");
        }
        int pos = 0, eqt = 0;
#pragma unroll
        for (int j = 0; j < 32; ++j) if (64 * j < n4) {
            bool eq[4], gt[4]; unsigned long long em[4]; int eq_before = eqt;
#pragma unroll
            for (int c = 0; c < 4; ++c) { const unsigned u = key[j][c]; eq[c] = (u == prefix); gt[c] = (u > prefix); em[c] = __ballot(eq[c]); eq_before += __builtin_popcountll(em[c] & lt_mask); }
            bool take[4]; unsigned long long tm[4]; int tk_before = pos, run_eq = eq_before;
#pragma unroll
            for (int c = 0; c < 4; ++c) { take[c] = gt[c] || (eq[c] && run_eq < kk); run_eq += eq[c] ? 1 : 0; tm[c] = __ballot(take[c]); tk_before += __builtin_popcountll(tm[c] & lt_mask); }
            int slot = tk_before;
#pragma unroll
            for (int c = 0; c < 4; ++c) { if (take[c]) { if (slot < TOPK) out[slot] = 256 * j + 4 * lane + c; ++slot; } }
#pragma unroll
            for (int c = 0; c < 4; ++c) { pos += __builtin_popcountll(tm[c]); eqt += __builtin_popcountll(em[c]); }
        }
    }
}

DI void indexer_phase(unsigned char* ws, LAS unsigned char* lds, int wave) {
    float* scratch = (float*)(ws + WS_SCORE) + (size_t)blockIdx.x * 32 * SEQ;
    for (int pr = blockIdx.x; pr < 256; pr += gridDim.x) {
        const int b = pr >> 7, j = pr & 127;
        for (int half = 0; half < 2; ++half) { const int blk = half ? 255 - j : j;
            indexer_unit(ws, lds, b, blk, scratch, wave);
            VM_WAIT(); __syncthreads();
#ifndef REP_SEL
#define REP_SEL 1
#endif
            for (int rs_ = 0; rs_ < REP_SEL; ++rs_) select_unit(ws, lds, b, blk, scratch, wave);
            VM_WAIT(); __syncthreads(); }
    }
}

typedef int v4i __attribute__((ext_vector_type(4)));
#define ATT_FENCE() asm volatile("" ::: "memory")
DI void attn_worker(unsigned char* ws, LAS unsigned char* lds, LAS unsigned* qctr, int wave) {
    const int lane = lane_opaque();
    const bf16* q = (const bf16*)(ws + WS_Q); const bf16* kbuf = (const bf16*)(ws + WS_K); const bf16* vbuf = (const bf16*)(ws + WS_V);
    const int* idx = (const int*)(ws + WS_IDX); bf16* ao = (bf16*)(ws + WS_AO);
    LAS int* idl = (LAS int*)(lds + wave * 5120); LAS float* pl = (LAS float*)(lds + wave * 5120 + 1024);
    const int G = gridDim.x, bg = blockIdx.x & 7, b = bg >> 2, g = bg & 3;
    const int nbk = (G - bg + 7) >> 3, rank = blockIdx.x >> 3, nq = (SEQ - rank + nbk - 1) / nbk;
    const int kr = lane & 15, kq = lane >> 4;
    const int kg = lane >> 4, dg = lane & 15;
    const bf16* kbase = kbuf + (size_t)(b * SEQ) * KVD + g * 128 + 8 * kq;
    const bf16* vbase = vbuf + (size_t)(b * SEQ) * KVD + g * 128 + 8 * dg;
    int qn; { unsigned v_ = 0u; if (lane == 0) v_ = __hip_atomic_fetch_add(qctr, 1u, __ATOMIC_RELAXED, __HIP_MEMORY_SCOPE_WORKGROUP); qn = __builtin_amdgcn_readfirstlane((int)v_); }
    int ixg[4]; bf16x8 qf[4];
    if (qn < nq) { const int mq = b * SEQ + rank + nbk * qn;
#pragma unroll
        for (int c = 0; c < 4; ++c) ixg[c] = idx[(size_t)mq * TOPK + lane + 64 * c];
#pragma unroll
        for (int ks = 0; ks < 4; ++ks) { if (kr < 4) qf[ks] = *(const bf16x8*)(q + (size_t)mq * DA + (4 * g + kr) * 128 + 32 * ks + 8 * kq); else qf[ks] = (bf16x8){0, 0, 0, 0, 0, 0, 0, 0}; } }
    while (qn < nq) {
        const int t = rank + nbk * qn, mq = b * SEQ + t, nvalid = (t + 1 < TOPK) ? t + 1 : TOPK;
#pragma unroll
        for (int c = 0; c < 4; ++c) idl[lane + 64 * c] = ixg[c];
        LDS_WAIT(); ATT_FENCE();
        int qn2; { unsigned v_ = 0u; if (lane == 0) v_ = __hip_atomic_fetch_add(qctr, 1u, __ATOMIC_RELAXED, __HIP_MEMORY_SCOPE_WORKGROUP); qn2 = __builtin_amdgcn_readfirstlane((int)v_); }
        if (qn2 < nq) { const int mq2 = b * SEQ + rank + nbk * qn2;
#pragma unroll
            for (int c = 0; c < 4; ++c) ixg[c] = idx[(size_t)mq2 * TOPK + lane + 64 * c]; }
        ATT_FENCE();
        int kidx[16];
#pragma unroll
        for (int kt = 0; kt < 16; ++kt) kidx[kt] = idl[64 * (kr >> 2) + 4 * kt + (kr & 3)];
        f32x4 s[16]; bf16x8 kf[3][2][4];
#pragma unroll
        for (int hg = 0; hg < 2; ++hg) {
#pragma unroll
            for (int j = 0; j < 2; ++j) { const bf16* kp = kbase + (size_t)kidx[2 * hg + j] * KVD;
#pragma unroll
                for (int ks = 0; ks < 4; ++ks) kf[hg][j][ks] = *(const bf16x8*)(kp + 32 * ks); }
            ATT_FENCE(); }
#pragma unroll
        for (int hg = 0; hg < 8; ++hg) {
            if (hg + 2 < 8) {
#pragma unroll
                for (int j = 0; j < 2; ++j) { const bf16* kp = kbase + (size_t)kidx[2 * (hg + 2) + j] * KVD;
#pragma unroll
                    for (int ks = 0; ks < 4; ++ks) kf[(hg + 2) % 3][j][ks] = *(const bf16x8*)(kp + 32 * ks); }
                ATT_FENCE(); }
#pragma unroll
            for (int j = 0; j < 2; ++j) { f32x4 a = {0.f, 0.f, 0.f, 0.f};
#pragma unroll
                for (int ks = 0; ks < 4; ++ks) a = __builtin_amdgcn_mfma_f32_16x16x32_bf16(kf[hg % 3][j][ks], qf[ks], a, 0, 0, 0);
                s[2 * hg + j] = a; }
        }
        if (qn2 < nq && kr < 4) { const int mq2 = b * SEQ + rank + nbk * qn2;
#pragma unroll
            for (int ks = 0; ks < 4; ++ks) qf[ks] = *(const bf16x8*)(q + (size_t)mq2 * DA + (4 * g + kr) * 128 + 32 * ks + 8 * kq); }
        ATT_FENCE();
        v4i ix[3][2]; v4u vv[3][8];
#pragma unroll
        for (int ch = 0; ch < 2; ++ch) {
            ix[ch][0] = *(const LAS v4i*)(idl + 64 * kg + 8 * ch); ix[ch][1] = *(const LAS v4i*)(idl + 64 * kg + 8 * ch + 4);
#pragma unroll
            for (int j = 0; j < 8; ++j) vv[ch][j] = *(const v4u*)(vbase + (size_t)ix[ch][j >> 2][j & 3] * KVD);
            ATT_FENCE(); }
        float mx = -3.0e38f;
#pragma unroll
        for (int kt = 0; kt < 16; ++kt)
#pragma unroll
            for (int e = 0; e < 4; ++e) { const bool ok = (64 * kq + 4 * kt + e) < nvalid; s[kt][e] = ok ? s[kt][e] * 0.08838834764831845f : -3.0e38f; mx = fmaxf(mx, s[kt][e]); }
        mx = fmaxf(mx, __shfl_xor(mx, 16)); mx = fmaxf(mx, __shfl_xor(mx, 32));
        float sum = 0.f;
#pragma unroll
        for (int kt = 0; kt < 16; ++kt)
#pragma unroll
            for (int e = 0; e < 4; ++e) { const bool ok = (64 * kq + 4 * kt + e) < nvalid; const float p = ok ? __expf(s[kt][e] - mx) : 0.f; s[kt][e] = p; sum += p; }
        sum += __shfl_xor(sum, 16); sum += __shfl_xor(sum, 32);
        const float inv = 1.0f / sum;
        if (kr < 4) {
#pragma unroll
            for (int kt = 0; kt < 16; ++kt) *(LAS f32x4*)(pl + kr * 256 + 64 * kq + 4 * kt) = s[kt] * inv; }
        LDS_WAIT(); ATT_FENCE();
        f32x2 acc[4][4];
#pragma unroll
        for (int h = 0; h < 4; ++h)
#pragma unroll
            for (int d = 0; d < 4; ++d) acc[h][d] = (f32x2){0.f, 0.f};
#pragma unroll
        for (int ch = 0; ch < 8; ++ch) {
            if (ch + 2 < 8) { const int c2 = (ch + 2) % 3;
                ix[c2][0] = *(const LAS v4i*)(idl + 64 * kg + 8 * (ch + 2)); ix[c2][1] = *(const LAS v4i*)(idl + 64 * kg + 8 * (ch + 2) + 4);
#pragma unroll
                for (int j = 0; j < 8; ++j) vv[c2][j] = *(const v4u*)(vbase + (size_t)ix[c2][j >> 2][j & 3] * KVD);
                ATT_FENCE(); }
            f32x4 pp[4][2];
#pragma unroll
            for (int h = 0; h < 4; ++h) { pp[h][0] = *(const LAS f32x4*)(pl + h * 256 + 64 * kg + 8 * ch); pp[h][1] = *(const LAS f32x4*)(pl + h * 256 + 64 * kg + 8 * ch + 4); }
#pragma unroll
            for (int j = 0; j < 8; ++j) { const v4u w = vv[ch % 3][j];
                const f32x2 v0 = {bf_lo(w.x), bf_hi(w.x)}, v1 = {bf_lo(w.y), bf_hi(w.y)}, v2 = {bf_lo(w.z), bf_hi(w.z)}, v3 = {bf_lo(w.w), bf_hi(w.w)};
#pragma unroll
                for (int h = 0; h < 4; ++h) { const float p = pp[h][j >> 2][j & 3]; const f32x2 p2 = {p, p};
                    acc[h][0] += p2 * v0; acc[h][1] += p2 * v1; acc[h][2] += p2 * v2; acc[h][3] += p2 * v3; }
            }
        }
#pragma unroll
        for (int h = 0; h < 4; ++h)
#pragma unroll
            for (int d = 0; d < 4; ++d) {
                acc[h][d][0] += __shfl_xor(acc[h][d][0], 16); acc[h][d][1] += __shfl_xor(acc[h][d][1], 16);
                acc[h][d][0] += __shfl_xor(acc[h][d][0], 32); acc[h][d][1] += __shfl_xor(acc[h][d][1], 32); }
        if (kg == 0) {
#pragma unroll
            for (int h = 0; h < 4; ++h) { v4u w; w.x = pk2(acc[h][0][0], acc[h][0][1]); w.y = pk2(acc[h][1][0], acc[h][1][1]); w.z = pk2(acc[h][2][0], acc[h][2][1]); w.w = pk2(acc[h][3][0], acc[h][3][1]);
                *(v4u*)(ao + (size_t)mq * DA + (4 * g + h) * 128 + 8 * dg) = w; } }
        LDS_WAIT(); ATT_FENCE();
        qn = qn2;
    }
}

constexpr int SC_STEPS = 32, SC_STEP_BYTES = 1344, SC_BUF_BYTES = SC_STEPS * SC_STEP_BYTES;
constexpr int SC_Y_OFF = 2 * SC_BUF_BYTES;

template <int CTRL> DI float dpp_add(float x) { return x + __builtin_bit_cast(float, __builtin_amdgcn_update_dpp(0, __builtin_bit_cast(int, x), CTRL, 0xf, 0xf, false)); }
DI float red16(float x) { x = dpp_add<0xB1>(x); x = dpp_add<0x4E>(x); x = dpp_add<0x141>(x); x = dpp_add<0x140>(x); return x; }

struct ScanRaw { v2u rc, rp, kc, kp, vc, vp, ac; f32x4 dc; };
struct ScanConst { f32x4 mu_r, mu_k, mu_v, kkw, kaw, rkw; };
DI f32x4 bf4(const v2u& w) { f32x4 r; r[0] = bf_lo(w.x); r[1] = bf_hi(w.x); r[2] = bf_lo(w.y); r[3] = bf_hi(w.y); return r; }

DI void scan_issue(ScanRaw& R, const unsigned char* ws, int b, int h, int t, int cg) {
    const bf16* rb = (const bf16*)(ws + WS_RB); const bf16* kb = (const bf16*)(ws + WS_KB); const bf16* vb = (const bf16*)(ws + WS_VB);
    const float* decay = (const float*)(ws + WS_DECAY); const bf16* av = (const bf16*)(ws + WS_AOUT);
    const size_t o = (size_t)(b * SEQ + t) * DB + h * HDB + 4 * cg;
    R.rc = *(const v2u*)(rb + o); R.kc = *(const v2u*)(kb + o); R.vc = *(const v2u*)(vb + o); R.dc = *(const f32x4*)(decay + o); R.ac = *(const v2u*)(av + o);
    if (t > 0) { R.rp = *(const v2u*)(rb + o - DB); R.kp = *(const v2u*)(kb + o - DB); R.vp = *(const v2u*)(vb + o - DB); }
    else { R.rp = (v2u){0u, 0u}; R.kp = (v2u){0u, 0u}; R.vp = (v2u){0u, 0u}; }
}
DI void scan_emit(const ScanRaw& R, const ScanConst& C, LAS float* sb, int cg, int qr, float* bonus_dst) {
    const f32x4 rc = bf4(R.rc), rp = bf4(R.rp), kc = bf4(R.kc), kp = bf4(R.kp), vc = bf4(R.vc), vp = bf4(R.vp), a = bf4(R.ac);
    const f32x4 r1 = rc + (rp - rc) * C.mu_r, k0 = kc + (kp - kc) * C.mu_k, v1 = vc + (vp - vc) * C.mu_v;
    const f32x4 kkv = k0 * C.kkw;
    const float nrm = sqrtf(red16((kkv[0] * kkv[0] + kkv[1] * kkv[1]) + (kkv[2] * kkv[2] + kkv[3] * kkv[3])));
    const f32x4 kkn = kkv * (1.0f / fmaxf(nrm, 1e-12f));
    const f32x4 k1 = k0 * (1.0f + (a - 1.0f) * C.kaw);
    const f32x4 rk = r1 * k1 * C.rkw;
    const float bc = red16((rk[0] + rk[1]) + (rk[2] + rk[3]));
    *(LAS f32x4*)(sb + 4 * cg) = R.dc; *(LAS f32x4*)(sb + 64 + 4 * cg) = -kkn; *(LAS f32x4*)(sb + 128 + 4 * cg) = kkn * a;
    *(LAS f32x4*)(sb + 192 + 4 * cg) = k1; *(LAS f32x4*)(sb + 256 + 4 * cg) = r1;
    if ((cg >> 2) == qr) *(LAS f32x4*)(sb + 320 + 4 * (cg & 3)) = v1;
    if (bonus_dst != nullptr && cg == 0) *bonus_dst = bc;
}
DI float red8(float x) { x = dpp_add<0xB1>(x); x = dpp_add<0x4E>(x); x = dpp_add<0x141>(x); return x; }
struct ScanVec { f32x4 w0, w1, a0, a1, b0, b1, k0, k1, r0, r1; float v; };
DI void scan_ld(ScanVec& V, const LAS float* sb, int cg, int vrow) {
    V.w0 = *(const LAS f32x4*)(sb + 8 * cg); V.w1 = *(const LAS f32x4*)(sb + 8 * cg + 4); V.a0 = *(const LAS f32x4*)(sb + 64 + 8 * cg); V.a1 = *(const LAS f32x4*)(sb + 64 + 8 * cg + 4);
    V.b0 = *(const LAS f32x4*)(sb + 128 + 8 * cg); V.b1 = *(const LAS f32x4*)(sb + 128 + 8 * cg + 4); V.k0 = *(const LAS f32x4*)(sb + 192 + 8 * cg); V.k1 = *(const LAS f32x4*)(sb + 192 + 8 * cg + 4);
    V.r0 = *(const LAS f32x4*)(sb + 256 + 8 * cg); V.r1 = *(const LAS f32x4*)(sb + 256 + 8 * cg + 4); V.v = sb[320 + vrow];
}
DI float scan_step(f32x4& s0, f32x4& s1, const ScanVec& V) {
    const f32x4 t0 = s0 * V.w0 + V.k0 * V.v, t1 = s1 * V.w1 + V.k1 * V.v;
    const f32x4 p = s0 * V.a0 + s1 * V.a1;
    const float sa = red8((p[0] + p[1]) + (p[2] + p[3]));
    s0 = t0 + V.b0 * sa; s1 = t1 + V.b1 * sa;
    const f32x4 q = s0 * V.r0 + s1 * V.r1;
    return red8((q[0] + q[1]) + (q[2] + q[3]));
}
DI void lds_signal(LAS unsigned* p, int lane) { asm volatile("s_waitcnt lgkmcnt(0)" ::: "memory"); if (lane == 0) __hip_atomic_fetch_add(p, 1u, __ATOMIC_RELAXED, __HIP_MEMORY_SCOPE_WORKGROUP); }
DI void lds_wait_ge(LAS unsigned* p, unsigned v) {
    unsigned spins = 0;
    while ((unsigned)__builtin_amdgcn_readfirstlane(__hip_atomic_load(p, __ATOMIC_RELAXED, __HIP_MEMORY_SCOPE_WORKGROUP)) < v) { __builtin_amdgcn_s_sleep(1); if (++spins > (1u << 24)) break; }
    asm volatile("" ::: "memory");
}
constexpr int SC_YW_OFF = 2 * SC_BUF_BYTES;
constexpr int SC_NSCAN = 2, SC_NLOAD = 2;

DI void scan_task(const float* const* in, unsigned char* ws, float* y, LAS unsigned char* lds, LAS unsigned* ctr, int task, int wave) {
    const int lane = lane_opaque();
    float* bonus = (float*)(ws + WS_BONUS);
    constexpr int NCHUNK = SEQ / SC_STEPS;
    const int bh = task >> 2, qr = task & 3, b = bh >> 5, h = bh & 31;
    if (wave < SC_NSCAN) {
        const int rl = lane >> 3, cg = lane & 7, vrow = 8 * wave + rl;
        f32x4 s0 = {0.f, 0.f, 0.f, 0.f}, s1 = s0;
        LAS float* yb = (LAS float*)(lds + SC_YW_OFF + wave * 1024);
        for (int c = 0; c < NCHUNK; ++c) {
            lds_wait_ge(ctr, (unsigned)(c + 1)); lds_wait_ge(ctr + 1, (unsigned)(c + 1));
            const LAS unsigned char* buf = lds + (c & 1) * SC_BUF_BYTES;
            ScanVec A, B; scan_ld(A, (const LAS float*)buf, cg, vrow);
#pragma unroll 2
            for (int s = 0; s < SC_STEPS; s += 2) {
                scan_ld(B, (const LAS float*)(buf + (s + 1) * SC_STEP_BYTES), cg, vrow);
                const float y0 = scan_step(s0, s1, A);
                if (s + 2 < SC_STEPS) scan_ld(A, (const LAS float*)(buf + (s + 2) * SC_STEP_BYTES), cg, vrow);
                const float y1 = scan_step(s0, s1, B);
                if (cg == 0) { yb[s * 8 + rl] = y0; yb[(s + 1) * 8 + rl] = y1; }
            }
            lds_signal(ctr + 2 + wave, lane);
            { const int s = lane >> 1, hf = lane & 1, t = c * SC_STEPS + s;
              *(f32x4*)(y + (size_t)(b * SEQ + t) * DB + h * HDB + 16 * qr + 8 * wave + 4 * hf) = *(const LAS f32x4*)(yb + s * 8 + 4 * hf); }
            asm volatile("s_waitcnt lgkmcnt(0)" ::: "memory");
        }
    } else if (wave < SC_NSCAN + SC_NLOAD) {
        const int lw = wave - SC_NSCAN, rl = lane >> 4, cg = lane & 15, col0 = h * HDB + 4 * cg;
        ScanConst C; C.mu_r = *(const f32x4*)(in[I_MU_RKV] + col0); C.mu_k = *(const f32x4*)(in[I_MU_RKV] + DB + col0); C.mu_v = *(const f32x4*)(in[I_MU_RKV] + 2 * DB + col0);
        C.kkw = *(const f32x4*)(in[I_KK] + col0); C.kaw = *(const f32x4*)(in[I_KA] + col0); C.rkw = *(const f32x4*)(in[I_RK] + col0);
        ScanRaw R[4];
#pragma unroll
        for (int p = 0; p < 4; ++p) scan_issue(R[p], ws, b, h, 4 * (lw + 2 * p) + rl, cg);
        for (int c = 0; c < NCHUNK; ++c) {
            if (c >= 2) { lds_wait_ge(ctr + 2, (unsigned)(c - 1)); lds_wait_ge(ctr + 3, (unsigned)(c - 1)); }
            LAS float* base = (LAS float*)(lds + (c & 1) * SC_BUF_BYTES); const int t0 = c * SC_STEPS;
#pragma unroll
            for (int p = 0; p < 4; ++p) { const int st = 4 * (lw + 2 * p) + rl;
                scan_emit(R[p], C, base + st * (SC_STEP_BYTES / 4), cg, qr, qr == 0 ? bonus + (size_t)(b * SEQ + t0 + st) * NHB + h : nullptr);
                if (c + 1 < NCHUNK) scan_issue(R[p], ws, b, h, t0 + SC_STEPS + st, cg); }
            lds_signal(ctr + lw, lane);
        }
    }
}

constexpr int ATT_LDS_OFF = 90112;
DI void scan_attn_phase(const float* const* in, unsigned char* ws, float* y, LAS unsigned char* lds, LAS unsigned* ctr, int wave, int lane) {
    bool first = true;
    for (int task = blockIdx.x; task < BATCH * NHB * 4 || first; task += gridDim.x) {
        __syncthreads();
        if (wave == 0 && lane_opaque() == 0) { ((LAS v4u*)ctr)[0] = (v4u){0u, 0u, 0u, 0u}; ((LAS v4u*)ctr)[1] = (v4u){0u, 0u, 0u, 0u}; }
        __syncthreads();
        if (task < BATCH * NHB * 4) scan_task(in, ws, y, lds, ctr, task, wave);
        if (first) attn_worker(ws, lds + ATT_LDS_OFF, ctr + 4, wave);
        first = false;
    }
}

DI void gn_phase(const float* const* in, unsigned char* ws, const float* y, int gw, int NGW, int lane) {
    const bf16* vb = (const bf16*)(ws + WS_VB); const bf16* gout = (const bf16*)(ws + WS_GOUT);
    const float* bonus = (const float*)(ws + WS_BONUS); bf16* ro = (bf16*)(ws + WS_AO) + (size_t)M * DB;
    const int per = (M * 8 + NGW - 1) / NGW, it0 = gw * per, it1 = (it0 + per < M * 8) ? it0 + per : M * 8;
    const int hh = lane >> 4, cg = lane & 15;
#pragma unroll 2
    for (int it = it0; it < it1; ++it) {
        const int m = it >> 3, h = (it & 7) * 4 + hh, col = h * HDB + 4 * cg; const size_t o = (size_t)m * DB + col;
        const f32x4 yv = *(const f32x4*)(y + o);
        const f32x4 vc = bf4(*(const v2u*)(vb + o)), g4 = bf4(*(const v2u*)(gout + o));
        f32x4 vp = {0.f, 0.f, 0.f, 0.f}; if (m & (SEQ - 1)) vp = bf4(*(const v2u*)(vb + o - DB));
        const float bc = bonus[(size_t)m * NHB + h];
        const f32x4 lw = *(const f32x4*)(in[I_LNW] + col), lb = *(const f32x4*)(in[I_LNB] + col), muv = *(const f32x4*)(in[I_MU_RKV] + 2 * DB + col);
        const float mean = red16((yv[0] + yv[1]) + (yv[2] + yv[3])) * (1.0f / 64.0f); const f32x4 d = yv - mean;
        const float var = red16((d[0] * d[0] + d[1] * d[1]) + (d[2] * d[2] + d[3] * d[3])) * (1.0f / 64.0f);
        const f32x4 yn = d * (1.0f / sqrtf(var + GN_EPS)) * lw + lb;
        const f32x4 v1 = vc + (vp - vc) * muv;
        const f32x4 res = (yn + v1 * bc) * g4;
        v2u w; w.x = pk2(res[0], res[1]); w.y = pk2(res[2], res[3]);
        *(v2u*)(ro + o) = w;
    }
}

DI void final_phase(const float* const* in, unsigned char* ws, float* out, int gw, int NGW, int lane) {
    const float* ss3 = (const float*)(ws + SS3_OFF); const float* nf = in[I_NORM_FINAL];
    for (int m = gw; m < M; m += NGW) { const float r = 1.0f / sqrtf(ss3[m] * (1.0f / D) + RMS_EPS);
        GAS f32x4* o = (GAS f32x4*)(out + (size_t)m * D) + lane; const GAS f32x4* g = (const GAS f32x4*)nf + lane;
#pragma unroll 4
        for (int j = 0; j < 16; ++j) { f32x4 v = o[64 * j]; const f32x4 gg = g[64 * j]; v = v * r * gg; o[64 * j] = v; } }
}

#ifndef MK_N_LAUNCHES
#define MK_N_LAUNCHES 1
#endif
constexpr int N_PHASES = 13;
#ifndef REP_P2
#define REP_P2 1
#endif
#ifndef REP_P3
#define REP_P3 1
#endif
#ifndef REP_P6
#define REP_P6 1
#endif
#ifndef REP_P7
#define REP_P7 1
#endif
#ifndef REP_P10
#define REP_P10 1
#endif
#ifndef REP_C
#define REP_C 1
#endif
#ifndef PG8_SP2
#define PG8_SP2 true
#endif
#ifndef PG8_ALIGN
#define PG8_ALIGN true
#endif

__global__ void __launch_bounds__(NWAVES * 64, 2) hybrid_fwd(Args args) {
    extern __shared__ __attribute__((aligned(16))) unsigned char lds_raw[];
    LAS unsigned char* lds = (LAS unsigned char*)lds_raw;
    volatile LAS unsigned* MISC = (volatile LAS unsigned*)(lds + MISC_OFF);
    const int wave = __builtin_amdgcn_readfirstlane(threadIdx.x >> 6);
    const int G = gridDim.x, gw = blockIdx.x * NWAVES + wave, NGW = G * NWAVES;
    unsigned char* ws = args.ws; const float* const* in = args.in;
    { const int tid0 = wave * 64 + lane_opaque(); for (int u = tid0; u < (LDS_BYTES - LDSCTL_OFF) / 4; u += NWAVES * 64) ((LAS unsigned*)(lds + LDSCTL_OFF))[u] = 0u; }
    __syncthreads();
    unsigned* ctl = (unsigned*)(ws + WS_CTL);
    XcdBarrier bar; bar.bar = ctl + CW_BAR; bar.x = 0; bar.st = nullptr;
    const bool multi = (args.ph_hi - args.ph_lo) > 1;
    if (multi) bar = xcd_barrier_post(ctl + CW_BAR, MISC + 8, wave == 0 && lane_opaque() == 0);
    const int lo = args.ph_lo, hi = args.ph_hi;
#ifndef PHASE_MASK
#define PHASE_MASK 0x3fff
#endif
#define IN(k) ((((PHASE_MASK) >> (k)) & 1) && lo <= (k) && (k) < hi)
#define SEAM(k) do { if (IN(k) && IN((k) + 1)) xcd_barrier(bar, wave == 0 && lane_opaque() == 0); } while (0)
#define LANE lane_opaque()
    LAS unsigned* scr = (LAS unsigned*)(lds + RING_OFF + wave * 16384);

    if (IN(0)) { const int lane = LANE; for (int rep = 0; rep < REP_C; ++rep) { convert_set_a(in, ws, scr, gw, NGW, lane); prologue_rows(in, ws, gw, NGW, lane); } }
    SEAM(0);
    if (IN(1)) {
        pg8::Gemm g{(const bf16*)(ws + WS_XB), (const bf16*)(ws + WS_WCAT), M, NCAT, D}; pg8::StaticOrder S; S.init(M, NCAT, G, (int)blockIdx.x);
        epi::InProj E{(bf16*)(ws + WS_Q), (bf16*)(ws + WS_K), (bf16*)(ws + WS_V), (bf16*)(ws + WS_QI), (bf16*)(ws + WS_KI), (bf16*)(ws + WS_RB), (bf16*)(ws + WS_KB), (bf16*)(ws + WS_VB),
                      (bf16*)(ws + WS_LORA), (bf16*)(ws + WS_GATES), (float*)(ws + WS_WI), (const float*)(ws + WS_RSTDX), (const float*)(ws + WS_RCOS), (const float*)(ws + WS_RSIN)};
        pg8::gemm_phase<epi::InProj, pg8::StaticOrder, PG8_ALIGN, PG8_SP2>(lds + RING_OFF, g, S, E, wave);
    }
    SEAM(1);
    if (IN(2)) { for (int rep = 0; rep < REP_P2; ++rep) indexer_phase(ws, lds + RING_OFF, wave); }
    SEAM(2);
    if (IN(4)) build_alora(ws, blockIdx.x * (NWAVES * 64) + wave * 64 + LANE, G * NWAVES * 64);
    SEAM(4);
    if (IN(5)) {
        int k256 = 256; asm volatile("" : "+s"(k256));
        pg8::Gemm g{(const bf16*)(ws + WS_ALORA), (const bf16*)(ws + WS_WL2), 3 * M, 3 * DB, k256}; epi::Stack3Order S{G, (int)blockIdx.x};
        epi::LoraUp E{(float*)(ws + WS_DECAY), (bf16*)(ws + WS_AOUT), (bf16*)(ws + WS_GOUT), in[I_W0], in[I_A0]};
        pg8::gemm_phase<epi::LoraUp, epi::Stack3Order, PG8_ALIGN, PG8_SP2>(lds + RING_OFF, g, S, E, wave);
    }
    SEAM(5);
    if (IN(6)) { for (int rep = 0; rep < REP_P6; ++rep) scan_attn_phase(in, ws, args.out, lds + RING_OFF, (LAS unsigned*)(lds + MISC_OFF + 64), wave, LANE); }
    SEAM(6);
    if (IN(7)) { for (int rep = 0; rep < REP_P7; ++rep) gn_phase(in, ws, args.out, gw, NGW, LANE); }
    if (IN(7)) { const int lane = LANE; __syncthreads(); for (int rep = 0; rep < REP_C; ++rep) convert_set_b(in, ws, scr, gw, NGW, lane); }
    SEAM(7);
    if (IN(8)) {
        pg8::Gemm g{(const bf16*)(ws + WS_AO), (const bf16*)(ws + WS_WPAB), 2 * M, 2 * D, DA}; epi::ChainOrder S; S.so.init(M, D, G, (int)blockIdx.x);
        epi::GateMix E{(const bf16*)(ws + WS_GATES), in[I_BGATE], (bf16*)(ws + WS_MIX)};
        pg8::gemm_phase<epi::GateMix, epi::ChainOrder, PG8_ALIGN, PG8_SP2>(lds + RING_OFF, g, S, E, wave);
    }
    SEAM(8);
    if (IN(9)) {
        pg8::Gemm g{(const bf16*)(ws + WS_MIX), (const bf16*)(ws + WS_WO), M, D, D}; pg8::StaticOrder S; S.init(M, D, G, (int)blockIdx.x);
        epi::Resid E{in[I_X], args.out, (bf16*)(ws + WS_H1B), (float*)(ws + SS1_OFF)};
        pg8::gemm_phase<epi::Resid, pg8::StaticOrder, PG8_ALIGN, PG8_SP2>(lds + RING_OFF, g, S, E, wave);
    }
    SEAM(9);
    if (IN(10)) {
        pg8::Gemm g{(const bf16*)(ws + WS_H1B), (const bf16*)(ws + WS_W13), M, N13, D}; pg8::StaticOrder S; S.init(M, N13, G, (int)blockIdx.x);
        epi::FfnUp E{(const float*)(ws + SS1_OFF), (bf16*)(ws + WS_U)};
        pg8::gemm_phase<epi::FfnUp, pg8::StaticOrder, PG8_ALIGN, PG8_SP2>(lds + RING_OFF, g, S, E, wave);
#if REP_P10 > 1
        pg8::gemm_phase<epi::FfnUp, pg8::StaticOrder, PG8_ALIGN, PG8_SP2>(lds + RING_OFF, g, S, E, wave);
#endif
    }
    SEAM(10);
    if (IN(11)) {
        { pg8::Gemm g{(const bf16*)(ws + WS_U), (const bf16*)(ws + WS_W2), M, D, DFF}; pg8::StaticOrder S; S.init(M, D, G, (int)blockIdx.x);
          epi::Resid E{args.out, args.out, (bf16*)(ws + WS_H2B), (float*)(ws + SS2_OFF)};
          pg8::gemm_phase<epi::Resid, pg8::StaticOrder, PG8_ALIGN, PG8_SP2>(lds + RING_OFF, g, S, E, wave); }
        { int k256 = 256; asm volatile("" : "+s"(k256));
          pg8::Gemm g{(const bf16*)(ws + WS_PB), (const bf16*)(ws + WS_WPLE), M, D, k256}; pg8::StaticOrder S; S.init(M, D, G, (int)blockIdx.x);
          epi::StoreBf E{(bf16*)(ws + WS_PP), D};
          pg8::gemm_phase<epi::StoreBf, pg8::StaticOrder, PG8_ALIGN, PG8_SP2>(lds + RING_OFF, g, S, E, wave); }
    }
    SEAM(11);
    if (IN(12)) {
        pg8::Gemm g{(const bf16*)(ws + WS_H2B), (const bf16*)(ws + WS_WPG), M, D, D}; pg8::StaticOrder S; S.init(M, D, G, (int)blockIdx.x);
        epi::PleGate E{args.out, (const bf16*)(ws + WS_PP), (const float*)(ws + SS2_OFF), (float*)(ws + SS3_OFF)};
        pg8::gemm_phase<epi::PleGate, pg8::StaticOrder, PG8_ALIGN, PG8_SP2>(lds + RING_OFF, g, S, E, wave);
    }
    SEAM(12);
    if (IN(13)) final_phase(in, ws, args.out, gw, NGW, LANE);
#undef IN
#undef SEAM
#undef LANE
}

extern "C" void kernel_launch(void* const* d_in, const int* in_sizes, int n_in, void* d_out, int out_size, void* d_ws, size_t ws_size, hipStream_t stream) {
    static int grid = 0;
    if (grid == 0) {
        if (n_in != 32 || in_sizes[0] != M * D || out_size != M * D || ws_size < WS_END) { fprintf(stderr, "kernel_launch: unexpected shapes: n_in %d in0 %d out %d ws %zu (need %zu)\n", n_in, n_in > 0 ? in_sizes[0] : -1, out_size, ws_size, (size_t)WS_END); grid = -1; return; }
        int dev = 0, cus = 0, per_cu = 0;
        if (hipGetDevice(&dev) != hipSuccess || hipDeviceGetAttribute(&cus, hipDeviceAttributeMultiprocessorCount, dev) != hipSuccess) { grid = -1; return; }
        if (hipFuncSetAttribute((const void*)hybrid_fwd, hipFuncAttributeMaxDynamicSharedMemorySize, LDS_BYTES) != hipSuccess) { fprintf(stderr, "kernel_launch: hipFuncSetAttribute failed\n"); grid = -1; return; }
        if (hipOccupancyMaxActiveBlocksPerMultiprocessor(&per_cu, (const void*)hybrid_fwd, NWAVES * 64, LDS_BYTES) != hipSuccess || per_cu < 1) fprintf(stderr, "kernel_launch: occupancy query says %d\n", per_cu);
        (void)hipGetLastError();
        grid = cus;
    }
    if (grid < 0) return;
    if (hipMemsetAsync((char*)d_ws + WS_CTL, 0, CTL_ZERO_BYTES, stream) != hipSuccess) return;
    Args a{};
    for (int i = 0; i < 32; ++i) a.in[i] = (const float*)d_in[i];
    a.out = (float*)d_out; a.ws = (unsigned char*)d_ws;
#if MK_N_LAUNCHES == 1
    a.ph_lo = 0; a.ph_hi = N_PHASES + 1;
    hipLaunchKernelGGL(hybrid_fwd, dim3(grid), dim3(NWAVES * 64), LDS_BYTES, stream, a);
#else
    for (int p = 0; p <= N_PHASES; ++p) { a.ph_lo = p; a.ph_hi = p + 1; hipLaunchKernelGGL(hybrid_fwd, dim3(grid), dim3(NWAVES * 64), LDS_BYTES, stream, a); }
#endif
}
```

```cpp
#include <hip/hip_runtime.h>
#include <cstdio>
#include <cstdint>
__device__ __forceinline__ int lane_opaque() { int l; asm volatile("v_mbcnt_lo_u32_b32 %0, -1, 0\n\tv_mbcnt_hi_u32_b32 %0, -1, %0" : "=v"(l)); return l; }

namespace pg8 {
#define PG8_LAS __attribute__((address_space(3)))
typedef unsigned short bf16_t;
typedef short bf16x8 __attribute__((ext_vector_type(8)));
typedef float f32x4 __attribute__((ext_vector_type(4)));
typedef unsigned u32x4 __attribute__((ext_vector_type(4)));
constexpr int BM = 256, BK = 64, HALF = 128, HTB = HALF * BK * 2  , STAGE_BYTES = 8 * HTB, NXCD = 8, WGM = 8;

__host__ __device__ __forceinline__ int lds_byte(int r, int c) { const int st = (r >> 4) * 2 + (c >> 5), rr = r & 15, cc = c & 31, ob = rr * 64 + cc * 2; return st * 1024 + (ob ^ (((ob >> 9) & 1) << 5)); }
__host__ __device__ __forceinline__ void stage_rc(int b, int& R, int& C) { const int st = b / 1024, sb = b % 1024, swz = sb ^ (((sb >> 9) & 1) << 5); R = (st >> 1) * 16 + swz / 64; C = (st & 1) * 32 + (swz % 64) / 2; }
__host__ __device__ __forceinline__ int perm32(int rho) { const int n = rho >> 4, i = rho & 15; return 8 * (i >> 2) + 4 * n + (i & 3); }

struct Unit { int pm, pn; };
struct Gemm { const bf16_t* A; const bf16_t* Bt; int M, N, K; };

struct StaticOrder {
    int nM, nN, nwg, G, c;
    __host__ __device__ void init(int M, int N, int G_, int c_) { nM = M / BM; nN = N / BM; nwg = nM * nN; G = G_; c = c_; }
    __host__ __device__ bool next(int i, Unit& u) const {
        const long L = (long)i * G + c; if (L >= nwg) return false;
        int wgid = (int)L; { const int q = nwg / NXCD, r = nwg % NXCD, xcd = wgid % NXCD, off = wgid / NXCD; wgid = (xcd < r ? xcd * (q + 1) : r * (q + 1) + (xcd - r) * q) + off; }
        const int nig = WGM * nN, gid = wgid / nig, fm = gid * WGM, gsz = (nM - fm) < WGM ? (nM - fm) : WGM;
        u.pm = fm + ((wgid % nig) % gsz); u.pn = (wgid % nig) / gsz; return true;
    }
    __device__ __forceinline__ void a_ready(const Unit&) const {}
    __device__ __forceinline__ void done(const Unit&) const {}
};
__device__ __forceinline__ unsigned cvt_pk_bf16(float lo, float hi) { unsigned r; asm volatile("v_cvt_pk_bf16_f32 %0, %1, %2" : "=v"(r) : "v"(lo), "v"(hi)); return r; }
template <class Epi, class Sched, bool ALIGN_EPI = false, bool SP2 = false>
__device__ __forceinline__ void gemm_phase(PG8_LAS unsigned char* lds, const Gemm g, const Sched& S, const Epi& E, const int wid) {
    const int lane = lane_opaque(), tid = wid * 64 + lane, wr = wid >> 2, wc = wid & 3, fr = lane & 15, fq = lane >> 4;
    const int K = g.K, nt = K / BK;
    unsigned voffA[2], voffB[2];
#pragma unroll
    for (int i = 0; i < 2; ++i) { int R, C; stage_rc(tid * 16 + i * 8192, R, C); const int Rb = Epi::PERM ? ((R & ~31) + perm32(R & 31)) : R;
        voffA[i] = (unsigned)(R * K + C) * 2u; voffB[i] = (unsigned)(Rb * K + C) * 2u; }
    const size_t kstep = (size_t)(BK * 2);
    const size_t hstep = (size_t)HALF * K * 2;
    const size_t tstep = 2 * hstep;
    const unsigned ldsw = (unsigned)wid * 1024u;
    const int aoff = lds_byte(wr * 64 + fr, fq * 8), boff = lds_byte(wc * 32 + fr, fq * 8);
#define PG8_SA(b, h) (((b) * 2 + (h)) * HTB)
#define PG8_SB(b, h) ((4 + (b) * 2 + (h)) * HTB)
#define PG8_STAGE(bufoff, gbase, voff) do { _Pragma("unroll") for (int _i = 0; _i < 2; ++_i) \
        __builtin_amdgcn_global_load_lds((const unsigned*)((const char*)(gbase) + (voff)[_i]), (PG8_LAS unsigned*)(lds + (bufoff) + ldsw + _i * 8192), 16, 0, 0); } while (0)
#define PG8_LDA(dst, b, h) do { _Pragma("unroll") for (int m = 0; m < 4; ++m) _Pragma("unroll") for (int k = 0; k < 2; ++k) dst[m][k] = *(const PG8_LAS bf16x8*)(lds + PG8_SA(b, h) + aoff + m * 2048 + k * 1024); } while (0)
#define PG8_LDB(dst, b, h) do { _Pragma("unroll") for (int n = 0; n < 2; ++n) _Pragma("unroll") for (int k = 0; k < 2; ++k) dst[n][k] = *(const PG8_LAS bf16x8*)(lds + PG8_SB(b, h) + boff + n * 2048 + k * 1024); } while (0)
#define PG8_MMA(ai, bj, At, Bt) do { __builtin_amdgcn_s_setprio(1); _Pragma("unroll") for (int m = 0; m < 4; ++m) _Pragma("unroll") for (int n = 0; n < 2; ++n) _Pragma("unroll") for (int k = 0; k < 2; ++k) \
        acc[ai][bj][m][n] = __builtin_amdgcn_mfma_f32_16x16x32_bf16(Bt[n][k], At[m][k], acc[ai][bj][m][n], 0, 0, 0); __builtin_amdgcn_s_setprio(0); } while (0)
#define PG8_WAIT_V(n) asm volatile("s_waitcnt vmcnt(" #n ")" ::: "memory")
#define PG8_WAIT_L(n) asm volatile("s_waitcnt lgkmcnt(" #n ")" ::: "memory")
#define PG8_BAR __builtin_amdgcn_s_barrier()
#define PG8_SCHED __builtin_amdgcn_sched_barrier(0)
    Unit cur, nxt; int ui = 0;
    if (!S.next(0, cur)) return;
    f32x4 acc[2][2][4][2];
#pragma unroll
    for (int a = 0; a < 2; ++a)
#pragma unroll
        for (int b = 0; b < 2; ++b)
#pragma unroll
            for (int m = 0; m < 4; ++m)
#pragma unroll
                for (int n = 0; n < 2; ++n) acc[a][b][m][n] = (f32x4){0.f, 0.f, 0.f, 0.f};
    bf16x8 At[4][2], B0[2][2], B1[2][2];
    const char* cA = (const char*)g.A + (size_t)cur.pm * tstep; const char* cB = (const char*)g.Bt + (size_t)cur.pn * tstep;
    S.a_ready(cur);
    if constexpr (SP2) {
        PG8_STAGE(PG8_SB(0, 0), cB, voffB); PG8_STAGE(PG8_SB(0, 1), cB + hstep, voffB); PG8_STAGE(PG8_SA(0, 0), cA, voffA); PG8_STAGE(PG8_SA(0, 1), cA + hstep, voffA);
        if (wr == 1) PG8_BAR;
        PG8_WAIT_V(2); PG8_BAR;
        PG8_STAGE(PG8_SB(1, 0), cB + kstep, voffB); PG8_STAGE(PG8_SA(1, 0), cA + kstep, voffA); PG8_STAGE(PG8_SB(1, 1), cB + hstep + kstep, voffB);
        PG8_WAIT_V(6); PG8_BAR;
    } else {
        PG8_STAGE(PG8_SB(0, 0), cB, voffB); PG8_STAGE(PG8_SA(0, 0), cA, voffA); PG8_STAGE(PG8_SB(0, 1), cB + hstep, voffB); PG8_STAGE(PG8_SA(0, 1), cA + hstep, voffA);
        if (wr == 1) PG8_BAR;
        PG8_WAIT_V(4); PG8_BAR;
        PG8_STAGE(PG8_SB(1, 0), cB + kstep, voffB); PG8_STAGE(PG8_SA(1, 0), cA + kstep, voffA); PG8_STAGE(PG8_SB(1, 1), cB + hstep + kstep, voffB);
        PG8_WAIT_V(6); PG8_BAR;
    }
    for (;;) {
        const bool has_next = S.next(ui + 1, nxt);
        const char* nA = has_next ? (const char*)g.A + (size_t)nxt.pm * tstep : cA; const char* nB = has_next ? (const char*)g.Bt + (size_t)nxt.pn * tstep : cB;
        for (int t = 0; t < nt; t += 2) {
            const bool last = (t == nt - 2);
            const char* a1 = cA + (size_t)(t + 1) * kstep;
            const char* a2 = last ? nA : cA + (size_t)(t + 2) * kstep; const char* b2 = last ? nB : cB + (size_t)(t + 2) * kstep;
            const char* a3 = a2 + kstep; const char* b3 = b2 + kstep;
            if (last && has_next) S.a_ready(nxt);
            if constexpr (SP2) {
            PG8_LDB(B0, 0, 0); PG8_LDB(B1, 0, 1); PG8_SCHED; PG8_LDA(At, 0, 0); PG8_STAGE(PG8_SA(1, 1), a1 + hstep, voffA);
            PG8_WAIT_V(8); PG8_WAIT_L(0); PG8_BAR; PG8_MMA(0, 0, At, B0); PG8_MMA(0, 1, At, B1); PG8_BAR; PG8_SCHED;
            PG8_LDA(At, 0, 1); PG8_STAGE(PG8_SB(0, 0), b2, voffB); PG8_STAGE(PG8_SB(0, 1), b2 + hstep, voffB); PG8_STAGE(PG8_SA(0, 0), a2, voffA);
            PG8_WAIT_V(8); PG8_WAIT_L(0); PG8_BAR; PG8_MMA(1, 0, At, B0); PG8_MMA(1, 1, At, B1); PG8_BAR; PG8_SCHED;
            PG8_LDB(B0, 1, 0); PG8_LDB(B1, 1, 1); PG8_SCHED; PG8_LDA(At, 1, 0); PG8_STAGE(PG8_SA(0, 1), a2 + hstep, voffA);
            PG8_WAIT_V(8); PG8_WAIT_L(0); PG8_BAR; PG8_MMA(0, 0, At, B0); PG8_MMA(0, 1, At, B1); PG8_BAR; PG8_SCHED;
            PG8_LDA(At, 1, 1); PG8_STAGE(PG8_SB(1, 0), b3, voffB); PG8_STAGE(PG8_SB(1, 1), b3 + hstep, voffB); PG8_STAGE(PG8_SA(1, 0), a3, voffA);
            PG8_WAIT_V(8); PG8_WAIT_L(0); PG8_BAR; PG8_MMA(1, 0, At, B0); PG8_MMA(1, 1, At, B1); PG8_BAR; PG8_SCHED;
            } else {
            PG8_LDB(B0, 0, 0); PG8_SCHED; PG8_LDA(At, 0, 0); PG8_STAGE(PG8_SA(1, 1), a1 + hstep, voffA);
            PG8_WAIT_L(8); PG8_BAR; PG8_WAIT_L(0); PG8_MMA(0, 0, At, B0); PG8_BAR; PG8_SCHED;
            PG8_LDB(B1, 0, 1); PG8_STAGE(PG8_SB(0, 0), b2, voffB);
            PG8_BAR; PG8_WAIT_L(0); PG8_MMA(0, 1, At, B1); PG8_BAR;
            PG8_LDA(At, 0, 1); PG8_STAGE(PG8_SA(0, 0), a2, voffA);
            PG8_BAR; PG8_WAIT_L(0); PG8_MMA(1, 0, At, B0); PG8_BAR; PG8_SCHED;
            PG8_STAGE(PG8_SB(0, 1), b2 + hstep, voffB);
            PG8_WAIT_V(6); PG8_BAR; PG8_MMA(1, 1, At, B1); PG8_BAR;
            PG8_LDB(B0, 1, 0); PG8_SCHED; PG8_LDA(At, 1, 0); PG8_STAGE(PG8_SA(0, 1), a2 + hstep, voffA);
            PG8_WAIT_L(8); PG8_BAR; PG8_WAIT_L(0); PG8_MMA(0, 0, At, B0); PG8_BAR; PG8_SCHED;
            PG8_LDB(B1, 1, 1); PG8_STAGE(PG8_SB(1, 0), b3, voffB);
            PG8_BAR; PG8_WAIT_L(0); PG8_MMA(0, 1, At, B1); PG8_BAR;
            PG8_LDA(At, 1, 1); PG8_STAGE(PG8_SA(1, 0), a3, voffA);
            PG8_BAR; PG8_WAIT_L(0); PG8_MMA(1, 0, At, B0); PG8_BAR; PG8_SCHED;
            PG8_STAGE(PG8_SB(1, 1), b3 + hstep, voffB);
            PG8_WAIT_V(6); PG8_BAR; PG8_MMA(1, 1, At, B1); PG8_BAR;
            }
        }
        if constexpr (ALIGN_EPI) { if (wr == 0) PG8_BAR; }
        if constexpr (!Epi::AFTER_DRAIN) { E(acc, cur, wr, wc, fr, fq); S.done(cur); }
        if (!has_next) break;
        if (!Epi::CHAIN || !E.keep(cur)) {
#pragma unroll
        for (int a = 0; a < 2; ++a)
#pragma unroll
            for (int b = 0; b < 2; ++b)
#pragma unroll
                for (int m = 0; m < 4; ++m)
#pragma unroll
                    for (int n = 0; n < 2; ++n) acc[a][b][m][n] = (f32x4){0.f, 0.f, 0.f, 0.f};
        }
        cur = nxt; cA = nA; cB = nB; ++ui;
        if constexpr (ALIGN_EPI) { if (wr == 1) PG8_BAR; }
    }
    PG8_WAIT_V(0);
    if constexpr (!ALIGN_EPI) { if (wr == 0) PG8_BAR; }
    PG8_BAR;
    if constexpr (Epi::AFTER_DRAIN) { E.fused(acc, cur, wr, wc, fr, fq, lds, wid, lane); S.done(cur); }
#undef PG8_SA
#undef PG8_SB
#undef PG8_STAGE
#undef PG8_LDA
#undef PG8_LDB
#undef PG8_MMA
#undef PG8_WAIT_V
#undef PG8_WAIT_L
#undef PG8_BAR
#undef PG8_SCHED
}
}

#define LAS __attribute__((address_space(3)))
#define XB_TMO      128
#define XB_XCNT(j)  (256  + 64 * (j))
#define XB_XSUB(j)  (1280 + 64 * (j))
#define XB_XGEN(j)  (2304 + 64 * (j))
#define XB_TOP      3328
#define XB_TOPGEN   3392
#define XCD_BAR_WORDS 3456
#define XB_SPIN_CAP (1u << 18)

__device__ __forceinline__ unsigned xb_ld(unsigned* p)              { return __hip_atomic_load(p, __ATOMIC_RELAXED, __HIP_MEMORY_SCOPE_AGENT); }
__device__ __forceinline__ unsigned xb_add(unsigned* p, unsigned v) { return __hip_atomic_fetch_add(p, v, __ATOMIC_RELAXED, __HIP_MEMORY_SCOPE_AGENT); }
__device__ __forceinline__ unsigned xb_xcc_id() { return (unsigned)__builtin_amdgcn_s_getreg((3 << 11) | 20) & 0xFu; }
#define XB_SPIN(cond, bar) do { unsigned _sp = 0; while (cond) { __builtin_amdgcn_s_sleep(1); \
    if ((++_sp & 255u) == 0u) { if (xb_ld(&(bar)[XB_TMO])) break; if (_sp > XB_SPIN_CAP) { atomicAdd(&(bar)[XB_TMO], 1u); break; } } } } while (0)

struct XcdBarrier {
    unsigned* bar; unsigned x;
    volatile LAS unsigned* st;
};

__device__ __forceinline__ XcdBarrier xcd_barrier_post(unsigned* bar, volatile LAS unsigned* st, const bool leader  ) {
    XcdBarrier b; b.bar = bar; b.x = xb_xcc_id(); b.st = st;
    if (leader) (void)xb_add(&bar[XB_XCNT(b.x)], 1u);
    return b;
}
__device__ __forceinline__ void xcd_barrier_complete(unsigned* bar, unsigned x, unsigned& nloc, unsigned& nx) {
    const unsigned G = gridDim.x * gridDim.y * gridDim.z;
    unsigned sum, cnt, mine, sp = 0u;
    for (;;) {
        sum = 0u; cnt = 0u; mine = 0u;
#pragma unroll
        for (unsigned j = 0; j < 16; ++j) { const unsigned c = xb_ld(&bar[XB_XCNT(j)]); sum += c; cnt += (c > 0u) ? 1u : 0u; mine = (j == x) ? c : mine; }
        if (sum == G) break;
        __builtin_amdgcn_s_sleep(1);
        if ((++sp & 255u) == 0u) { if (xb_ld(&bar[XB_TMO])) break; if (sp > XB_SPIN_CAP) { atomicAdd(&bar[XB_TMO], 1u); break; } }
    }
    nloc = mine > 0u ? mine : 1u; nx = cnt > 0u ? cnt : 1u;
}

__device__ __forceinline__ void xcd_barrier(const XcdBarrier& b, const bool leader  ) {
    asm volatile("s_waitcnt vmcnt(0)" ::: "memory");
    __syncthreads();
    if (leader) {
        unsigned* bar = b.bar;
        __builtin_amdgcn_s_waitcnt(0);
        unsigned nloc = b.st[0], nx = b.st[1];
        if (nloc == 0u) { xcd_barrier_complete(bar, b.x, nloc, nx); b.st[0] = nloc; b.st[1] = nx; }
        const unsigned old = xb_add(&bar[XB_XSUB(b.x)], 1u);
        const unsigned gen = old / nloc;
        if (old + 1u == (gen + 1u) * nloc) {
            __builtin_amdgcn_fence(__ATOMIC_RELEASE, "agent");
            asm volatile("s_waitcnt vmcnt(0)" ::: "memory");
            const unsigned og = xb_add(&bar[XB_TOP], 1u);
            const unsigned tg = og / nx;
            if (og + 1u == (tg + 1u) * nx) xb_add(&bar[XB_TOPGEN], 1u);
            else XB_SPIN(xb_ld(&bar[XB_TOPGEN]) == tg, bar);
            __builtin_amdgcn_fence(__ATOMIC_ACQUIRE, "agent");
            xb_add(&bar[XB_XGEN(b.x)], 1u);
            asm volatile("s_waitcnt vmcnt(0)" ::: "memory");
        } else {
            XB_SPIN(xb_ld(&bar[XB_XGEN(b.x)]) == gen, bar);
            __builtin_amdgcn_fence(__ATOMIC_ACQUIRE, "agent");
            asm volatile("s_waitcnt vmcnt(0)" ::: "memory");
        }
    }
    __syncthreads();
}

constexpr int BATCH = 2, SEQ = 8192, M = BATCH * SEQ, D = 4096;
constexpr int DA = 2048, KVD = 512, DIQ = 2048, HDI = 128, NHI = 16, DB = 2048, NHB = 32, HDB = 64;
constexpr int DIN = 11408, DFF = 11008, DPLE = 256, TOPK = 256;
constexpr int NCAT = 81 * 256;
constexpr int N13 = 2 * DFF;
constexpr int LORA_LD = 1024;
constexpr float RMS_EPS = 1e-6f, GN_EPS = 64e-5f;

#define GAS __attribute__((address_space(1)))
typedef unsigned short bf16;
typedef unsigned v4u __attribute__((ext_vector_type(4)));
typedef unsigned v2u __attribute__((ext_vector_type(2)));
typedef float f32x4 __attribute__((ext_vector_type(4)));
typedef float f32x16 __attribute__((ext_vector_type(16)));
typedef float f32x2 __attribute__((ext_vector_type(2)));
typedef short bf16x8 __attribute__((ext_vector_type(8)));
typedef GAS unsigned gu32;
#define RLX_AGENT __ATOMIC_RELAXED, __HIP_MEMORY_SCOPE_AGENT
#define LDS_WAIT() asm volatile("s_waitcnt lgkmcnt(0)" ::: "memory")
#define VM_WAIT() asm volatile("s_waitcnt vmcnt(0)" ::: "memory")
#define DI __device__ __forceinline__

DI unsigned f2bf(float f) { unsigned u = __builtin_bit_cast(unsigned, f); return (u + 0x7fffu + ((u >> 16) & 1u)) >> 16; }
DI unsigned pk2(float lo, float hi) { return f2bf(lo) | (f2bf(hi) << 16); }
DI float bf_lo(unsigned w) { return __builtin_bit_cast(float, w << 16); }
DI float bf_hi(unsigned w) { return __builtin_bit_cast(float, w & 0xffff0000u); }
DI float bf2f(bf16 h) { return __builtin_bit_cast(float, ((unsigned)h) << 16); }
DI float sigmoidf_(float z) { return 1.0f / (1.0f + __expf(-z)); }
DI float wave_sum(float v) {
#pragma unroll
    for (int o = 1; o < 64; o <<= 1) v += __shfl_xor(v, o);
    return v;
}

namespace epi {
using pg8::Unit; using pg8::BM; using pg8::HALF; using pg8::cvt_pk_bf16;
typedef pg8::f32x4 f4;
DI v4u pack8(const f4& a, const f4& b) { v4u w; w.x = cvt_pk_bf16(a[0], a[1]); w.y = cvt_pk_bf16(a[2], a[3]); w.z = cvt_pk_bf16(b[0], b[1]); w.w = cvt_pk_bf16(b[2], b[3]); return w; }
DI void unpack8(const v4u& w, f4& a, f4& b) { a[0] = bf_lo(w.x); a[1] = bf_hi(w.x); a[2] = bf_lo(w.y); a[3] = bf_hi(w.y); b[0] = bf_lo(w.z); b[1] = bf_hi(w.z); b[2] = bf_lo(w.w); b[3] = bf_hi(w.w); }

struct InProj {
    static constexpr bool PERM = true, AFTER_DRAIN = false, CHAIN = false;
    bf16 *q, *k, *v, *qi, *ki, *rb, *kb, *vb, *lora, *gates; float* wi;
    const float *rstd, *rcos, *rsin;
    DI bool keep(const Unit&) const { return false; }
    DI void operator()(f4 (&acc)[2][2][4][2], const Unit& u, int wr, int wc, int fr, int fq) const {
        { const int ln_ = lane_opaque(); fr = ln_ & 15; fq = ln_ >> 4; }
        const int pn = u.pn, row0 = u.pm * BM + wr * 64 + fr;
        int kind = 0, ld, cb; bf16* dst;
        float rsv[2][4];
#pragma unroll
        for (int ai = 0; ai < 2; ++ai)
#pragma unroll
            for (int m = 0; m < 4; ++m) rsv[ai][m] = rstd[row0 + ai * HALF + m * 16];
        if (pn < 8)       { kind = 1; dst = q;  ld = DA;  cb = pn * 256; }
        else if (pn < 10) { kind = 1; dst = k;  ld = KVD; cb = (pn - 8) * 256; }
        else if (pn < 12) { dst = v;  ld = KVD; cb = (pn - 10) * 256; }
        else if (pn < 20) { kind = 1; dst = qi; ld = DIQ; cb = (pn - 12) * 256; }
        else if (pn == 20){ kind = 2; dst = ki; ld = HDI; cb = 0; }
        else if (pn < 29) { dst = rb; ld = DB; cb = (pn - 21) * 256; }
        else if (pn < 37) { dst = kb; ld = DB; cb = (pn - 29) * 256; }
        else if (pn < 45) { dst = vb; ld = DB; cb = (pn - 37) * 256; }
        else if (pn < 49) { dst = lora; ld = LORA_LD; cb = (pn - 45) * 256; }
        else              { dst = gates; ld = 2 * D; cb = (pn - 49) * 256; }
        if (kind == 0) {
#pragma unroll
            for (int ai = 0; ai < 2; ++ai)
#pragma unroll
                for (int m = 0; m < 4; ++m) { const int row = row0 + ai * HALF + m * 16; const float rs = rsv[ai][m];
#pragma unroll
                    for (int bj = 0; bj < 2; ++bj) *(v4u*)(dst + (size_t)row * ld + cb + bj * HALF + wc * 32 + 8 * fq) = pack8(acc[ai][bj][m][0] * rs, acc[ai][bj][m][1] * rs); }
        } else if (kind == 1 || wc < 2) {
            const int hb = cb + (wc >> 1) * 128, dd0 = (wc & 1) * 32 + 8 * fq;
#pragma unroll
            for (int ai = 0; ai < 2; ++ai)
#pragma unroll
                for (int m = 0; m < 4; ++m) { const int row = row0 + ai * HALF + m * 16; const float rs = rsv[ai][m];
                    const f4 c0 = *(const f4*)(rcos + (size_t)row * 64 + dd0), c1 = *(const f4*)(rcos + (size_t)row * 64 + dd0 + 4);
                    const f4 s0 = *(const f4*)(rsin + (size_t)row * 64 + dd0), s1 = *(const f4*)(rsin + (size_t)row * 64 + dd0 + 4);
                    const f4 a0 = acc[ai][0][m][0] * rs, a1 = acc[ai][0][m][1] * rs, b0 = acc[ai][1][m][0] * rs, b1 = acc[ai][1][m][1] * rs;
                    bf16* p = dst + (size_t)row * ld + hb + dd0;
                    *(v4u*)(p)      = pack8(a0 * c0 - b0 * s0, a1 * c1 - b1 * s1);
                    *(v4u*)(p + 64) = pack8(a0 * s0 + b0 * c0, a1 * s1 + b1 * c1); }
        } else if (wc == 2 && fq < 2) {
#pragma unroll
            for (int ai = 0; ai < 2; ++ai)
#pragma unroll
                for (int m = 0; m < 4; ++m) { const int row = row0 + ai * HALF + m * 16; const float rs = rsv[ai][m] * 0.25f;
                    *(f4*)(wi + (size_t)row * 16 + 8 * fq) = acc[ai][0][m][0] * rs; *(f4*)(wi + (size_t)row * 16 + 8 * fq + 4) = acc[ai][0][m][1] * rs; }
        }
    }
};

struct LoraUp {
    static constexpr bool PERM = true, AFTER_DRAIN = false, CHAIN = false;
    float* decay; bf16 *aout, *gout; const float *w0, *a0;
    DI bool keep(const Unit&) const { return false; }
    DI void operator()(f4 (&acc)[2][2][4][2], const Unit& u, int wr, int wc, int fr, int fq) const {
        { const int ln_ = lane_opaque(); fr = ln_ & 15; fq = ln_ >> 4; }
        const int which = u.pm >> 6, row0 = (u.pm & 63) * BM + wr * 64 + fr, col0 = (u.pn & 7) * BM + wc * 32 + 8 * fq;
        if (which == 0) {
#pragma unroll
            for (int bj = 0; bj < 2; ++bj) { const int col = col0 + bj * HALF; const f4 z0 = *(const f4*)(w0 + col), z1 = *(const f4*)(w0 + col + 4);
#pragma unroll
                for (int ai = 0; ai < 2; ++ai)
#pragma unroll
                    for (int m = 0; m < 4; ++m) { const size_t off = (size_t)(row0 + ai * HALF + m * 16) * DB + col;
                        f4 x0 = acc[ai][bj][m][0] + z0, x1 = acc[ai][bj][m][1] + z1;
#pragma unroll
                        for (int e = 0; e < 4; ++e) { x0[e] = __expf(-0.6065306597126334f * sigmoidf_(x0[e])); x1[e] = __expf(-0.6065306597126334f * sigmoidf_(x1[e])); }
                        *(f4*)(decay + off) = x0; *(f4*)(decay + off + 4) = x1;
                        asm volatile("" ::: "memory"); } }
        } else if (which == 1) {
#pragma unroll
            for (int bj = 0; bj < 2; ++bj) { const int col = col0 + bj * HALF; const f4 z0 = *(const f4*)(a0 + col), z1 = *(const f4*)(a0 + col + 4);
#pragma unroll
                for (int ai = 0; ai < 2; ++ai)
#pragma unroll
                    for (int m = 0; m < 4; ++m) { const size_t off = (size_t)(row0 + ai * HALF + m * 16) * DB + col;
                        f4 x0 = acc[ai][bj][m][0] + z0, x1 = acc[ai][bj][m][1] + z1;
#pragma unroll
                        for (int e = 0; e < 4; ++e) { x0[e] = sigmoidf_(x0[e]); x1[e] = sigmoidf_(x1[e]); }
                        *(v4u*)(aout + off) = pack8(x0, x1);
                        asm volatile("" ::: "memory"); } }
        } else {
#pragma unroll
            for (int bj = 0; bj < 2; ++bj)
#pragma unroll
                for (int ai = 0; ai < 2; ++ai)
#pragma unroll
                    for (int m = 0; m < 4; ++m) *(v4u*)(gout + (size_t)(row0 + ai * HALF + m * 16) * DB + col0 + bj * HALF) = pack8(acc[ai][bj][m][0], acc[ai][bj][m][1]);
        }
    }
};

struct GateMix {
    static constexpr bool PERM = true, AFTER_DRAIN = false, CHAIN = true;
    const bf16* gates; const float* bgate; bf16* mout;
    DI bool keep(const Unit& u) const { return u.pm < 64; }
    DI void operator()(f4 (&acc)[2][2][4][2], const Unit& u, int wr, int wc, int fr, int fq) const {
        { const int ln_ = lane_opaque(); fr = ln_ & 15; fq = ln_ >> 4; }
        const int which = u.pm >> 6, row0 = (u.pm & 63) * BM + wr * 64 + fr, col0 = (u.pn & 15) * BM + wc * 32 + 8 * fq;
#pragma unroll
        for (int bj = 0; bj < 2; ++bj) { const int col = col0 + bj * HALF;
            const f4 ba0 = *(const f4*)(bgate + col), ba1 = *(const f4*)(bgate + col + 4), bb0 = *(const f4*)(bgate + D + col), bb1 = *(const f4*)(bgate + D + col + 4);
#pragma unroll
            for (int ai = 0; ai < 2; ++ai)
#pragma unroll
                for (int m = 0; m < 4; ++m) { const int row = row0 + ai * HALF + m * 16;
                    f4 zb0, zb1; unpack8(*(const v4u*)(gates + (size_t)row * (2 * D) + D + col), zb0, zb1); zb0 += bb0; zb1 += bb1;
                    if (which == 0) {
                        f4 za0, za1; unpack8(*(const v4u*)(gates + (size_t)row * (2 * D) + col), za0, za1); za0 += ba0; za1 += ba1;
#pragma unroll
                        for (int e = 0; e < 4; ++e) {
                            acc[ai][bj][m][0][e] *= (1.0f + __expf(-zb0[e])) / (1.0f + __expf(-za0[e]));
                            acc[ai][bj][m][1][e] *= (1.0f + __expf(-zb1[e])) / (1.0f + __expf(-za1[e])); }
                    } else {
                        f4 o0, o1;
#pragma unroll
                        for (int e = 0; e < 4; ++e) { o0[e] = acc[ai][bj][m][0][e] * sigmoidf_(zb0[e]); o1[e] = acc[ai][bj][m][1][e] * sigmoidf_(zb1[e]); }
                        *(v4u*)(mout + (size_t)row * D + col) = pack8(o0, o1);
                    } } }
    }
};

struct Resid {
    static constexpr bool PERM = true, AFTER_DRAIN = false, CHAIN = false;
    const float* base; float* out; bf16* outb; float* ss;
    DI bool keep(const Unit&) const { return false; }
    DI void operator()(f4 (&acc)[2][2][4][2], const Unit& u, int wr, int wc, int fr, int fq) const {
        { const int ln_ = lane_opaque(); fr = ln_ & 15; fq = ln_ >> 4; }
        const int row0 = u.pm * BM + wr * 64 + fr, col0 = u.pn * BM + wc * 32 + 8 * fq;
#pragma unroll
        for (int ai = 0; ai < 2; ++ai)
#pragma unroll
            for (int m = 0; m < 4; ++m) { const int row = row0 + ai * HALF + m * 16; float s = 0.f;
#pragma unroll
                for (int bj = 0; bj < 2; ++bj) { const size_t off = (size_t)row * D + col0 + bj * HALF;
                    const f4 h0 = *(const f4*)(base + off) + acc[ai][bj][m][0], h1 = *(const f4*)(base + off + 4) + acc[ai][bj][m][1];
                    *(f4*)(out + off) = h0; *(f4*)(out + off + 4) = h1; *(v4u*)(outb + off) = pack8(h0, h1);
                    s += (h0[0] * h0[0] + h0[1] * h0[1]) + (h0[2] * h0[2] + h0[3] * h0[3]) + (h1[0] * h1[0] + h1[1] * h1[1]) + (h1[2] * h1[2] + h1[3] * h1[3]); }
                s += __shfl_xor(s, 16); s += __shfl_xor(s, 32);
                if (fq == 0) atomicAdd(ss + row, s); }
    }
};

struct FfnUp {
    static constexpr bool PERM = true, AFTER_DRAIN = false, CHAIN = false;
    const float* ss; bf16* uout;
    DI bool keep(const Unit&) const { return false; }
    DI void operator()(f4 (&acc)[2][2][4][2], const Unit& u, int wr, int wc, int fr, int fq) const {
        { const int ln_ = lane_opaque(); fr = ln_ & 15; fq = ln_ >> 4; }
        const int row0 = u.pm * BM + wr * 64 + fr, col0 = u.pn * HALF + wc * 32 + 8 * fq;
        float rr[2][4];
#pragma unroll
        for (int ai = 0; ai < 2; ++ai)
#pragma unroll
            for (int m = 0; m < 4; ++m) rr[ai][m] = ss[row0 + ai * HALF + m * 16];
#pragma unroll
        for (int ai = 0; ai < 2; ++ai)
#pragma unroll
            for (int m = 0; m < 4; ++m) { const int row = row0 + ai * HALF + m * 16; const float r = __builtin_amdgcn_rsqf(rr[ai][m] * (1.0f / D) + RMS_EPS);
                f4 o0, o1;
#pragma unroll
                for (int e = 0; e < 4; ++e) { const float a0 = acc[ai][0][m][0][e] * r, a1 = acc[ai][0][m][1][e] * r;
                    o0[e] = a0 * sigmoidf_(a0) * (acc[ai][1][m][0][e] * r); o1[e] = a1 * sigmoidf_(a1) * (acc[ai][1][m][1][e] * r); }
                *(v4u*)(uout + (size_t)row * DFF + col0) = pack8(o0, o1); }
    }
};

struct StoreBf {
    static constexpr bool PERM = true, AFTER_DRAIN = false, CHAIN = false;
    bf16* o; int ld;
    DI bool keep(const Unit&) const { return false; }
    DI void operator()(f4 (&acc)[2][2][4][2], const Unit& u, int wr, int wc, int fr, int fq) const {
        { const int ln_ = lane_opaque(); fr = ln_ & 15; fq = ln_ >> 4; }
        const int row0 = u.pm * BM + wr * 64 + fr, col0 = u.pn * BM + wc * 32 + 8 * fq;
#pragma unroll
        for (int ai = 0; ai < 2; ++ai)
#pragma unroll
            for (int m = 0; m < 4; ++m)
#pragma unroll
                for (int bj = 0; bj < 2; ++bj) *(v4u*)(o + (size_t)(row0 + ai * HALF + m * 16) * ld + col0 + bj * HALF) = pack8(acc[ai][bj][m][0], acc[ai][bj][m][1]);
    }
};

struct PleGate {
    static constexpr bool PERM = true, AFTER_DRAIN = false, CHAIN = false;
    float* h; const bf16* pp; const float* ss_in; float* ss_out;
    DI bool keep(const Unit&) const { return false; }
    DI void operator()(f4 (&acc)[2][2][4][2], const Unit& u, int wr, int wc, int fr, int fq) const {
        { const int ln_ = lane_opaque(); fr = ln_ & 15; fq = ln_ >> 4; }
        const int row0 = u.pm * BM + wr * 64 + fr, col0 = u.pn * BM + wc * 32 + 8 * fq;
#pragma unroll
        for (int ai = 0; ai < 2; ++ai)
#pragma unroll
            for (int m = 0; m < 4; ++m) { const int row = row0 + ai * HALF + m * 16; const float r = __builtin_amdgcn_rsqf(ss_in[row] * (1.0f / D) + RMS_EPS); float s = 0.f;
#pragma unroll
                for (int bj = 0; bj < 2; ++bj) { const size_t off = (size_t)row * D + col0 + bj * HALF;
                    f4 p0, p1; unpack8(*(const v4u*)(pp + off), p0, p1);
                    f4 h0 = *(const f4*)(h + off), h1 = *(const f4*)(h + off + 4);
#pragma unroll
                    for (int e = 0; e < 4; ++e) { h0[e] += sigmoidf_(acc[ai][bj][m][0][e] * r) * p0[e]; h1[e] += sigmoidf_(acc[ai][bj][m][1][e] * r) * p1[e]; }
                    *(f4*)(h + off) = h0; *(f4*)(h + off + 4) = h1;
                    s += (h0[0] * h0[0] + h0[1] * h0[1]) + (h0[2] * h0[2] + h0[3] * h0[3]) + (h1[0] * h1[0] + h1[1] * h1[1]) + (h1[2] * h1[2] + h1[3] * h1[3]); }
                s += __shfl_xor(s, 16); s += __shfl_xor(s, 32);
                if (fq == 0) atomicAdd(ss_out + row, s); }
    }
};

struct Stack3Order {
    int G, c;
    DI bool next(int i, Unit& u) const { const int L = i * G + c; if (L >= 1536) return false; const int which = L >> 9, r = L & 511; u.pm = which * 64 + (r & 63); u.pn = which * 8 + (r >> 6); return true; }
    DI void a_ready(const Unit&) const {}
    DI void done(const Unit&) const {}
};
struct ChainOrder {
    pg8::StaticOrder so;
    DI bool next(int i, Unit& u) const { Unit t; if (!so.next(i >> 1, t)) return false; const int which = i & 1; u.pm = which * 64 + t.pm; u.pn = which * 16 + t.pn; return true; }
    DI void a_ready(const Unit&) const {}
    DI void done(const Unit&) const {}
};
}

constexpr size_t MiB = 1u << 20;
constexpr size_t WS_CTL = 0, CTL_ZERO_BYTES = 1 * MiB;
constexpr int CW_TMO = 0, CW_BAR = 4096;
constexpr size_t SS1_OFF = 256 * 1024, SS2_OFF = 320 * 1024, SS3_OFF = 384 * 1024;
constexpr size_t WS_RSTDX = 1 * MiB;
constexpr size_t WS_BONUS = 2 * MiB;
constexpr size_t WS_RCOS = 4 * MiB, WS_RSIN = 8 * MiB;
constexpr size_t WS_WI = 12 * MiB;
constexpr size_t WS_PB = 13 * MiB;
constexpr size_t WS_WPAB = 24 * MiB;
constexpr size_t WS_WO = 56 * MiB, WS_WPG = 88 * MiB;
constexpr size_t WS_WPLE = 120 * MiB;
constexpr size_t WS_WL2 = 122 * MiB;
constexpr size_t WS_R1 = 126 * MiB;
constexpr size_t WS_WCAT = 126 * MiB;
constexpr size_t WS_XB = 288 * MiB;
constexpr size_t WS_SCORE = 126 * MiB;
constexpr size_t WS_IDX = 1252 * MiB;
constexpr size_t WS_DECAY = 126 * MiB;
constexpr size_t WS_AOUT = 254 * MiB;
constexpr size_t WS_ALORA = 318 * MiB;
constexpr size_t WS_W13 = 126 * MiB;
constexpr size_t WS_W2 = 318 * MiB;
constexpr size_t WS_Q = 416 * MiB, WS_K = 480 * MiB, WS_V = 496 * MiB, WS_QI = 512 * MiB, WS_KI = 576 * MiB;
constexpr size_t WS_RB = 580 * MiB, WS_KB = 644 * MiB, WS_VB = 708 * MiB, WS_LORA = 772 * MiB, WS_GATES = 804 * MiB;
constexpr size_t WS_Y = 416 * MiB;
constexpr size_t WS_MIX = 416 * MiB;
constexpr size_t WS_H1B = 544 * MiB;
constexpr size_t WS_U = 672 * MiB;
constexpr size_t WS_H2B = 416 * MiB;
constexpr size_t WS_PP = 544 * MiB;
constexpr size_t WS_AO = 1060 * MiB;
constexpr size_t WS_GOUT = 1188 * MiB;
constexpr size_t WS_END = 1268 * MiB;

constexpr int RING_OFF = 0, RING_BYTES = 131072;
constexpr int LDSCTL_OFF = RING_BYTES, MISC_OFF = LDSCTL_OFF + 320;
constexpr int LDS_BYTES = 147456;
constexpr int NWAVES = 8;

struct Args {
    const float* in[32]; float* out; unsigned char* ws; int ph_lo, ph_hi;
};
enum { I_X = 0, I_P, I_POS, I_NORM_MIX, I_W_IN, I_MU_RKV, I_MU_WAG, I_W0, I_W1, I_W2, I_A0, I_A1, I_A2, I_G1, I_G2, I_KK, I_KA, I_RK, I_LNW, I_LNB,
       I_WPA, I_WPB, I_WGATE, I_BGATE, I_WO, I_NORM_FFN, I_WFFN1, I_WFFN3, I_WFFN2, I_WPLEG, I_WPLE, I_NORM_FINAL };

struct TrSrc { const float* p; int ld, col0, nvalid, kvalid; const float* ksc; const float* mu; int mumode; };
DI void tr_item(const TrSrc& s, bf16* WT, int dK, int n0, int k0, LAS unsigned* T, int lane) {
    const int ng = lane & 15, kq = lane >> 4;
    f32x4 v[8][2]; f32x2 sc[8];
    const bool nok = 4 * ng < s.nvalid;
#pragma unroll
    for (int st = 0; st < 8; ++st) { const int k = k0 + 8 * st + 2 * kq;
#pragma unroll
        for (int j = 0; j < 2; ++j) v[st][j] = (nok && k + j < s.kvalid) ? *(const f32x4*)(s.p + (size_t)(k + j) * s.ld + s.col0 + 4 * ng) : (f32x4){0.f, 0.f, 0.f, 0.f};
        f32x2 c = {1.f, 1.f};
        if (s.ksc) c = *(const f32x2*)(s.ksc + k);
        if (s.mumode == 1) { const f32x2 m = *(const f32x2*)(s.mu + k); c = c * (1.0f - m); } else if (s.mumode == 2) { const f32x2 m = *(const f32x2*)(s.mu + k); c = c * m; }
        sc[st] = c; }
#pragma unroll
    for (int st = 0; st < 8; ++st) { const int kp = 4 * st + kq;
#pragma unroll
        for (int i = 0; i < 4; ++i) T[(4 * ng + i) * 32 + (kp ^ (4 * (ng & 7)))] = pk2(v[st][0][i] * sc[st][0], v[st][1][i] * sc[st][1]); }
    LDS_WAIT(); asm volatile("" ::: "memory");
#pragma unroll
    for (int j = 0; j < 8; ++j) { const int n = (lane >> 3) + 8 * j, c = lane & 7;
        *(GAS v4u*)(WT + (size_t)(n0 + n) * dK + k0 + 8 * c) = *(const LAS v4u*)(T + n * 32 + 4 * (c ^ ((n >> 2) & 7))); }
    LDS_WAIT(); asm volatile("" ::: "memory");
}
DI TrSrc src_wcat(const float* const* in, int n0) {
    TrSrc s; s.p = in[I_W_IN]; s.ld = DIN; s.col0 = 0; s.nvalid = 64; s.kvalid = D; s.ksc = in[I_NORM_MIX]; s.mu = nullptr; s.mumode = 0;
    const int tile = n0 >> 8, p = n0 & 255, bj = p >> 7, hh = (p >> 6) & 1;
    if (tile < 8)        s.col0 = 0    + (2 * tile + hh) * 128 + 64 * bj;
    else if (tile < 10)  s.col0 = 2048 + (2 * (tile - 8) + hh) * 128 + 64 * bj;
    else if (tile < 12)  s.col0 = 2560 + (tile - 10) * 256 + p;
    else if (tile < 20)  s.col0 = 3072 + (2 * (tile - 12) + hh) * 128 + 64 * bj;
    else if (tile == 20) { if (hh == 0) s.col0 = 5120 + 64 * bj; else if (bj == 0) { s.col0 = 5248; s.nvalid = 16; } else s.nvalid = 0; }
    else if (tile < 45)  s.col0 = 5264 + (tile - 21) * 256 + p;
    else if (tile < 49)  { const int c = (tile - 45) * 256 + p;
        const int seg = c < 128 ? 0 : c < 256 ? 1 : c < 512 ? 2 : c < 640 ? 3 : c < 768 ? 4 : 5, sbeg = seg == 0 ? 0 : seg == 1 ? 128 : seg == 2 ? 256 : seg == 3 ? 512 : seg == 4 ? 640 : 768;
        const int kind = seg % 3;
        s.p = in[kind == 0 ? I_W1 : (kind == 1 ? I_A1 : I_G1)]; s.ld = kind == 2 ? 256 : 96; s.col0 = c - sbeg; s.mu = in[I_MU_WAG] + kind * D; s.mumode = seg < 3 ? 1 : 2;
        if (kind != 2) s.nvalid = (s.col0 == 0) ? 64 : 32; }
    else { s.p = in[I_WGATE]; s.ld = 2 * D; s.col0 = (tile - 49) * 256 + p; }
    return s;
}
DI TrSrc src_plain(const float* p, int ld, int col0, int kvalid, const float* ksc) { TrSrc s; s.p = p; s.ld = ld; s.col0 = col0; s.nvalid = 64; s.kvalid = kvalid; s.ksc = ksc; s.mu = nullptr; s.mumode = 0; return s; }

DI void convert_set_a(const float* const* in, unsigned char* ws, LAS unsigned* scr, int gw, int NGW, int lane) {
    constexpr int I0 = (NCAT / 64) * (D / 64);
    constexpr int I6 = (DB / 64) * (256 / 64);
    constexpr int NITEMS = I0 + 3 * I6;
    for (int it = gw; it < NITEMS; it += NGW) {
        int r = it;
        if (r < I0) { const int nblk = NCAT / 64, kb = r / nblk, nb = r % nblk; tr_item(src_wcat(in, 64 * nb), (bf16*)(ws + WS_WCAT), D, 64 * nb, 64 * kb, scr, lane); continue; } r -= I0;
        { const int w = r / I6; r -= w * I6; const int nblk = DB / 64, kb = r / nblk, nb = r % nblk;
          tr_item(src_plain(in[w == 0 ? I_W2 : (w == 1 ? I_A2 : I_G2)], DB, 64 * nb, w == 2 ? 256 : 96, nullptr), (bf16*)(ws + WS_WL2) + (size_t)w * DB * 256, 256, 64 * nb, 64 * kb, scr, lane); }
    }
}
constexpr int A1_I1 = (D / 64) * (DA / 64), A1_I3 = (D / 64) * (D / 64), A1_I5 = (D / 64) * (DPLE / 64), A1_NITEMS = 2 * A1_I1 + 2 * A1_I3 + A1_I5;
DI void convert_a1_item(const float* const* in, unsigned char* ws, LAS unsigned* scr, int it, int lane) {
    int r = it;
    if (r < 2 * A1_I1) { const int w = r / A1_I1; r -= w * A1_I1; const int nblk = D / 64, kb = r / nblk, nb = r % nblk;
        tr_item(src_plain(in[w ? I_WPB : I_WPA], D, 64 * nb, DA, nullptr), (bf16*)(ws + WS_WPAB) + (size_t)w * D * DA, DA, 64 * nb, 64 * kb, scr, lane); return; } r -= 2 * A1_I1;
    if (r < 2 * A1_I3) { const int w = r / A1_I3; r -= w * A1_I3; const int nblk = D / 64, kb = r / nblk, nb = r % nblk;
        tr_item(src_plain(in[w ? I_WPLEG : I_WO], D, 64 * nb, D, nullptr), (bf16*)(ws + (w ? WS_WPG : WS_WO)), D, 64 * nb, 64 * kb, scr, lane); return; } r -= 2 * A1_I3;
    { const int nblk = D / 64, kb = r / nblk, nb = r % nblk; tr_item(src_plain(in[I_WPLE], D, 64 * nb, DPLE, nullptr), (bf16*)(ws + WS_WPLE), DPLE, 64 * nb, 64 * kb, scr, lane); }
}
DI void convert_set_b(const float* const* in, unsigned char* ws, LAS unsigned* scr, int gw, int NGW, int lane) {
    constexpr int I0 = (N13 / 64) * (D / 64);
    for (int it = gw; it < I0; it += NGW) {
        const int nblk = N13 / 64, kb = it / nblk, nb = it % nblk, n0 = 64 * nb, tile = n0 >> 8, p = n0 & 255;
        tr_item(src_plain(in[(p >> 7) ? I_WFFN3 : I_WFFN1], DFF, tile * 128 + (p & 127), D, in[I_NORM_FFN]), (bf16*)(ws + WS_W13), D, n0, 64 * kb, scr, lane);
    }
}
constexpr int W2_NITEMS = (D / 64) * (DFF / 64);
DI void convert_w2_item(const float* const* in, unsigned char* ws, LAS unsigned* scr, int it, int lane) {
    const int nblk = D / 64, kb = it / nblk, nb = it % nblk; tr_item(src_plain(in[I_WFFN2], D, 64 * nb, DFF, nullptr), (bf16*)(ws + WS_W2), DFF, 64 * nb, 64 * kb, scr, lane);
}
DI void prologue_rows(const float* const* in, unsigned char* ws, int gw, int NGW, int lane) {
    const float* x = in[I_X]; bf16* xb = (bf16*)(ws + WS_XB); float* rstd = (float*)(ws + WS_RSTDX);
    for (int m = gw; m < M; m += NGW) {
        const GAS f32x4* xr = (const GAS f32x4*)(x + (size_t)m * D) + lane; GAS v2u* o = (GAS v2u*)(xb + (size_t)m * D) + lane; float s = 0.f;
f32x4 xv[16];
#pragma unroll
        for (int j = 0; j < 16; ++j) xv[j] = xr[64 * j];
#pragma unroll
        for (int j = 0; j < 16; ++j) { const f32x4 v = xv[j]; s += (v.x * v.x + v.y * v.y) + (v.z * v.z + v.w * v.w); v2u w; w.x = pk2(v.x, v.y); w.y = pk2(v.z, v.w); o[64 * j] = w; }
        s = wave_sum(s);
        if (lane == 0) rstd[m] = 1.0f / sqrtf(s * (1.0f / D) + RMS_EPS);
    }
    const int* pos = (const int*)in[I_POS]; float* rc = (float*)(ws + WS_RCOS); float* rsn = (float*)(ws + WS_RSIN);
    for (int e = gw * 64 + lane; e < M * 64; e += NGW * 64) {
        const int m = e >> 6, i = e & 63; double inv = 1.0; for (int j = 0; j < i; ++j) inv *= 0.8659643233600653523;
        const double ang = (double)pos[m] * inv;
        const double qd = __builtin_rint(ang * 0.63661977236758134308); const int qi = (int)((long long)qd & 3);
        double r = __builtin_fma(-qd, 1.5707963267948965580, ang); r = __builtin_fma(-qd, 6.1232339957367658860e-17, r);
        const double r2 = r * r;
        const double sn = r * (1.0 + r2 * (-1.0 / 6 + r2 * (1.0 / 120 + r2 * (-1.0 / 5040 + r2 * (1.0 / 362880 + r2 * (-1.0 / 39916800 + r2 * (1.0 / 6227020800.0)))))));
        const double cs = 1.0 + r2 * (-0.5 + r2 * (1.0 / 24 + r2 * (-1.0 / 720 + r2 * (1.0 / 40320 + r2 * (-1.0 / 3628800 + r2 * (1.0 / 479001600.0 + r2 * (-1.0 / 87178291200.0)))))));
        const double c4 = (qi == 0) ? cs : (qi == 1) ? -sn : (qi == 2) ? -cs : sn;
        const double s4 = (qi == 0) ? sn : (qi == 1) ? cs : (qi == 2) ? -sn : -cs;
        rc[e] = (float)c4; rsn[e] = (float)s4;
    }
    const float* p = in[I_P]; bf16* pb = (bf16*)(ws + WS_PB);
    for (int e = gw * 64 + lane; e < M * DPLE / 4; e += NGW * 64) { const f32x4 v = ((const GAS f32x4*)p)[e]; v2u w; w.x = pk2(v.x, v.y); w.y = pk2(v.z, v.w); ((GAS v2u*)pb)[e] = w; }
}
DI void build_alora(unsigned char* ws, int gtid, int NT) {
    const bf16* L = (const bf16*)(ws + WS_LORA); bf16* A = (bf16*)(ws + WS_ALORA);
    for (int e = gtid; e < 3 * M * 32; e += NT) {
        const int which = e / (M * 32), r = e - which * (M * 32), m = r >> 5, j0 = (r & 31) * 8;
        f32x4 o0 = {0.f, 0.f, 0.f, 0.f}, o1 = o0;
        const int width = which == 2 ? 256 : 96, ca = which == 0 ? 0 : (which == 1 ? 128 : 256), cbb = which == 0 ? 512 : (which == 1 ? 640 : 768);
        if (j0 < width) {
            f32x4 c0, c1, p0 = {0.f, 0.f, 0.f, 0.f}, p1 = p0;
            epi::unpack8(*(const v4u*)(L + (size_t)m * LORA_LD + ca + j0), c0, c1);
            if ((m & (SEQ - 1)) != 0) epi::unpack8(*(const v4u*)(L + (size_t)(m - 1) * LORA_LD + cbb + j0), p0, p1);
            o0 = c0 + p0; o1 = c1 + p1;
            if (which == 0) {
#pragma unroll
                for (int t = 0; t < 4; ++t) { o0[t] = 1.0f - 2.0f / (__expf(2.0f * o0[t]) + 1.0f); o1[t] = 1.0f - 2.0f / (__expf(2.0f * o1[t]) + 1.0f); } }
            if (which == 2) {
#pragma unroll
                for (int t = 0; t < 4; ++t) { o0[t] = sigmoidf_(o0[t]); o1[t] = sigmoidf_(o1[t]); } }
        }
        *(v4u*)(A + ((size_t)which * M + m) * 256 + j0) = epi::pack8(o0, o1);
    }
}

constexpr int IDX_TS = 272;
constexpr int IDX_TILE_BYTES = 64 * IDX_TS;
constexpr int IDX_HIST_OFF = 2 * IDX_TILE_BYTES;

DI unsigned fkey(float f) { unsigned u = __builtin_bit_cast(unsigned, f); if (u == 0x80000000u) u = 0u; return (u & 0x80000000u) ? ~u : (u | 0x80000000u); }

DI void indexer_unit(unsigned char* ws, LAS unsigned char* lds, int b, int blk, float* scratch, int wave) {
    const int lane = lane_opaque(), tid = wave * 64 + lane;
    const bf16* qi = (const bf16*)(ws + WS_QI); const bf16* ki = (const bf16*)(ws + WS_KI); const float* wi = (const float*)(ws + WS_WI);
    const int t0 = blk * 32, mrow0 = b * SEQ + t0;
    const int r = lane & 31, kh = lane >> 5, aq = (r >> 2) & 1, ah = (r & 3) + 4 * (r >> 3);
    bf16x8 af[2][8]; f32x4 wg[2][4];
#pragma unroll
    for (int rt = 0; rt < 2; ++rt) {
        const bf16* src = qi + (size_t)(mrow0 + 4 * wave + 2 * rt + aq) * DIQ + ah * HDI + 8 * kh;
#pragma unroll
        for (int ks = 0; ks < 8; ++ks) af[rt][ks] = *(const bf16x8*)(src + 16 * ks);
        const float* wsrc = wi + (size_t)(mrow0 + 4 * wave + 2 * rt + kh) * NHI;
#pragma unroll
        for (int j = 0; j < 4; ++j) wg[rt][j] = *(const f32x4*)(wsrc + 4 * j) * 0.08838834764831845f;
    }
    const int nk = (t0 + 32 + 63) >> 6;
    const int lkey = tid >> 3, lpart = tid & 7;
    const bf16* kbase = ki + (size_t)(b * SEQ) * HDI;
    v4u st0, st1;
    { const v4u* g = (const v4u*)(kbase + (size_t)lkey * HDI + lpart * 16); st0 = g[0]; st1 = g[1]; }
    __syncthreads();
    { LAS v4u* d = (LAS v4u*)(lds + lkey * IDX_TS + lpart * 32); d[0] = st0; d[1] = st1; }
    __syncthreads();
#pragma unroll
    for (int rt = 0; rt < 2; ++rt) {
#pragma unroll
        for (int ks = 0; ks < 8; ++ks) asm volatile("; pin %0" : "+v"(af[rt][ks]));
#pragma unroll
        for (int j = 0; j < 4; ++j) asm volatile("; pin %0" : "+v"(wg[rt][j])); }
    for (int kt = 0; kt < nk; ++kt) {
        if (kt + 1 < nk) { const v4u* g = (const v4u*)(kbase + (size_t)((kt + 1) * 64 + lkey) * HDI + lpart * 16); st0 = g[0]; st1 = g[1]; }
        const LAS unsigned char* tb = lds + (kt & 1) * IDX_TILE_BYTES;
#pragma unroll
        for (int ct = 0; ct < 2; ++ct) {
            bf16x8 bfr[8];
#pragma unroll
            for (int ks = 0; ks < 8; ++ks) bfr[ks] = *(const LAS bf16x8*)(tb + (32 * ct + r) * IDX_TS + (16 * ks + 8 * kh) * 2);
#pragma unroll
            for (int rt = 0; rt < 2; ++rt) {
                f32x16 c;
#pragma unroll
                for (int j = 0; j < 16; ++j) c[j] = 0.f;
#pragma unroll
                for (int ks = 0; ks < 8; ++ks) c = __builtin_amdgcn_mfma_f32_32x32x16_bf16(af[rt][ks], bfr[ks], c, 0, 0, 0);
                float s = 0.f;
#pragma unroll
                for (int j = 0; j < 16; ++j) s += wg[rt][j >> 2][j & 3] * __builtin_amdgcn_fmed3f(c[j], 0.f, 3.0e38f);
                scratch[(size_t)(4 * wave + 2 * rt + kh) * SEQ + kt * 64 + 32 * ct + r] = s;
            }
        }
        if (kt + 1 < nk) { LAS v4u* d = (LAS v4u*)(lds + ((kt + 1) & 1) * IDX_TILE_BYTES + lkey * IDX_TS + lpart * 32); d[0] = st0; d[1] = st1; }
        asm volatile("s_waitcnt lgkmcnt(0)" ::: "memory"); __builtin_amdgcn_s_barrier(); asm volatile("" ::: "memory");
    }
}

DI void select_unit(unsigned char* ws, LAS unsigned char* lds, int b, int blk, const float* scratch, int wave) {
    int* idx = (int*)(ws + WS_IDX);
    LAS unsigned* hist = (LAS unsigned*)(lds + IDX_HIST_OFF + wave * 8192);
    for (int qq = 0; qq < 4; ++qq) {
        const int lane = lane_opaque(); const unsigned long long lt_mask = (1ull << lane) - 1ull;
        const int ql = wave * 4 + qq, t = blk * 32 + ql, n = t + 1;
        const float* sc = scratch + (size_t)ql * SEQ; int* out = idx + (size_t)(b * SEQ + t) * TOPK;
        if (n <= TOPK) { for (int e = lane; e < TOPK; e += 64) out[e] = (e < n) ? e : 0; continue; }
        const int n4 = (n + 3) >> 2;
        v4u key[32];
#pragma unroll
        for (int j = 0; j < 32; ++j) { key[j] = (v4u){0u, 0u, 0u, 0u};
            if (64 * j < n4) { const int gi = 64 * j + lane; if (gi < n4) { const f32x4 v = *(const f32x4*)(sc + 4 * gi); const int e0 = 4 * gi;
                key[j].x = fkey(v[0]); key[j].y = (e0 + 1 < n) ? fkey(v[1]) : 0u; key[j].z = (e0 + 2 < n) ? fkey(v[2]) : 0u; key[j].w = (e0 + 3 < n) ? fkey(v[3]) : 0u; } } }
        unsigned prefix = 0u, pmask = 0u; int kk = TOPK;
        for (int pass = 0; pass < 4; ++pass) {
            const int shift = 24 - 8 * pass;
#pragma unroll
            for (int z = 0; z < 8; ++z) *(LAS v4u*)(hist + 4 * (lane + 64 * z)) = (v4u){0u, 0u, 0u, 0u};
            LAS unsigned* hc = hist + 256 * (lane & 7);
#pragma unroll
            for (int j = 0; j < 32; ++j) if (64 * j < n4) {
#pragma unroll
                for (int c = 0; c < 4; ++c) { const unsigned u = key[j][c]; if ((u & pmask) == prefix) __hip_atomic_fetch_add(hc + ((u >> shift) & 255u), 1u, __ATOMIC_RELAXED, __HIP_MEMORY_SCOPE_WORKGROUP); } }
            LDS_WAIT(); asm volatile("" ::: "memory");
            v4u hs = {0u, 0u, 0u, 0u};
#pragma unroll
            for (int z = 0; z < 8; ++z) hs += *(const LAS v4u*)(hist + 256 * z + 4 * lane);
            const int c0 = (int)hs.x, c1 = (int)hs.y, c2 = (int)hs.z, c3 = (int)hs.w;
            const int T = c0 + c1 + c2 + c3; int S = T;
#pragma unroll
            for (int o = 1; o < 64; o <<= 1) { const int v = __shfl_down(S, o); if (lane + o < 64) S += v; }
            const int E = S - T;
            const bool found = (E < kk) && (kk <= S);
            int d = 0, knew = 0;
            if (found) { int run = E;
                if (run + c3 >= kk) { d = 4 * lane + 3; knew = kk - run; } else { run += c3;
                if (run + c2 >= kk) { d = 4 * lane + 2; knew = kk - run; } else { run += c2;
                if (run + c1 >= kk) { d = 4 * lane + 1; knew = kk - run; } else { run += c1; d = 4 * lane; knew = kk - run; } } } }
            const unsigned long long fm = __ballot(found); const int src = fm ? (int)__builtin_ctzll(fm) : 0;
            d = __shfl(d, src); knew = __shfl(knew, src);
            prefix |= ((unsigned)d) << shift; pmask |= 0xffu << shift; kk = knew;
            asm volatile("" ::: "memory");
        }
        int pos = 0, eqt = 0;
#pragma unroll
        for (int j = 0; j < 32; ++j) if (64 * j < n4) {
            bool eq[4], gt[4]; unsigned long long em[4]; int eq_before = eqt;
#pragma unroll
            for (int c = 0; c < 4; ++c) { const unsigned u = key[j][c]; eq[c] = (u == prefix); gt[c] = (u > prefix); em[c] = __ballot(eq[c]); eq_before += __builtin_popcountll(em[c] & lt_mask); }
            bool take[4]; unsigned long long tm[4]; int tk_before = pos, run_eq = eq_before;
#pragma unroll
            for (int c = 0; c < 4; ++c) { take[c] = gt[c] || (eq[c] && run_eq < kk); run_eq += eq[c] ? 1 : 0; tm[c] = __ballot(take[c]); tk_before += __builtin_popcountll(tm[c] & lt_mask); }
            int slot = tk_before;
#pragma unroll
            for (int c = 0; c < 4; ++c) { if (take[c]) { if (slot < TOPK) out[slot] = 256 * j + 4 * lane + c; ++slot; } }
#pragma unroll
            for (int c = 0; c < 4; ++c) { pos += __builtin_popcountll(tm[c]); eqt += __builtin_popcountll(em[c]); }
        }
    }
}

DI void indexer_phase(unsigned char* ws, LAS unsigned char* lds, int wave) {
    float* scratch = (float*)(ws + WS_SCORE) + (size_t)blockIdx.x * 32 * SEQ;
    for (int pr = blockIdx.x; pr < 256; pr += gridDim.x) {
        const int b = pr >> 7, j = pr & 127;
        for (int half = 0; half < 2; ++half) { const int blk = half ? 255 - j : j;
            indexer_unit(ws, lds, b, blk, scratch, wave);
            VM_WAIT(); __syncthreads();
#ifndef REP_SEL
#define REP_SEL 1
#endif
            for (int rs_ = 0; rs_ < REP_SEL; ++rs_) select_unit(ws, lds, b, blk, scratch, wave);
            VM_WAIT(); __syncthreads(); }
    }
}

typedef int v4i __attribute__((ext_vector_type(4)));
#define ATT_FENCE() asm volatile("" ::: "memory")
DI void attn_worker(unsigned char* ws, LAS unsigned char* lds, LAS unsigned* qctr, int wave) {
    const int lane = lane_opaque();
    const bf16* q = (const bf16*)(ws + WS_Q); const bf16* kbuf = (const bf16*)(ws + WS_K); const bf16* vbuf = (const bf16*)(ws + WS_V);
    const int* idx = (const int*)(ws + WS_IDX); bf16* ao = (bf16*)(ws + WS_AO);
    LAS int* idl = (LAS int*)(lds); LAS float* pl = (LAS float*)(lds + 1024);
    const int G = gridDim.x, bg = blockIdx.x & 7, b = bg >> 2, g = bg & 3;
    const int nbk = (G - bg + 7) >> 3, rank = blockIdx.x >> 3, nq = (SEQ - rank + nbk - 1) / nbk;
    const int kr = lane & 15, kq = lane >> 4;
    const int kg = lane >> 4, dg = lane & 15;
    const bf16* kbase = kbuf + (size_t)(b * SEQ) * KVD + g * 128 + 8 * kq;
    const bf16* vbase = vbuf + (size_t)(b * SEQ) * KVD + g * 128 + 8 * dg;
    int qn; { unsigned v_ = 0u; if (lane == 0) v_ = __hip_atomic_fetch_add(qctr, 1u, __ATOMIC_RELAXED, __HIP_MEMORY_SCOPE_WORKGROUP); qn = __builtin_amdgcn_readfirstlane((int)v_); }
    int ixg[4]; bf16x8 qf[4];
    if (qn < nq) { const int mq = b * SEQ + rank + nbk * qn;
#pragma unroll
        for (int c = 0; c < 4; ++c) ixg[c] = idx[(size_t)mq * TOPK + lane + 64 * c];
#pragma unroll
        for (int ks = 0; ks < 4; ++ks) { if (kr < 4) qf[ks] = *(const bf16x8*)(q + (size_t)mq * DA + (4 * g + kr) * 128 + 32 * ks + 8 * kq); else qf[ks] = (bf16x8){0, 0, 0, 0, 0, 0, 0, 0}; } }
    while (qn < nq) {
        const int t = rank + nbk * qn, mq = b * SEQ + t, nvalid = (t + 1 < TOPK) ? t + 1 : TOPK;
#pragma unroll
        for (int c = 0; c < 4; ++c) idl[lane + 64 * c] = ixg[c];
        LDS_WAIT(); ATT_FENCE();
        int qn2; { unsigned v_ = 0u; if (lane == 0) v_ = __hip_atomic_fetch_add(qctr, 1u, __ATOMIC_RELAXED, __HIP_MEMORY_SCOPE_WORKGROUP); qn2 = __builtin_amdgcn_readfirstlane((int)v_); }
        if (qn2 < nq) { const int mq2 = b * SEQ + rank + nbk * qn2;
#pragma unroll
            for (int c = 0; c < 4; ++c) ixg[c] = idx[(size_t)mq2 * TOPK + lane + 64 * c]; }
        ATT_FENCE();
        int kidx[16];
#pragma unroll
        for (int kt = 0; kt < 16; ++kt) kidx[kt] = idl[64 * (kr >> 2) + 4 * kt + (kr & 3)];
        f32x4 s[16]; bf16x8 kf[3][2][4];
#pragma unroll
        for (int hg = 0; hg < 2; ++hg) {
#pragma unroll
            for (int j = 0; j < 2; ++j) { const bf16* kp = kbase + (size_t)kidx[2 * hg + j] * KVD;
#pragma unroll
                for (int ks = 0; ks < 4; ++ks) kf[hg][j][ks] = *(const bf16x8*)(kp + 32 * ks); }
            ATT_FENCE(); }
#pragma unroll
        for (int hg = 0; hg < 8; ++hg) {
            if (hg + 2 < 8) {
#pragma unroll
                for (int j = 0; j < 2; ++j) { const bf16* kp = kbase + (size_t)kidx[2 * (hg + 2) + j] * KVD;
#pragma unroll
                    for (int ks = 0; ks < 4; ++ks) kf[(hg + 2) % 3][j][ks] = *(const bf16x8*)(kp + 32 * ks); }
                ATT_FENCE(); }
#pragma unroll
            for (int j = 0; j < 2; ++j) { f32x4 a = {0.f, 0.f, 0.f, 0.f};
#pragma unroll
                for (int ks = 0; ks < 4; ++ks) a = __builtin_amdgcn_mfma_f32_16x16x32_bf16(kf[hg % 3][j][ks], qf[ks], a, 0, 0, 0);
                s[2 * hg + j] = a; }
        }
        if (qn2 < nq && kr < 4) { const int mq2 = b * SEQ + rank + nbk * qn2;
#pragma unroll
            for (int ks = 0; ks < 4; ++ks) qf[ks] = *(const bf16x8*)(q + (size_t)mq2 * DA + (4 * g + kr) * 128 + 32 * ks + 8 * kq); }
        ATT_FENCE();
        v4i ix[3][2]; v4u vv[3][8];
#pragma unroll
        for (int ch = 0; ch < 2; ++ch) {
            ix[ch][0] = *(const LAS v4i*)(idl + 64 * kg + 8 * ch); ix[ch][1] = *(const LAS v4i*)(idl + 64 * kg + 8 * ch + 4);
#pragma unroll
            for (int j = 0; j < 8; ++j) vv[ch][j] = *(const v4u*)(vbase + (size_t)ix[ch][j >> 2][j & 3] * KVD);
            ATT_FENCE(); }
        float mx = -3.0e38f;
#pragma unroll
        for (int kt = 0; kt < 16; ++kt)
#pragma unroll
            for (int e = 0; e < 4; ++e) { const bool ok = (64 * kq + 4 * kt + e) < nvalid; s[kt][e] = ok ? s[kt][e] * 0.08838834764831845f : -3.0e38f; mx = fmaxf(mx, s[kt][e]); }
        mx = fmaxf(mx, __shfl_xor(mx, 16)); mx = fmaxf(mx, __shfl_xor(mx, 32));
        float sum = 0.f;
#pragma unroll
        for (int kt = 0; kt < 16; ++kt)
#pragma unroll
            for (int e = 0; e < 4; ++e) { const bool ok = (64 * kq + 4 * kt + e) < nvalid; const float p = ok ? __expf(s[kt][e] - mx) : 0.f; s[kt][e] = p; sum += p; }
        sum += __shfl_xor(sum, 16); sum += __shfl_xor(sum, 32);
        const float inv = 1.0f / sum;
        if (kr < 4) {
#pragma unroll
            for (int kt = 0; kt < 16; ++kt) *(LAS f32x4*)(pl + kr * 256 + 64 * kq + 4 * kt) = s[kt] * inv; }
        LDS_WAIT(); ATT_FENCE();
        f32x2 acc[4][4];
#pragma unroll
        for (int h = 0; h < 4; ++h)
#pragma unroll
            for (int d = 0; d < 4; ++d) acc[h][d] = (f32x2){0.f, 0.f};
#pragma unroll
        for (int ch = 0; ch < 8; ++ch) {
            if (ch + 2 < 8) { const int c2 = (ch + 2) % 3;
                ix[c2][0] = *(const LAS v4i*)(idl + 64 * kg + 8 * (ch + 2)); ix[c2][1] = *(const LAS v4i*)(idl + 64 * kg + 8 * (ch + 2) + 4);
#pragma unroll
                for (int j = 0; j < 8; ++j) vv[c2][j] = *(const v4u*)(vbase + (size_t)ix[c2][j >> 2][j & 3] * KVD);
                ATT_FENCE(); }
            f32x4 pp[4][2];
#pragma unroll
            for (int h = 0; h < 4; ++h) { pp[h][0] = *(const LAS f32x4*)(pl + h * 256 + 64 * kg + 8 * ch); pp[h][1] = *(const LAS f32x4*)(pl + h * 256 + 64 * kg + 8 * ch + 4); }
#pragma unroll
            for (int j = 0; j < 8; ++j) { const v4u w = vv[ch % 3][j];
                const f32x2 v0 = {bf_lo(w.x), bf_hi(w.x)}, v1 = {bf_lo(w.y), bf_hi(w.y)}, v2 = {bf_lo(w.z), bf_hi(w.z)}, v3 = {bf_lo(w.w), bf_hi(w.w)};
#pragma unroll
                for (int h = 0; h < 4; ++h) { const float p = pp[h][j >> 2][j & 3]; const f32x2 p2 = {p, p};
                    acc[h][0] += p2 * v0; acc[h][1] += p2 * v1; acc[h][2] += p2 * v2; acc[h][3] += p2 * v3; }
            }
        }
#pragma unroll
        for (int h = 0; h < 4; ++h)
#pragma unroll
            for (int d = 0; d < 4; ++d) {
                acc[h][d][0] += __shfl_xor(acc[h][d][0], 16); acc[h][d][1] += __shfl_xor(acc[h][d][1], 16);
                acc[h][d][0] += __shfl_xor(acc[h][d][0], 32); acc[h][d][1] += __shfl_xor(acc[h][d][1], 32); }
        if (kg == 0) {
#pragma unroll
            for (int h = 0; h < 4; ++h) { v4u w; w.x = pk2(acc[h][0][0], acc[h][0][1]); w.y = pk2(acc[h][1][0], acc[h][1][1]); w.z = pk2(acc[h][2][0], acc[h][2][1]); w.w = pk2(acc[h][3][0], acc[h][3][1]);
                *(v4u*)(ao + (size_t)mq * DA + (4 * g + h) * 128 + 8 * dg) = w; } }
        LDS_WAIT(); ATT_FENCE();
        qn = qn2;
    }
}

constexpr int SC_STEPS = 32, SC_STEP_BYTES = 1344, SC_BUF_BYTES = SC_STEPS * SC_STEP_BYTES;
constexpr int SC_Y_OFF = 2 * SC_BUF_BYTES;

template <int CTRL> DI float dpp_add(float x) { return x + __builtin_bit_cast(float, __builtin_amdgcn_update_dpp(0, __builtin_bit_cast(int, x), CTRL, 0xf, 0xf, false)); }
DI float red16(float x) { x = dpp_add<0xB1>(x); x = dpp_add<0x4E>(x); x = dpp_add<0x141>(x); x = dpp_add<0x140>(x); return x; }

struct ScanRaw { v2u rc, rp, kc, kp, vc, vp, ac; f32x4 dc; };
struct ScanConst { f32x4 mu_r, mu_k, mu_v, kkw, kaw, rkw; };
DI f32x4 bf4(const v2u& w) { f32x4 r; r[0] = bf_lo(w.x); r[1] = bf_hi(w.x); r[2] = bf_lo(w.y); r[3] = bf_hi(w.y); return r; }

DI void scan_issue(ScanRaw& R, const unsigned char* ws, int b, int h, int t, int cg) {
    const bf16* rb = (const bf16*)(ws + WS_RB); const bf16* kb = (const bf16*)(ws + WS_KB); const bf16* vb = (const bf16*)(ws + WS_VB);
    const float* decay = (const float*)(ws + WS_DECAY); const bf16* av = (const bf16*)(ws + WS_AOUT);
    const size_t o = (size_t)(b * SEQ + t) * DB + h * HDB + 4 * cg;
    R.rc = *(const v2u*)(rb + o); R.kc = *(const v2u*)(kb + o); R.vc = *(const v2u*)(vb + o); R.dc = *(const f32x4*)(decay + o); R.ac = *(const v2u*)(av + o);
    if (t > 0) { R.rp = *(const v2u*)(rb + o - DB); R.kp = *(const v2u*)(kb + o - DB); R.vp = *(const v2u*)(vb + o - DB); }
    else { R.rp = (v2u){0u, 0u}; R.kp = (v2u){0u, 0u}; R.vp = (v2u){0u, 0u}; }
}
DI void scan_emit(const ScanRaw& R, const ScanConst& C, LAS float* sb, int cg, int qr, float* bonus_dst) {
    const f32x4 rc = bf4(R.rc), rp = bf4(R.rp), kc = bf4(R.kc), kp = bf4(R.kp), vc = bf4(R.vc), vp = bf4(R.vp), a = bf4(R.ac);
    const f32x4 r1 = rc + (rp - rc) * C.mu_r, k0 = kc + (kp - kc) * C.mu_k, v1 = vc + (vp - vc) * C.mu_v;
    const f32x4 kkv = k0 * C.kkw;
    const float nrm = sqrtf(red16((kkv[0] * kkv[0] + kkv[1] * kkv[1]) + (kkv[2] * kkv[2] + kkv[3] * kkv[3])));
    const f32x4 kkn = kkv * (1.0f / fmaxf(nrm, 1e-12f));
    const f32x4 k1 = k0 * (1.0f + (a - 1.0f) * C.kaw);
    const f32x4 rk = r1 * k1 * C.rkw;
    const float bc = red16((rk[0] + rk[1]) + (rk[2] + rk[3]));
    *(LAS f32x4*)(sb + 4 * cg) = R.dc; *(LAS f32x4*)(sb + 64 + 4 * cg) = -kkn; *(LAS f32x4*)(sb + 128 + 4 * cg) = kkn * a;
    *(LAS f32x4*)(sb + 192 + 4 * cg) = k1; *(LAS f32x4*)(sb + 256 + 4 * cg) = r1;
    if ((cg >> 2) == qr) *(LAS f32x4*)(sb + 320 + 4 * (cg & 3)) = v1;
    if (bonus_dst != nullptr && cg == 0) *bonus_dst = bc;
}
DI float red8(float x) { x = dpp_add<0xB1>(x); x = dpp_add<0x4E>(x); x = dpp_add<0x141>(x); return x; }
struct ScanVec { f32x4 w0, w1, a0, a1, b0, b1, k0, k1, r0, r1; float v; };
DI void scan_ld(ScanVec& V, const LAS float* sb, int cg, int vrow) {
    V.w0 = *(const LAS f32x4*)(sb + 8 * cg); V.w1 = *(const LAS f32x4*)(sb + 8 * cg + 4); V.a0 = *(const LAS f32x4*)(sb + 64 + 8 * cg); V.a1 = *(const LAS f32x4*)(sb + 64 + 8 * cg + 4);
    V.b0 = *(const LAS f32x4*)(sb + 128 + 8 * cg); V.b1 = *(const LAS f32x4*)(sb + 128 + 8 * cg + 4); V.k0 = *(const LAS f32x4*)(sb + 192 + 8 * cg); V.k1 = *(const LAS f32x4*)(sb + 192 + 8 * cg + 4);
    V.r0 = *(const LAS f32x4*)(sb + 256 + 8 * cg); V.r1 = *(const LAS f32x4*)(sb + 256 + 8 * cg + 4); V.v = sb[320 + vrow];
}
DI float scan_step(f32x4& s0, f32x4& s1, const ScanVec& V) {
    const f32x4 t0 = s0 * V.w0 + V.k0 * V.v, t1 = s1 * V.w1 + V.k1 * V.v;
    const f32x4 p = s0 * V.a0 + s1 * V.a1;
    const float sa = red8((p[0] + p[1]) + (p[2] + p[3]));
    s0 = t0 + V.b0 * sa; s1 = t1 + V.b1 * sa;
    const f32x4 q = s0 * V.r0 + s1 * V.r1;
    return red8((q[0] + q[1]) + (q[2] + q[3]));
}
DI void lds_signal(LAS unsigned* p, int lane) { asm volatile("s_waitcnt lgkmcnt(0)" ::: "memory"); if (lane == 0) __hip_atomic_fetch_add(p, 1u, __ATOMIC_RELAXED, __HIP_MEMORY_SCOPE_WORKGROUP); }
DI void lds_wait_ge(LAS unsigned* p, unsigned v) {
    unsigned spins = 0;
    while ((unsigned)__builtin_amdgcn_readfirstlane(__hip_atomic_load(p, __ATOMIC_RELAXED, __HIP_MEMORY_SCOPE_WORKGROUP)) < v) { __builtin_amdgcn_s_sleep(1); if (++spins > (1u << 24)) break; }
    asm volatile("" ::: "memory");
}
constexpr int SC_YW_OFF = 2 * SC_BUF_BYTES;
constexpr int SC_NSCAN = 2, SC_NLOAD = 2;

DI void scan_task(const float* const* in, unsigned char* ws, float* y, LAS unsigned char* lds, LAS unsigned* ctr, int task, int wave) {
    const int lane = lane_opaque();
    float* bonus = (float*)(ws + WS_BONUS);
    constexpr int NCHUNK = SEQ / SC_STEPS;
    const int bh = task >> 2, qr = task & 3, b = bh >> 5, h = bh & 31;
    if (wave < SC_NSCAN) {
        const int rl = lane >> 3, cg = lane & 7, vrow = 8 * wave + rl;
        f32x4 s0 = {0.f, 0.f, 0.f, 0.f}, s1 = s0;
        LAS float* yb = (LAS float*)(lds + SC_YW_OFF + wave * 1024);
        for (int c = 0; c < NCHUNK; ++c) {
            lds_wait_ge(ctr, (unsigned)(c + 1)); lds_wait_ge(ctr + 1, (unsigned)(c + 1));
            const LAS unsigned char* buf = lds + (c & 1) * SC_BUF_BYTES;
            ScanVec A, B; scan_ld(A, (const LAS float*)buf, cg, vrow);
#pragma unroll 2
            for (int s = 0; s < SC_STEPS; s += 2) {
                scan_ld(B, (const LAS float*)(buf + (s + 1) * SC_STEP_BYTES), cg, vrow);
                const float y0 = scan_step(s0, s1, A);
                if (s + 2 < SC_STEPS) scan_ld(A, (const LAS float*)(buf + (s + 2) * SC_STEP_BYTES), cg, vrow);
                const float y1 = scan_step(s0, s1, B);
                if (cg == 0) { yb[s * 8 + rl] = y0; yb[(s + 1) * 8 + rl] = y1; }
            }
            lds_signal(ctr + 2 + wave, lane);
            { const int s = lane >> 1, hf = lane & 1, t = c * SC_STEPS + s;
              *(f32x4*)(y + (size_t)(b * SEQ + t) * DB + h * HDB + 16 * qr + 8 * wave + 4 * hf) = *(const LAS f32x4*)(yb + s * 8 + 4 * hf); }
            asm volatile("s_waitcnt lgkmcnt(0)" ::: "memory");
        }
    } else if (wave < SC_NSCAN + SC_NLOAD) {
        const int lw = wave - SC_NSCAN, rl = lane >> 4, cg = lane & 15, col0 = h * HDB + 4 * cg;
        ScanConst C; C.mu_r = *(const f32x4*)(in[I_MU_RKV] + col0); C.mu_k = *(const f32x4*)(in[I_MU_RKV] + DB + col0); C.mu_v = *(const f32x4*)(in[I_MU_RKV] + 2 * DB + col0);
        C.kkw = *(const f32x4*)(in[I_KK] + col0); C.kaw = *(const f32x4*)(in[I_KA] + col0); C.rkw = *(const f32x4*)(in[I_RK] + col0);
        ScanRaw R[4];
#pragma unroll
        for (int p = 0; p < 4; ++p) scan_issue(R[p], ws, b, h, 4 * (lw + 2 * p) + rl, cg);
        for (int c = 0; c < NCHUNK; ++c) {
            if (c >= 2) { lds_wait_ge(ctr + 2, (unsigned)(c - 1)); lds_wait_ge(ctr + 3, (unsigned)(c - 1)); }
            LAS float* base = (LAS float*)(lds + (c & 1) * SC_BUF_BYTES); const int t0 = c * SC_STEPS;
#pragma unroll
            for (int p = 0; p < 4; ++p) { const int st = 4 * (lw + 2 * p) + rl;
                scan_emit(R[p], C, base + st * (SC_STEP_BYTES / 4), cg, qr, qr == 0 ? bonus + (size_t)(b * SEQ + t0 + st) * NHB + h : nullptr);
                if (c + 1 < NCHUNK) scan_issue(R[p], ws, b, h, t0 + SC_STEPS + st, cg); }
            lds_signal(ctr + lw, lane);
        }
    }
}

constexpr int ATT_LDS_OFF = 90112;
constexpr int ATT_LDS_OFF2 = 132096;
DI void scan_attn_phase(const float* const* in, unsigned char* ws, float* y, LAS unsigned char* lds, LAS unsigned char* lds_all, LAS unsigned* ctr, int wave) {
    bool first = true;
    for (int task = blockIdx.x; task < BATCH * NHB * 4 || first; task += gridDim.x) {
        __syncthreads();
        if (wave == 0 && lane_opaque() == 0) { ((LAS v4u*)ctr)[0] = (v4u){0u, 0u, 0u, 0u}; ((LAS v4u*)ctr)[1] = (v4u){0u, 0u, 0u, 0u}; }
        __syncthreads();
        if (task < BATCH * NHB * 4) scan_task(in, ws, y, lds, ctr, task, wave);
        if (first) {
            LAS unsigned char* mine = wave >= 3 ? lds + ATT_LDS_OFF + (wave - 3) * 8192 : lds_all + ATT_LDS_OFF2 + wave * 5120;
            attn_worker(ws, mine, ctr + 4, wave);
            if (wave >= 3) { const int lane = lane_opaque(); constexpr int NSIDE = A1_NITEMS + W2_NITEMS; const int nmine = (NSIDE - (int)blockIdx.x + (int)gridDim.x - 1) / (int)gridDim.x;
                for (;;) { unsigned v_ = 0u; if (lane == 0) v_ = __hip_atomic_fetch_add(ctr + 5, 1u, __ATOMIC_RELAXED, __HIP_MEMORY_SCOPE_WORKGROUP);
                    const int i = __builtin_amdgcn_readfirstlane((int)v_); if (i >= nmine) break;
                    const int it = (int)blockIdx.x + i * (int)gridDim.x;
                    if (it < A1_NITEMS) convert_a1_item(in, ws, (LAS unsigned*)mine, it, lane); else convert_w2_item(in, ws, (LAS unsigned*)mine, it - A1_NITEMS, lane); } }
        }
        first = false;
    }
}

DI void gn_phase(const float* const* in, unsigned char* ws, const float* y, int gw, int NGW, int lane) {
    const bf16* vb = (const bf16*)(ws + WS_VB); const bf16* gout = (const bf16*)(ws + WS_GOUT);
    const float* bonus = (const float*)(ws + WS_BONUS); bf16* ro = (bf16*)(ws + WS_AO) + (size_t)M * DB;
    const int per = (M * 8 + NGW - 1) / NGW, it0 = gw * per, it1 = (it0 + per < M * 8) ? it0 + per : M * 8;
    const int hh = lane >> 4, cg = lane & 15;
#pragma unroll 2
    for (int it = it0; it < it1; ++it) {
        const int m = it >> 3, h = (it & 7) * 4 + hh, col = h * HDB + 4 * cg; const size_t o = (size_t)m * DB + col;
        const f32x4 yv = *(const f32x4*)(y + o);
        const f32x4 vc = bf4(*(const v2u*)(vb + o)), g4 = bf4(*(const v2u*)(gout + o));
        f32x4 vp = {0.f, 0.f, 0.f, 0.f}; if (m & (SEQ - 1)) vp = bf4(*(const v2u*)(vb + o - DB));
        const float bc = bonus[(size_t)m * NHB + h];
        const f32x4 lw = *(const f32x4*)(in[I_LNW] + col), lb = *(const f32x4*)(in[I_LNB] + col), muv = *(const f32x4*)(in[I_MU_RKV] + 2 * DB + col);
        const float mean = red16((yv[0] + yv[1]) + (yv[2] + yv[3])) * (1.0f / 64.0f); const f32x4 d = yv - mean;
        const float var = red16((d[0] * d[0] + d[1] * d[1]) + (d[2] * d[2] + d[3] * d[3])) * (1.0f / 64.0f);
        const f32x4 yn = d * (1.0f / sqrtf(var + GN_EPS)) * lw + lb;
        const f32x4 v1 = vc + (vp - vc) * muv;
        const f32x4 res = (yn + v1 * bc) * g4;
        v2u w; w.x = pk2(res[0], res[1]); w.y = pk2(res[2], res[3]);
        *(v2u*)(ro + o) = w;
    }
}

DI void final_phase(const float* const* in, unsigned char* ws, float* out, int gw, int NGW, int lane) {
    const float* ss3 = (const float*)(ws + SS3_OFF); const float* nf = in[I_NORM_FINAL];
    for (int m = gw; m < M; m += NGW) { const float r = 1.0f / sqrtf(ss3[m] * (1.0f / D) + RMS_EPS);
        GAS f32x4* o = (GAS f32x4*)(out + (size_t)m * D) + lane; const GAS f32x4* g = (const GAS f32x4*)nf + lane;
#pragma unroll 4
        for (int j = 0; j < 16; ++j) { f32x4 v = o[64 * j]; const f32x4 gg = g[64 * j]; v = v * r * gg; o[64 * j] = v; } }
}

#ifndef MK_N_LAUNCHES
#define MK_N_LAUNCHES 1
#endif
constexpr int N_PHASES = 13;
#ifndef REP_P2
#define REP_P2 1
#endif
#ifndef REP_P3
#define REP_P3 1
#endif
#ifndef REP_P6
#define REP_P6 1
#endif
#ifndef REP_P7
#define REP_P7 1
#endif
#ifndef REP_P10
#define REP_P10 1
#endif
#ifndef REP_C
#define REP_C 1
#endif
#ifndef PG8_SP2
#define PG8_SP2 true
#endif
#ifndef PG8_ALIGN
#define PG8_ALIGN true
#endif

__global__ void __launch_bounds__(NWAVES * 64, 2) hybrid_fwd(Args args) {
    extern __shared__ __attribute__((aligned(16))) unsigned char lds_raw[];
    LAS unsigned char* lds = (LAS unsigned char*)lds_raw;
    volatile LAS unsigned* MISC = (volatile LAS unsigned*)(lds + MISC_OFF);
    const int wave = __builtin_amdgcn_readfirstlane(threadIdx.x >> 6);
    const int G = gridDim.x, gw = blockIdx.x * NWAVES + wave, NGW = G * NWAVES;
    unsigned char* ws = args.ws; const float* const* in = args.in;
    { const int tid0 = wave * 64 + lane_opaque(); for (int u = tid0; u < (LDS_BYTES - LDSCTL_OFF) / 4; u += NWAVES * 64) ((LAS unsigned*)(lds + LDSCTL_OFF))[u] = 0u; }
    __syncthreads();
    unsigned* ctl = (unsigned*)(ws + WS_CTL);
    XcdBarrier bar; bar.bar = ctl + CW_BAR; bar.x = 0; bar.st = nullptr;
    const bool multi = (args.ph_hi - args.ph_lo) > 1;
    if (multi) bar = xcd_barrier_post(ctl + CW_BAR, MISC + 8, wave == 0 && lane_opaque() == 0);
    const int lo = args.ph_lo, hi = args.ph_hi;
#ifndef PHASE_MASK
#define PHASE_MASK 0x3fff
#endif
#define IN(k) ((((PHASE_MASK) >> (k)) & 1) && lo <= (k) && (k) < hi)
#define SEAM(k) do { if (IN(k) && IN((k) + 1)) xcd_barrier(bar, wave == 0 && lane_opaque() == 0); } while (0)
#define LANE lane_opaque()
    LAS unsigned* scr = (LAS unsigned*)(lds + RING_OFF + wave * 16384);

    if (IN(0)) { const int lane = LANE; for (int rep = 0; rep < REP_C; ++rep) { convert_set_a(in, ws, scr, gw, NGW, lane); prologue_rows(in, ws, gw, NGW, lane); } }
    SEAM(0);
    if (IN(1)) {
        pg8::Gemm g{(const bf16*)(ws + WS_XB), (const bf16*)(ws + WS_WCAT), M, NCAT, D}; pg8::StaticOrder S; S.init(M, NCAT, G, (int)blockIdx.x);
        epi::InProj E{(bf16*)(ws + WS_Q), (bf16*)(ws + WS_K), (bf16*)(ws + WS_V), (bf16*)(ws + WS_QI), (bf16*)(ws + WS_KI), (bf16*)(ws + WS_RB), (bf16*)(ws + WS_KB), (bf16*)(ws + WS_VB),
                      (bf16*)(ws + WS_LORA), (bf16*)(ws + WS_GATES), (float*)(ws + WS_WI), (const float*)(ws + WS_RSTDX), (const float*)(ws + WS_RCOS), (const float*)(ws + WS_RSIN)};
        pg8::gemm_phase<epi::InProj, pg8::StaticOrder, PG8_ALIGN, PG8_SP2>(lds + RING_OFF, g, S, E, wave);
    }
    SEAM(1);
    if (IN(2)) { for (int rep = 0; rep < REP_P2; ++rep) indexer_phase(ws, lds + RING_OFF, wave); }
    SEAM(2);
    if (IN(4)) build_alora(ws, blockIdx.x * (NWAVES * 64) + wave * 64 + LANE, G * NWAVES * 64);
    SEAM(4);
    if (IN(5)) {
        int k256 = 256; asm volatile("" : "+s"(k256));
        pg8::Gemm g{(const bf16*)(ws + WS_ALORA), (const bf16*)(ws + WS_WL2), 3 * M, 3 * DB, k256}; epi::Stack3Order S{G, (int)blockIdx.x};
        epi::LoraUp E{(float*)(ws + WS_DECAY), (bf16*)(ws + WS_AOUT), (bf16*)(ws + WS_GOUT), in[I_W0], in[I_A0]};
        pg8::gemm_phase<epi::LoraUp, epi::Stack3Order, PG8_ALIGN, PG8_SP2>(lds + RING_OFF, g, S, E, wave);
    }
    SEAM(5);
    if (IN(6)) { for (int rep = 0; rep < REP_P6; ++rep) scan_attn_phase(in, ws, args.out, lds + RING_OFF, lds, (LAS unsigned*)(lds + MISC_OFF + 64), wave); }
    SEAM(6);
    if (IN(7)) { for (int rep = 0; rep < REP_P7; ++rep) gn_phase(in, ws, args.out, gw, NGW, LANE); }
    if (IN(7)) { const int lane = LANE; __syncthreads(); for (int rep = 0; rep < REP_C; ++rep) convert_set_b(in, ws, scr, gw, NGW, lane); }
    SEAM(7);
    if (IN(8)) {
        pg8::Gemm g{(const bf16*)(ws + WS_AO), (const bf16*)(ws + WS_WPAB), 2 * M, 2 * D, DA}; epi::ChainOrder S; S.so.init(M, D, G, (int)blockIdx.x);
        epi::GateMix E{(const bf16*)(ws + WS_GATES), in[I_BGATE], (bf16*)(ws + WS_MIX)};
        pg8::gemm_phase<epi::GateMix, epi::ChainOrder, PG8_ALIGN, PG8_SP2>(lds + RING_OFF, g, S, E, wave);
    }
    SEAM(8);
    if (IN(9)) {
        pg8::Gemm g{(const bf16*)(ws + WS_MIX), (const bf16*)(ws + WS_WO), M, D, D}; pg8::StaticOrder S; S.init(M, D, G, (int)blockIdx.x);
        epi::Resid E{in[I_X], args.out, (bf16*)(ws + WS_H1B), (float*)(ws + SS1_OFF)};
        pg8::gemm_phase<epi::Resid, pg8::StaticOrder, PG8_ALIGN, PG8_SP2>(lds + RING_OFF, g, S, E, wave);
    }
    SEAM(9);
    if (IN(10)) {
        pg8::Gemm g{(const bf16*)(ws + WS_H1B), (const bf16*)(ws + WS_W13), M, N13, D}; pg8::StaticOrder S; S.init(M, N13, G, (int)blockIdx.x);
        epi::FfnUp E{(const float*)(ws + SS1_OFF), (bf16*)(ws + WS_U)};
        pg8::gemm_phase<epi::FfnUp, pg8::StaticOrder, PG8_ALIGN, PG8_SP2>(lds + RING_OFF, g, S, E, wave);
#if REP_P10 > 1
        pg8::gemm_phase<epi::FfnUp, pg8::StaticOrder, PG8_ALIGN, PG8_SP2>(lds + RING_OFF, g, S, E, wave);
#endif
    }
    SEAM(10);
    if (IN(11)) {
        { pg8::Gemm g{(const bf16*)(ws + WS_U), (const bf16*)(ws + WS_W2), M, D, DFF}; pg8::StaticOrder S; S.init(M, D, G, (int)blockIdx.x);
          epi::Resid E{args.out, args.out, (bf16*)(ws + WS_H2B), (float*)(ws + SS2_OFF)};
          pg8::gemm_phase<epi::Resid, pg8::StaticOrder, PG8_ALIGN, PG8_SP2>(lds + RING_OFF, g, S, E, wave); }
        { int k256 = 256; asm volatile("" : "+s"(k256));
          pg8::Gemm g{(const bf16*)(ws + WS_PB), (const bf16*)(ws + WS_WPLE), M, D, k256}; pg8::StaticOrder S; S.init(M, D, G, (int)blockIdx.x);
          epi::StoreBf E{(bf16*)(ws + WS_PP), D};
          pg8::gemm_phase<epi::StoreBf, pg8::StaticOrder, PG8_ALIGN, PG8_SP2>(lds + RING_OFF, g, S, E, wave); }
    }
    SEAM(11);
    if (IN(12)) {
        pg8::Gemm g{(const bf16*)(ws + WS_H2B), (const bf16*)(ws + WS_WPG), M, D, D}; pg8::StaticOrder S; S.init(M, D, G, (int)blockIdx.x);
        epi::PleGate E{args.out, (const bf16*)(ws + WS_PP), (const float*)(ws + SS2_OFF), (float*)(ws + SS3_OFF)};
        pg8::gemm_phase<epi::PleGate, pg8::StaticOrder, PG8_ALIGN, PG8_SP2>(lds + RING_OFF, g, S, E, wave);
    }
    SEAM(12);
    if (IN(13)) final_phase(in, ws, args.out, gw, NGW, LANE);
#undef IN
#undef SEAM
#undef LANE
}

extern "C" void kernel_launch(void* const* d_in, const int* in_sizes, int n_in, void* d_out, int out_size, void* d_ws, size_t ws_size, hipStream_t stream) {
    static int grid = 0;
    if (grid == 0) {
        if (n_in != 32 || in_sizes[0] != M * D || out_size != M * D || ws_size < WS_END) { fprintf(stderr, "kernel_launch: unexpected shapes: n_in %d in0 %d out %d ws %zu (need %zu)\n", n_in, n_in > 0 ? in_sizes[0] : -1, out_size, ws_size, (size_t)WS_END); grid = -1; return; }
        int dev = 0, cus = 0, per_cu = 0;
        if (hipGetDevice(&dev) != hipSuccess || hipDeviceGetAttribute(&cus, hipDeviceAttributeMultiprocessorCount, dev) != hipSuccess) { grid = -1; return; }
        if (hipFuncSetAttribute((const void*)hybrid_fwd, hipFuncAttributeMaxDynamicSharedMemorySize, LDS_BYTES) != hipSuccess) { fprintf(stderr, "kernel_launch: hipFuncSetAttribute failed\n"); grid = -1; return; }
        if (hipOccupancyMaxActiveBlocksPerMultiprocessor(&per_cu, (const void*)hybrid_fwd, NWAVES * 64, LDS_BYTES) != hipSuccess || per_cu < 1) fprintf(stderr, "kernel_launch: occupancy query says %d\n", per_cu);
        (void)hipGetLastError();
        grid = cus;
    }
    if (grid < 0) return;
    if (hipMemsetAsync((char*)d_ws + WS_CTL, 0, CTL_ZERO_BYTES, stream) != hipSuccess) return;
    Args a{};
    for (int i = 0; i < 32; ++i) a.in[i] = (const float*)d_in[i];
    a.out = (float*)d_out; a.ws = (unsigned char*)d_ws;
#if MK_N_LAUNCHES == 1
    a.ph_lo = 0; a.ph_hi = N_PHASES + 1;
    hipLaunchKernelGGL(hybrid_fwd, dim3(grid), dim3(NWAVES * 64), LDS_BYTES, stream, a);
#else
    for (int p = 0; p <= N_PHASES; ++p) { a.ph_lo = p; a.ph_hi = p + 1; hipLaunchKernelGGL(hybrid_fwd, dim3(grid), dim3(NWAVES * 64), LDS_BYTES, stream, a); }
#endif
}
```

```cpp
#include <hip/hip_runtime.h>
#include <cstdio>
#include <cstdint>
__device__ __forceinline__ int lane_opaque() { int l; asm volatile("v_mbcnt_lo_u32_b32 %0, -1, 0\n\tv_mbcnt_hi_u32_b32 %0, -1, %0" : "=v"(l)); return l; }

namespace pg8 {
#define PG8_LAS __attribute__((address_space(3)))
typedef unsigned short bf16_t;
typedef short bf16x8 __attribute__((ext_vector_type(8)));
typedef float f32x4 __attribute__((ext_vector_type(4)));
typedef unsigned u32x4 __attribute__((ext_vector_type(4)));
constexpr int BM = 256, BK = 64, HALF = 128, HTB = HALF * BK * 2  , STAGE_BYTES = 8 * HTB, NXCD = 8, WGM = 8;

__host__ __device__ __forceinline__ int lds_byte(int r, int c) { const int st = (r >> 4) * 2 + (c >> 5), rr = r & 15, cc = c & 31, ob = rr * 64 + cc * 2; return st * 1024 + (ob ^ (((ob >> 9) & 1) << 5)); }
__host__ __device__ __forceinline__ void stage_rc(int b, int& R, int& C) { const int st = b / 1024, sb = b % 1024, swz = sb ^ (((sb >> 9) & 1) << 5); R = (st >> 1) * 16 + swz / 64; C = (st & 1) * 32 + (swz % 64) / 2; }
__host__ __device__ __forceinline__ int perm32(int rho) { const int n = rho >> 4, i = rho & 15; return 8 * (i >> 2) + 4 * n + (i & 3); }

struct Unit { int pm, pn; };
struct Gemm { const bf16_t* A; const bf16_t* Bt; int M, N, K; };

struct StaticOrder {
    int nM, nN, nwg, G, c;
    __host__ __device__ void init(int M, int N, int G_, int c_) { nM = M / BM; nN = N / BM; nwg = nM * nN; G = G_; c = c_; }
    __host__ __device__ bool next(int i, Unit& u) const {
        const long L = (long)i * G + c; if (L >= nwg) return false;
        int wgid = (int)L; { const int q = nwg / NXCD, r = nwg % NXCD, xcd = wgid % NXCD, off = wgid / NXCD; wgid = (xcd < r ? xcd * (q + 1) : r * (q + 1) + (xcd - r) * q) + off; }
        const int nig = WGM * nN, gid = wgid / nig, fm = gid * WGM, gsz = (nM - fm) < WGM ? (nM - fm) : WGM;
        u.pm = fm + ((wgid % nig) % gsz); u.pn = (wgid % nig) / gsz; return true;
    }
    __device__ __forceinline__ void a_ready(const Unit&) const {}
    __device__ __forceinline__ void done(const Unit&) const {}
};
__device__ __forceinline__ unsigned cvt_pk_bf16(float lo, float hi) { unsigned r; asm volatile("v_cvt_pk_bf16_f32 %0, %1, %2" : "=v"(r) : "v"(lo), "v"(hi)); return r; }
template <class Epi, class Sched, bool ALIGN_EPI = false, bool SP2 = false>
__device__ __forceinline__ void gemm_phase(PG8_LAS unsigned char* lds, const Gemm g, const Sched& S, const Epi& E, const int wid) {
    const int lane = lane_opaque(), tid = wid * 64 + lane, wr = wid >> 2, wc = wid & 3, fr = lane & 15, fq = lane >> 4;
    const int K = g.K, nt = K / BK;
    unsigned voffA[2], voffB[2];
#pragma unroll
    for (int i = 0; i < 2; ++i) { int R, C; stage_rc(tid * 16 + i * 8192, R, C); const int Rb = Epi::PERM ? ((R & ~31) + perm32(R & 31)) : R;
        voffA[i] = (unsigned)(R * K + C) * 2u; voffB[i] = (unsigned)(Rb * K + C) * 2u; }
    const size_t kstep = (size_t)(BK * 2);
    const size_t hstep = (size_t)HALF * K * 2;
    const size_t tstep = 2 * hstep;
    const unsigned ldsw = (unsigned)wid * 1024u;
    const int aoff = lds_byte(wr * 64 + fr, fq * 8), boff = lds_byte(wc * 32 + fr, fq * 8);
#define PG8_SA(b, h) (((b) * 2 + (h)) * HTB)
#define PG8_SB(b, h) ((4 + (b) * 2 + (h)) * HTB)
#define PG8_STAGE(bufoff, gbase, voff) do { _Pragma("unroll") for (int _i = 0; _i < 2; ++_i) \
        __builtin_amdgcn_global_load_lds((const unsigned*)((const char*)(gbase) + (voff)[_i]), (PG8_LAS unsigned*)(lds + (bufoff) + ldsw + _i * 8192), 16, 0, 0); } while (0)
#define PG8_LDA(dst, b, h) do { _Pragma("unroll") for (int m = 0; m < 4; ++m) _Pragma("unroll") for (int k = 0; k < 2; ++k) dst[m][k] = *(const PG8_LAS bf16x8*)(lds + PG8_SA(b, h) + aoff + m * 2048 + k * 1024); } while (0)
#define PG8_LDB(dst, b, h) do { _Pragma("unroll") for (int n = 0; n < 2; ++n) _Pragma("unroll") for (int k = 0; k < 2; ++k) dst[n][k] = *(const PG8_LAS bf16x8*)(lds + PG8_SB(b, h) + boff + n * 2048 + k * 1024); } while (0)
#define PG8_MMA(ai, bj, At, Bt) do { __builtin_amdgcn_s_setprio(1); _Pragma("unroll") for (int m = 0; m < 4; ++m) _Pragma("unroll") for (int n = 0; n < 2; ++n) _Pragma("unroll") for (int k = 0; k < 2; ++k) \
        acc[ai][bj][m][n] = __builtin_amdgcn_mfma_f32_16x16x32_bf16(Bt[n][k], At[m][k], acc[ai][bj][m][n], 0, 0, 0); __builtin_amdgcn_s_setprio(0); } while (0)
#define PG8_WAIT_V(n) asm volatile("s_waitcnt vmcnt(" #n ")" ::: "memory")
#define PG8_WAIT_L(n) asm volatile("s_waitcnt lgkmcnt(" #n ")" ::: "memory")
#define PG8_BAR __builtin_amdgcn_s_barrier()
#define PG8_SCHED __builtin_amdgcn_sched_barrier(0)
    Unit cur, nxt; int ui = 0;
    if (!S.next(0, cur)) return;
    f32x4 acc[2][2][4][2];
#pragma unroll
    for (int a = 0; a < 2; ++a)
#pragma unroll
        for (int b = 0; b < 2; ++b)
#pragma unroll
            for (int m = 0; m < 4; ++m)
#pragma unroll
                for (int n = 0; n < 2; ++n) acc[a][b][m][n] = (f32x4){0.f, 0.f, 0.f, 0.f};
    bf16x8 At[4][2], B0[2][2], B1[2][2];
    const char* cA = (const char*)g.A + (size_t)cur.pm * tstep; const char* cB = (const char*)g.Bt + (size_t)cur.pn * tstep;
    S.a_ready(cur);
    if constexpr (SP2) {
        PG8_STAGE(PG8_SB(0, 0), cB, voffB); PG8_STAGE(PG8_SB(0, 1), cB + hstep, voffB); PG8_STAGE(PG8_SA(0, 0), cA, voffA); PG8_STAGE(PG8_SA(0, 1), cA + hstep, voffA);
        if (wr == 1) PG8_BAR;
        PG8_WAIT_V(2); PG8_BAR;
        PG8_STAGE(PG8_SB(1, 0), cB + kstep, voffB); PG8_STAGE(PG8_SA(1, 0), cA + kstep, voffA); PG8_STAGE(PG8_SB(1, 1), cB + hstep + kstep, voffB);
        PG8_WAIT_V(6); PG8_BAR;
    } else {
        PG8_STAGE(PG8_SB(0, 0), cB, voffB); PG8_STAGE(PG8_SA(0, 0), cA, voffA); PG8_STAGE(PG8_SB(0, 1), cB + hstep, voffB); PG8_STAGE(PG8_SA(0, 1), cA + hstep, voffA);
        if (wr == 1) PG8_BAR;
        PG8_WAIT_V(4); PG8_BAR;
        PG8_STAGE(PG8_SB(1, 0), cB + kstep, voffB); PG8_STAGE(PG8_SA(1, 0), cA + kstep, voffA); PG8_STAGE(PG8_SB(1, 1), cB + hstep + kstep, voffB);
        PG8_WAIT_V(6); PG8_BAR;
    }
    for (;;) {
        const bool has_next = S.next(ui + 1, nxt);
        const char* nA = has_next ? (const char*)g.A + (size_t)nxt.pm * tstep : cA; const char* nB = has_next ? (const char*)g.Bt + (size_t)nxt.pn * tstep : cB;
        for (int t = 0; t < nt; t += 2) {
            const bool last = (t == nt - 2);
            const char* a1 = cA + (size_t)(t + 1) * kstep;
            const char* a2 = last ? nA : cA + (size_t)(t + 2) * kstep; const char* b2 = last ? nB : cB + (size_t)(t + 2) * kstep;
            const char* a3 = a2 + kstep; const char* b3 = b2 + kstep;
            if (last && has_next) S.a_ready(nxt);
            if constexpr (SP2) {
            PG8_LDB(B0, 0, 0); PG8_LDB(B1, 0, 1); PG8_SCHED; PG8_LDA(At, 0, 0); PG8_STAGE(PG8_SA(1, 1), a1 + hstep, voffA);
            PG8_WAIT_V(8); PG8_WAIT_L(0); PG8_BAR; PG8_MMA(0, 0, At, B0); PG8_MMA(0, 1, At, B1); PG8_BAR; PG8_SCHED;
            PG8_LDA(At, 0, 1); PG8_STAGE(PG8_SB(0, 0), b2, voffB); PG8_STAGE(PG8_SB(0, 1), b2 + hstep, voffB); PG8_STAGE(PG8_SA(0, 0), a2, voffA);
            PG8_WAIT_V(8); PG8_WAIT_L(0); PG8_BAR; PG8_MMA(1, 0, At, B0); PG8_MMA(1, 1, At, B1); PG8_BAR; PG8_SCHED;
            PG8_LDB(B0, 1, 0); PG8_LDB(B1, 1, 1); PG8_SCHED; PG8_LDA(At, 1, 0); PG8_STAGE(PG8_SA(0, 1), a2 + hstep, voffA);
            PG8_WAIT_V(8); PG8_WAIT_L(0); PG8_BAR; PG8_MMA(0, 0, At, B0); PG8_MMA(0, 1, At, B1); PG8_BAR; PG8_SCHED;
            PG8_LDA(At, 1, 1); PG8_STAGE(PG8_SB(1, 0), b3, voffB); PG8_STAGE(PG8_SB(1, 1), b3 + hstep, voffB); PG8_STAGE(PG8_SA(1, 0), a3, voffA);
            PG8_WAIT_V(8); PG8_WAIT_L(0); PG8_BAR; PG8_MMA(1, 0, At, B0); PG8_MMA(1, 1, At, B1); PG8_BAR; PG8_SCHED;
            } else {
            PG8_LDB(B0, 0, 0); PG8_SCHED; PG8_LDA(At, 0, 0); PG8_STAGE(PG8_SA(1, 1), a1 + hstep, voffA);
            PG8_WAIT_L(8); PG8_BAR; PG8_WAIT_L(0); PG8_MMA(0, 0, At, B0); PG8_BAR; PG8_SCHED;
            PG8_LDB(B1, 0, 1); PG8_STAGE(PG8_SB(0, 0), b2, voffB);
            PG8_BAR; PG8_WAIT_L(0); PG8_MMA(0, 1, At, B1); PG8_BAR;
            PG8_LDA(At, 0, 1); PG8_STAGE(PG8_SA(0, 0), a2, voffA);
            PG8_BAR; PG8_WAIT_L(0); PG8_MMA(1, 0, At, B0); PG8_BAR; PG8_SCHED;
            PG8_STAGE(PG8_SB(0, 1), b2 + hstep, voffB);
            PG8_WAIT_V(6); PG8_BAR; PG8_MMA(1, 1, At, B1); PG8_BAR;
            PG8_LDB(B0, 1, 0); PG8_SCHED; PG8_LDA(At, 1, 0); PG8_STAGE(PG8_SA(0, 1), a2 + hstep, voffA);
            PG8_WAIT_L(8); PG8_BAR; PG8_WAIT_L(0); PG8_MMA(0, 0, At, B0); PG8_BAR; PG8_SCHED;
            PG8_LDB(B1, 1, 1); PG8_STAGE(PG8_SB(1, 0), b3, voffB);
            PG8_BAR; PG8_WAIT_L(0); PG8_MMA(0, 1, At, B1); PG8_BAR;
            PG8_LDA(At, 1, 1); PG8_STAGE(PG8_SA(1, 0), a3, voffA);
            PG8_BAR; PG8_WAIT_L(0); PG8_MMA(1, 0, At, B0); PG8_BAR; PG8_SCHED;
            PG8_STAGE(PG8_SB(1, 1), b3 + hstep, voffB);
            PG8_WAIT_V(6); PG8_BAR; PG8_MMA(1, 1, At, B1); PG8_BAR;
            }
        }
        if constexpr (ALIGN_EPI) { if (wr == 0) PG8_BAR; }
        if constexpr (!Epi::AFTER_DRAIN) { E(acc, cur, wr, wc, fr, fq); S.done(cur); }
        if (!has_next) break;
        if (!Epi::CHAIN || !E.keep(cur)) {
#pragma unroll
        for (int a = 0; a < 2; ++a)
#pragma unroll
            for (int b = 0; b < 2; ++b)
#pragma unroll
                for (int m = 0; m < 4; ++m)
#pragma unroll
                    for (int n = 0; n < 2; ++n) acc[a][b][m][n] = (f32x4){0.f, 0.f, 0.f, 0.f};
        }
        cur = nxt; cA = nA; cB = nB; ++ui;
        if constexpr (ALIGN_EPI) { if (wr == 1) PG8_BAR; }
    }
    PG8_WAIT_V(0);
    if constexpr (!ALIGN_EPI) { if (wr == 0) PG8_BAR; }
    PG8_BAR;
    if constexpr (Epi::AFTER_DRAIN) { E.fused(acc, cur, wr, wc, fr, fq, lds, wid, lane); S.done(cur); }
#undef PG8_SA
#undef PG8_SB
#undef PG8_STAGE
#undef PG8_LDA
#undef PG8_LDB
#undef PG8_MMA
#undef PG8_WAIT_V
#undef PG8_WAIT_L
#undef PG8_BAR
#undef PG8_SCHED
}
}

#define LAS __attribute__((address_space(3)))
#define XB_TMO      128
#define XB_XCNT(j)  (256  + 64 * (j))
#define XB_XSUB(j)  (1280 + 64 * (j))
#define XB_XGEN(j)  (2304 + 64 * (j))
#define XB_TOP      3328
#define XB_TOPGEN   3392
#define XCD_BAR_WORDS 3456
#define XB_SPIN_CAP (1u << 18)

__device__ __forceinline__ unsigned xb_ld(unsigned* p)              { return __hip_atomic_load(p, __ATOMIC_RELAXED, __HIP_MEMORY_SCOPE_AGENT); }
__device__ __forceinline__ unsigned xb_add(unsigned* p, unsigned v) { return __hip_atomic_fetch_add(p, v, __ATOMIC_RELAXED, __HIP_MEMORY_SCOPE_AGENT); }
__device__ __forceinline__ unsigned xb_xcc_id() { return (unsigned)__builtin_amdgcn_s_getreg((3 << 11) | 20) & 0xFu; }
#define XB_SPIN(cond, bar) do { unsigned _sp = 0; while (cond) { __builtin_amdgcn_s_sleep(1); \
    if ((++_sp & 255u) == 0u) { if (xb_ld(&(bar)[XB_TMO])) break; if (_sp > XB_SPIN_CAP) { atomicAdd(&(bar)[XB_TMO], 1u); break; } } } } while (0)

struct XcdBarrier {
    unsigned* bar; unsigned x;
    volatile LAS unsigned* st;
};

__device__ __forceinline__ XcdBarrier xcd_barrier_post(unsigned* bar, volatile LAS unsigned* st, const bool leader  ) {
    XcdBarrier b; b.bar = bar; b.x = xb_xcc_id(); b.st = st;
    if (leader) (void)xb_add(&bar[XB_XCNT(b.x)], 1u);
    return b;
}
__device__ __forceinline__ void xcd_barrier_complete(unsigned* bar, unsigned x, unsigned& nloc, unsigned& nx) {
    const unsigned G = gridDim.x * gridDim.y * gridDim.z;
    unsigned sum, cnt, mine, sp = 0u;
    for (;;) {
        sum = 0u; cnt = 0u; mine = 0u;
#pragma unroll
        for (unsigned j = 0; j < 16; ++j) { const unsigned c = xb_ld(&bar[XB_XCNT(j)]); sum += c; cnt += (c > 0u) ? 1u : 0u; mine = (j == x) ? c : mine; }
        if (sum == G) break;
        __builtin_amdgcn_s_sleep(1);
        if ((++sp & 255u) == 0u) { if (xb_ld(&bar[XB_TMO])) break; if (sp > XB_SPIN_CAP) { atomicAdd(&bar[XB_TMO], 1u); break; } }
    }
    nloc = mine > 0u ? mine : 1u; nx = cnt > 0u ? cnt : 1u;
}

__device__ __forceinline__ void xcd_barrier(const XcdBarrier& b, const bool leader  ) {
    asm volatile("s_waitcnt vmcnt(0)" ::: "memory");
    __syncthreads();
    if (leader) {
        unsigned* bar = b.bar;
        __builtin_amdgcn_s_waitcnt(0);
        unsigned nloc = b.st[0], nx = b.st[1];
        if (nloc == 0u) { xcd_barrier_complete(bar, b.x, nloc, nx); b.st[0] = nloc; b.st[1] = nx; }
        const unsigned old = xb_add(&bar[XB_XSUB(b.x)], 1u);
        const unsigned gen = old / nloc;
        if (old + 1u == (gen + 1u) * nloc) {
            __builtin_amdgcn_fence(__ATOMIC_RELEASE, "agent");
            asm volatile("s_waitcnt vmcnt(0)" ::: "memory");
            const unsigned og = xb_add(&bar[XB_TOP], 1u);
            const unsigned tg = og / nx;
            if (og + 1u == (tg + 1u) * nx) xb_add(&bar[XB_TOPGEN], 1u);
            else XB_SPIN(xb_ld(&bar[XB_TOPGEN]) == tg, bar);
            __builtin_amdgcn_fence(__ATOMIC_ACQUIRE, "agent");
            xb_add(&bar[XB_XGEN(b.x)], 1u);
            asm volatile("s_waitcnt vmcnt(0)" ::: "memory");
        } else {
            XB_SPIN(xb_ld(&bar[XB_XGEN(b.x)]) == gen, bar);
            __builtin_amdgcn_fence(__ATOMIC_ACQUIRE, "agent");
            asm volatile("s_waitcnt vmcnt(0)" ::: "memory");
        }
    }
    __syncthreads();
}

constexpr int BATCH = 2, SEQ = 8192, M = BATCH * SEQ, D = 4096;
constexpr int DA = 2048, KVD = 512, DIQ = 2048, HDI = 128, NHI = 16, DB = 2048, NHB = 32, HDB = 64;
constexpr int DIN = 11408, DFF = 11008, DPLE = 256, TOPK = 256;
constexpr int NCAT = 81 * 256;
constexpr int N13 = 2 * DFF;
constexpr int LORA_LD = 1024;
constexpr float RMS_EPS = 1e-6f, GN_EPS = 64e-5f;

#define GAS __attribute__((address_space(1)))
typedef unsigned short bf16;
typedef unsigned v4u __attribute__((ext_vector_type(4)));
typedef unsigned v2u __attribute__((ext_vector_type(2)));
typedef float f32x4 __attribute__((ext_vector_type(4)));
typedef float f32x16 __attribute__((ext_vector_type(16)));
typedef float f32x2 __attribute__((ext_vector_type(2)));
typedef short bf16x8 __attribute__((ext_vector_type(8)));
typedef GAS unsigned gu32;
#define RLX_AGENT __ATOMIC_RELAXED, __HIP_MEMORY_SCOPE_AGENT
#define LDS_WAIT() asm volatile("s_waitcnt lgkmcnt(0)" ::: "memory")
#define VM_WAIT() asm volatile("s_waitcnt vmcnt(0)" ::: "memory")
#define DI __device__ __forceinline__

DI unsigned f2bf(float f) { unsigned u = __builtin_bit_cast(unsigned, f); return (u + 0x7fffu + ((u >> 16) & 1u)) >> 16; }
DI unsigned pk2(float lo, float hi) { return f2bf(lo) | (f2bf(hi) << 16); }
DI float bf_lo(unsigned w) { return __builtin_bit_cast(float, w << 16); }
DI float bf_hi(unsigned w) { return __builtin_bit_cast(float, w & 0xffff0000u); }
DI float bf2f(bf16 h) { return __builtin_bit_cast(float, ((unsigned)h) << 16); }
DI float sigmoidf_(float z) { return 1.0f / (1.0f + __expf(-z)); }
DI float wave_sum(float v) {
#pragma unroll
    for (int o = 1; o < 64; o <<= 1) v += __shfl_xor(v, o);
    return v;
}

namespace epi {
using pg8::Unit; using pg8::BM; using pg8::HALF; using pg8::cvt_pk_bf16;
typedef pg8::f32x4 f4;
DI v4u pack8(const f4& a, const f4& b) { v4u w; w.x = cvt_pk_bf16(a[0], a[1]); w.y = cvt_pk_bf16(a[2], a[3]); w.z = cvt_pk_bf16(b[0], b[1]); w.w = cvt_pk_bf16(b[2], b[3]); return w; }
DI void unpack8(const v4u& w, f4& a, f4& b) { a[0] = bf_lo(w.x); a[1] = bf_hi(w.x); a[2] = bf_lo(w.y); a[3] = bf_hi(w.y); b[0] = bf_lo(w.z); b[1] = bf_hi(w.z); b[2] = bf_lo(w.w); b[3] = bf_hi(w.w); }

struct InProj {
    static constexpr bool PERM = true, AFTER_DRAIN = false, CHAIN = false;
    bf16 *q, *k, *v, *qi, *ki, *rb, *kb, *vb, *lora, *gates; float* wi;
    const float *rstd, *rcos, *rsin;
    DI bool keep(const Unit&) const { return false; }
    DI void operator()(f4 (&acc)[2][2][4][2], const Unit& u, int wr, int wc, int fr, int fq) const {
        { const int ln_ = lane_opaque(); fr = ln_ & 15; fq = ln_ >> 4; }
        const int pn = u.pn, row0 = u.pm * BM + wr * 64 + fr;
        int kind = 0, ld, cb; bf16* dst;
        float rsv[2][4];
#pragma unroll
        for (int ai = 0; ai < 2; ++ai)
#pragma unroll
            for (int m = 0; m < 4; ++m) rsv[ai][m] = rstd[row0 + ai * HALF + m * 16];
        if (pn < 8)       { kind = 1; dst = q;  ld = DA;  cb = pn * 256; }
        else if (pn < 10) { kind = 1; dst = k;  ld = KVD; cb = (pn - 8) * 256; }
        else if (pn < 12) { dst = v;  ld = KVD; cb = (pn - 10) * 256; }
        else if (pn < 20) { kind = 1; dst = qi; ld = DIQ; cb = (pn - 12) * 256; }
        else if (pn == 20){ kind = 2; dst = ki; ld = HDI; cb = 0; }
        else if (pn < 29) { dst = rb; ld = DB; cb = (pn - 21) * 256; }
        else if (pn < 37) { dst = kb; ld = DB; cb = (pn - 29) * 256; }
        else if (pn < 45) { dst = vb; ld = DB; cb = (pn - 37) * 256; }
        else if (pn < 49) { dst = lora; ld = LORA_LD; cb = (pn - 45) * 256; }
        else              { dst = gates; ld = 2 * D; cb = (pn - 49) * 256; }
        if (kind == 0) {
#pragma unroll
            for (int ai = 0; ai < 2; ++ai)
#pragma unroll
                for (int m = 0; m < 4; ++m) { const int row = row0 + ai * HALF + m * 16; const float rs = rsv[ai][m];
#pragma unroll
                    for (int bj = 0; bj < 2; ++bj) *(v4u*)(dst + (size_t)row * ld + cb + bj * HALF + wc * 32 + 8 * fq) = pack8(acc[ai][bj][m][0] * rs, acc[ai][bj][m][1] * rs); }
        } else if (kind == 1 || wc < 2) {
            const int hb = cb + (wc >> 1) * 128, dd0 = (wc & 1) * 32 + 8 * fq;
#pragma unroll
            for (int ai = 0; ai < 2; ++ai)
#pragma unroll
              for (int mp = 0; mp < 2; ++mp) {
                f4 cv[2][2], sv[2][2];
#pragma unroll
                for (int mm = 0; mm < 2; ++mm) { const size_t to = (size_t)(row0 + ai * HALF + (2 * mp + mm) * 16) * 64 + dd0; cv[mm][0] = *(const f4*)(rcos + to); cv[mm][1] = *(const f4*)(rcos + to + 4); sv[mm][0] = *(const f4*)(rsin + to); sv[mm][1] = *(const f4*)(rsin + to + 4); }
                asm volatile("" ::: "memory");
#pragma unroll
                for (int mm = 0; mm < 2; ++mm) { const int m = 2 * mp + mm, row = row0 + ai * HALF + m * 16; const float rs = rsv[ai][m];
                    const f4 c0 = cv[mm][0], c1 = cv[mm][1], s0 = sv[mm][0], s1 = sv[mm][1];
                    const f4 a0 = acc[ai][0][m][0] * rs, a1 = acc[ai][0][m][1] * rs, b0 = acc[ai][1][m][0] * rs, b1 = acc[ai][1][m][1] * rs;
                    bf16* p = dst + (size_t)row * ld + hb + dd0;
                    *(v4u*)(p)      = pack8(a0 * c0 - b0 * s0, a1 * c1 - b1 * s1);
                    *(v4u*)(p + 64) = pack8(a0 * s0 + b0 * c0, a1 * s1 + b1 * c1); }
                asm volatile("" ::: "memory"); }
        } else if (wc == 2 && fq < 2) {
#pragma unroll
            for (int ai = 0; ai < 2; ++ai)
#pragma unroll
                for (int m = 0; m < 4; ++m) { const int row = row0 + ai * HALF + m * 16; const float rs = rsv[ai][m] * 0.25f;
                    *(f4*)(wi + (size_t)row * 16 + 8 * fq) = acc[ai][0][m][0] * rs; *(f4*)(wi + (size_t)row * 16 + 8 * fq + 4) = acc[ai][0][m][1] * rs; }
        }
    }
};

struct LoraUp {
    static constexpr bool PERM = true, AFTER_DRAIN = false, CHAIN = false;
    float* decay; bf16 *aout, *gout; const float *w0, *a0;
    DI bool keep(const Unit&) const { return false; }
    DI void operator()(f4 (&acc)[2][2][4][2], const Unit& u, int wr, int wc, int fr, int fq) const {
        { const int ln_ = lane_opaque(); fr = ln_ & 15; fq = ln_ >> 4; }
        const int which = u.pm >> 6, row0 = (u.pm & 63) * BM + wr * 64 + fr, col0 = (u.pn & 7) * BM + wc * 32 + 8 * fq;
        if (which == 0) {
#pragma unroll
            for (int bj = 0; bj < 2; ++bj) { const int col = col0 + bj * HALF; const f4 z0 = *(const f4*)(w0 + col), z1 = *(const f4*)(w0 + col + 4);
#pragma unroll
                for (int ai = 0; ai < 2; ++ai)
#pragma unroll
                    for (int m = 0; m < 4; ++m) { const size_t off = (size_t)(row0 + ai * HALF + m * 16) * DB + col;
                        f4 x0 = acc[ai][bj][m][0] + z0, x1 = acc[ai][bj][m][1] + z1;
#pragma unroll
                        for (int e = 0; e < 4; ++e) { x0[e] = __expf(-0.6065306597126334f * sigmoidf_(x0[e])); x1[e] = __expf(-0.6065306597126334f * sigmoidf_(x1[e])); }
                        *(f4*)(decay + off) = x0; *(f4*)(decay + off + 4) = x1;
                        asm volatile("" ::: "memory"); } }
        } else if (which == 1) {
#pragma unroll
            for (int bj = 0; bj < 2; ++bj) { const int col = col0 + bj * HALF; const f4 z0 = *(const f4*)(a0 + col), z1 = *(const f4*)(a0 + col + 4);
#pragma unroll
                for (int ai = 0; ai < 2; ++ai)
#pragma unroll
                    for (int m = 0; m < 4; ++m) { const size_t off = (size_t)(row0 + ai * HALF + m * 16) * DB + col;
                        f4 x0 = acc[ai][bj][m][0] + z0, x1 = acc[ai][bj][m][1] + z1;
#pragma unroll
                        for (int e = 0; e < 4; ++e) { x0[e] = sigmoidf_(x0[e]); x1[e] = sigmoidf_(x1[e]); }
                        *(v4u*)(aout + off) = pack8(x0, x1);
                        asm volatile("" ::: "memory"); } }
        } else {
#pragma unroll
            for (int bj = 0; bj < 2; ++bj)
#pragma unroll
                for (int ai = 0; ai < 2; ++ai)
#pragma unroll
                    for (int m = 0; m < 4; ++m) *(v4u*)(gout + (size_t)(row0 + ai * HALF + m * 16) * DB + col0 + bj * HALF) = pack8(acc[ai][bj][m][0], acc[ai][bj][m][1]);
        }
    }
};

struct GateMix {
    static constexpr bool PERM = true, AFTER_DRAIN = false, CHAIN = true;
    const bf16* gates; const float* bgate; bf16* mout;
    DI bool keep(const Unit& u) const { return u.pm < 64; }
    DI void operator()(f4 (&acc)[2][2][4][2], const Unit& u, int wr, int wc, int fr, int fq) const {
        { const int ln_ = lane_opaque(); fr = ln_ & 15; fq = ln_ >> 4; }
        const int which = u.pm >> 6, row0 = (u.pm & 63) * BM + wr * 64 + fr, col0 = (u.pn & 15) * BM + wc * 32 + 8 * fq;
        f4 ba[2][2], bb[2][2];
#pragma unroll
        for (int bj = 0; bj < 2; ++bj) { const int col = col0 + bj * HALF; ba[bj][0] = *(const f4*)(bgate + col); ba[bj][1] = *(const f4*)(bgate + col + 4); bb[bj][0] = *(const f4*)(bgate + D + col); bb[bj][1] = *(const f4*)(bgate + D + col + 4); }
#pragma unroll
        for (int ai = 0; ai < 2; ++ai)
#pragma unroll
          for (int mp = 0; mp < 2; ++mp) {
            v4u zbv[2][2], zav[2][2];
#pragma unroll
            for (int mm = 0; mm < 2; ++mm)
#pragma unroll
                for (int bj = 0; bj < 2; ++bj) { const size_t go = (size_t)(row0 + ai * HALF + (2 * mp + mm) * 16) * (2 * D) + col0 + bj * HALF;
                    zbv[mm][bj] = *(const v4u*)(gates + go + D); if (which == 0) zav[mm][bj] = *(const v4u*)(gates + go); else zav[mm][bj] = (v4u){0u, 0u, 0u, 0u}; }
            asm volatile("" ::: "memory");
#pragma unroll
            for (int mm = 0; mm < 2; ++mm) { const int m = 2 * mp + mm, row = row0 + ai * HALF + m * 16;
#pragma unroll
                for (int bj = 0; bj < 2; ++bj) { const int col = col0 + bj * HALF;
                    f4 zb0, zb1; unpack8(zbv[mm][bj], zb0, zb1); zb0 += bb[bj][0]; zb1 += bb[bj][1];
                    if (which == 0) {
                        f4 za0, za1; unpack8(zav[mm][bj], za0, za1); za0 += ba[bj][0]; za1 += ba[bj][1];
#pragma unroll
                        for (int t = 0; t < 4; ++t) {
                            acc[ai][bj][m][0][t] *= (1.0f + __expf(-zb0[t])) / (1.0f + __expf(-za0[t]));
                            acc[ai][bj][m][1][t] *= (1.0f + __expf(-zb1[t])) / (1.0f + __expf(-za1[t])); }
                    } else {
                        f4 o0, o1;
#pragma unroll
                        for (int t = 0; t < 4; ++t) { o0[t] = acc[ai][bj][m][0][t] * sigmoidf_(zb0[t]); o1[t] = acc[ai][bj][m][1][t] * sigmoidf_(zb1[t]); }
                        *(v4u*)(mout + (size_t)row * D + col) = pack8(o0, o1);
                    } } }
            asm volatile("" ::: "memory");
          }
    }
};

struct Resid {
    static constexpr bool PERM = true, AFTER_DRAIN = false, CHAIN = false;
    const float* base; float* out; bf16* outb; float* ss;
    DI bool keep(const Unit&) const { return false; }
    DI void operator()(f4 (&acc)[2][2][4][2], const Unit& u, int wr, int wc, int fr, int fq) const {
        { const int ln_ = lane_opaque(); fr = ln_ & 15; fq = ln_ >> 4; }
        const int row0 = u.pm * BM + wr * 64 + fr, col0 = u.pn * BM + wc * 32 + 8 * fq;
#pragma unroll
        for (int ai = 0; ai < 2; ++ai) {
            f4 b0[4][2], b1[4][2];
#pragma unroll
            for (int m = 0; m < 4; ++m)
#pragma unroll
                for (int bj = 0; bj < 2; ++bj) { const size_t off = (size_t)(row0 + ai * HALF + m * 16) * D + col0 + bj * HALF; b0[m][bj] = *(const f4*)(base + off); b1[m][bj] = *(const f4*)(base + off + 4); }
            asm volatile("" ::: "memory");
#pragma unroll
            for (int m = 0; m < 4; ++m) { const int row = row0 + ai * HALF + m * 16; float s = 0.f;
#pragma unroll
                for (int bj = 0; bj < 2; ++bj) { const size_t off = (size_t)row * D + col0 + bj * HALF;
                    const f4 h0 = b0[m][bj] + acc[ai][bj][m][0], h1 = b1[m][bj] + acc[ai][bj][m][1];
                    *(f4*)(out + off) = h0; *(f4*)(out + off + 4) = h1; *(v4u*)(outb + off) = pack8(h0, h1);
                    s += (h0[0] * h0[0] + h0[1] * h0[1]) + (h0[2] * h0[2] + h0[3] * h0[3]) + (h1[0] * h1[0] + h1[1] * h1[1]) + (h1[2] * h1[2] + h1[3] * h1[3]); }
                s += __shfl_xor(s, 16); s += __shfl_xor(s, 32);
                if (fq == 0) atomicAdd(ss + row, s); }
            asm volatile("" ::: "memory");
        }
    }
};

struct FfnUp {
    static constexpr bool PERM = true, AFTER_DRAIN = false, CHAIN = false;
    const float* ss; bf16* uout;
    DI bool keep(const Unit&) const { return false; }
    DI void operator()(f4 (&acc)[2][2][4][2], const Unit& u, int wr, int wc, int fr, int fq) const {
        { const int ln_ = lane_opaque(); fr = ln_ & 15; fq = ln_ >> 4; }
        const int row0 = u.pm * BM + wr * 64 + fr, col0 = u.pn * HALF + wc * 32 + 8 * fq;
        float rr[2][4];
#pragma unroll
        for (int ai = 0; ai < 2; ++ai)
#pragma unroll
            for (int m = 0; m < 4; ++m) rr[ai][m] = ss[row0 + ai * HALF + m * 16];
#pragma unroll
        for (int ai = 0; ai < 2; ++ai)
#pragma unroll
            for (int m = 0; m < 4; ++m) { const int row = row0 + ai * HALF + m * 16; const float r = __builtin_amdgcn_rsqf(rr[ai][m] * (1.0f / D) + RMS_EPS);
                f4 o0, o1;
#pragma unroll
                for (int e = 0; e < 4; ++e) { const float a0 = acc[ai][0][m][0][e] * r, a1 = acc[ai][0][m][1][e] * r;
                    o0[e] = a0 * sigmoidf_(a0) * (acc[ai][1][m][0][e] * r); o1[e] = a1 * sigmoidf_(a1) * (acc[ai][1][m][1][e] * r); }
                *(v4u*)(uout + (size_t)row * DFF + col0) = pack8(o0, o1); }
    }
};

struct StoreBf {
    static constexpr bool PERM = true, AFTER_DRAIN = false, CHAIN = false;
    bf16* o; int ld;
    DI bool keep(const Unit&) const { return false; }
    DI void operator()(f4 (&acc)[2][2][4][2], const Unit& u, int wr, int wc, int fr, int fq) const {
        { const int ln_ = lane_opaque(); fr = ln_ & 15; fq = ln_ >> 4; }
        const int row0 = u.pm * BM + wr * 64 + fr, col0 = u.pn * BM + wc * 32 + 8 * fq;
#pragma unroll
        for (int ai = 0; ai < 2; ++ai)
#pragma unroll
            for (int m = 0; m < 4; ++m)
#pragma unroll
                for (int bj = 0; bj < 2; ++bj) *(v4u*)(o + (size_t)(row0 + ai * HALF + m * 16) * ld + col0 + bj * HALF) = pack8(acc[ai][bj][m][0], acc[ai][bj][m][1]);
    }
};

struct PleGate {
    static constexpr bool PERM = true, AFTER_DRAIN = false, CHAIN = false;
    float* h; const bf16* pp; const float* ss_in; float* ss_out;
    DI bool keep(const Unit&) const { return false; }
    DI void operator()(f4 (&acc)[2][2][4][2], const Unit& u, int wr, int wc, int fr, int fq) const {
        { const int ln_ = lane_opaque(); fr = ln_ & 15; fq = ln_ >> 4; }
        const int row0 = u.pm * BM + wr * 64 + fr, col0 = u.pn * BM + wc * 32 + 8 * fq;
        float rr[2][4];
#pragma unroll
        for (int ai = 0; ai < 2; ++ai)
#pragma unroll
            for (int m = 0; m < 4; ++m) rr[ai][m] = ss_in[row0 + ai * HALF + m * 16];
#pragma unroll
        for (int ai = 0; ai < 2; ++ai)
#pragma unroll
            for (int mp = 0; mp < 2; ++mp) {
                v4u pv[2][2]; f4 h0v[2][2], h1v[2][2];
#pragma unroll
                for (int mm = 0; mm < 2; ++mm)
#pragma unroll
                    for (int bj = 0; bj < 2; ++bj) { const size_t off = (size_t)(row0 + ai * HALF + (2 * mp + mm) * 16) * D + col0 + bj * HALF;
                        pv[mm][bj] = *(const v4u*)(pp + off); h0v[mm][bj] = *(const f4*)(h + off); h1v[mm][bj] = *(const f4*)(h + off + 4); }
                asm volatile("" ::: "memory");
#pragma unroll
                for (int mm = 0; mm < 2; ++mm) { const int m = 2 * mp + mm, row = row0 + ai * HALF + m * 16; const float r = __builtin_amdgcn_rsqf(rr[ai][m] * (1.0f / D) + RMS_EPS); float s = 0.f;
#pragma unroll
                    for (int bj = 0; bj < 2; ++bj) { const size_t off = (size_t)row * D + col0 + bj * HALF;
                        f4 p0, p1; unpack8(pv[mm][bj], p0, p1);
                        f4 h0 = h0v[mm][bj], h1 = h1v[mm][bj];
#pragma unroll
                        for (int t = 0; t < 4; ++t) { h0[t] += sigmoidf_(acc[ai][bj][m][0][t] * r) * p0[t]; h1[t] += sigmoidf_(acc[ai][bj][m][1][t] * r) * p1[t]; }
                        *(f4*)(h + off) = h0; *(f4*)(h + off + 4) = h1;
                        s += (h0[0] * h0[0] + h0[1] * h0[1]) + (h0[2] * h0[2] + h0[3] * h0[3]) + (h1[0] * h1[0] + h1[1] * h1[1]) + (h1[2] * h1[2] + h1[3] * h1[3]); }
                    s += __shfl_xor(s, 16); s += __shfl_xor(s, 32);
                    if (fq == 0) atomicAdd(ss_out + row, s); }
                asm volatile("" ::: "memory");
            }
    }
};

struct Stack3Order {
    int G, c;
    DI bool next(int i, Unit& u) const { const int L = i * G + c; if (L >= 1536) return false; const int which = L >> 9, r = L & 511; u.pm = which * 64 + (r & 63); u.pn = which * 8 + (r >> 6); return true; }
    DI void a_ready(const Unit&) const {}
    DI void done(const Unit&) const {}
};
struct ChainOrder {
    pg8::StaticOrder so;
    DI bool next(int i, Unit& u) const { Unit t; if (!so.next(i >> 1, t)) return false; const int which = i & 1; u.pm = which * 64 + t.pm; u.pn = which * 16 + t.pn; return true; }
    DI void a_ready(const Unit&) const {}
    DI void done(const Unit&) const {}
};
}

constexpr size_t MiB = 1u << 20;
constexpr size_t WS_CTL = 0, CTL_ZERO_BYTES = 1 * MiB;
constexpr int CW_TMO = 0, CW_BAR = 4096;
constexpr size_t SS1_OFF = 256 * 1024, SS2_OFF = 320 * 1024, SS3_OFF = 384 * 1024;
constexpr size_t WS_RSTDX = 1 * MiB;
constexpr size_t WS_BONUS = 2 * MiB;
constexpr size_t WS_RCOS = 4 * MiB, WS_RSIN = 8 * MiB;
constexpr size_t WS_WI = 12 * MiB;
constexpr size_t WS_PB = 13 * MiB;
constexpr size_t WS_WPAB = 24 * MiB;
constexpr size_t WS_WO = 56 * MiB, WS_WPG = 88 * MiB;
constexpr size_t WS_WPLE = 120 * MiB;
constexpr size_t WS_WL2 = 122 * MiB;
constexpr size_t WS_R1 = 126 * MiB;
constexpr size_t WS_WCAT = 126 * MiB;
constexpr size_t WS_XB = 288 * MiB;
constexpr size_t WS_SCORE = 126 * MiB;
constexpr size_t WS_IDX = 1252 * MiB;
constexpr size_t WS_DECAY = 126 * MiB;
constexpr size_t WS_AOUT = 254 * MiB;
constexpr size_t WS_ALORA = 318 * MiB;
constexpr size_t WS_W13 = 126 * MiB;
constexpr size_t WS_W2 = 318 * MiB;
constexpr size_t WS_Q = 416 * MiB, WS_K = 480 * MiB, WS_V = 496 * MiB, WS_QI = 512 * MiB, WS_KI = 576 * MiB;
constexpr size_t WS_RB = 580 * MiB, WS_KB = 644 * MiB, WS_VB = 708 * MiB, WS_LORA = 772 * MiB, WS_GATES = 804 * MiB;
constexpr size_t WS_Y = 416 * MiB;
constexpr size_t WS_MIX = 416 * MiB;
constexpr size_t WS_H1B = 544 * MiB;
constexpr size_t WS_U = 672 * MiB;
constexpr size_t WS_H2B = 416 * MiB;
constexpr size_t WS_PP = 544 * MiB;
constexpr size_t WS_AO = 1060 * MiB;
constexpr size_t WS_GOUT = 1188 * MiB;
constexpr size_t WS_END = 1268 * MiB;

constexpr int RING_OFF = 0, RING_BYTES = 131072;
constexpr int LDSCTL_OFF = RING_BYTES, MISC_OFF = LDSCTL_OFF + 320;
constexpr int LDS_BYTES = 147456;
constexpr int NWAVES = 8;

struct Args {
    const float* in[32]; float* out; unsigned char* ws; int ph_lo, ph_hi;
};
enum { I_X = 0, I_P, I_POS, I_NORM_MIX, I_W_IN, I_MU_RKV, I_MU_WAG, I_W0, I_W1, I_W2, I_A0, I_A1, I_A2, I_G1, I_G2, I_KK, I_KA, I_RK, I_LNW, I_LNB,
       I_WPA, I_WPB, I_WGATE, I_BGATE, I_WO, I_NORM_FFN, I_WFFN1, I_WFFN3, I_WFFN2, I_WPLEG, I_WPLE, I_NORM_FINAL };

struct TrSrc { const float* p; int ld, col0, nvalid, kvalid; const float* ksc; const float* mu; int mumode; };
DI void tr_item(const TrSrc& s, bf16* WT, int dK, int n0, int k0, LAS unsigned* T, int lane) {
    const int ng = lane & 15, kq = lane >> 4;
    f32x4 v[8][2]; f32x2 sc[8];
    const bool nok = 4 * ng < s.nvalid;
#pragma unroll
    for (int st = 0; st < 8; ++st) { const int k = k0 + 8 * st + 2 * kq;
#pragma unroll
        for (int j = 0; j < 2; ++j) v[st][j] = (nok && k + j < s.kvalid) ? *(const f32x4*)(s.p + (size_t)(k + j) * s.ld + s.col0 + 4 * ng) : (f32x4){0.f, 0.f, 0.f, 0.f};
        f32x2 c = {1.f, 1.f};
        if (s.ksc) c = *(const f32x2*)(s.ksc + k);
        if (s.mumode == 1) { const f32x2 m = *(const f32x2*)(s.mu + k); c = c * (1.0f - m); } else if (s.mumode == 2) { const f32x2 m = *(const f32x2*)(s.mu + k); c = c * m; }
        sc[st] = c; }
#pragma unroll
    for (int st = 0; st < 8; ++st) { const int kp = 4 * st + kq;
#pragma unroll
        for (int i = 0; i < 4; ++i) T[(4 * ng + i) * 32 + (kp ^ (4 * (ng & 7)))] = pk2(v[st][0][i] * sc[st][0], v[st][1][i] * sc[st][1]); }
    LDS_WAIT(); asm volatile("" ::: "memory");
#pragma unroll
    for (int j = 0; j < 8; ++j) { const int n = (lane >> 3) + 8 * j, c = lane & 7;
        *(GAS v4u*)(WT + (size_t)(n0 + n) * dK + k0 + 8 * c) = *(const LAS v4u*)(T + n * 32 + 4 * (c ^ ((n >> 2) & 7))); }
    LDS_WAIT(); asm volatile("" ::: "memory");
}
DI TrSrc src_wcat(const float* const* in, int n0) {
    TrSrc s; s.p = in[I_W_IN]; s.ld = DIN; s.col0 = 0; s.nvalid = 64; s.kvalid = D; s.ksc = in[I_NORM_MIX]; s.mu = nullptr; s.mumode = 0;
    const int tile = n0 >> 8, p = n0 & 255, bj = p >> 7, hh = (p >> 6) & 1;
    if (tile < 8)        s.col0 = 0    + (2 * tile + hh) * 128 + 64 * bj;
    else if (tile < 10)  s.col0 = 2048 + (2 * (tile - 8) + hh) * 128 + 64 * bj;
    else if (tile < 12)  s.col0 = 2560 + (tile - 10) * 256 + p;
    else if (tile < 20)  s.col0 = 3072 + (2 * (tile - 12) + hh) * 128 + 64 * bj;
    else if (tile == 20) { if (hh == 0) s.col0 = 5120 + 64 * bj; else if (bj == 0) { s.col0 = 5248; s.nvalid = 16; } else s.nvalid = 0; }
    else if (tile < 45)  s.col0 = 5264 + (tile - 21) * 256 + p;
    else if (tile < 49)  { const int c = (tile - 45) * 256 + p;
        const int seg = c < 128 ? 0 : c < 256 ? 1 : c < 512 ? 2 : c < 640 ? 3 : c < 768 ? 4 : 5, sbeg = seg == 0 ? 0 : seg == 1 ? 128 : seg == 2 ? 256 : seg == 3 ? 512 : seg == 4 ? 640 : 768;
        const int kind = seg % 3;
        s.p = in[kind == 0 ? I_W1 : (kind == 1 ? I_A1 : I_G1)]; s.ld = kind == 2 ? 256 : 96; s.col0 = c - sbeg; s.mu = in[I_MU_WAG] + kind * D; s.mumode = seg < 3 ? 1 : 2;
        if (kind != 2) s.nvalid = (s.col0 == 0) ? 64 : 32; }
    else { s.p = in[I_WGATE]; s.ld = 2 * D; s.col0 = (tile - 49) * 256 + p; }
    return s;
}
DI TrSrc src_plain(const float* p, int ld, int col0, int kvalid, const float* ksc) { TrSrc s; s.p = p; s.ld = ld; s.col0 = col0; s.nvalid = 64; s.kvalid = kvalid; s.ksc = ksc; s.mu = nullptr; s.mumode = 0; return s; }

DI void convert_set_a(const float* const* in, unsigned char* ws, LAS unsigned* scr, int gw, int NGW, int lane) {
    constexpr int I0 = (NCAT / 64) * (D / 64);
    constexpr int I6 = (DB / 64) * (256 / 64);
    constexpr int NITEMS = I0 + 3 * I6;
    for (int it = gw; it < NITEMS; it += NGW) {
        int r = it;
        if (r < I0) { const int nblk = NCAT / 64, kb = r / nblk, nb = r % nblk; tr_item(src_wcat(in, 64 * nb), (bf16*)(ws + WS_WCAT), D, 64 * nb, 64 * kb, scr, lane); continue; } r -= I0;
        { const int w = r / I6; r -= w * I6; const int nblk = DB / 64, kb = r / nblk, nb = r % nblk;
          tr_item(src_plain(in[w == 0 ? I_W2 : (w == 1 ? I_A2 : I_G2)], DB, 64 * nb, w == 2 ? 256 : 96, nullptr), (bf16*)(ws + WS_WL2) + (size_t)w * DB * 256, 256, 64 * nb, 64 * kb, scr, lane); }
    }
}
constexpr int A1_I1 = (D / 64) * (DA / 64), A1_I3 = (D / 64) * (D / 64), A1_I5 = (D / 64) * (DPLE / 64), A1_NITEMS = 2 * A1_I1 + 2 * A1_I3 + A1_I5;
DI void convert_a1_item(const float* const* in, unsigned char* ws, LAS unsigned* scr, int it, int lane) {
    int r = it;
    if (r < 2 * A1_I1) { const int w = r / A1_I1; r -= w * A1_I1; const int nblk = D / 64, kb = r / nblk, nb = r % nblk;
        tr_item(src_plain(in[w ? I_WPB : I_WPA], D, 64 * nb, DA, nullptr), (bf16*)(ws + WS_WPAB) + (size_t)w * D * DA, DA, 64 * nb, 64 * kb, scr, lane); return; } r -= 2 * A1_I1;
    if (r < 2 * A1_I3) { const int w = r / A1_I3; r -= w * A1_I3; const int nblk = D / 64, kb = r / nblk, nb = r % nblk;
        tr_item(src_plain(in[w ? I_WPLEG : I_WO], D, 64 * nb, D, nullptr), (bf16*)(ws + (w ? WS_WPG : WS_WO)), D, 64 * nb, 64 * kb, scr, lane); return; } r -= 2 * A1_I3;
    { const int nblk = D / 64, kb = r / nblk, nb = r % nblk; tr_item(src_plain(in[I_WPLE], D, 64 * nb, DPLE, nullptr), (bf16*)(ws + WS_WPLE), DPLE, 64 * nb, 64 * kb, scr, lane); }
}
DI void convert_set_b(const float* const* in, unsigned char* ws, LAS unsigned* scr, int gw, int NGW, int lane) {
    constexpr int I0 = (N13 / 64) * (D / 64);
    for (int it = gw; it < I0; it += NGW) {
        const int nblk = N13 / 64, kb = it / nblk, nb = it % nblk, n0 = 64 * nb, tile = n0 >> 8, p = n0 & 255;
        tr_item(src_plain(in[(p >> 7) ? I_WFFN3 : I_WFFN1], DFF, tile * 128 + (p & 127), D, in[I_NORM_FFN]), (bf16*)(ws + WS_W13), D, n0, 64 * kb, scr, lane);
    }
}
constexpr int W2_NITEMS = (D / 64) * (DFF / 64);
DI void convert_w2_item(const float* const* in, unsigned char* ws, LAS unsigned* scr, int it, int lane) {
    const int nblk = D / 64, kb = it / nblk, nb = it % nblk; tr_item(src_plain(in[I_WFFN2], D, 64 * nb, DFF, nullptr), (bf16*)(ws + WS_W2), DFF, 64 * nb, 64 * kb, scr, lane);
}
DI void prologue_rows(const float* const* in, unsigned char* ws, int gw, int NGW, int lane) {
    const float* x = in[I_X]; bf16* xb = (bf16*)(ws + WS_XB); float* rstd = (float*)(ws + WS_RSTDX);
    for (int m = gw; m < M; m += NGW) {
        const GAS f32x4* xr = (const GAS f32x4*)(x + (size_t)m * D) + lane; GAS v2u* o = (GAS v2u*)(xb + (size_t)m * D) + lane; float s = 0.f;
f32x4 xv[16];
#pragma unroll
        for (int j = 0; j < 16; ++j) xv[j] = xr[64 * j];
#pragma unroll
        for (int j = 0; j < 16; ++j) { const f32x4 v = xv[j]; s += (v.x * v.x + v.y * v.y) + (v.z * v.z + v.w * v.w); v2u w; w.x = pk2(v.x, v.y); w.y = pk2(v.z, v.w); o[64 * j] = w; }
        s = wave_sum(s);
        if (lane == 0) rstd[m] = 1.0f / sqrtf(s * (1.0f / D) + RMS_EPS);
    }
    const int* pos = (const int*)in[I_POS]; float* rc = (float*)(ws + WS_RCOS); float* rsn = (float*)(ws + WS_RSIN);
    for (int e = gw * 64 + lane; e < M * 64; e += NGW * 64) {
        const int m = e >> 6, i = e & 63; double inv = 1.0; for (int j = 0; j < i; ++j) inv *= 0.8659643233600653523;
        const double ang = (double)pos[m] * inv;
        const double qd = __builtin_rint(ang * 0.63661977236758134308); const int qi = (int)((long long)qd & 3);
        double r = __builtin_fma(-qd, 1.5707963267948965580, ang); r = __builtin_fma(-qd, 6.1232339957367658860e-17, r);
        const double r2 = r * r;
        const double sn = r * (1.0 + r2 * (-1.0 / 6 + r2 * (1.0 / 120 + r2 * (-1.0 / 5040 + r2 * (1.0 / 362880 + r2 * (-1.0 / 39916800 + r2 * (1.0 / 6227020800.0)))))));
        const double cs = 1.0 + r2 * (-0.5 + r2 * (1.0 / 24 + r2 * (-1.0 / 720 + r2 * (1.0 / 40320 + r2 * (-1.0 / 3628800 + r2 * (1.0 / 479001600.0 + r2 * (-1.0 / 87178291200.0)))))));
        const double c4 = (qi == 0) ? cs : (qi == 1) ? -sn : (qi == 2) ? -cs : sn;
        const double s4 = (qi == 0) ? sn : (qi == 1) ? cs : (qi == 2) ? -sn : -cs;
        rc[e] = (float)c4; rsn[e] = (float)s4;
    }
    const float* p = in[I_P]; bf16* pb = (bf16*)(ws + WS_PB);
    for (int e = gw * 64 + lane; e < M * DPLE / 4; e += NGW * 64) { const f32x4 v = ((const GAS f32x4*)p)[e]; v2u w; w.x = pk2(v.x, v.y); w.y = pk2(v.z, v.w); ((GAS v2u*)pb)[e] = w; }
}
DI void build_alora(unsigned char* ws, int gtid, int NT) {
    const bf16* L = (const bf16*)(ws + WS_LORA); bf16* A = (bf16*)(ws + WS_ALORA);
    for (int e = gtid; e < 3 * M * 32; e += NT) {
        const int which = e / (M * 32), r = e - which * (M * 32), m = r >> 5, j0 = (r & 31) * 8;
        f32x4 o0 = {0.f, 0.f, 0.f, 0.f}, o1 = o0;
        const int width = which == 2 ? 256 : 96, ca = which == 0 ? 0 : (which == 1 ? 128 : 256), cbb = which == 0 ? 512 : (which == 1 ? 640 : 768);
        if (j0 < width) {
            f32x4 c0, c1, p0 = {0.f, 0.f, 0.f, 0.f}, p1 = p0;
            epi::unpack8(*(const v4u*)(L + (size_t)m * LORA_LD + ca + j0), c0, c1);
            if ((m & (SEQ - 1)) != 0) epi::unpack8(*(const v4u*)(L + (size_t)(m - 1) * LORA_LD + cbb + j0), p0, p1);
            o0 = c0 + p0; o1 = c1 + p1;
            if (which == 0) {
#pragma unroll
                for (int t = 0; t < 4; ++t) { o0[t] = 1.0f - 2.0f / (__expf(2.0f * o0[t]) + 1.0f); o1[t] = 1.0f - 2.0f / (__expf(2.0f * o1[t]) + 1.0f); } }
            if (which == 2) {
#pragma unroll
                for (int t = 0; t < 4; ++t) { o0[t] = sigmoidf_(o0[t]); o1[t] = sigmoidf_(o1[t]); } }
        }
        *(v4u*)(A + ((size_t)which * M + m) * 256 + j0) = epi::pack8(o0, o1);
    }
}

constexpr int IDX_TS = 272;
constexpr int IDX_TILE_BYTES = 64 * IDX_TS;
constexpr int IDX_HIST_OFF = 2 * IDX_TILE_BYTES;

DI unsigned fkey(float f) { unsigned u = __builtin_bit_cast(unsigned, f); if (u == 0x80000000u) u = 0u; return (u & 0x80000000u) ? ~u : (u | 0x80000000u); }

DI void indexer_unit(unsigned char* ws, LAS unsigned char* lds, int b, int blk, float* scratch, int wave) {
    const int lane = lane_opaque(), tid = wave * 64 + lane;
    const bf16* qi = (const bf16*)(ws + WS_QI); const bf16* ki = (const bf16*)(ws + WS_KI); const float* wi = (const float*)(ws + WS_WI);
    const int t0 = blk * 32, mrow0 = b * SEQ + t0;
    const int r = lane & 31, kh = lane >> 5, aq = (r >> 2) & 1, ah = (r & 3) + 4 * (r >> 3);
    bf16x8 af[2][8]; f32x4 wg[2][4];
#pragma unroll
    for (int rt = 0; rt < 2; ++rt) {
        const bf16* src = qi + (size_t)(mrow0 + 4 * wave + 2 * rt + aq) * DIQ + ah * HDI + 8 * kh;
#pragma unroll
        for (int ks = 0; ks < 8; ++ks) af[rt][ks] = *(const bf16x8*)(src + 16 * ks);
        const float* wsrc = wi + (size_t)(mrow0 + 4 * wave + 2 * rt + kh) * NHI;
#pragma unroll
        for (int j = 0; j < 4; ++j) wg[rt][j] = *(const f32x4*)(wsrc + 4 * j) * 0.08838834764831845f;
    }
    const int nk = (t0 + 32 + 63) >> 6;
    const int lkey = tid >> 3, lpart = tid & 7;
    const bf16* kbase = ki + (size_t)(b * SEQ) * HDI;
    v4u st0, st1;
    { const v4u* g = (const v4u*)(kbase + (size_t)lkey * HDI + lpart * 16); st0 = g[0]; st1 = g[1]; }
    __syncthreads();
    { LAS v4u* d = (LAS v4u*)(lds + lkey * IDX_TS + lpart * 32); d[0] = st0; d[1] = st1; }
    __syncthreads();
#pragma unroll
    for (int rt = 0; rt < 2; ++rt) {
#pragma unroll
        for (int ks = 0; ks < 8; ++ks) asm volatile("; pin %0" : "+v"(af[rt][ks]));
#pragma unroll
        for (int j = 0; j < 4; ++j) asm volatile("; pin %0" : "+v"(wg[rt][j])); }
    for (int kt = 0; kt < nk; ++kt) {
        if (kt + 1 < nk) { const v4u* g = (const v4u*)(kbase + (size_t)((kt + 1) * 64 + lkey) * HDI + lpart * 16); st0 = g[0]; st1 = g[1]; }
        const LAS unsigned char* tb = lds + (kt & 1) * IDX_TILE_BYTES;
#pragma unroll
        for (int ct = 0; ct < 2; ++ct) {
            bf16x8 bfr[8];
#pragma unroll
            for (int ks = 0; ks < 8; ++ks) bfr[ks] = *(const LAS bf16x8*)(tb + (32 * ct + r) * IDX_TS + (16 * ks + 8 * kh) * 2);
#pragma unroll
            for (int rt = 0; rt < 2; ++rt) {
                f32x16 c;
#pragma unroll
                for (int j = 0; j < 16; ++j) c[j] = 0.f;
#pragma unroll
                for (int ks = 0; ks < 8; ++ks) c = __builtin_amdgcn_mfma_f32_32x32x16_bf16(af[rt][ks], bfr[ks], c, 0, 0, 0);
                float s = 0.f;
#pragma unroll
                for (int j = 0; j < 16; ++j) s += wg[rt][j >> 2][j & 3] * __builtin_amdgcn_fmed3f(c[j], 0.f, 3.0e38f);
                scratch[(size_t)(4 * wave + 2 * rt + kh) * SEQ + kt * 64 + 32 * ct + r] = s;
            }
        }
        if (kt + 1 < nk) { LAS v4u* d = (LAS v4u*)(lds + ((kt + 1) & 1) * IDX_TILE_BYTES + lkey * IDX_TS + lpart * 32); d[0] = st0; d[1] = st1; }
        asm volatile("s_waitcnt lgkmcnt(0)" ::: "memory"); __builtin_amdgcn_s_barrier(); asm volatile("" ::: "memory");
    }
}

DI void select_unit(unsigned char* ws, LAS unsigned char* lds, int b, int blk, const float* scratch, int wave) {
    int* idx = (int*)(ws + WS_IDX);
    LAS unsigned* hist = (LAS unsigned*)(lds + IDX_HIST_OFF + wave * 8192);
    for (int qq = 0; qq < 4; ++qq) {
        const int lane = lane_opaque(); const unsigned long long lt_mask = (1ull << lane) - 1ull;
        const int ql = wave * 4 + qq, t = blk * 32 + ql, n = t + 1;
        const float* sc = scratch + (size_t)ql * SEQ; int* out = idx + (size_t)(b * SEQ + t) * TOPK;
        if (n <= TOPK) { for (int e = lane; e < TOPK; e += 64) out[e] = (e < n) ? e : 0; continue; }
        const int n4 = (n + 3) >> 2;
        v4u key[32];
#pragma unroll
        for (int j = 0; j < 32; ++j) { key[j] = (v4u){0u, 0u, 0u, 0u};
            if (64 * j < n4) { const int gi = 64 * j + lane; if (gi < n4) { const f32x4 v = *(const f32x4*)(sc + 4 * gi); const int e0 = 4 * gi;
                key[j].x = fkey(v[0]); key[j].y = (e0 + 1 < n) ? fkey(v[1]) : 0u; key[j].z = (e0 + 2 < n) ? fkey(v[2]) : 0u; key[j].w = (e0 + 3 < n) ? fkey(v[3]) : 0u; } } }
        unsigned prefix = 0u, pmask = 0u; int kk = TOPK;
        for (int pass = 0; pass < 4; ++pass) {
            const int shift = 24 - 8 * pass;
#pragma unroll
            for (int z = 0; z < 8; ++z) *(LAS v4u*)(hist + 4 * (lane + 64 * z)) = (v4u){0u, 0u, 0u, 0u};
            LAS unsigned* hc = hist + 256 * (lane & 7);
#pragma unroll
            for (int j = 0; j < 32; ++j) if (64 * j < n4) {
#pragma unroll
                for (int c = 0; c < 4; ++c) { const unsigned u = key[j][c]; if ((u & pmask) == prefix) __hip_atomic_fetch_add(hc + ((u >> shift) & 255u), 1u, __ATOMIC_RELAXED, __HIP_MEMORY_SCOPE_WORKGROUP); } }
            LDS_WAIT(); asm volatile("" ::: "memory");
            v4u hs = {0u, 0u, 0u, 0u};
#pragma unroll
            for (int z = 0; z < 8; ++z) hs += *(const LAS v4u*)(hist + 256 * z + 4 * lane);
            const int c0 = (int)hs.x, c1 = (int)hs.y, c2 = (int)hs.z, c3 = (int)hs.w;
            const int T = c0 + c1 + c2 + c3; int S = T;
#pragma unroll
            for (int o = 1; o < 64; o <<= 1) { const int v = __shfl_down(S, o); if (lane + o < 64) S += v; }
            const int E = S - T;
            const bool found = (E < kk) && (kk <= S);
            int d = 0, knew = 0;
            if (found) { int run = E;
                if (run + c3 >= kk) { d = 4 * lane + 3; knew = kk - run; } else { run += c3;
                if (run + c2 >= kk) { d = 4 * lane + 2; knew = kk - run; } else { run += c2;
                if (run + c1 >= kk) { d = 4 * lane + 1; knew = kk - run; } else { run += c1; d = 4 * lane; knew = kk - run; } } } }
            const unsigned long long fm = __ballot(found); const int src = fm ? (int)__builtin_ctzll(fm) : 0;
            d = __shfl(d, src); knew = __shfl(knew, src);
            prefix |= ((unsigned)d) << shift; pmask |= 0xffu << shift; kk = knew;
            asm volatile("" ::: "memory");
        }
        int pos = 0, eqt = 0;
#pragma unroll
        for (int j = 0; j < 32; ++j) if (64 * j < n4) {
            bool eq[4], gt[4]; unsigned long long em[4]; int eq_before = eqt;
#pragma unroll
            for (int c = 0; c < 4; ++c) { const unsigned u = key[j][c]; eq[c] = (u == prefix); gt[c] = (u > prefix); em[c] = __ballot(eq[c]); eq_before += __builtin_popcountll(em[c] & lt_mask); }
            bool take[4]; unsigned long long tm[4]; int tk_before = pos, run_eq = eq_before;
#pragma unroll
            for (int c = 0; c < 4; ++c) { take[c] = gt[c] || (eq[c] && run_eq < kk); run_eq += eq[c] ? 1 : 0; tm[c] = __ballot(take[c]); tk_before += __builtin_popcountll(tm[c] & lt_mask); }
            int slot = tk_before;
#pragma unroll
            for (int c = 0; c < 4; ++c) { if (take[c]) { if (slot < TOPK) out[slot] = 256 * j + 4 * lane + c; ++slot; } }
#pragma unroll
            for (int c = 0; c < 4; ++c) { pos += __builtin_popcountll(tm[c]); eqt += __builtin_popcountll(em[c]); }
        }
    }
}

DI void indexer_phase(unsigned char* ws, LAS unsigned char* lds, int wave) {
    float* scratch = (float*)(ws + WS_SCORE) + (size_t)blockIdx.x * 32 * SEQ;
    for (int pr = blockIdx.x; pr < 256; pr += gridDim.x) {
        const int b = pr >> 7, j = pr & 127;
        for (int half = 0; half < 2; ++half) { const int blk = half ? 255 - j : j;
            indexer_unit(ws, lds, b, blk, scratch, wave);
            VM_WAIT(); __syncthreads();
#ifndef REP_SEL
#define REP_SEL 1
#endif
            for (int rs_ = 0; rs_ < REP_SEL; ++rs_) select_unit(ws, lds, b, blk, scratch, wave);
            VM_WAIT(); __syncthreads(); }
    }
}

typedef int v4i __attribute__((ext_vector_type(4)));
#define ATT_FENCE() asm volatile("" ::: "memory")
DI void attn_worker(unsigned char* ws, LAS unsigned char* lds, LAS unsigned* qctr, int wave) {
    const int lane = lane_opaque();
    const bf16* q = (const bf16*)(ws + WS_Q); const bf16* kbuf = (const bf16*)(ws + WS_K); const bf16* vbuf = (const bf16*)(ws + WS_V);
    const int* idx = (const int*)(ws + WS_IDX); bf16* ao = (bf16*)(ws + WS_AO);
    LAS int* idl = (LAS int*)(lds); LAS float* pl = (LAS float*)(lds + 1024);
    const int G = gridDim.x, bg = blockIdx.x & 7, b = bg >> 2, g = bg & 3;
    const int nbk = (G - bg + 7) >> 3, rank = blockIdx.x >> 3, nq = (SEQ - rank + nbk - 1) / nbk;
    const int kr = lane & 15, kq = lane >> 4;
    const int kg = lane >> 4, dg = lane & 15;
    const bf16* kbase = kbuf + (size_t)(b * SEQ) * KVD + g * 128 + 8 * kq;
    const bf16* vbase = vbuf + (size_t)(b * SEQ) * KVD + g * 128 + 8 * dg;
    int qn; { unsigned v_ = 0u; if (lane == 0) v_ = __hip_atomic_fetch_add(qctr, 1u, __ATOMIC_RELAXED, __HIP_MEMORY_SCOPE_WORKGROUP); qn = __builtin_amdgcn_readfirstlane((int)v_); }
    int ixg[4]; bf16x8 qf[4];
    if (qn < nq) { const int mq = b * SEQ + rank + nbk * qn;
#pragma unroll
        for (int c = 0; c < 4; ++c) ixg[c] = idx[(size_t)mq * TOPK + lane + 64 * c];
#pragma unroll
        for (int ks = 0; ks < 4; ++ks) { if (kr < 4) qf[ks] = *(const bf16x8*)(q + (size_t)mq * DA + (4 * g + kr) * 128 + 32 * ks + 8 * kq); else qf[ks] = (bf16x8){0, 0, 0, 0, 0, 0, 0, 0}; } }
    while (qn < nq) {
        const int t = rank + nbk * qn, mq = b * SEQ + t, nvalid = (t + 1 < TOPK) ? t + 1 : TOPK;
#pragma unroll
        for (int c = 0; c < 4; ++c) idl[lane + 64 * c] = ixg[c];
        LDS_WAIT(); ATT_FENCE();
        int qn2; { unsigned v_ = 0u; if (lane == 0) v_ = __hip_atomic_fetch_add(qctr, 1u, __ATOMIC_RELAXED, __HIP_MEMORY_SCOPE_WORKGROUP); qn2 = __builtin_amdgcn_readfirstlane((int)v_); }
        if (qn2 < nq) { const int mq2 = b * SEQ + rank + nbk * qn2;
#pragma unroll
            for (int c = 0; c < 4; ++c) ixg[c] = idx[(size_t)mq2 * TOPK + lane + 64 * c]; }
        ATT_FENCE();
        int kidx[16];
#pragma unroll
        for (int kt = 0; kt < 16; ++kt) kidx[kt] = idl[64 * (kr >> 2) + 4 * kt + (kr & 3)];
        f32x4 s[16]; bf16x8 kf[3][2][4];
#pragma unroll
        for (int hg = 0; hg < 2; ++hg) {
#pragma unroll
            for (int j = 0; j < 2; ++j) { const bf16* kp = kbase + (size_t)kidx[2 * hg + j] * KVD;
#pragma unroll
                for (int ks = 0; ks < 4; ++ks) kf[hg][j][ks] = *(const bf16x8*)(kp + 32 * ks); }
            ATT_FENCE(); }
#pragma unroll
        for (int hg = 0; hg < 8; ++hg) {
            if (hg + 2 < 8) {
#pragma unroll
                for (int j = 0; j < 2; ++j) { const bf16* kp = kbase + (size_t)kidx[2 * (hg + 2) + j] * KVD;
#pragma unroll
                    for (int ks = 0; ks < 4; ++ks) kf[(hg + 2) % 3][j][ks] = *(const bf16x8*)(kp + 32 * ks); }
                ATT_FENCE(); }
#pragma unroll
            for (int j = 0; j < 2; ++j) { f32x4 a = {0.f, 0.f, 0.f, 0.f};
#pragma unroll
                for (int ks = 0; ks < 4; ++ks) a = __builtin_amdgcn_mfma_f32_16x16x32_bf16(kf[hg % 3][j][ks], qf[ks], a, 0, 0, 0);
                s[2 * hg + j] = a; }
        }
        if (qn2 < nq && kr < 4) { const int mq2 = b * SEQ + rank + nbk * qn2;
#pragma unroll
            for (int ks = 0; ks < 4; ++ks) qf[ks] = *(const bf16x8*)(q + (size_t)mq2 * DA + (4 * g + kr) * 128 + 32 * ks + 8 * kq); }
        ATT_FENCE();
        v4i ix[3][2]; v4u vv[3][8];
#pragma unroll
        for (int ch = 0; ch < 2; ++ch) {
            ix[ch][0] = *(const LAS v4i*)(idl + 64 * kg + 8 * ch); ix[ch][1] = *(const LAS v4i*)(idl + 64 * kg + 8 * ch + 4);
#pragma unroll
            for (int j = 0; j < 8; ++j) vv[ch][j] = *(const v4u*)(vbase + (size_t)ix[ch][j >> 2][j & 3] * KVD);
            ATT_FENCE(); }
        float mx = -3.0e38f;
#pragma unroll
        for (int kt = 0; kt < 16; ++kt)
#pragma unroll
            for (int e = 0; e < 4; ++e) { const bool ok = (64 * kq + 4 * kt + e) < nvalid; s[kt][e] = ok ? s[kt][e] * 0.08838834764831845f : -3.0e38f; mx = fmaxf(mx, s[kt][e]); }
        mx = fmaxf(mx, __shfl_xor(mx, 16)); mx = fmaxf(mx, __shfl_xor(mx, 32));
        float sum = 0.f;
#pragma unroll
        for (int kt = 0; kt < 16; ++kt)
#pragma unroll
            for (int e = 0; e < 4; ++e) { const bool ok = (64 * kq + 4 * kt + e) < nvalid; const float p = ok ? __expf(s[kt][e] - mx) : 0.f; s[kt][e] = p; sum += p; }
        sum += __shfl_xor(sum, 16); sum += __shfl_xor(sum, 32);
        const float inv = 1.0f / sum;
        if (kr < 4) {
#pragma unroll
            for (int kt = 0; kt < 16; ++kt) *(LAS f32x4*)(pl + kr * 256 + 64 * kq + 4 * kt) = s[kt] * inv; }
        LDS_WAIT(); ATT_FENCE();
        f32x2 acc[4][4];
#pragma unroll
        for (int h = 0; h < 4; ++h)
#pragma unroll
            for (int d = 0; d < 4; ++d) acc[h][d] = (f32x2){0.f, 0.f};
#pragma unroll
        for (int ch = 0; ch < 8; ++ch) {
            if (ch + 2 < 8) { const int c2 = (ch + 2) % 3;
                ix[c2][0] = *(const LAS v4i*)(idl + 64 * kg + 8 * (ch + 2)); ix[c2][1] = *(const LAS v4i*)(idl + 64 * kg + 8 * (ch + 2) + 4);
#pragma unroll
                for (int j = 0; j < 8; ++j) vv[c2][j] = *(const v4u*)(vbase + (size_t)ix[c2][j >> 2][j & 3] * KVD);
                ATT_FENCE(); }
            f32x4 pp[4][2];
#pragma unroll
            for (int h = 0; h < 4; ++h) { pp[h][0] = *(const LAS f32x4*)(pl + h * 256 + 64 * kg + 8 * ch); pp[h][1] = *(const LAS f32x4*)(pl + h * 256 + 64 * kg + 8 * ch + 4); }
#pragma unroll
            for (int j = 0; j < 8; ++j) { const v4u w = vv[ch % 3][j];
                const f32x2 v0 = {bf_lo(w.x), bf_hi(w.x)}, v1 = {bf_lo(w.y), bf_hi(w.y)}, v2 = {bf_lo(w.z), bf_hi(w.z)}, v3 = {bf_lo(w.w), bf_hi(w.w)};
#pragma unroll
                for (int h = 0; h < 4; ++h) { const float p = pp[h][j >> 2][j & 3]; const f32x2 p2 = {p, p};
                    acc[h][0] += p2 * v0; acc[h][1] += p2 * v1; acc[h][2] += p2 * v2; acc[h][3] += p2 * v3; }
            }
        }
#pragma unroll
        for (int h = 0; h < 4; ++h)
#pragma unroll
            for (int d = 0; d < 4; ++d) {
                acc[h][d][0] += __shfl_xor(acc[h][d][0], 16); acc[h][d][1] += __shfl_xor(acc[h][d][1], 16);
                acc[h][d][0] += __shfl_xor(acc[h][d][0], 32); acc[h][d][1] += __shfl_xor(acc[h][d][1], 32); }
        if (kg == 0) {
#pragma unroll
            for (int h = 0; h < 4; ++h) { v4u w; w.x = pk2(acc[h][0][0], acc[h][0][1]); w.y = pk2(acc[h][1][0], acc[h][1][1]); w.z = pk2(acc[h][2][0], acc[h][2][1]); w.w = pk2(acc[h][3][0], acc[h][3][1]);
                *(v4u*)(ao + (size_t)mq * DA + (4 * g + h) * 128 + 8 * dg) = w; } }
        LDS_WAIT(); ATT_FENCE();
        qn = qn2;
    }
}

constexpr int SC_STEPS = 32, SC_STEP_BYTES = 1344, SC_BUF_BYTES = SC_STEPS * SC_STEP_BYTES;
constexpr int SC_Y_OFF = 2 * SC_BUF_BYTES;

template <int CTRL> DI float dpp_add(float x) { return x + __builtin_bit_cast(float, __builtin_amdgcn_update_dpp(0, __builtin_bit_cast(int, x), CTRL, 0xf, 0xf, false)); }
DI float red16(float x) { x = dpp_add<0xB1>(x); x = dpp_add<0x4E>(x); x = dpp_add<0x141>(x); x = dpp_add<0x140>(x); return x; }

struct ScanRaw { v2u rc, rp, kc, kp, vc, vp, ac; f32x4 dc; };
struct ScanConst { f32x4 mu_r, mu_k, mu_v, kkw, kaw, rkw; };
DI f32x4 bf4(const v2u& w) { f32x4 r; r[0] = bf_lo(w.x); r[1] = bf_hi(w.x); r[2] = bf_lo(w.y); r[3] = bf_hi(w.y); return r; }

DI void scan_issue(ScanRaw& R, const unsigned char* ws, int b, int h, int t, int cg) {
    const bf16* rb = (const bf16*)(ws + WS_RB); const bf16* kb = (const bf16*)(ws + WS_KB); const bf16* vb = (const bf16*)(ws + WS_VB);
    const float* decay = (const float*)(ws + WS_DECAY); const bf16* av = (const bf16*)(ws + WS_AOUT);
    const size_t o = (size_t)(b * SEQ + t) * DB + h * HDB + 4 * cg;
    R.rc = *(const v2u*)(rb + o); R.kc = *(const v2u*)(kb + o); R.vc = *(const v2u*)(vb + o); R.dc = *(const f32x4*)(decay + o); R.ac = *(const v2u*)(av + o);
    if (t > 0) { R.rp = *(const v2u*)(rb + o - DB); R.kp = *(const v2u*)(kb + o - DB); R.vp = *(const v2u*)(vb + o - DB); }
    else { R.rp = (v2u){0u, 0u}; R.kp = (v2u){0u, 0u}; R.vp = (v2u){0u, 0u}; }
}
DI void scan_emit(const ScanRaw& R, const ScanConst& C, LAS float* sb, int cg, int qr, float* bonus_dst) {
    const f32x4 rc = bf4(R.rc), rp = bf4(R.rp), kc = bf4(R.kc), kp = bf4(R.kp), vc = bf4(R.vc), vp = bf4(R.vp), a = bf4(R.ac);
    const f32x4 r1 = rc + (rp - rc) * C.mu_r, k0 = kc + (kp - kc) * C.mu_k, v1 = vc + (vp - vc) * C.mu_v;
    const f32x4 kkv = k0 * C.kkw;
    const float nrm = sqrtf(red16((kkv[0] * kkv[0] + kkv[1] * kkv[1]) + (kkv[2] * kkv[2] + kkv[3] * kkv[3])));
    const f32x4 kkn = kkv * (1.0f / fmaxf(nrm, 1e-12f));
    const f32x4 k1 = k0 * (1.0f + (a - 1.0f) * C.kaw);
    const f32x4 rk = r1 * k1 * C.rkw;
    const float bc = red16((rk[0] + rk[1]) + (rk[2] + rk[3]));
    *(LAS f32x4*)(sb + 4 * cg) = R.dc; *(LAS f32x4*)(sb + 64 + 4 * cg) = -kkn; *(LAS f32x4*)(sb + 128 + 4 * cg) = kkn * a;
    *(LAS f32x4*)(sb + 192 + 4 * cg) = k1; *(LAS f32x4*)(sb + 256 + 4 * cg) = r1;
    if ((cg >> 2) == qr) *(LAS f32x4*)(sb + 320 + 4 * (cg & 3)) = v1;
    if (bonus_dst != nullptr && cg == 0) *bonus_dst = bc;
}
DI float red8(float x) { x = dpp_add<0xB1>(x); x = dpp_add<0x4E>(x); x = dpp_add<0x141>(x); return x; }
struct ScanVec { f32x4 w0, w1, a0, a1, b0, b1, k0, k1, r0, r1; float v; };
DI void scan_ld(ScanVec& V, const LAS float* sb, int cg, int vrow) {
    V.w0 = *(const LAS f32x4*)(sb + 8 * cg); V.w1 = *(const LAS f32x4*)(sb + 8 * cg + 4); V.a0 = *(const LAS f32x4*)(sb + 64 + 8 * cg); V.a1 = *(const LAS f32x4*)(sb + 64 + 8 * cg + 4);
    V.b0 = *(const LAS f32x4*)(sb + 128 + 8 * cg); V.b1 = *(const LAS f32x4*)(sb + 128 + 8 * cg + 4); V.k0 = *(const LAS f32x4*)(sb + 192 + 8 * cg); V.k1 = *(const LAS f32x4*)(sb + 192 + 8 * cg + 4);
    V.r0 = *(const LAS f32x4*)(sb + 256 + 8 * cg); V.r1 = *(const LAS f32x4*)(sb + 256 + 8 * cg + 4); V.v = sb[320 + vrow];
}
DI float scan_step(f32x4& s0, f32x4& s1, const ScanVec& V) {
    const f32x4 t0 = s0 * V.w0 + V.k0 * V.v, t1 = s1 * V.w1 + V.k1 * V.v;
    const f32x4 p = s0 * V.a0 + s1 * V.a1;
    const float sa = red8((p[0] + p[1]) + (p[2] + p[3]));
    s0 = t0 + V.b0 * sa; s1 = t1 + V.b1 * sa;
    const f32x4 q = s0 * V.r0 + s1 * V.r1;
    return red8((q[0] + q[1]) + (q[2] + q[3]));
}
DI void lds_signal(LAS unsigned* p, int lane) { asm volatile("s_waitcnt lgkmcnt(0)" ::: "memory"); if (lane == 0) __hip_atomic_fetch_add(p, 1u, __ATOMIC_RELAXED, __HIP_MEMORY_SCOPE_WORKGROUP); }
DI void lds_wait_ge(LAS unsigned* p, unsigned v) {
    unsigned spins = 0;
    while ((unsigned)__builtin_amdgcn_readfirstlane(__hip_atomic_load(p, __ATOMIC_RELAXED, __HIP_MEMORY_SCOPE_WORKGROUP)) < v) { __builtin_amdgcn_s_sleep(1); if (++spins > (1u << 24)) break; }
    asm volatile("" ::: "memory");
}
constexpr int SC_YW_OFF = 2 * SC_BUF_BYTES;
constexpr int SC_NSCAN = 2, SC_NLOAD = 2;

DI void scan_task(const float* const* in, unsigned char* ws, float* y, LAS unsigned char* lds, LAS unsigned* ctr, int task, int wave) {
    const int lane = lane_opaque();
    float* bonus = (float*)(ws + WS_BONUS);
    constexpr int NCHUNK = SEQ / SC_STEPS;
    const int bh = task >> 2, qr = task & 3, b = bh >> 5, h = bh & 31;
    if (wave < SC_NSCAN) {
        const int rl = lane >> 3, cg = lane & 7, vrow = 8 * wave + rl;
        f32x4 s0 = {0.f, 0.f, 0.f, 0.f}, s1 = s0;
        LAS float* yb = (LAS float*)(lds + SC_YW_OFF + wave * 1024);
        for (int c = 0; c < NCHUNK; ++c) {
            lds_wait_ge(ctr, (unsigned)(c + 1)); lds_wait_ge(ctr + 1, (unsigned)(c + 1));
            const LAS unsigned char* buf = lds + (c & 1) * SC_BUF_BYTES;
            ScanVec A, B; scan_ld(A, (const LAS float*)buf, cg, vrow);
#pragma unroll 2
            for (int s = 0; s < SC_STEPS; s += 2) {
                scan_ld(B, (const LAS float*)(buf + (s + 1) * SC_STEP_BYTES), cg, vrow);
                const float y0 = scan_step(s0, s1, A);
                if (s + 2 < SC_STEPS) scan_ld(A, (const LAS float*)(buf + (s + 2) * SC_STEP_BYTES), cg, vrow);
                const float y1 = scan_step(s0, s1, B);
                if (cg == 0) { yb[s * 8 + rl] = y0; yb[(s + 1) * 8 + rl] = y1; }
            }
            lds_signal(ctr + 2 + wave, lane);
            { const int s = lane >> 1, hf = lane & 1, t = c * SC_STEPS + s;
              *(f32x4*)(y + (size_t)(b * SEQ + t) * DB + h * HDB + 16 * qr + 8 * wave + 4 * hf) = *(const LAS f32x4*)(yb + s * 8 + 4 * hf); }
            asm volatile("s_waitcnt lgkmcnt(0)" ::: "memory");
        }
    } else if (wave < SC_NSCAN + SC_NLOAD) {
        const int lw = wave - SC_NSCAN, rl = lane >> 4, cg = lane & 15, col0 = h * HDB + 4 * cg;
        ScanConst C; C.mu_r = *(const f32x4*)(in[I_MU_RKV] + col0); C.mu_k = *(const f32x4*)(in[I_MU_RKV] + DB + col0); C.mu_v = *(const f32x4*)(in[I_MU_RKV] + 2 * DB + col0);
        C.kkw = *(const f32x4*)(in[I_KK] + col0); C.kaw = *(const f32x4*)(in[I_KA] + col0); C.rkw = *(const f32x4*)(in[I_RK] + col0);
        ScanRaw R[4];
#pragma unroll
        for (int p = 0; p < 4; ++p) scan_issue(R[p], ws, b, h, 4 * (lw + 2 * p) + rl, cg);
        for (int c = 0; c < NCHUNK; ++c) {
            if (c >= 2) { lds_wait_ge(ctr + 2, (unsigned)(c - 1)); lds_wait_ge(ctr + 3, (unsigned)(c - 1)); }
            LAS float* base = (LAS float*)(lds + (c & 1) * SC_BUF_BYTES); const int t0 = c * SC_STEPS;
#pragma unroll
            for (int p = 0; p < 4; ++p) { const int st = 4 * (lw + 2 * p) + rl;
                scan_emit(R[p], C, base + st * (SC_STEP_BYTES / 4), cg, qr, qr == 0 ? bonus + (size_t)(b * SEQ + t0 + st) * NHB + h : nullptr);
                if (c + 1 < NCHUNK) scan_issue(R[p], ws, b, h, t0 + SC_STEPS + st, cg); }
            lds_signal(ctr + lw, lane);
        }
    }
}

constexpr int ATT_LDS_OFF = 90112;
constexpr int ATT_LDS_OFF2 = 132096;
DI void scan_attn_phase(const float* const* in, unsigned char* ws, float* y, LAS unsigned char* lds, LAS unsigned char* lds_all, LAS unsigned* ctr, int wave) {
    bool first = true;
    for (int task = blockIdx.x; task < BATCH * NHB * 4 || first; task += gridDim.x) {
        __syncthreads();
        if (wave == 0 && lane_opaque() == 0) { ((LAS v4u*)ctr)[0] = (v4u){0u, 0u, 0u, 0u}; ((LAS v4u*)ctr)[1] = (v4u){0u, 0u, 0u, 0u}; }
        __syncthreads();
        if (task < BATCH * NHB * 4) scan_task(in, ws, y, lds, ctr, task, wave);
        if (first) {
            LAS unsigned char* mine = wave >= 3 ? lds + ATT_LDS_OFF + (wave - 3) * 8192 : lds_all + ATT_LDS_OFF2 + wave * 5120;
            attn_worker(ws, mine, ctr + 4, wave);
            if (wave >= 3) { const int lane = lane_opaque(); constexpr int NSIDE = A1_NITEMS + W2_NITEMS; const int nmine = (NSIDE - (int)blockIdx.x + (int)gridDim.x - 1) / (int)gridDim.x;
                for (;;) { unsigned v_ = 0u; if (lane == 0) v_ = __hip_atomic_fetch_add(ctr + 5, 1u, __ATOMIC_RELAXED, __HIP_MEMORY_SCOPE_WORKGROUP);
                    const int i = __builtin_amdgcn_readfirstlane((int)v_); if (i >= nmine) break;
                    const int it = (int)blockIdx.x + i * (int)gridDim.x;
                    if (it < A1_NITEMS) convert_a1_item(in, ws, (LAS unsigned*)mine, it, lane); else convert_w2_item(in, ws, (LAS unsigned*)mine, it - A1_NITEMS, lane); } }
        }
        first = false;
    }
}

DI void gn_phase(const float* const* in, unsigned char* ws, const float* y, int gw, int NGW, int lane) {
    const bf16* vb = (const bf16*)(ws + WS_VB); const bf16* gout = (const bf16*)(ws + WS_GOUT);
    const float* bonus = (const float*)(ws + WS_BONUS); bf16* ro = (bf16*)(ws + WS_AO) + (size_t)M * DB;
    const int per = (M * 8 + NGW - 1) / NGW, it0 = gw * per, it1 = (it0 + per < M * 8) ? it0 + per : M * 8;
    const int hh = lane >> 4, cg = lane & 15;
#pragma unroll 2
    for (int it = it0; it < it1; ++it) {
        const int m = it >> 3, h = (it & 7) * 4 + hh, col = h * HDB + 4 * cg; const size_t o = (size_t)m * DB + col;
        const f32x4 yv = *(const f32x4*)(y + o);
        const f32x4 vc = bf4(*(const v2u*)(vb + o)), g4 = bf4(*(const v2u*)(gout + o));
        f32x4 vp = {0.f, 0.f, 0.f, 0.f}; if (m & (SEQ - 1)) vp = bf4(*(const v2u*)(vb + o - DB));
        const float bc = bonus[(size_t)m * NHB + h];
        const f32x4 lw = *(const f32x4*)(in[I_LNW] + col), lb = *(const f32x4*)(in[I_LNB] + col), muv = *(const f32x4*)(in[I_MU_RKV] + 2 * DB + col);
        const float mean = red16((yv[0] + yv[1]) + (yv[2] + yv[3])) * (1.0f / 64.0f); const f32x4 d = yv - mean;
        const float var = red16((d[0] * d[0] + d[1] * d[1]) + (d[2] * d[2] + d[3] * d[3])) * (1.0f / 64.0f);
        const f32x4 yn = d * (1.0f / sqrtf(var + GN_EPS)) * lw + lb;
        const f32x4 v1 = vc + (vp - vc) * muv;
        const f32x4 res = (yn + v1 * bc) * g4;
        v2u w; w.x = pk2(res[0], res[1]); w.y = pk2(res[2], res[3]);
        *(v2u*)(ro + o) = w;
    }
}

DI void final_phase(const float* const* in, unsigned char* ws, float* out, int gw, int NGW, int lane) {
    const float* ss3 = (const float*)(ws + SS3_OFF); const float* nf = in[I_NORM_FINAL];
    for (int m = gw; m < M; m += NGW) { const float r = 1.0f / sqrtf(ss3[m] * (1.0f / D) + RMS_EPS);
        GAS f32x4* o = (GAS f32x4*)(out + (size_t)m * D) + lane; const GAS f32x4* g = (const GAS f32x4*)nf + lane;
#pragma unroll 4
        for (int j = 0; j < 16; ++j) { f32x4 v = o[64 * j]; const f32x4 gg = g[64 * j]; v = v * r * gg; o[64 * j] = v; } }
}

#ifndef MK_N_LAUNCHES
#define MK_N_LAUNCHES 1
#endif
constexpr int N_PHASES = 13;
#ifndef REP_P2
#define REP_P2 1
#endif
#ifndef REP_P3
#define REP_P3 1
#endif
#ifndef REP_P6
#define REP_P6 1
#endif
#ifndef REP_P7
#define REP_P7 1
#endif
#ifndef REP_P10
#define REP_P10 1
#endif
#ifndef REP_C
#define REP_C 1
#endif
#ifndef PG8_SP2
#define PG8_SP2 true
#endif
#ifndef PG8_ALIGN
#define PG8_ALIGN true
#endif

__global__ void __launch_bounds__(NWAVES * 64, 2) hybrid_fwd(Args args) {
    extern __shared__ __attribute__((aligned(16))) unsigned char lds_raw[];
    LAS unsigned char* lds = (LAS unsigned char*)lds_raw;
    volatile LAS unsigned* MISC = (volatile LAS unsigned*)(lds + MISC_OFF);
    const int wave = __builtin_amdgcn_readfirstlane(threadIdx.x >> 6);
    const int G = gridDim.x, gw = blockIdx.x * NWAVES + wave, NGW = G * NWAVES;
    unsigned char* ws = args.ws; const float* const* in = args.in;
    { const int tid0 = wave * 64 + lane_opaque(); for (int u = tid0; u < (LDS_BYTES - LDSCTL_OFF) / 4; u += NWAVES * 64) ((LAS unsigned*)(lds + LDSCTL_OFF))[u] = 0u; }
    __syncthreads();
    unsigned* ctl = (unsigned*)(ws + WS_CTL);
    XcdBarrier bar; bar.bar = ctl + CW_BAR; bar.x = 0; bar.st = nullptr;
    const bool multi = (args.ph_hi - args.ph_lo) > 1;
    if (multi) bar = xcd_barrier_post(ctl + CW_BAR, MISC + 8, wave == 0 && lane_opaque() == 0);
    const int lo = args.ph_lo, hi = args.ph_hi;
#ifndef PHASE_MASK
#define PHASE_MASK 0x3fff
#endif
#define IN(k) ((((PHASE_MASK) >> (k)) & 1) && lo <= (k) && (k) < hi)
#define SEAM(k) do { if (IN(k) && IN((k) + 1)) xcd_barrier(bar, wave == 0 && lane_opaque() == 0); } while (0)
#define LANE lane_opaque()
    LAS unsigned* scr = (LAS unsigned*)(lds + RING_OFF + wave * 16384);

    if (IN(0)) { const int lane = LANE; for (int rep = 0; rep < REP_C; ++rep) { convert_set_a(in, ws, scr, gw, NGW, lane); prologue_rows(in, ws, gw, NGW, lane); } }
    SEAM(0);
    if (IN(1)) {
        pg8::Gemm g{(const bf16*)(ws + WS_XB), (const bf16*)(ws + WS_WCAT), M, NCAT, D}; pg8::StaticOrder S; S.init(M, NCAT, G, (int)blockIdx.x);
        epi::InProj E{(bf16*)(ws + WS_Q), (bf16*)(ws + WS_K), (bf16*)(ws + WS_V), (bf16*)(ws + WS_QI), (bf16*)(ws + WS_KI), (bf16*)(ws + WS_RB), (bf16*)(ws + WS_KB), (bf16*)(ws + WS_VB),
                      (bf16*)(ws + WS_LORA), (bf16*)(ws + WS_GATES), (float*)(ws + WS_WI), (const float*)(ws + WS_RSTDX), (const float*)(ws + WS_RCOS), (const float*)(ws + WS_RSIN)};
        pg8::gemm_phase<epi::InProj, pg8::StaticOrder, PG8_ALIGN, PG8_SP2>(lds + RING_OFF, g, S, E, wave);
    }
    SEAM(1);
    if (IN(2)) { for (int rep = 0; rep < REP_P2; ++rep) indexer_phase(ws, lds + RING_OFF, wave); }
    SEAM(2);
    if (IN(4)) build_alora(ws, blockIdx.x * (NWAVES * 64) + wave * 64 + LANE, G * NWAVES * 64);
    SEAM(4);
    if (IN(5)) {
        int k256 = 256; asm volatile("" : "+s"(k256));
        pg8::Gemm g{(const bf16*)(ws + WS_ALORA), (const bf16*)(ws + WS_WL2), 3 * M, 3 * DB, k256}; epi::Stack3Order S{G, (int)blockIdx.x};
        epi::LoraUp E{(float*)(ws + WS_DECAY), (bf16*)(ws + WS_AOUT), (bf16*)(ws + WS_GOUT), in[I_W0], in[I_A0]};
        pg8::gemm_phase<epi::LoraUp, epi::Stack3Order, PG8_ALIGN, PG8_SP2>(lds + RING_OFF, g, S, E, wave);
    }
    SEAM(5);
    if (IN(6)) { for (int rep = 0; rep < REP_P6; ++rep) scan_attn_phase(in, ws, args.out, lds + RING_OFF, lds, (LAS unsigned*)(lds + MISC_OFF + 64), wave); }
    SEAM(6);
    if (IN(7)) { for (int rep = 0; rep < REP_P7; ++rep) gn_phase(in, ws, args.out, gw, NGW, LANE); }
    if (IN(7)) { const int lane = LANE; __syncthreads(); for (int rep = 0; rep < REP_C; ++rep) convert_set_b(in, ws, scr, gw, NGW, lane); }
    SEAM(7);
    if (IN(8)) {
        pg8::Gemm g{(const bf16*)(ws + WS_AO), (const bf16*)(ws + WS_WPAB), 2 * M, 2 * D, DA}; epi::ChainOrder S; S.so.init(M, D, G, (int)blockIdx.x);
        epi::GateMix E{(const bf16*)(ws + WS_GATES), in[I_BGATE], (bf16*)(ws + WS_MIX)};
        pg8::gemm_phase<epi::GateMix, epi::ChainOrder, PG8_ALIGN, PG8_SP2>(lds + RING_OFF, g, S, E, wave);
    }
    SEAM(8);
    if (IN(9)) {
        pg8::Gemm g{(const bf16*)(ws + WS_MIX), (const bf16*)(ws + WS_WO), M, D, D}; pg8::StaticOrder S; S.init(M, D, G, (int)blockIdx.x);
        epi::Resid E{in[I_X], args.out, (bf16*)(ws + WS_H1B), (float*)(ws + SS1_OFF)};
        pg8::gemm_phase<epi::Resid, pg8::StaticOrder, PG8_ALIGN, PG8_SP2>(lds + RING_OFF, g, S, E, wave);
    }
    SEAM(9);
    if (IN(10)) {
        pg8::Gemm g{(const bf16*)(ws + WS_H1B), (const bf16*)(ws + WS_W13), M, N13, D}; pg8::StaticOrder S; S.init(M, N13, G, (int)blockIdx.x);
        epi::FfnUp E{(const float*)(ws + SS1_OFF), (bf16*)(ws + WS_U)};
        pg8::gemm_phase<epi::FfnUp, pg8::StaticOrder, PG8_ALIGN, PG8_SP2>(lds + RING_OFF, g, S, E, wave);
#if REP_P10 > 1
        pg8::gemm_phase<epi::FfnUp, pg8::StaticOrder, PG8_ALIGN, PG8_SP2>(lds + RING_OFF, g, S, E, wave);
#endif
    }
    SEAM(10);
    if (IN(11)) {
        { pg8::Gemm g{(const bf16*)(ws + WS_U), (const bf16*)(ws + WS_W2), M, D, DFF}; pg8::StaticOrder S; S.init(M, D, G, (int)blockIdx.x);
          epi::Resid E{args.out, args.out, (bf16*)(ws + WS_H2B), (float*)(ws + SS2_OFF)};
          pg8::gemm_phase<epi::Resid, pg8::StaticOrder, PG8_ALIGN, PG8_SP2>(lds + RING_OFF, g, S, E, wave); }
        { int k256 = 256; asm volatile("" : "+s"(k256));
          pg8::Gemm g{(const bf16*)(ws + WS_PB), (const bf16*)(ws + WS_WPLE), M, D, k256}; pg8::StaticOrder S; S.init(M, D, G, (int)blockIdx.x);
          epi::StoreBf E{(bf16*)(ws + WS_PP), D};
          pg8::gemm_phase<epi::StoreBf, pg8::StaticOrder, PG8_ALIGN, PG8_SP2>(lds + RING_OFF, g, S, E, wave); }
    }
    SEAM(11);
    if (IN(12)) {
        pg8::Gemm g{(const bf16*)(ws + WS_H2B), (const bf16*)(ws + WS_WPG), M, D, D}; pg8::StaticOrder S; S.init(M, D, G, (int)blockIdx.x);
        epi::PleGate E{args.out, (const bf16*)(ws + WS_PP), (const float*)(ws + SS2_OFF), (float*)(ws + SS3_OFF)};
        pg8::gemm_phase<epi::PleGate, pg8::StaticOrder, PG8_ALIGN, PG8_SP2>(lds + RING_OFF, g, S, E, wave);
    }
    SEAM(12);
    if (IN(13)) final_phase(in, ws, args.out, gw, NGW, LANE);
#undef IN
#undef SEAM
#undef LANE
}

extern "C" void kernel_launch(void* const* d_in, const int* in_sizes, int n_in, void* d_out, int out_size, void* d_ws, size_t ws_size, hipStream_t stream) {
    static int grid = 0;
    if (grid == 0) {
        if (n_in != 32 || in_sizes[0] != M * D || out_size != M * D || ws_size < WS_END) { fprintf(stderr, "kernel_launch: unexpected shapes: n_in %d in0 %d out %d ws %zu (need %zu)\n", n_in, n_in > 0 ? in_sizes[0] : -1, out_size, ws_size, (size_t)WS_END); grid = -1; return; }
        int dev = 0, cus = 0, per_cu = 0;
        if (hipGetDevice(&dev) != hipSuccess || hipDeviceGetAttribute(&cus, hipDeviceAttributeMultiprocessorCount, dev) != hipSuccess) { grid = -1; return; }
        if (hipFuncSetAttribute((const void*)hybrid_fwd, hipFuncAttributeMaxDynamicSharedMemorySize, LDS_BYTES) != hipSuccess) { fprintf(stderr, "kernel_launch: hipFuncSetAttribute failed\n"); grid = -1; return; }
        if (hipOccupancyMaxActiveBlocksPerMultiprocessor(&per_cu, (const void*)hybrid_fwd, NWAVES * 64, LDS_BYTES) != hipSuccess || per_cu < 1) fprintf(stderr, "kernel_launch: occupancy query says %d\n", per_cu);
        (void)hipGetLastError();
        grid = cus;
    }
    if (grid < 0) return;
    if (hipMemsetAsync((char*)d_ws + WS_CTL, 0, CTL_ZERO_BYTES, stream) != hipSuccess) return;
    Args a{};
    for (int i = 0; i < 32; ++i) a.in[i] = (const float*)d_in[i];
    a.out = (float*)d_out; a.ws = (unsigned char*)d_ws;
#if MK_N_LAUNCHES == 1
    a.ph_lo = 0; a.ph_hi = N_PHASES + 1;
    hipLaunchKernelGGL(hybrid_fwd, dim3(grid), dim3(NWAVES * 64), LDS_BYTES, stream, a);
#else
    for (int p = 0; p <= N_PHASES; ++p) { a.ph_lo = p; a.ph_hi = p + 1; hipLaunchKernelGGL(hybrid_fwd, dim3(grid), dim3(NWAVES * 64), LDS_BYTES, stream, a); }
#endif
}
```

```cpp
#include <hip/hip_runtime.h>
#include <cstdio>
#include <cstdint>
__device__ __forceinline__ int lane_opaque() { int l; asm volatile("v_mbcnt_lo_u32_b32 %0, -1, 0\n\tv_mbcnt_hi_u32_b32 %0, -1, %0" : "=v"(l)); return l; }

namespace pg8 {
#define PG8_LAS __attribute__((address_space(3)))
typedef unsigned short bf16_t;
typedef short bf16x8 __attribute__((ext_vector_type(8)));
typedef float f32x4 __attribute__((ext_vector_type(4)));
typedef unsigned u32x4 __attribute__((ext_vector_type(4)));
constexpr int BM = 256, BK = 64, HALF = 128, HTB = HALF * BK * 2  , STAGE_BYTES = 8 * HTB, NXCD = 8, WGM = 8;

__host__ __device__ __forceinline__ int lds_byte(int r, int c) { const int st = (r >> 4) * 2 + (c >> 5), rr = r & 15, cc = c & 31, ob = rr * 64 + cc * 2; return st * 1024 + (ob ^ (((ob >> 9) & 1) << 5)); }
__host__ __device__ __forceinline__ void stage_rc(int b, int& R, int& C) { const int st = b / 1024, sb = b % 1024, swz = sb ^ (((sb >> 9) & 1) << 5); R = (st >> 1) * 16 + swz / 64; C = (st & 1) * 32 + (swz % 64) / 2; }
__host__ __device__ __forceinline__ int perm32(int rho) { const int n = rho >> 4, i = rho & 15; return 8 * (i >> 2) + 4 * n + (i & 3); }

struct Unit { int pm, pn; };
struct Gemm { const bf16_t* A; const bf16_t* Bt; int M, N, K; };

struct StaticOrder {
    int nM, nN, nwg, G, c;
    __host__ __device__ void init(int M, int N, int G_, int c_) { nM = M / BM; nN = N / BM; nwg = nM * nN; G = G_; c = c_; }
    __host__ __device__ bool next(int i, Unit& u) const {
        const long L = (long)i * G + c; if (L >= nwg) return false;
        int wgid = (int)L; { const int q = nwg / NXCD, r = nwg % NXCD, xcd = wgid % NXCD, off = wgid / NXCD; wgid = (xcd < r ? xcd * (q + 1) : r * (q + 1) + (xcd - r) * q) + off; }
        const int nig = WGM * nN, gid = wgid / nig, fm = gid * WGM, gsz = (nM - fm) < WGM ? (nM - fm) : WGM;
        u.pm = fm + ((wgid % nig) % gsz); u.pn = (wgid % nig) / gsz; return true;
    }
    __device__ __forceinline__ void a_ready(const Unit&) const {}
    __device__ __forceinline__ void done(const Unit&) const {}
};
__device__ __forceinline__ unsigned cvt_pk_bf16(float lo, float hi) { unsigned r; asm volatile("v_cvt_pk_bf16_f32 %0, %1, %2" : "=v"(r) : "v"(lo), "v"(hi)); return r; }
template <class Epi, class Sched, bool ALIGN_EPI = false, bool SP2 = false>
__device__ __forceinline__ void gemm_phase(PG8_LAS unsigned char* lds, const Gemm g, const Sched& S, const Epi& E, const int wid) {
    const int lane = lane_opaque(), tid = wid * 64 + lane, wr = wid >> 2, wc = wid & 3, fr = lane & 15, fq = lane >> 4;
    const int K = g.K, nt = K / BK;
    unsigned voffA[2], voffB[2];
#pragma unroll
    for (int i = 0; i < 2; ++i) { int R, C; stage_rc(tid * 16 + i * 8192, R, C); const int Rb = Epi::PERM ? ((R & ~31) + perm32(R & 31)) : R;
        voffA[i] = (unsigned)(R * K + C) * 2u; voffB[i] = (unsigned)(Rb * K + C) * 2u; }
    const size_t kstep = (size_t)(BK * 2);
    const size_t hstep = (size_t)HALF * K * 2;
    const size_t tstep = 2 * hstep;
    const unsigned ldsw = (unsigned)wid * 1024u;
    const int aoff = lds_byte(wr * 64 + fr, fq * 8), boff = lds_byte(wc * 32 + fr, fq * 8);
#define PG8_SA(b, h) (((b) * 2 + (h)) * HTB)
#define PG8_SB(b, h) ((4 + (b) * 2 + (h)) * HTB)
#define PG8_STAGE(bufoff, gbase, voff) do { _Pragma("unroll") for (int _i = 0; _i < 2; ++_i) \
        __builtin_amdgcn_global_load_lds((const unsigned*)((const char*)(gbase) + (voff)[_i]), (PG8_LAS unsigned*)(lds + (bufoff) + ldsw + _i * 8192), 16, 0, 0); } while (0)
#define PG8_LDA(dst, b, h) do { _Pragma("unroll") for (int m = 0; m < 4; ++m) _Pragma("unroll") for (int k = 0; k < 2; ++k) dst[m][k] = *(const PG8_LAS bf16x8*)(lds + PG8_SA(b, h) + aoff + m * 2048 + k * 1024); } while (0)
#define PG8_LDB(dst, b, h) do { _Pragma("unroll") for (int n = 0; n < 2; ++n) _Pragma("unroll") for (int k = 0; k < 2; ++k) dst[n][k] = *(const PG8_LAS bf16x8*)(lds + PG8_SB(b, h) + boff + n * 2048 + k * 1024); } while (0)
#define PG8_MMA(ai, bj, At, Bt) do { __builtin_amdgcn_s_setprio(1); _Pragma("unroll") for (int m = 0; m < 4; ++m) _Pragma("unroll") for (int n = 0; n < 2; ++n) _Pragma("unroll") for (int k = 0; k < 2; ++k) \
        acc[ai][bj][m][n] = __builtin_amdgcn_mfma_f32_16x16x32_bf16(Bt[n][k], At[m][k], acc[ai][bj][m][n], 0, 0, 0); __builtin_amdgcn_s_setprio(0); } while (0)
#define PG8_WAIT_V(n) asm volatile("s_waitcnt vmcnt(" #n ")" ::: "memory")
#define PG8_WAIT_L(n) asm volatile("s_waitcnt lgkmcnt(" #n ")" ::: "memory")
#define PG8_BAR __builtin_amdgcn_s_barrier()
#define PG8_SCHED __builtin_amdgcn_sched_barrier(0)
    Unit cur, nxt; int ui = 0;
    if (!S.next(0, cur)) return;
    f32x4 acc[2][2][4][2];
#pragma unroll
    for (int a = 0; a < 2; ++a)
#pragma unroll
        for (int b = 0; b < 2; ++b)
#pragma unroll
            for (int m = 0; m < 4; ++m)
#pragma unroll
                for (int n = 0; n < 2; ++n) acc[a][b][m][n] = (f32x4){0.f, 0.f, 0.f, 0.f};
    bf16x8 At[4][2], B0[2][2], B1[2][2];
    const char* cA = (const char*)g.A + (size_t)cur.pm * tstep; const char* cB = (const char*)g.Bt + (size_t)cur.pn * tstep;
    S.a_ready(cur);
    if constexpr (SP2) {
        PG8_STAGE(PG8_SB(0, 0), cB, voffB); PG8_STAGE(PG8_SB(0, 1), cB + hstep, voffB); PG8_STAGE(PG8_SA(0, 0), cA, voffA); PG8_STAGE(PG8_SA(0, 1), cA + hstep, voffA);
        if (wr == 1) PG8_BAR;
        PG8_WAIT_V(2); PG8_BAR;
        PG8_STAGE(PG8_SB(1, 0), cB + kstep, voffB); PG8_STAGE(PG8_SA(1, 0), cA + kstep, voffA); PG8_STAGE(PG8_SB(1, 1), cB + hstep + kstep, voffB);
        PG8_WAIT_V(6); PG8_BAR;
    } else {
        PG8_STAGE(PG8_SB(0, 0), cB, voffB); PG8_STAGE(PG8_SA(0, 0), cA, voffA); PG8_STAGE(PG8_SB(0, 1), cB + hstep, voffB); PG8_STAGE(PG8_SA(0, 1), cA + hstep, voffA);
        if (wr == 1) PG8_BAR;
        PG8_WAIT_V(4); PG8_BAR;
        PG8_STAGE(PG8_SB(1, 0), cB + kstep, voffB); PG8_STAGE(PG8_SA(1, 0), cA + kstep, voffA); PG8_STAGE(PG8_SB(1, 1), cB + hstep + kstep, voffB);
        PG8_WAIT_V(6); PG8_BAR;
    }
    for (;;) {
        const bool has_next = S.next(ui + 1, nxt);
        const char* nA = has_next ? (const char*)g.A + (size_t)nxt.pm * tstep : cA; const char* nB = has_next ? (const char*)g.Bt + (size_t)nxt.pn * tstep : cB;
        for (int t = 0; t < nt; t += 2) {
            const bool last = (t == nt - 2);
            const char* a1 = cA + (size_t)(t + 1) * kstep;
            const char* a2 = last ? nA : cA + (size_t)(t + 2) * kstep; const char* b2 = last ? nB : cB + (size_t)(t + 2) * kstep;
            const char* a3 = a2 + kstep; const char* b3 = b2 + kstep;
            if (last && has_next) S.a_ready(nxt);
            if constexpr (SP2) {
            PG8_LDB(B0, 0, 0); PG8_LDB(B1, 0, 1); PG8_SCHED; PG8_LDA(At, 0, 0); PG8_STAGE(PG8_SA(1, 1), a1 + hstep, voffA);
            PG8_WAIT_V(8); PG8_WAIT_L(0); PG8_BAR; PG8_MMA(0, 0, At, B0); PG8_MMA(0, 1, At, B1); PG8_BAR; PG8_SCHED;
            PG8_LDA(At, 0, 1); PG8_STAGE(PG8_SB(0, 0), b2, voffB); PG8_STAGE(PG8_SB(0, 1), b2 + hstep, voffB); PG8_STAGE(PG8_SA(0, 0), a2, voffA);
            PG8_WAIT_V(8); PG8_WAIT_L(0); PG8_BAR; PG8_MMA(1, 0, At, B0); PG8_MMA(1, 1, At, B1); PG8_BAR; PG8_SCHED;
            PG8_LDB(B0, 1, 0); PG8_LDB(B1, 1, 1); PG8_SCHED; PG8_LDA(At, 1, 0); PG8_STAGE(PG8_SA(0, 1), a2 + hstep, voffA);
            PG8_WAIT_V(8); PG8_WAIT_L(0); PG8_BAR; PG8_MMA(0, 0, At, B0); PG8_MMA(0, 1, At, B1); PG8_BAR; PG8_SCHED;
            PG8_LDA(At, 1, 1); PG8_STAGE(PG8_SB(1, 0), b3, voffB); PG8_STAGE(PG8_SB(1, 1), b3 + hstep, voffB); PG8_STAGE(PG8_SA(1, 0), a3, voffA);
            PG8_WAIT_V(8); PG8_WAIT_L(0); PG8_BAR; PG8_MMA(1, 0, At, B0); PG8_MMA(1, 1, At, B1); PG8_BAR; PG8_SCHED;
            } else {
            PG8_LDB(B0, 0, 0); PG8_SCHED; PG8_LDA(At, 0, 0); PG8_STAGE(PG8_SA(1, 1), a1 + hstep, voffA);
            PG8_WAIT_L(8); PG8_BAR; PG8_WAIT_L(0); PG8_MMA(0, 0, At, B0); PG8_BAR; PG8_SCHED;
            PG8_LDB(B1, 0, 1); PG8_STAGE(PG8_SB(0, 0), b2, voffB);
            PG8_BAR; PG8_WAIT_L(0); PG8_MMA(0, 1, At, B1); PG8_BAR;
            PG8_LDA(At, 0, 1); PG8_STAGE(PG8_SA(0, 0), a2, voffA);
            PG8_BAR; PG8_WAIT_L(0); PG8_MMA(1, 0, At, B0); PG8_BAR; PG8_SCHED;
            PG8_STAGE(PG8_SB(0, 1), b2 + hstep, voffB);
            PG8_WAIT_V(6); PG8_BAR; PG8_MMA(1, 1, At, B1); PG8_BAR;
            PG8_LDB(B0, 1, 0); PG8_SCHED; PG8_LDA(At, 1, 0); PG8_STAGE(PG8_SA(0, 1), a2 + hstep, voffA);
            PG8_WAIT_L(8); PG8_BAR; PG8_WAIT_L(0); PG8_MMA(0, 0, At, B0); PG8_BAR; PG8_SCHED;
            PG8_LDB(B1, 1, 1); PG8_STAGE(PG8_SB(1, 0), b3, voffB);
            PG8_BAR; PG8_WAIT_L(0); PG8_MMA(0, 1, At, B1); PG8_BAR;
            PG8_LDA(At, 1, 1); PG8_STAGE(PG8_SA(1, 0), a3, voffA);
            PG8_BAR; PG8_WAIT_L(0); PG8_MMA(1, 0, At, B0); PG8_BAR; PG8_SCHED;
            PG8_STAGE(PG8_SB(1, 1), b3 + hstep, voffB);
            PG8_WAIT_V(6); PG8_BAR; PG8_MMA(1, 1, At, B1); PG8_BAR;
            }
        }
        if constexpr (ALIGN_EPI) { if (wr == 0) PG8_BAR; }
        if constexpr (!Epi::AFTER_DRAIN) { E(acc, cur, wr, wc, fr, fq); S.done(cur); }
        if (!has_next) break;
        if (!Epi::CHAIN || !E.keep(cur)) {
#pragma unroll
        for (int a = 0; a < 2; ++a)
#pragma unroll
            for (int b = 0; b < 2; ++b)
#pragma unroll
                for (int m = 0; m < 4; ++m)
#pragma unroll
                    for (int n = 0; n < 2; ++n) acc[a][b][m][n] = (f32x4){0.f, 0.f, 0.f, 0.f};
        }
        cur = nxt; cA = nA; cB = nB; ++ui;
        if constexpr (ALIGN_EPI) { if (wr == 1) PG8_BAR; }
    }
    PG8_WAIT_V(0);
    if constexpr (!ALIGN_EPI) { if (wr == 0) PG8_BAR; }
    PG8_BAR;
    if constexpr (Epi::AFTER_DRAIN) { E.fused(acc, cur, wr, wc, fr, fq, lds, wid, lane); S.done(cur); }
#undef PG8_SA
#undef PG8_SB
#undef PG8_STAGE
#undef PG8_LDA
#undef PG8_LDB
#undef PG8_MMA
#undef PG8_WAIT_V
#undef PG8_WAIT_L
#undef PG8_BAR
#undef PG8_SCHED
}
}

#define LAS __attribute__((address_space(3)))
#define XB_TMO      128
#define XB_XCNT(j)  (256  + 64 * (j))
#define XB_XSUB(j)  (1280 + 64 * (j))
#define XB_XGEN(j)  (2304 + 64 * (j))
#define XB_TOP      3328
#define XB_TOPGEN   3392
#define XCD_BAR_WORDS 3456
#define XB_SPIN_CAP (1u << 18)

__device__ __forceinline__ unsigned xb_ld(unsigned* p)              { return __hip_atomic_load(p, __ATOMIC_RELAXED, __HIP_MEMORY_SCOPE_AGENT); }
__device__ __forceinline__ unsigned xb_add(unsigned* p, unsigned v) { return __hip_atomic_fetch_add(p, v, __ATOMIC_RELAXED, __HIP_MEMORY_SCOPE_AGENT); }
__device__ __forceinline__ unsigned xb_xcc_id() { return (unsigned)__builtin_amdgcn_s_getreg((3 << 11) | 20) & 0xFu; }
#define XB_SPIN(cond, bar) do { unsigned _sp = 0; while (cond) { __builtin_amdgcn_s_sleep(1); \
    if ((++_sp & 255u) == 0u) { if (xb_ld(&(bar)[XB_TMO])) break; if (_sp > XB_SPIN_CAP) { atomicAdd(&(bar)[XB_TMO], 1u); break; } } } } while (0)

struct XcdBarrier {
    unsigned* bar; unsigned x;
    volatile LAS unsigned* st;
};

__device__ __forceinline__ XcdBarrier xcd_barrier_post(unsigned* bar, volatile LAS unsigned* st, const bool leader  ) {
    XcdBarrier b; b.bar = bar; b.x = xb_xcc_id(); b.st = st;
    if (leader) (void)xb_add(&bar[XB_XCNT(b.x)], 1u);
    return b;
}
__device__ __forceinline__ void xcd_barrier_complete(unsigned* bar, unsigned x, unsigned& nloc, unsigned& nx) {
    const unsigned G = gridDim.x * gridDim.y * gridDim.z;
    unsigned sum, cnt, mine, sp = 0u;
    for (;;) {
        sum = 0u; cnt = 0u; mine = 0u;
#pragma unroll
        for (unsigned j = 0; j < 16; ++j) { const unsigned c = xb_ld(&bar[XB_XCNT(j)]); sum += c; cnt += (c > 0u) ? 1u : 0u; mine = (j == x) ? c : mine; }
        if (sum == G) break;
        __builtin_amdgcn_s_sleep(1);
        if ((++sp & 255u) == 0u) { if (xb_ld(&bar[XB_TMO])) break; if (sp > XB_SPIN_CAP) { atomicAdd(&bar[XB_TMO], 1u); break; } }
    }
    nloc = mine > 0u ? mine : 1u; nx = cnt > 0u ? cnt : 1u;
}

__device__ __forceinline__ void xcd_barrier(const XcdBarrier& b, const bool leader  ) {
    asm volatile("s_waitcnt vmcnt(0)" ::: "memory");
    __syncthreads();
    if (leader) {
        unsigned* bar = b.bar;
        __builtin_amdgcn_s_waitcnt(0);
        unsigned nloc = b.st[0], nx = b.st[1];
        if (nloc == 0u) { xcd_barrier_complete(bar, b.x, nloc, nx); b.st[0] = nloc; b.st[1] = nx; }
        const unsigned old = xb_add(&bar[XB_XSUB(b.x)], 1u);
        const unsigned gen = old / nloc;
        if (old + 1u == (gen + 1u) * nloc) {
            __builtin_amdgcn_fence(__ATOMIC_RELEASE, "agent");
            asm volatile("s_waitcnt vmcnt(0)" ::: "memory");
            const unsigned og = xb_add(&bar[XB_TOP], 1u);
            const unsigned tg = og / nx;
            if (og + 1u == (tg + 1u) * nx) xb_add(&bar[XB_TOPGEN], 1u);
            else XB_SPIN(xb_ld(&bar[XB_TOPGEN]) == tg, bar);
            __builtin_amdgcn_fence(__ATOMIC_ACQUIRE, "agent");
            xb_add(&bar[XB_XGEN(b.x)], 1u);
            asm volatile("s_waitcnt vmcnt(0)" ::: "memory");
        } else {
            XB_SPIN(xb_ld(&bar[XB_XGEN(b.x)]) == gen, bar);
            __builtin_amdgcn_fence(__ATOMIC_ACQUIRE, "agent");
            asm volatile("s_waitcnt vmcnt(0)" ::: "memory");
        }
    }
    __syncthreads();
}

constexpr int BATCH = 2, SEQ = 8192, M = BATCH * SEQ, D = 4096;
constexpr int DA = 2048, KVD = 512, DIQ = 2048, HDI = 128, NHI = 16, DB = 2048, NHB = 32, HDB = 64;
constexpr int DIN = 11408, DFF = 11008, DPLE = 256, TOPK = 256;
constexpr int NCAT = 81 * 256;
constexpr int N13 = 2 * DFF;
constexpr int LORA_LD = 1024;
constexpr float RMS_EPS = 1e-6f, GN_EPS = 64e-5f;

#define GAS __attribute__((address_space(1)))
typedef unsigned short bf16;
typedef unsigned v4u __attribute__((ext_vector_type(4)));
typedef unsigned v2u __attribute__((ext_vector_type(2)));
typedef float f32x4 __attribute__((ext_vector_type(4)));
typedef float f32x16 __attribute__((ext_vector_type(16)));
typedef float f32x2 __attribute__((ext_vector_type(2)));
typedef short bf16x8 __attribute__((ext_vector_type(8)));
typedef GAS unsigned gu32;
#define RLX_AGENT __ATOMIC_RELAXED, __HIP_MEMORY_SCOPE_AGENT
#define LDS_WAIT() asm volatile("s_waitcnt lgkmcnt(0)" ::: "memory")
#define VM_WAIT() asm volatile("s_waitcnt vmcnt(0)" ::: "memory")
#define DI __device__ __forceinline__

DI unsigned f2bf(float f) { unsigned u = __builtin_bit_cast(unsigned, f); return (u + 0x7fffu + ((u >> 16) & 1u)) >> 16; }
DI unsigned pk2(float lo, float hi) { return f2bf(lo) | (f2bf(hi) << 16); }
DI float bf_lo(unsigned w) { return __builtin_bit_cast(float, w << 16); }
DI float bf_hi(unsigned w) { return __builtin_bit_cast(float, w & 0xffff0000u); }
DI float bf2f(bf16 h) { return __builtin_bit_cast(float, ((unsigned)h) << 16); }
DI float sigmoidf_(float z) { return 1.0f / (1.0f + __expf(-z)); }
DI float wave_sum(float v) {
#pragma unroll
    for (int o = 1; o < 64; o <<= 1) v += __shfl_xor(v, o);
    return v;
}

namespace epi {
using pg8::Unit; using pg8::BM; using pg8::HALF; using pg8::cvt_pk_bf16;
typedef pg8::f32x4 f4;
DI v4u pack8(const f4& a, const f4& b) { v4u w; w.x = cvt_pk_bf16(a[0], a[1]); w.y = cvt_pk_bf16(a[2], a[3]); w.z = cvt_pk_bf16(b[0], b[1]); w.w = cvt_pk_bf16(b[2], b[3]); return w; }
DI void unpack8(const v4u& w, f4& a, f4& b) { a[0] = bf_lo(w.x); a[1] = bf_hi(w.x); a[2] = bf_lo(w.y); a[3] = bf_hi(w.y); b[0] = bf_lo(w.z); b[1] = bf_hi(w.z); b[2] = bf_lo(w.w); b[3] = bf_hi(w.w); }

struct InProj {
    static constexpr bool PERM = true, AFTER_DRAIN = false, CHAIN = false;
    bf16 *q, *k, *v, *qi, *ki, *rb, *kb, *vb, *lora, *gates; float* wi;
    const float *rstd, *rcos, *rsin;
    DI bool keep(const Unit&) const { return false; }
    DI void operator()(f4 (&acc)[2][2][4][2], const Unit& u, int wr, int wc, int fr, int fq) const {
        { const int ln_ = lane_opaque(); fr = ln_ & 15; fq = ln_ >> 4; }
        const int pn = u.pn, row0 = u.pm * BM + wr * 64 + fr;
        int kind = 0, ld, cb; bf16* dst;
        float rsv[2][4];
#pragma unroll
        for (int ai = 0; ai < 2; ++ai)
#pragma unroll
            for (int m = 0; m < 4; ++m) rsv[ai][m] = rstd[row0 + ai * HALF + m * 16];
        if (pn < 8)       { kind = 1; dst = q;  ld = DA;  cb = pn * 256; }
        else if (pn < 10) { kind = 1; dst = k;  ld = KVD; cb = (pn - 8) * 256; }
        else if (pn < 12) { dst = v;  ld = KVD; cb = (pn - 10) * 256; }
        else if (pn < 20) { kind = 1; dst = qi; ld = DIQ; cb = (pn - 12) * 256; }
        else if (pn == 20){ kind = 2; dst = ki; ld = HDI; cb = 0; }
        else if (pn < 29) { dst = rb; ld = DB; cb = (pn - 21) * 256; }
        else if (pn < 37) { dst = kb; ld = DB; cb = (pn - 29) * 256; }
        else if (pn < 45) { dst = vb; ld = DB; cb = (pn - 37) * 256; }
        else if (pn < 49) { dst = lora; ld = LORA_LD; cb = (pn - 45) * 256; }
        else              { dst = gates; ld = 2 * D; cb = (pn - 49) * 256; }
        if (kind == 0) {
#pragma unroll
            for (int ai = 0; ai < 2; ++ai)
#pragma unroll
                for (int m = 0; m < 4; ++m) { const int row = row0 + ai * HALF + m * 16; const float rs = rsv[ai][m];
#pragma unroll
                    for (int bj = 0; bj < 2; ++bj) *(v4u*)(dst + (size_t)row * ld + cb + bj * HALF + wc * 32 + 8 * fq) = pack8(acc[ai][bj][m][0] * rs, acc[ai][bj][m][1] * rs); }
        } else if (kind == 1 || wc < 2) {
            const int hb = cb + (wc >> 1) * 128, dd0 = (wc & 1) * 32 + 8 * fq;
#pragma unroll
            for (int ai = 0; ai < 2; ++ai)
#pragma unroll
              for (int mp = 0; mp < 2; ++mp) {
                f4 cv[2][2], sv[2][2];
#pragma unroll
                for (int mm = 0; mm < 2; ++mm) { const size_t to = (size_t)(row0 + ai * HALF + (2 * mp + mm) * 16) * 64 + dd0; cv[mm][0] = *(const f4*)(rcos + to); cv[mm][1] = *(const f4*)(rcos + to + 4); sv[mm][0] = *(const f4*)(rsin + to); sv[mm][1] = *(const f4*)(rsin + to + 4); }
                asm volatile("" ::: "memory");
#pragma unroll
                for (int mm = 0; mm < 2; ++mm) { const int m = 2 * mp + mm, row = row0 + ai * HALF + m * 16; const float rs = rsv[ai][m];
                    const f4 c0 = cv[mm][0], c1 = cv[mm][1], s0 = sv[mm][0], s1 = sv[mm][1];
                    const f4 a0 = acc[ai][0][m][0] * rs, a1 = acc[ai][0][m][1] * rs, b0 = acc[ai][1][m][0] * rs, b1 = acc[ai][1][m][1] * rs;
                    bf16* p = dst + (size_t)row * ld + hb + dd0;
                    *(v4u*)(p)      = pack8(a0 * c0 - b0 * s0, a1 * c1 - b1 * s1);
                    *(v4u*)(p + 64) = pack8(a0 * s0 + b0 * c0, a1 * s1 + b1 * c1); }
                asm volatile("" ::: "memory"); }
        } else if (wc == 2 && fq < 2) {
#pragma unroll
            for (int ai = 0; ai < 2; ++ai)
#pragma unroll
                for (int m = 0; m < 4; ++m) { const int row = row0 + ai * HALF + m * 16; const float rs = rsv[ai][m] * 0.25f;
                    *(f4*)(wi + (size_t)row * 16 + 8 * fq) = acc[ai][0][m][0] * rs; *(f4*)(wi + (size_t)row * 16 + 8 * fq + 4) = acc[ai][0][m][1] * rs; }
        }
    }
};

struct LoraUp {
    static constexpr bool PERM = true, AFTER_DRAIN = false, CHAIN = false;
    float* decay; bf16 *aout, *gout; const float *w0, *a0;
    DI bool keep(const Unit&) const { return false; }
    DI void operator()(f4 (&acc)[2][2][4][2], const Unit& u, int wr, int wc, int fr, int fq) const {
        { const int ln_ = lane_opaque(); fr = ln_ & 15; fq = ln_ >> 4; }
        const int which = u.pm >> 6, row0 = (u.pm & 63) * BM + wr * 64 + fr, col0 = (u.pn & 7) * BM + wc * 32 + 8 * fq;
        if (which == 0) {
#pragma unroll
            for (int bj = 0; bj < 2; ++bj) { const int col = col0 + bj * HALF; const f4 z0 = *(const f4*)(w0 + col), z1 = *(const f4*)(w0 + col + 4);
#pragma unroll
                for (int ai = 0; ai < 2; ++ai)
#pragma unroll
                    for (int m = 0; m < 4; ++m) { const size_t off = (size_t)(row0 + ai * HALF + m * 16) * DB + col;
                        f4 x0 = acc[ai][bj][m][0] + z0, x1 = acc[ai][bj][m][1] + z1;
#pragma unroll
                        for (int e = 0; e < 4; ++e) { x0[e] = __expf(-0.6065306597126334f * sigmoidf_(x0[e])); x1[e] = __expf(-0.6065306597126334f * sigmoidf_(x1[e])); }
                        *(f4*)(decay + off) = x0; *(f4*)(decay + off + 4) = x1;
                        asm volatile("" ::: "memory"); } }
        } else if (which == 1) {
#pragma unroll
            for (int bj = 0; bj < 2; ++bj) { const int col = col0 + bj * HALF; const f4 z0 = *(const f4*)(a0 + col), z1 = *(const f4*)(a0 + col + 4);
#pragma unroll
                for (int ai = 0; ai < 2; ++ai)
#pragma unroll
                    for (int m = 0; m < 4; ++m) { const size_t off = (size_t)(row0 + ai * HALF + m * 16) * DB + col;
                        f4 x0 = acc[ai][bj][m][0] + z0, x1 = acc[ai][bj][m][1] + z1;
#pragma unroll
                        for (int e = 0; e < 4; ++e) { x0[e] = sigmoidf_(x0[e]); x1[e] = sigmoidf_(x1[e]); }
                        *(v4u*)(aout + off) = pack8(x0, x1);
                        asm volatile("" ::: "memory"); } }
        } else {
#pragma unroll
            for (int bj = 0; bj < 2; ++bj)
#pragma unroll
                for (int ai = 0; ai < 2; ++ai)
#pragma unroll
                    for (int m = 0; m < 4; ++m) *(v4u*)(gout + (size_t)(row0 + ai * HALF + m * 16) * DB + col0 + bj * HALF) = pack8(acc[ai][bj][m][0], acc[ai][bj][m][1]);
        }
    }
};

struct GateMix {
    static constexpr bool PERM = true, AFTER_DRAIN = false, CHAIN = true;
    const bf16* gates; const float* bgate; bf16* mout;
    DI bool keep(const Unit& u) const { return u.pm < 64; }
    DI void operator()(f4 (&acc)[2][2][4][2], const Unit& u, int wr, int wc, int fr, int fq) const {
        { const int ln_ = lane_opaque(); fr = ln_ & 15; fq = ln_ >> 4; }
        const int which = u.pm >> 6, row0 = (u.pm & 63) * BM + wr * 64 + fr, col0 = (u.pn & 15) * BM + wc * 32 + 8 * fq;
        f4 ba[2][2], bb[2][2];
#pragma unroll
        for (int bj = 0; bj < 2; ++bj) { const int col = col0 + bj * HALF; ba[bj][0] = *(const f4*)(bgate + col); ba[bj][1] = *(const f4*)(bgate + col + 4); bb[bj][0] = *(const f4*)(bgate + D + col); bb[bj][1] = *(const f4*)(bgate + D + col + 4); }
#pragma unroll
        for (int ai = 0; ai < 2; ++ai)
#pragma unroll
          for (int mp = 0; mp < 2; ++mp) {
            v4u zbv[2][2], zav[2][2];
#pragma unroll
            for (int mm = 0; mm < 2; ++mm)
#pragma unroll
                for (int bj = 0; bj < 2; ++bj) { const size_t go = (size_t)(row0 + ai * HALF + (2 * mp + mm) * 16) * (2 * D) + col0 + bj * HALF;
                    zbv[mm][bj] = *(const v4u*)(gates + go + D); if (which == 0) zav[mm][bj] = *(const v4u*)(gates + go); else zav[mm][bj] = (v4u){0u, 0u, 0u, 0u}; }
            asm volatile("" ::: "memory");
#pragma unroll
            for (int mm = 0; mm < 2; ++mm) { const int m = 2 * mp + mm, row = row0 + ai * HALF + m * 16;
#pragma unroll
                for (int bj = 0; bj < 2; ++bj) { const int col = col0 + bj * HALF;
                    f4 zb0, zb1; unpack8(zbv[mm][bj], zb0, zb1); zb0 += bb[bj][0]; zb1 += bb[bj][1];
                    if (which == 0) {
                        f4 za0, za1; unpack8(zav[mm][bj], za0, za1); za0 += ba[bj][0]; za1 += ba[bj][1];
#pragma unroll
                        for (int t = 0; t < 4; ++t) {
                            acc[ai][bj][m][0][t] *= (1.0f + __expf(-zb0[t])) / (1.0f + __expf(-za0[t]));
                            acc[ai][bj][m][1][t] *= (1.0f + __expf(-zb1[t])) / (1.0f + __expf(-za1[t])); }
                    } else {
                        f4 o0, o1;
#pragma unroll
                        for (int t = 0; t < 4; ++t) { o0[t] = acc[ai][bj][m][0][t] * sigmoidf_(zb0[t]); o1[t] = acc[ai][bj][m][1][t] * sigmoidf_(zb1[t]); }
                        *(v4u*)(mout + (size_t)row * D + col) = pack8(o0, o1);
                    } } }
            asm volatile("" ::: "memory");
          }
    }
};

struct Resid {
    static constexpr bool PERM = true, AFTER_DRAIN = false, CHAIN = false;
    const float* base; float* out; bf16* outb; float* ss;
    DI bool keep(const Unit&) const { return false; }
    DI void operator()(f4 (&acc)[2][2][4][2], const Unit& u, int wr, int wc, int fr, int fq) const {
        { const int ln_ = lane_opaque(); fr = ln_ & 15; fq = ln_ >> 4; }
        const int row0 = u.pm * BM + wr * 64 + fr, col0 = u.pn * BM + wc * 32 + 8 * fq;
#pragma unroll
        for (int ai = 0; ai < 2; ++ai) {
            f4 b0[4][2], b1[4][2];
#pragma unroll
            for (int m = 0; m < 4; ++m)
#pragma unroll
                for (int bj = 0; bj < 2; ++bj) { const size_t off = (size_t)(row0 + ai * HALF + m * 16) * D + col0 + bj * HALF; b0[m][bj] = *(const f4*)(base + off); b1[m][bj] = *(const f4*)(base + off + 4); }
            asm volatile("" ::: "memory");
#pragma unroll
            for (int m = 0; m < 4; ++m) { const int row = row0 + ai * HALF + m * 16; float s = 0.f;
#pragma unroll
                for (int bj = 0; bj < 2; ++bj) { const size_t off = (size_t)row * D + col0 + bj * HALF;
                    const f4 h0 = b0[m][bj] + acc[ai][bj][m][0], h1 = b1[m][bj] + acc[ai][bj][m][1];
                    *(f4*)(out + off) = h0; *(f4*)(out + off + 4) = h1; *(v4u*)(outb + off) = pack8(h0, h1);
                    s += (h0[0] * h0[0] + h0[1] * h0[1]) + (h0[2] * h0[2] + h0[3] * h0[3]) + (h1[0] * h1[0] + h1[1] * h1[1]) + (h1[2] * h1[2] + h1[3] * h1[3]); }
                s += __shfl_xor(s, 16); s += __shfl_xor(s, 32);
                if (fq == 0) atomicAdd(ss + row, s); }
            asm volatile("" ::: "memory");
        }
    }
};

struct FfnUp {
    static constexpr bool PERM = true, AFTER_DRAIN = false, CHAIN = false;
    const float* ss; bf16* uout;
    DI bool keep(const Unit&) const { return false; }
    DI void operator()(f4 (&acc)[2][2][4][2], const Unit& u, int wr, int wc, int fr, int fq) const {
        { const int ln_ = lane_opaque(); fr = ln_ & 15; fq = ln_ >> 4; }
        const int row0 = u.pm * BM + wr * 64 + fr, col0 = u.pn * HALF + wc * 32 + 8 * fq;
        float rr[2][4];
#pragma unroll
        for (int ai = 0; ai < 2; ++ai)
#pragma unroll
            for (int m = 0; m < 4; ++m) rr[ai][m] = ss[row0 + ai * HALF + m * 16];
#pragma unroll
        for (int ai = 0; ai < 2; ++ai)
#pragma unroll
            for (int m = 0; m < 4; ++m) { const int row = row0 + ai * HALF + m * 16; const float r = __builtin_amdgcn_rsqf(rr[ai][m] * (1.0f / D) + RMS_EPS);
                f4 o0, o1;
#pragma unroll
                for (int e = 0; e < 4; ++e) { const float a0 = acc[ai][0][m][0][e] * r, a1 = acc[ai][0][m][1][e] * r;
                    o0[e] = a0 * sigmoidf_(a0) * (acc[ai][1][m][0][e] * r); o1[e] = a1 * sigmoidf_(a1) * (acc[ai][1][m][1][e] * r); }
                *(v4u*)(uout + (size_t)row * DFF + col0) = pack8(o0, o1); }
    }
};

struct StoreBf {
    static constexpr bool PERM = true, AFTER_DRAIN = false, CHAIN = false;
    bf16* o; int ld;
    DI bool keep(const Unit&) const { return false; }
    DI void operator()(f4 (&acc)[2][2][4][2], const Unit& u, int wr, int wc, int fr, int fq) const {
        { const int ln_ = lane_opaque(); fr = ln_ & 15; fq = ln_ >> 4; }
        const int row0 = u.pm * BM + wr * 64 + fr, col0 = u.pn * BM + wc * 32 + 8 * fq;
#pragma unroll
        for (int ai = 0; ai < 2; ++ai)
#pragma unroll
            for (int m = 0; m < 4; ++m)
#pragma unroll
                for (int bj = 0; bj < 2; ++bj) *(v4u*)(o + (size_t)(row0 + ai * HALF + m * 16) * ld + col0 + bj * HALF) = pack8(acc[ai][bj][m][0], acc[ai][bj][m][1]);
    }
};

struct PleGate {
    static constexpr bool PERM = true, AFTER_DRAIN = false, CHAIN = false;
    float* h; const bf16* pp; const float* ss_in; float* ss_out;
    DI bool keep(const Unit&) const { return false; }
    DI void operator()(f4 (&acc)[2][2][4][2], const Unit& u, int wr, int wc, int fr, int fq) const {
        { const int ln_ = lane_opaque(); fr = ln_ & 15; fq = ln_ >> 4; }
        const int row0 = u.pm * BM + wr * 64 + fr, col0 = u.pn * BM + wc * 32 + 8 * fq;
        float rr[2][4];
#pragma unroll
        for (int ai = 0; ai < 2; ++ai)
#pragma unroll
            for (int m = 0; m < 4; ++m) rr[ai][m] = ss_in[row0 + ai * HALF + m * 16];
#pragma unroll
        for (int ai = 0; ai < 2; ++ai)
#pragma unroll
            for (int mp = 0; mp < 2; ++mp) {
                v4u pv[2][2]; f4 h0v[2][2], h1v[2][2];
#pragma unroll
                for (int mm = 0; mm < 2; ++mm)
#pragma unroll
                    for (int bj = 0; bj < 2; ++bj) { const size_t off = (size_t)(row0 + ai * HALF + (2 * mp + mm) * 16) * D + col0 + bj * HALF;
                        pv[mm][bj] = *(const v4u*)(pp + off); h0v[mm][bj] = *(const f4*)(h + off); h1v[mm][bj] = *(const f4*)(h + off + 4); }
                asm volatile("" ::: "memory");
#pragma unroll
                for (int mm = 0; mm < 2; ++mm) { const int m = 2 * mp + mm, row = row0 + ai * HALF + m * 16; const float r = __builtin_amdgcn_rsqf(rr[ai][m] * (1.0f / D) + RMS_EPS); float s = 0.f;
#pragma unroll
                    for (int bj = 0; bj < 2; ++bj) { const size_t off = (size_t)row * D + col0 + bj * HALF;
                        f4 p0, p1; unpack8(pv[mm][bj], p0, p1);
                        f4 h0 = h0v[mm][bj], h1 = h1v[mm][bj];
#pragma unroll
                        for (int t = 0; t < 4; ++t) { h0[t] += sigmoidf_(acc[ai][bj][m][0][t] * r) * p0[t]; h1[t] += sigmoidf_(acc[ai][bj][m][1][t] * r) * p1[t]; }
                        *(f4*)(h + off) = h0; *(f4*)(h + off + 4) = h1;
                        s += (h0[0] * h0[0] + h0[1] * h0[1]) + (h0[2] * h0[2] + h0[3] * h0[3]) + (h1[0] * h1[0] + h1[1] * h1[1]) + (h1[2] * h1[2] + h1[3] * h1[3]); }
                    s += __shfl_xor(s, 16); s += __shfl_xor(s, 32);
                    if (fq == 0) atomicAdd(ss_out + row, s); }
                asm volatile("" ::: "memory");
            }
    }
};

struct Stack3Order {
    int G, c;
    DI bool next(int i, Unit& u) const { const int L = i * G + c; if (L >= 1536) return false; const int which = L >> 9, r = L & 511; u.pm = which * 64 + (r & 63); u.pn = which * 8 + (r >> 6); return true; }
    DI void a_ready(const Unit&) const {}
    DI void done(const Unit&) const {}
};
struct ChainOrder {
    pg8::StaticOrder so;
    DI bool next(int i, Unit& u) const { Unit t; if (!so.next(i >> 1, t)) return false; const int which = i & 1; u.pm = which * 64 + t.pm; u.pn = which * 16 + t.pn; return true; }
    DI void a_ready(const Unit&) const {}
    DI void done(const Unit&) const {}
};
}

constexpr size_t MiB = 1u << 20;
constexpr size_t WS_CTL = 0, CTL_ZERO_BYTES = 1 * MiB;
constexpr int CW_TMO = 0, CW_BAR = 4096;
constexpr size_t SS1_OFF = 256 * 1024, SS2_OFF = 320 * 1024, SS3_OFF = 384 * 1024;
constexpr size_t WS_RSTDX = 1 * MiB;
constexpr size_t WS_BONUS = 2 * MiB;
constexpr size_t WS_RCOS = 4 * MiB, WS_RSIN = 8 * MiB;
constexpr size_t WS_WI = 12 * MiB;
constexpr size_t WS_PB = 13 * MiB;
constexpr size_t WS_WPAB = 24 * MiB;
constexpr size_t WS_WO = 56 * MiB, WS_WPG = 88 * MiB;
constexpr size_t WS_WPLE = 120 * MiB;
constexpr size_t WS_WL2 = 122 * MiB;
constexpr size_t WS_R1 = 126 * MiB;
constexpr size_t WS_WCAT = 126 * MiB;
constexpr size_t WS_XB = 288 * MiB;
constexpr size_t WS_SCORE = 126 * MiB;
constexpr size_t WS_IDX = 1252 * MiB;
constexpr size_t WS_DECAY = 126 * MiB;
constexpr size_t WS_AOUT = 254 * MiB;
constexpr size_t WS_ALORA = 318 * MiB;
constexpr size_t WS_W13 = 126 * MiB;
constexpr size_t WS_W2 = 318 * MiB;
constexpr size_t WS_Q = 416 * MiB, WS_K = 480 * MiB, WS_V = 496 * MiB, WS_QI = 512 * MiB, WS_KI = 576 * MiB;
constexpr size_t WS_RB = 580 * MiB, WS_KB = 644 * MiB, WS_VB = 708 * MiB, WS_LORA = 772 * MiB, WS_GATES = 804 * MiB;
constexpr size_t WS_Y = 416 * MiB;
constexpr size_t WS_MIX = 416 * MiB;
constexpr size_t WS_H1B = 544 * MiB;
constexpr size_t WS_U = 672 * MiB;
constexpr size_t WS_H2B = 416 * MiB;
constexpr size_t WS_PP = 544 * MiB;
constexpr size_t WS_AO = 1060 * MiB;
constexpr size_t WS_GOUT = 1188 * MiB;
constexpr size_t WS_END = 1268 * MiB;

constexpr int RING_OFF = 0, RING_BYTES = 131072;
constexpr int LDSCTL_OFF = RING_BYTES, MISC_OFF = LDSCTL_OFF + 320;
constexpr int LDS_BYTES = 147456;
constexpr int NWAVES = 8;

struct Args {
    const float* in[32]; float* out; unsigned char* ws; int ph_lo, ph_hi;
};
enum { I_X = 0, I_P, I_POS, I_NORM_MIX, I_W_IN, I_MU_RKV, I_MU_WAG, I_W0, I_W1, I_W2, I_A0, I_A1, I_A2, I_G1, I_G2, I_KK, I_KA, I_RK, I_LNW, I_LNB,
       I_WPA, I_WPB, I_WGATE, I_BGATE, I_WO, I_NORM_FFN, I_WFFN1, I_WFFN3, I_WFFN2, I_WPLEG, I_WPLE, I_NORM_FINAL };

struct TrSrc { const float* p; int ld, col0, nvalid, kvalid; const float* ksc; const float* mu; int mumode; };
DI void tr_item(const TrSrc& s, bf16* WT, int dK, int n0, int k0, LAS unsigned* T, int lane) {
    const int ng = lane & 15, kq = lane >> 4;
    f32x4 v[8][2]; f32x2 sc[8];
    const bool nok = 4 * ng < s.nvalid;
#pragma unroll
    for (int st = 0; st < 8; ++st) { const int k = k0 + 8 * st + 2 * kq;
#pragma unroll
        for (int j = 0; j < 2; ++j) v[st][j] = (nok && k + j < s.kvalid) ? *(const f32x4*)(s.p + (size_t)(k + j) * s.ld + s.col0 + 4 * ng) : (f32x4){0.f, 0.f, 0.f, 0.f};
        f32x2 c = {1.f, 1.f};
        if (s.ksc) c = *(const f32x2*)(s.ksc + k);
        if (s.mumode == 1) { const f32x2 m = *(const f32x2*)(s.mu + k); c = c * (1.0f - m); } else if (s.mumode == 2) { const f32x2 m = *(const f32x2*)(s.mu + k); c = c * m; }
        sc[st] = c; }
#pragma unroll
    for (int st = 0; st < 8; ++st) { const int kp = 4 * st + kq;
#pragma unroll
        for (int i = 0; i < 4; ++i) T[(4 * ng + i) * 32 + (kp ^ (4 * (ng & 7)))] = pk2(v[st][0][i] * sc[st][0], v[st][1][i] * sc[st][1]); }
    LDS_WAIT(); asm volatile("" ::: "memory");
#pragma unroll
    for (int j = 0; j < 8; ++j) { const int n = (lane >> 3) + 8 * j, c = lane & 7;
        *(GAS v4u*)(WT + (size_t)(n0 + n) * dK + k0 + 8 * c) = *(const LAS v4u*)(T + n * 32 + 4 * (c ^ ((n >> 2) & 7))); }
    LDS_WAIT(); asm volatile("" ::: "memory");
}
DI TrSrc src_wcat(const float* const* in, int n0) {
    TrSrc s; s.p = in[I_W_IN]; s.ld = DIN; s.col0 = 0; s.nvalid = 64; s.kvalid = D; s.ksc = in[I_NORM_MIX]; s.mu = nullptr; s.mumode = 0;
    const int tile = n0 >> 8, p = n0 & 255, bj = p >> 7, hh = (p >> 6) & 1;
    if (tile < 8)        s.col0 = 0    + (2 * tile + hh) * 128 + 64 * bj;
    else if (tile < 10)  s.col0 = 2048 + (2 * (tile - 8) + hh) * 128 + 64 * bj;
    else if (tile < 12)  s.col0 = 2560 + (tile - 10) * 256 + p;
    else if (tile < 20)  s.col0 = 3072 + (2 * (tile - 12) + hh) * 128 + 64 * bj;
    else if (tile == 20) { if (hh == 0) s.col0 = 5120 + 64 * bj; else if (bj == 0) { s.col0 = 5248; s.nvalid = 16; } else s.nvalid = 0; }
    else if (tile < 45)  s.col0 = 5264 + (tile - 21) * 256 + p;
    else if (tile < 49)  { const int c = (tile - 45) * 256 + p;
        const int seg = c < 128 ? 0 : c < 256 ? 1 : c < 512 ? 2 : c < 640 ? 3 : c < 768 ? 4 : 5, sbeg = seg == 0 ? 0 : seg == 1 ? 128 : seg == 2 ? 256 : seg == 3 ? 512 : seg == 4 ? 640 : 768;
        const int kind = seg % 3;
        s.p = in[kind == 0 ? I_W1 : (kind == 1 ? I_A1 : I_G1)]; s.ld = kind == 2 ? 256 : 96; s.col0 = c - sbeg; s.mu = in[I_MU_WAG] + kind * D; s.mumode = seg < 3 ? 1 : 2;
        if (kind != 2) s.nvalid = (s.col0 == 0) ? 64 : 32; }
    else { s.p = in[I_WGATE]; s.ld = 2 * D; s.col0 = (tile - 49) * 256 + p; }
    return s;
}
DI TrSrc src_plain(const float* p, int ld, int col0, int kvalid, const float* ksc) { TrSrc s; s.p = p; s.ld = ld; s.col0 = col0; s.nvalid = 64; s.kvalid = kvalid; s.ksc = ksc; s.mu = nullptr; s.mumode = 0; return s; }

DI void convert_set_a(const float* const* in, unsigned char* ws, LAS unsigned* scr, int gw, int NGW, int lane) {
    constexpr int I0 = (NCAT / 64) * (D / 64);
    constexpr int I6 = (DB / 64) * (256 / 64);
    constexpr int NITEMS = I0 + 3 * I6;
    for (int it = gw; it < NITEMS; it += NGW) {
        int r = it;
        if (r < I0) { const int nblk = NCAT / 64, kb = r / nblk, nb = r % nblk; tr_item(src_wcat(in, 64 * nb), (bf16*)(ws + WS_WCAT), D, 64 * nb, 64 * kb, scr, lane); continue; } r -= I0;
        { const int w = r / I6; r -= w * I6; const int nblk = DB / 64, kb = r / nblk, nb = r % nblk;
          tr_item(src_plain(in[w == 0 ? I_W2 : (w == 1 ? I_A2 : I_G2)], DB, 64 * nb, w == 2 ? 256 : 96, nullptr), (bf16*)(ws + WS_WL2) + (size_t)w * DB * 256, 256, 64 * nb, 64 * kb, scr, lane); }
    }
}
constexpr int A1_I1 = (D / 64) * (DA / 64), A1_I3 = (D / 64) * (D / 64), A1_I5 = (D / 64) * (DPLE / 64), A1_NITEMS = 2 * A1_I1 + 2 * A1_I3 + A1_I5;
DI void convert_a1_item(const float* const* in, unsigned char* ws, LAS unsigned* scr, int it, int lane) {
    int r = it;
    if (r < 2 * A1_I1) { const int w = r / A1_I1; r -= w * A1_I1; const int nblk = D / 64, kb = r / nblk, nb = r % nblk;
        tr_item(src_plain(in[w ? I_WPB : I_WPA], D, 64 * nb, DA, nullptr), (bf16*)(ws + WS_WPAB) + (size_t)w * D * DA, DA, 64 * nb, 64 * kb, scr, lane); return; } r -= 2 * A1_I1;
    if (r < 2 * A1_I3) { const int w = r / A1_I3; r -= w * A1_I3; const int nblk = D / 64, kb = r / nblk, nb = r % nblk;
        tr_item(src_plain(in[w ? I_WPLEG : I_WO], D, 64 * nb, D, nullptr), (bf16*)(ws + (w ? WS_WPG : WS_WO)), D, 64 * nb, 64 * kb, scr, lane); return; } r -= 2 * A1_I3;
    { const int nblk = D / 64, kb = r / nblk, nb = r % nblk; tr_item(src_plain(in[I_WPLE], D, 64 * nb, DPLE, nullptr), (bf16*)(ws + WS_WPLE), DPLE, 64 * nb, 64 * kb, scr, lane); }
}
DI void convert_set_b(const float* const* in, unsigned char* ws, LAS unsigned* scr, int gw, int NGW, int lane) {
    constexpr int I0 = (N13 / 64) * (D / 64);
    for (int it = gw; it < I0; it += NGW) {
        const int nblk = N13 / 64, kb = it / nblk, nb = it % nblk, n0 = 64 * nb, tile = n0 >> 8, p = n0 & 255;
        tr_item(src_plain(in[(p >> 7) ? I_WFFN3 : I_WFFN1], DFF, tile * 128 + (p & 127), D, in[I_NORM_FFN]), (bf16*)(ws + WS_W13), D, n0, 64 * kb, scr, lane);
    }
}
constexpr int W2_NITEMS = (D / 64) * (DFF / 64);
DI void convert_w2_item(const float* const* in, unsigned char* ws, LAS unsigned* scr, int it, int lane) {
    const int nblk = D / 64, kb = it / nblk, nb = it % nblk; tr_item(src_plain(in[I_WFFN2], D, 64 * nb, DFF, nullptr), (bf16*)(ws + WS_W2), DFF, 64 * nb, 64 * kb, scr, lane);
}
DI void prologue_rows(const float* const* in, unsigned char* ws, int gw, int NGW, int lane) {
    const float* x = in[I_X]; bf16* xb = (bf16*)(ws + WS_XB); float* rstd = (float*)(ws + WS_RSTDX);
    for (int m = gw; m < M; m += NGW) {
        const GAS f32x4* xr = (const GAS f32x4*)(x + (size_t)m * D) + lane; GAS v2u* o = (GAS v2u*)(xb + (size_t)m * D) + lane; float s = 0.f;
f32x4 xv[16];
#pragma unroll
        for (int j = 0; j < 16; ++j) xv[j] = xr[64 * j];
#pragma unroll
        for (int j = 0; j < 16; ++j) { const f32x4 v = xv[j]; s += (v.x * v.x + v.y * v.y) + (v.z * v.z + v.w * v.w); v2u w; w.x = pk2(v.x, v.y); w.y = pk2(v.z, v.w); o[64 * j] = w; }
        s = wave_sum(s);
        if (lane == 0) rstd[m] = 1.0f / sqrtf(s * (1.0f / D) + RMS_EPS);
    }
    const int* pos = (const int*)in[I_POS]; float* rc = (float*)(ws + WS_RCOS); float* rsn = (float*)(ws + WS_RSIN);
    for (int e = gw * 64 + lane; e < M * 64; e += NGW * 64) {
        const int m = e >> 6, i = e & 63; double inv = 1.0; for (int j = 0; j < i; ++j) inv *= 0.8659643233600653523;
        const double ang = (double)pos[m] * inv;
        const double qd = __builtin_rint(ang * 0.63661977236758134308); const int qi = (int)((long long)qd & 3);
        double r = __builtin_fma(-qd, 1.5707963267948965580, ang); r = __builtin_fma(-qd, 6.1232339957367658860e-17, r);
        const double r2 = r * r;
        const double sn = r * (1.0 + r2 * (-1.0 / 6 + r2 * (1.0 / 120 + r2 * (-1.0 / 5040 + r2 * (1.0 / 362880 + r2 * (-1.0 / 39916800 + r2 * (1.0 / 6227020800.0)))))));
        const double cs = 1.0 + r2 * (-0.5 + r2 * (1.0 / 24 + r2 * (-1.0 / 720 + r2 * (1.0 / 40320 + r2 * (-1.0 / 3628800 + r2 * (1.0 / 479001600.0 + r2 * (-1.0 / 87178291200.0)))))));
        const double c4 = (qi == 0) ? cs : (qi == 1) ? -sn : (qi == 2) ? -cs : sn;
        const double s4 = (qi == 0) ? sn : (qi == 1) ? cs : (qi == 2) ? -sn : -cs;
        rc[e] = (float)c4; rsn[e] = (float)s4;
    }
    const float* p = in[I_P]; bf16* pb = (bf16*)(ws + WS_PB);
    for (int e = gw * 64 + lane; e < M * DPLE / 4; e += NGW * 64) { const f32x4 v = ((const GAS f32x4*)p)[e]; v2u w; w.x = pk2(v.x, v.y); w.y = pk2(v.z, v.w); ((GAS v2u*)pb)[e] = w; }
}
DI void build_alora(unsigned char* ws, int gtid, int NT) {
    const bf16* L = (const bf16*)(ws + WS_LORA); bf16* A = (bf16*)(ws + WS_ALORA);
    for (int e = gtid; e < 3 * M * 32; e += NT) {
        const int which = e / (M * 32), r = e - which * (M * 32), m = r >> 5, j0 = (r & 31) * 8;
        f32x4 o0 = {0.f, 0.f, 0.f, 0.f}, o1 = o0;
        const int width = which == 2 ? 256 : 96, ca = which == 0 ? 0 : (which == 1 ? 128 : 256), cbb = which == 0 ? 512 : (which == 1 ? 640 : 768);
        if (j0 < width) {
            f32x4 c0, c1, p0 = {0.f, 0.f, 0.f, 0.f}, p1 = p0;
            epi::unpack8(*(const v4u*)(L + (size_t)m * LORA_LD + ca + j0), c0, c1);
            if ((m & (SEQ - 1)) != 0) epi::unpack8(*(const v4u*)(L + (size_t)(m - 1) * LORA_LD + cbb + j0), p0, p1);
            o0 = c0 + p0; o1 = c1 + p1;
            if (which == 0) {
#pragma unroll
                for (int t = 0; t < 4; ++t) { o0[t] = 1.0f - 2.0f / (__expf(2.0f * o0[t]) + 1.0f); o1[t] = 1.0f - 2.0f / (__expf(2.0f * o1[t]) + 1.0f); } }
            if (which == 2) {
#pragma unroll
                for (int t = 0; t < 4; ++t) { o0[t] = sigmoidf_(o0[t]); o1[t] = sigmoidf_(o1[t]); } }
        }
        *(v4u*)(A + ((size_t)which * M + m) * 256 + j0) = epi::pack8(o0, o1);
    }
}

constexpr int IDX_TS = 272;
constexpr int IDX_TILE_BYTES = 64 * IDX_TS;
constexpr int IDX_HIST_OFF = 2 * IDX_TILE_BYTES;

DI unsigned fkey(float f) { unsigned u = __builtin_bit_cast(unsigned, f); if (u == 0x80000000u) u = 0u; return (u & 0x80000000u) ? ~u : (u | 0x80000000u); }

DI void indexer_unit(unsigned char* ws, LAS unsigned char* lds, int b, int blk, float* scratch, int wave) {
    const int lane = lane_opaque(), tid = wave * 64 + lane;
    const bf16* qi = (const bf16*)(ws + WS_QI); const bf16* ki = (const bf16*)(ws + WS_KI); const float* wi = (const float*)(ws + WS_WI);
    const int t0 = blk * 32, mrow0 = b * SEQ + t0;
    const int r = lane & 31, kh = lane >> 5, aq = (r >> 2) & 1, ah = (r & 3) + 4 * (r >> 3);
    bf16x8 af[2][8]; f32x4 wg[2][4];
#pragma unroll
    for (int rt = 0; rt < 2; ++rt) {
        const bf16* src = qi + (size_t)(mrow0 + 4 * wave + 2 * rt + aq) * DIQ + ah * HDI + 8 * kh;
#pragma unroll
        for (int ks = 0; ks < 8; ++ks) af[rt][ks] = *(const bf16x8*)(src + 16 * ks);
        const float* wsrc = wi + (size_t)(mrow0 + 4 * wave + 2 * rt + kh) * NHI;
#pragma unroll
        for (int j = 0; j < 4; ++j) wg[rt][j] = *(const f32x4*)(wsrc + 4 * j) * 0.08838834764831845f;
    }
    const int nk = (t0 + 32 + 63) >> 6;
    const int lkey = tid >> 3, lpart = tid & 7;
    const bf16* kbase = ki + (size_t)(b * SEQ) * HDI;
    v4u st0, st1;
    { const v4u* g = (const v4u*)(kbase + (size_t)lkey * HDI + lpart * 16); st0 = g[0]; st1 = g[1]; }
    __syncthreads();
    { LAS v4u* d = (LAS v4u*)(lds + lkey * IDX_TS + lpart * 32); d[0] = st0; d[1] = st1; }
    __syncthreads();
#pragma unroll
    for (int rt = 0; rt < 2; ++rt) {
#pragma unroll
        for (int ks = 0; ks < 8; ++ks) asm volatile("; pin %0" : "+v"(af[rt][ks]));
#pragma unroll
        for (int j = 0; j < 4; ++j) asm volatile("; pin %0" : "+v"(wg[rt][j])); }
    for (int kt = 0; kt < nk; ++kt) {
        if (kt + 1 < nk) { const v4u* g = (const v4u*)(kbase + (size_t)((kt + 1) * 64 + lkey) * HDI + lpart * 16); st0 = g[0]; st1 = g[1]; }
        const LAS unsigned char* tb = lds + (kt & 1) * IDX_TILE_BYTES;
#pragma unroll
        for (int ct = 0; ct < 2; ++ct) {
            bf16x8 bfr[8];
#pragma unroll
            for (int ks = 0; ks < 8; ++ks) bfr[ks] = *(const LAS bf16x8*)(tb + (32 * ct + r) * IDX_TS + (16 * ks + 8 * kh) * 2);
#pragma unroll
            for (int rt = 0; rt < 2; ++rt) {
                f32x16 c;
#pragma unroll
                for (int j = 0; j < 16; ++j) c[j] = 0.f;
#pragma unroll
                for (int ks = 0; ks < 8; ++ks) c = __builtin_amdgcn_mfma_f32_32x32x16_bf16(af[rt][ks], bfr[ks], c, 0, 0, 0);
                float s = 0.f;
#pragma unroll
                for (int j = 0; j < 16; ++j) s += wg[rt][j >> 2][j & 3] * __builtin_amdgcn_fmed3f(c[j], 0.f, 3.0e38f);
                scratch[(size_t)(4 * wave + 2 * rt + kh) * SEQ + kt * 64 + 32 * ct + r] = s;
            }
        }
        if (kt + 1 < nk) { LAS v4u* d = (LAS v4u*)(lds + ((kt + 1) & 1) * IDX_TILE_BYTES + lkey * IDX_TS + lpart * 32); d[0] = st0; d[1] = st1; }
        asm volatile("s_waitcnt lgkmcnt(0)" ::: "memory"); __builtin_amdgcn_s_barrier(); asm volatile("" ::: "memory");
    }
}

DI void select_unit(unsigned char* ws, LAS unsigned char* lds, int b, int blk, const float* scratch, int wave) {
    int* idx = (int*)(ws + WS_IDX);
    LAS unsigned* hist = (LAS unsigned*)(lds + IDX_HIST_OFF + wave * 8192);
    for (int qq = 0; qq < 4; ++qq) {
        const int lane = lane_opaque(); const unsigned long long lt_mask = (1ull << lane) - 1ull;
        const int ql = wave * 4 + qq, t = blk * 32 + ql, n = t + 1;
        const float* sc = scratch + (size_t)ql * SEQ; int* out = idx + (size_t)(b * SEQ + t) * TOPK;
        if (n <= TOPK) { for (int e = lane; e < TOPK; e += 64) out[e] = (e < n) ? e : 0; continue; }
        const int n4 = (n + 3) >> 2;
        v4u key[32];
#pragma unroll
        for (int j = 0; j < 32; ++j) { key[j] = (v4u){0u, 0u, 0u, 0u};
            if (64 * j < n4) { const int gi = 64 * j + lane; if (gi < n4) { const f32x4 v = *(const f32x4*)(sc + 4 * gi); const int e0 = 4 * gi;
                key[j].x = fkey(v[0]); key[j].y = (e0 + 1 < n) ? fkey(v[1]) : 0u; key[j].z = (e0 + 2 < n) ? fkey(v[2]) : 0u; key[j].w = (e0 + 3 < n) ? fkey(v[3]) : 0u; } } }
        unsigned prefix = 0u, pmask = 0u; int kk = TOPK;
        for (int pass = 0; pass < 4; ++pass) {
            const int shift = 24 - 8 * pass;
#pragma unroll
            for (int z = 0; z < 8; ++z) *(LAS v4u*)(hist + 4 * (lane + 64 * z)) = (v4u){0u, 0u, 0u, 0u};
            LAS unsigned* hc = hist + 256 * (lane & 7);
#pragma unroll
            for (int j = 0; j < 32; ++j) if (64 * j < n4) {
#pragma unroll
                for (int c = 0; c < 4; ++c) { const unsigned u = key[j][c]; if ((u & pmask) == prefix) __hip_atomic_fetch_add(hc + ((u >> shift) & 255u), 1u, __ATOMIC_RELAXED, __HIP_MEMORY_SCOPE_WORKGROUP); } }
            LDS_WAIT(); asm volatile("" ::: "memory");
            v4u hs = {0u, 0u, 0u, 0u};
#pragma unroll
            for (int z = 0; z < 8; ++z) hs += *(const LAS v4u*)(hist + 256 * z + 4 * lane);
            const int c0 = (int)hs.x, c1 = (int)hs.y, c2 = (int)hs.z, c3 = (int)hs.w;
            const int T = c0 + c1 + c2 + c3; int S = T;
#pragma unroll
            for (int o = 1; o < 64; o <<= 1) { const int v = __shfl_down(S, o); if (lane + o < 64) S += v; }
            const int E = S - T;
            const bool found = (E < kk) && (kk <= S);
            int d = 0, knew = 0;
            if (found) { int run = E;
                if (run + c3 >= kk) { d = 4 * lane + 3; knew = kk - run; } else { run += c3;
                if (run + c2 >= kk) { d = 4 * lane + 2; knew = kk - run; } else { run += c2;
                if (run + c1 >= kk) { d = 4 * lane + 1; knew = kk - run; } else { run += c1; d = 4 * lane; knew = kk - run; } } } }
            const unsigned long long fm = __ballot(found); const int src = fm ? (int)__builtin_ctzll(fm) : 0;
            d = __shfl(d, src); knew = __shfl(knew, src);
            prefix |= ((unsigned)d) << shift; pmask |= 0xffu << shift; kk = knew;
            asm volatile("" ::: "memory");
        }
        int pos = 0, eqt = 0;
#pragma unroll
        for (int j = 0; j < 32; ++j) if (64 * j < n4) {
            bool eq[4], gt[4]; unsigned long long em[4]; int eq_before = eqt;
#pragma unroll
            for (int c = 0; c < 4; ++c) { const unsigned u = key[j][c]; eq[c] = (u == prefix); gt[c] = (u > prefix); em[c] = __ballot(eq[c]); eq_before += __builtin_popcountll(em[c] & lt_mask); }
            bool take[4]; unsigned long long tm[4]; int tk_before = pos, run_eq = eq_before;
#pragma unroll
            for (int c = 0; c < 4; ++c) { take[c] = gt[c] || (eq[c] && run_eq < kk); run_eq += eq[c] ? 1 : 0; tm[c] = __ballot(take[c]); tk_before += __builtin_popcountll(tm[c] & lt_mask); }
            int slot = tk_before;
#pragma unroll
            for (int c = 0; c < 4; ++c) { if (take[c]) { if (slot < TOPK) out[slot] = 256 * j + 4 * lane + c; ++slot; } }
#pragma unroll
            for (int c = 0; c < 4; ++c) { pos += __builtin_popcountll(tm[c]); eqt += __builtin_popcountll(em[c]); }
        }
    }
}

DI void indexer_phase(unsigned char* ws, LAS unsigned char* lds, int wave) {
    float* scratch = (float*)(ws + WS_SCORE) + (size_t)blockIdx.x * 32 * SEQ;
    for (int pr = blockIdx.x; pr < 256; pr += gridDim.x) {
        const int b = pr >> 7, j = pr & 127;
        for (int half = 0; half < 2; ++half) { const int blk = half ? 255 - j : j;
            indexer_unit(ws, lds, b, blk, scratch, wave);
            VM_WAIT(); __syncthreads();
#ifndef REP_SEL
#define REP_SEL 1
#endif
            for (int rs_ = 0; rs_ < REP_SEL; ++rs_) select_unit(ws, lds, b, blk, scratch, wave);
            VM_WAIT(); __syncthreads(); }
    }
}

typedef int v4i __attribute__((ext_vector_type(4)));
#define ATT_FENCE() asm volatile("" ::: "memory")
DI void attn_worker(unsigned char* ws, LAS unsigned char* lds, LAS unsigned* qctr, int wave) {
    const int lane = lane_opaque();
    const bf16* q = (const bf16*)(ws + WS_Q); const bf16* kbuf = (const bf16*)(ws + WS_K); const bf16* vbuf = (const bf16*)(ws + WS_V);
    const int* idx = (const int*)(ws + WS_IDX); bf16* ao = (bf16*)(ws + WS_AO);
    LAS int* idl = (LAS int*)(lds); LAS float* pl = (LAS float*)(lds + 1024);
    const int G = gridDim.x, bg = blockIdx.x & 7, b = bg >> 2, g = bg & 3;
    const int nbk = (G - bg + 7) >> 3, rank = blockIdx.x >> 3, nq = (SEQ - rank + nbk - 1) / nbk;
    const int kr = lane & 15, kq = lane >> 4;
    const int kg = lane >> 4, dg = lane & 15;
    const bf16* kbase = kbuf + (size_t)(b * SEQ) * KVD + g * 128 + 8 * kq;
    const bf16* vbase = vbuf + (size_t)(b * SEQ) * KVD + g * 128 + 8 * dg;
    int qn; { unsigned v_ = 0u; if (lane == 0) v_ = __hip_atomic_fetch_add(qctr, 1u, __ATOMIC_RELAXED, __HIP_MEMORY_SCOPE_WORKGROUP); qn = __builtin_amdgcn_readfirstlane((int)v_); }
    int ixg[4]; bf16x8 qf[4];
    if (qn < nq) { const int mq = b * SEQ + rank + nbk * qn;
#pragma unroll
        for (int c = 0; c < 4; ++c) ixg[c] = idx[(size_t)mq * TOPK + lane + 64 * c];
#pragma unroll
        for (int ks = 0; ks < 4; ++ks) { if (kr < 4) qf[ks] = *(const bf16x8*)(q + (size_t)mq * DA + (4 * g + kr) * 128 + 32 * ks + 8 * kq); else qf[ks] = (bf16x8){0, 0, 0, 0, 0, 0, 0, 0}; } }
    while (qn < nq) {
        const int t = rank + nbk * qn, mq = b * SEQ + t, nvalid = (t + 1 < TOPK) ? t + 1 : TOPK;
#pragma unroll
        for (int c = 0; c < 4; ++c) idl[lane + 64 * c] = ixg[c];
        LDS_WAIT(); ATT_FENCE();
        int qn2; { unsigned v_ = 0u; if (lane == 0) v_ = __hip_atomic_fetch_add(qctr, 1u, __ATOMIC_RELAXED, __HIP_MEMORY_SCOPE_WORKGROUP); qn2 = __builtin_amdgcn_readfirstlane((int)v_); }
        if (qn2 < nq) { const int mq2 = b * SEQ + rank + nbk * qn2;
#pragma unroll
            for (int c = 0; c < 4; ++c) ixg[c] = idx[(size_t)mq2 * TOPK + lane + 64 * c]; }
        ATT_FENCE();
        int kidx[16];
#pragma unroll
        for (int kt = 0; kt < 16; ++kt) kidx[kt] = idl[64 * (kr >> 2) + 4 * kt + (kr & 3)];
        f32x4 s[16]; bf16x8 kf[3][2][4];
#pragma unroll
        for (int hg = 0; hg < 2; ++hg) {
#pragma unroll
            for (int j = 0; j < 2; ++j) { const bf16* kp = kbase + (size_t)kidx[2 * hg + j] * KVD;
#pragma unroll
                for (int ks = 0; ks < 4; ++ks) kf[hg][j][ks] = *(const bf16x8*)(kp + 32 * ks); }
            ATT_FENCE(); }
#pragma unroll
        for (int hg = 0; hg < 8; ++hg) {
            if (hg + 2 < 8) {
#pragma unroll
                for (int j = 0; j < 2; ++j) { const bf16* kp = kbase + (size_t)kidx[2 * (hg + 2) + j] * KVD;
#pragma unroll
                    for (int ks = 0; ks < 4; ++ks) kf[(hg + 2) % 3][j][ks] = *(const bf16x8*)(kp + 32 * ks); }
                ATT_FENCE(); }
#pragma unroll
            for (int j = 0; j < 2; ++j) { f32x4 a = {0.f, 0.f, 0.f, 0.f};
#pragma unroll
                for (int ks = 0; ks < 4; ++ks) a = __builtin_amdgcn_mfma_f32_16x16x32_bf16(kf[hg % 3][j][ks], qf[ks], a, 0, 0, 0);
                s[2 * hg + j] = a; }
        }
        if (qn2 < nq && kr < 4) { const int mq2 = b * SEQ + rank + nbk * qn2;
#pragma unroll
            for (int ks = 0; ks < 4; ++ks) qf[ks] = *(const bf16x8*)(q + (size_t)mq2 * DA + (4 * g + kr) * 128 + 32 * ks + 8 * kq); }
        ATT_FENCE();
        v4i ix[3][2]; v4u vv[3][8];
#pragma unroll
        for (int ch = 0; ch < 2; ++ch) {
            ix[ch][0] = *(const LAS v4i*)(idl + 64 * kg + 8 * ch); ix[ch][1] = *(const LAS v4i*)(idl + 64 * kg + 8 * ch + 4);
#pragma unroll
            for (int j = 0; j < 8; ++j) vv[ch][j] = *(const v4u*)(vbase + (size_t)ix[ch][j >> 2][j & 3] * KVD);
            ATT_FENCE(); }
        float mx = -3.0e38f;
#pragma unroll
        for (int kt = 0; kt < 16; ++kt)
#pragma unroll
            for (int e = 0; e < 4; ++e) { const bool ok = (64 * kq + 4 * kt + e) < nvalid; s[kt][e] = ok ? s[kt][e] * 0.08838834764831845f : -3.0e38f; mx = fmaxf(mx, s[kt][e]); }
        mx = fmaxf(mx, __shfl_xor(mx, 16)); mx = fmaxf(mx, __shfl_xor(mx, 32));
        float sum = 0.f;
#pragma unroll
        for (int kt = 0; kt < 16; ++kt)
#pragma unroll
            for (int e = 0; e < 4; ++e) { const bool ok = (64 * kq + 4 * kt + e) < nvalid; const float p = ok ? __expf(s[kt][e] - mx) : 0.f; s[kt][e] = p; sum += p; }
        sum += __shfl_xor(sum, 16); sum += __shfl_xor(sum, 32);
        const float inv = 1.0f / sum;
        if (kr < 4) {
#pragma unroll
            for (int kt = 0; kt < 16; ++kt) *(LAS f32x4*)(pl + kr * 256 + 64 * kq + 4 * kt) = s[kt] * inv; }
        LDS_WAIT(); ATT_FENCE();
        f32x2 acc[4][4];
#pragma unroll
        for (int h = 0; h < 4; ++h)
#pragma unroll
            for (int d = 0; d < 4; ++d) acc[h][d] = (f32x2){0.f, 0.f};
#pragma unroll
        for (int ch = 0; ch < 8; ++ch) {
            if (ch + 2 < 8) { const int c2 = (ch + 2) % 3;
                ix[c2][0] = *(const LAS v4i*)(idl + 64 * kg + 8 * (ch + 2)); ix[c2][1] = *(const LAS v4i*)(idl + 64 * kg + 8 * (ch + 2) + 4);
#pragma unroll
                for (int j = 0; j < 8; ++j) vv[c2][j] = *(const v4u*)(vbase + (size_t)ix[c2][j >> 2][j & 3] * KVD);
                ATT_FENCE(); }
            f32x4 pp[4][2];
#pragma unroll
            for (int h = 0; h < 4; ++h) { pp[h][0] = *(const LAS f32x4*)(pl + h * 256 + 64 * kg + 8 * ch); pp[h][1] = *(const LAS f32x4*)(pl + h * 256 + 64 * kg + 8 * ch + 4); }
#pragma unroll
            for (int j = 0; j < 8; ++j) { const v4u w = vv[ch % 3][j];
                const f32x2 v0 = {bf_lo(w.x), bf_hi(w.x)}, v1 = {bf_lo(w.y), bf_hi(w.y)}, v2 = {bf_lo(w.z), bf_hi(w.z)}, v3 = {bf_lo(w.w), bf_hi(w.w)};
#pragma unroll
                for (int h = 0; h < 4; ++h) { const float p = pp[h][j >> 2][j & 3]; const f32x2 p2 = {p, p};
                    acc[h][0] += p2 * v0; acc[h][1] += p2 * v1; acc[h][2] += p2 * v2; acc[h][3] += p2 * v3; }
            }
        }
#pragma unroll
        for (int h = 0; h < 4; ++h)
#pragma unroll
            for (int d = 0; d < 4; ++d) {
                acc[h][d][0] += __shfl_xor(acc[h][d][0], 16); acc[h][d][1] += __shfl_xor(acc[h][d][1], 16);
                acc[h][d][0] += __shfl_xor(acc[h][d][0], 32); acc[h][d][1] += __shfl_xor(acc[h][d][1], 32); }
        if (kg == 0) {
#pragma unroll
            for (int h = 0; h < 4; ++h) { v4u w; w.x = pk2(acc[h][0][0], acc[h][0][1]); w.y = pk2(acc[h][1][0], acc[h][1][1]); w.z = pk2(acc[h][2][0], acc[h][2][1]); w.w = pk2(acc[h][3][0], acc[h][3][1]);
                *(v4u*)(ao + (size_t)mq * DA + (4 * g + h) * 128 + 8 * dg) = w; } }
        LDS_WAIT(); ATT_FENCE();
        qn = qn2;
    }
}

constexpr int SC_STEPS = 32, SC_STEP_BYTES = 1344, SC_BUF_BYTES = SC_STEPS * SC_STEP_BYTES;
constexpr int SC_Y_OFF = 2 * SC_BUF_BYTES;

template <int CTRL> DI float dpp_add(float x) { return x + __builtin_bit_cast(float, __builtin_amdgcn_update_dpp(0, __builtin_bit_cast(int, x), CTRL, 0xf, 0xf, false)); }
DI float red16(float x) { x = dpp_add<0xB1>(x); x = dpp_add<0x4E>(x); x = dpp_add<0x141>(x); x = dpp_add<0x140>(x); return x; }

struct ScanRaw { v2u rc, rp, kc, kp, vc, vp, ac; f32x4 dc; };
struct ScanConst { f32x4 mu_r, mu_k, mu_v, kkw, kaw, rkw; };
DI f32x4 bf4(const v2u& w) { f32x4 r; r[0] = bf_lo(w.x); r[1] = bf_hi(w.x); r[2] = bf_lo(w.y); r[3] = bf_hi(w.y); return r; }

DI void scan_issue(ScanRaw& R, const unsigned char* ws, int b, int h, int t, int cg) {
    const bf16* rb = (const bf16*)(ws + WS_RB); const bf16* kb = (const bf16*)(ws + WS_KB); const bf16* vb = (const bf16*)(ws + WS_VB);
    const float* decay = (const float*)(ws + WS_DECAY); const bf16* av = (const bf16*)(ws + WS_AOUT);
    const size_t o = (size_t)(b * SEQ + t) * DB + h * HDB + 4 * cg;
    R.rc = *(const v2u*)(rb + o); R.kc = *(const v2u*)(kb + o); R.vc = *(const v2u*)(vb + o); R.dc = *(const f32x4*)(decay + o); R.ac = *(const v2u*)(av + o);
    if (t > 0) { R.rp = *(const v2u*)(rb + o - DB); R.kp = *(const v2u*)(kb + o - DB); R.vp = *(const v2u*)(vb + o - DB); }
    else { R.rp = (v2u){0u, 0u}; R.kp = (v2u){0u, 0u}; R.vp = (v2u){0u, 0u}; }
}
DI void scan_emit(const ScanRaw& R, const ScanConst& C, LAS float* sb, int cg, int qr, float* bonus_dst) {
    const f32x4 rc = bf4(R.rc), rp = bf4(R.rp), kc = bf4(R.kc), kp = bf4(R.kp), vc = bf4(R.vc), vp = bf4(R.vp), a = bf4(R.ac);
    const f32x4 r1 = rc + (rp - rc) * C.mu_r, k0 = kc + (kp - kc) * C.mu_k, v1 = vc + (vp - vc) * C.mu_v;
    const f32x4 kkv = k0 * C.kkw;
    const float nrm = sqrtf(red16((kkv[0] * kkv[0] + kkv[1] * kkv[1]) + (kkv[2] * kkv[2] + kkv[3] * kkv[3])));
    const f32x4 kkn = kkv * (1.0f / fmaxf(nrm, 1e-12f));
    const f32x4 k1 = k0 * (1.0f + (a - 1.0f) * C.kaw);
    const f32x4 rk = r1 * k1 * C.rkw;
    const float bc = red16((rk[0] + rk[1]) + (rk[2] + rk[3]));
    *(LAS f32x4*)(sb + 4 * cg) = R.dc; *(LAS f32x4*)(sb + 64 + 4 * cg) = -kkn; *(LAS f32x4*)(sb + 128 + 4 * cg) = kkn * a;
    *(LAS f32x4*)(sb + 192 + 4 * cg) = k1; *(LAS f32x4*)(sb + 256 + 4 * cg) = r1;
    if ((cg >> 2) == qr) *(LAS f32x4*)(sb + 320 + 4 * (cg & 3)) = v1;
    if (bonus_dst != nullptr && cg == 0) *bonus_dst = bc;
}
DI float red8(float x) { x = dpp_add<0xB1>(x); x = dpp_add<0x4E>(x); x = dpp_add<0x141>(x); return x; }
struct ScanVec { f32x4 w0, w1, a0, a1, b0, b1, k0, k1, r0, r1; float v; };
DI void scan_ld(ScanVec& V, const LAS float* sb, int cg, int vrow) {
    V.w0 = *(const LAS f32x4*)(sb + 8 * cg); V.w1 = *(const LAS f32x4*)(sb + 8 * cg + 4); V.a0 = *(const LAS f32x4*)(sb + 64 + 8 * cg); V.a1 = *(const LAS f32x4*)(sb + 64 + 8 * cg + 4);
    V.b0 = *(const LAS f32x4*)(sb + 128 + 8 * cg); V.b1 = *(const LAS f32x4*)(sb + 128 + 8 * cg + 4); V.k0 = *(const LAS f32x4*)(sb + 192 + 8 * cg); V.k1 = *(const LAS f32x4*)(sb + 192 + 8 * cg + 4);
    V.r0 = *(const LAS f32x4*)(sb + 256 + 8 * cg); V.r1 = *(const LAS f32x4*)(sb + 256 + 8 * cg + 4); V.v = sb[320 + vrow];
}
DI float scan_step(f32x4& s0, f32x4& s1, const ScanVec& V) {
    const f32x4 t0 = s0 * V.w0 + V.k0 * V.v, t1 = s1 * V.w1 + V.k1 * V.v;
    const f32x4 p = s0 * V.a0 + s1 * V.a1;
    const float sa = red8((p[0] + p[1]) + (p[2] + p[3]));
    s0 = t0 + V.b0 * sa; s1 = t1 + V.b1 * sa;
    const f32x4 q = s0 * V.r0 + s1 * V.r1;
    return red8((q[0] + q[1]) + (q[2] + q[3]));
}
DI void lds_signal(LAS unsigned* p, int lane) { asm volatile("s_waitcnt lgkmcnt(0)" ::: "memory"); if (lane == 0) __hip_atomic_fetch_add(p, 1u, __ATOMIC_RELAXED, __HIP_MEMORY_SCOPE_WORKGROUP); }
DI void lds_wait_ge(LAS unsigned* p, unsigned v) {
    unsigned spins = 0;
    while ((unsigned)__builtin_amdgcn_readfirstlane(__hip_atomic_load(p, __ATOMIC_RELAXED, __HIP_MEMORY_SCOPE_WORKGROUP)) < v) { __builtin_amdgcn_s_sleep(1); if (++spins > (1u << 24)) break; }
    asm volatile("" ::: "memory");
}
constexpr int SC_YW_OFF = 2 * SC_BUF_BYTES;
constexpr int SC_NSCAN = 2, SC_NLOAD = 2;

DI void scan_task(const float* const* in, unsigned char* ws, float* y, LAS unsigned char* lds, LAS unsigned* ctr, int task, int wave) {
    const int lane = lane_opaque();
    float* bonus = (float*)(ws + WS_BONUS);
    constexpr int NCHUNK = SEQ / SC_STEPS;
    const int bh = task >> 2, qr = task & 3, b = bh >> 5, h = bh & 31;
    if (wave < SC_NSCAN) {
        const int rl = lane >> 3, cg = lane & 7, vrow = 8 * wave + rl;
        f32x4 s0 = {0.f, 0.f, 0.f, 0.f}, s1 = s0;
        LAS float* yb = (LAS float*)(lds + SC_YW_OFF + wave * 1024);
        for (int c = 0; c < NCHUNK; ++c) {
            lds_wait_ge(ctr, (unsigned)(c + 1)); lds_wait_ge(ctr + 1, (unsigned)(c + 1));
            const LAS unsigned char* buf = lds + (c & 1) * SC_BUF_BYTES;
            ScanVec A, B; scan_ld(A, (const LAS float*)buf, cg, vrow);
#pragma unroll 2
            for (int s = 0; s < SC_STEPS; s += 2) {
                scan_ld(B, (const LAS float*)(buf + (s + 1) * SC_STEP_BYTES), cg, vrow);
                const float y0 = scan_step(s0, s1, A);
                if (s + 2 < SC_STEPS) scan_ld(A, (const LAS float*)(buf + (s + 2) * SC_STEP_BYTES), cg, vrow);
                const float y1 = scan_step(s0, s1, B);
                if (cg == 0) { yb[s * 8 + rl] = y0; yb[(s + 1) * 8 + rl] = y1; }
            }
            lds_signal(ctr + 2 + wave, lane);
            { const int s = lane >> 1, hf = lane & 1, t = c * SC_STEPS + s;
              *(f32x4*)(y + (size_t)(b * SEQ + t) * DB + h * HDB + 16 * qr + 8 * wave + 4 * hf) = *(const LAS f32x4*)(yb + s * 8 + 4 * hf); }
            asm volatile("s_waitcnt lgkmcnt(0)" ::: "memory");
        }
    } else if (wave < SC_NSCAN + SC_NLOAD) {
        const int lw = wave - SC_NSCAN, rl = lane >> 4, cg = lane & 15, col0 = h * HDB + 4 * cg;
        ScanConst C; C.mu_r = *(const f32x4*)(in[I_MU_RKV] + col0); C.mu_k = *(const f32x4*)(in[I_MU_RKV] + DB + col0); C.mu_v = *(const f32x4*)(in[I_MU_RKV] + 2 * DB + col0);
        C.kkw = *(const f32x4*)(in[I_KK] + col0); C.kaw = *(const f32x4*)(in[I_KA] + col0); C.rkw = *(const f32x4*)(in[I_RK] + col0);
        ScanRaw R[4];
#pragma unroll
        for (int p = 0; p < 4; ++p) scan_issue(R[p], ws, b, h, 4 * (lw + 2 * p) + rl, cg);
        for (int c = 0; c < NCHUNK; ++c) {
            if (c >= 2) { lds_wait_ge(ctr + 2, (unsigned)(c - 1)); lds_wait_ge(ctr + 3, (unsigned)(c - 1)); }
            LAS float* base = (LAS float*)(lds + (c & 1) * SC_BUF_BYTES); const int t0 = c * SC_STEPS;
#pragma unroll
            for (int p = 0; p < 4; ++p) { const int st = 4 * (lw + 2 * p) + rl;
                scan_emit(R[p], C, base + st * (SC_STEP_BYTES / 4), cg, qr, qr == 0 ? bonus + (size_t)(b * SEQ + t0 + st) * NHB + h : nullptr);
                if (c + 1 < NCHUNK) scan_issue(R[p], ws, b, h, t0 + SC_STEPS + st, cg); }
            lds_signal(ctr + lw, lane);
        }
    }
}

constexpr int ATT_LDS_OFF = 90112;
constexpr int ATT_LDS_OFF2 = 132096;
DI void scan_attn_phase(const float* const* in, unsigned char* ws, float* y, LAS unsigned char* lds, LAS unsigned char* lds_all, LAS unsigned* ctr, int wave) {
    bool first = true;
    for (int task = blockIdx.x; task < BATCH * NHB * 4 || first; task += gridDim.x) {
        __syncthreads();
        if (wave == 0 && lane_opaque() == 0) { ((LAS v4u*)ctr)[0] = (v4u){0u, 0u, 0u, 0u}; ((LAS v4u*)ctr)[1] = (v4u){0u, 0u, 0u, 0u}; }
        __syncthreads();
        if (task < BATCH * NHB * 4) scan_task(in, ws, y, lds, ctr, task, wave);
        if (first) {
            LAS unsigned char* mine = wave >= 3 ? lds + ATT_LDS_OFF + (wave - 3) * 8192 : lds_all + ATT_LDS_OFF2 + wave * 5120;
            attn_worker(ws, mine, ctr + 4, wave);
            if (wave >= 3) { const int lane = lane_opaque(); constexpr int NSIDE = A1_NITEMS + W2_NITEMS; const int nmine = (NSIDE - (int)blockIdx.x + (int)gridDim.x - 1) / (int)gridDim.x;
                for (;;) { unsigned v_ = 0u; if (lane == 0) v_ = __hip_atomic_fetch_add(ctr + 5, 1u, __ATOMIC_RELAXED, __HIP_MEMORY_SCOPE_WORKGROUP);
                    const int i = __builtin_amdgcn_readfirstlane((int)v_); if (i >= nmine) break;
                    const int it = (int)blockIdx.x + i * (int)gridDim.x;
                    if (it < A1_NITEMS) convert_a1_item(in, ws, (LAS unsigned*)mine, it, lane); else convert_w2_item(in, ws, (LAS unsigned*)mine, it - A1_NITEMS, lane); } }
        }
        first = false;
    }
}

DI void gn_phase(const float* const* in, unsigned char* ws, const float* y, int gw, int NGW, int lane) {
    const bf16* vb = (const bf16*)(ws + WS_VB); const bf16* gout = (const bf16*)(ws + WS_GOUT);
    const float* bonus = (const float*)(ws + WS_BONUS); bf16* ro = (bf16*)(ws + WS_AO) + (size_t)M * DB;
    const int per = (M * 8 + NGW - 1) / NGW, it0 = gw * per, it1 = (it0 + per < M * 8) ? it0 + per : M * 8;
    const int hh = lane >> 4, cg = lane & 15;
#pragma unroll 2
    for (int it = it0; it < it1; ++it) {
        const int m = it >> 3, h = (it & 7) * 4 + hh, col = h * HDB + 4 * cg; const size_t o = (size_t)m * DB + col;
        const f32x4 yv = *(const f32x4*)(y + o);
        const f32x4 vc = bf4(*(const v2u*)(vb + o)), g4 = bf4(*(const v2u*)(gout + o));
        f32x4 vp = {0.f, 0.f, 0.f, 0.f}; if (m & (SEQ - 1)) vp = bf4(*(const v2u*)(vb + o - DB));
        const float bc = bonus[(size_t)m * NHB + h];
        const f32x4 lw = *(const f32x4*)(in[I_LNW] + col), lb = *(const f32x4*)(in[I_LNB] + col), muv = *(const f32x4*)(in[I_MU_RKV] + 2 * DB + col);
        const float mean = red16((yv[0] + yv[1]) + (yv[2] + yv[3])) * (1.0f / 64.0f); const f32x4 d = yv - mean;
        const float var = red16((d[0] * d[0] + d[1] * d[1]) + (d[2] * d[2] + d[3] * d[3])) * (1.0f / 64.0f);
        const f32x4 yn = d * (1.0f / sqrtf(var + GN_EPS)) * lw + lb;
        const f32x4 v1 = vc + (vp - vc) * muv;
        const f32x4 res = (yn + v1 * bc) * g4;
        v2u w; w.x = pk2(res[0], res[1]); w.y = pk2(res[2], res[3]);
        *(v2u*)(ro + o) = w;
    }
}

DI void final_phase(const float* const* in, unsigned char* ws, float* out, int gw, int NGW, int lane) {
    const float* ss3 = (const float*)(ws + SS3_OFF); const float* nf = in[I_NORM_FINAL];
    for (int m = gw; m < M; m += NGW) { const float r = 1.0f / sqrtf(ss3[m] * (1.0f / D) + RMS_EPS);
        GAS f32x4* o = (GAS f32x4*)(out + (size_t)m * D) + lane; const GAS f32x4* g = (const GAS f32x4*)nf + lane;
#pragma unroll 4
        for (int j = 0; j < 16; ++j) { f32x4 v = o[64 * j]; const f32x4 gg = g[64 * j]; v = v * r * gg; o[64 * j] = v; } }
}

#ifndef MK_N_LAUNCHES
#define MK_N_LAUNCHES 1
#endif
constexpr int N_PHASES = 13;
#ifndef REP_P2
#define REP_P2 1
#endif
#ifndef REP_P3
#define REP_P3 1
#endif
#ifndef REP_P6
#define REP_P6 1
#endif
#ifndef REP_P7
#define REP_P7 1
#endif
#ifndef REP_P10
#define REP_P10 1
#endif
#ifndef REP_C
#define REP_C 1
#endif
#ifndef PG8_SP2
#define PG8_SP2 true
#endif
#ifndef PG8_ALIGN
#define PG8_ALIGN true
#endif

__global__ void __launch_bounds__(NWAVES * 64, 2) hybrid_fwd(Args args) {
    extern __shared__ __attribute__((aligned(16))) unsigned char lds_raw[];
    LAS unsigned char* lds = (LAS unsigned char*)lds_raw;
    volatile LAS unsigned* MISC = (volatile LAS unsigned*)(lds + MISC_OFF);
    const int wave = __builtin_amdgcn_readfirstlane(threadIdx.x >> 6);
    const int G = gridDim.x, gw = blockIdx.x * NWAVES + wave, NGW = G * NWAVES;
    unsigned char* ws = args.ws; const float* const* in = args.in;
    { const int tid0 = wave * 64 + lane_opaque(); for (int u = tid0; u < (LDS_BYTES - LDSCTL_OFF) / 4; u += NWAVES * 64) ((LAS unsigned*)(lds + LDSCTL_OFF))[u] = 0u; }
    __syncthreads();
    unsigned* ctl = (unsigned*)(ws + WS_CTL);
    XcdBarrier bar; bar.bar = ctl + CW_BAR; bar.x = 0; bar.st = nullptr;
    const bool multi = (args.ph_hi - args.ph_lo) > 1;
    if (multi) bar = xcd_barrier_post(ctl + CW_BAR, MISC + 8, wave == 0 && lane_opaque() == 0);
    const int lo = args.ph_lo, hi = args.ph_hi;
#ifndef PHASE_MASK
#define PHASE_MASK 0x3fff
#endif
#define IN(k) ((((PHASE_MASK) >> (k)) & 1) && lo <= (k) && (k) < hi)
#define SEAM(k) do { if (IN(k) && IN((k) + 1)) xcd_barrier(bar, wave == 0 && lane_opaque() == 0); } while (0)
#define LANE lane_opaque()
    LAS unsigned* scr = (LAS unsigned*)(lds + RING_OFF + wave * 16384);

    if (IN(0)) { const int lane = LANE; for (int rep = 0; rep < REP_C; ++rep) { convert_set_a(in, ws, scr, gw, NGW, lane); prologue_rows(in, ws, gw, NGW, lane); } }
    SEAM(0);
    if (IN(1)) {
        pg8::Gemm g{(const bf16*)(ws + WS_XB), (const bf16*)(ws + WS_WCAT), M, NCAT, D}; pg8::StaticOrder S; S.init(M, NCAT, G, (int)blockIdx.x);
        epi::InProj E{(bf16*)(ws + WS_Q), (bf16*)(ws + WS_K), (bf16*)(ws + WS_V), (bf16*)(ws + WS_QI), (bf16*)(ws + WS_KI), (bf16*)(ws + WS_RB), (bf16*)(ws + WS_KB), (bf16*)(ws + WS_VB),
                      (bf16*)(ws + WS_LORA), (bf16*)(ws + WS_GATES), (float*)(ws + WS_WI), (const float*)(ws + WS_RSTDX), (const float*)(ws + WS_RCOS), (const float*)(ws + WS_RSIN)};
        pg8::gemm_phase<epi::InProj, pg8::StaticOrder, PG8_ALIGN, PG8_SP2>(lds + RING_OFF, g, S, E, wave);
#if defined(REP_P1)
        pg8::gemm_phase<epi::InProj, pg8::StaticOrder, PG8_ALIGN, PG8_SP2>(lds + RING_OFF, g, S, E, wave);
#endif
    }
    SEAM(1);
    if (IN(2)) { for (int rep = 0; rep < REP_P2; ++rep) indexer_phase(ws, lds + RING_OFF, wave); }
    SEAM(2);
    if (IN(4)) build_alora(ws, blockIdx.x * (NWAVES * 64) + wave * 64 + LANE, G * NWAVES * 64);
    SEAM(4);
    if (IN(5)) {
        int k256 = 256; asm volatile("" : "+s"(k256));
        pg8::Gemm g{(const bf16*)(ws + WS_ALORA), (const bf16*)(ws + WS_WL2), 3 * M, 3 * DB, k256}; epi::Stack3Order S{G, (int)blockIdx.x};
        epi::LoraUp E{(float*)(ws + WS_DECAY), (bf16*)(ws + WS_AOUT), (bf16*)(ws + WS_GOUT), in[I_W0], in[I_A0]};
        pg8::gemm_phase<epi::LoraUp, epi::Stack3Order, PG8_ALIGN, PG8_SP2>(lds + RING_OFF, g, S, E, wave);
    }
    SEAM(5);
    if (IN(6)) { for (int rep = 0; rep < REP_P6; ++rep) scan_attn_phase(in, ws, args.out, lds + RING_OFF, lds, (LAS unsigned*)(lds + MISC_OFF + 64), wave); }
    SEAM(6);
    if (IN(7)) { for (int rep = 0; rep < REP_P7; ++rep) gn_phase(in, ws, args.out, gw, NGW, LANE); }
    if (IN(7)) { const int lane = LANE; __syncthreads(); for (int rep = 0; rep < REP_C; ++rep) convert_set_b(in, ws, scr, gw, NGW, lane); }
    SEAM(7);
    if (IN(8)) {
        pg8::Gemm g{(const bf16*)(ws + WS_AO), (const bf16*)(ws + WS_WPAB), 2 * M, 2 * D, DA}; epi::ChainOrder S; S.so.init(M, D, G, (int)blockIdx.x);
        epi::GateMix E{(const bf16*)(ws + WS_GATES), in[I_BGATE], (bf16*)(ws + WS_MIX)};
        pg8::gemm_phase<epi::GateMix, epi::ChainOrder, PG8_ALIGN, PG8_SP2>(lds + RING_OFF, g, S, E, wave);
#if defined(REP_P8)
        pg8::gemm_phase<epi::GateMix, epi::ChainOrder, PG8_ALIGN, PG8_SP2>(lds + RING_OFF, g, S, E, wave);
#endif
    }
    SEAM(8);
    if (IN(9)) {
        pg8::Gemm g{(const bf16*)(ws + WS_MIX), (const bf16*)(ws + WS_WO), M, D, D}; pg8::StaticOrder S; S.init(M, D, G, (int)blockIdx.x);
        epi::Resid E{in[I_X], args.out, (bf16*)(ws + WS_H1B), (float*)(ws + SS1_OFF)};
        pg8::gemm_phase<epi::Resid, pg8::StaticOrder, PG8_ALIGN, PG8_SP2>(lds + RING_OFF, g, S, E, wave);
    }
    SEAM(9);
    if (IN(10)) {
        pg8::Gemm g{(const bf16*)(ws + WS_H1B), (const bf16*)(ws + WS_W13), M, N13, D}; pg8::StaticOrder S; S.init(M, N13, G, (int)blockIdx.x);
        epi::FfnUp E{(const float*)(ws + SS1_OFF), (bf16*)(ws + WS_U)};
        pg8::gemm_phase<epi::FfnUp, pg8::StaticOrder, PG8_ALIGN, PG8_SP2>(lds + RING_OFF, g, S, E, wave);
#if REP_P10 > 1
        pg8::gemm_phase<epi::FfnUp, pg8::StaticOrder, PG8_ALIGN, PG8_SP2>(lds + RING_OFF, g, S, E, wave);
#endif
    }
    SEAM(10);
    if (IN(11)) {
        { pg8::Gemm g{(const bf16*)(ws + WS_U), (const bf16*)(ws + WS_W2), M, D, DFF}; pg8::StaticOrder S; S.init(M, D, G, (int)blockIdx.x);
          epi::Resid E{args.out, args.out, (bf16*)(ws + WS_H2B), (float*)(ws + SS2_OFF)};
          pg8::gemm_phase<epi::Resid, pg8::StaticOrder, PG8_ALIGN, PG8_SP2>(lds + RING_OFF, g, S, E, wave); }
        { int k256 = 256; asm volatile("" : "+s"(k256));
          pg8::Gemm g{(const bf16*)(ws + WS_PB), (const bf16*)(ws + WS_WPLE), M, D, k256}; pg8::StaticOrder S; S.init(M, D, G, (int)blockIdx.x);
          epi::StoreBf E{(bf16*)(ws + WS_PP), D};
          pg8::gemm_phase<epi::StoreBf, pg8::StaticOrder, PG8_ALIGN, PG8_SP2>(lds + RING_OFF, g, S, E, wave); }
    }
    SEAM(11);
    if (IN(12)) {
        pg8::Gemm g{(const bf16*)(ws + WS_H2B), (const bf16*)(ws + WS_WPG), M, D, D}; pg8::StaticOrder S; S.init(M, D, G, (int)blockIdx.x);
        epi::PleGate E{args.out, (const bf16*)(ws + WS_PP), (const float*)(ws + SS2_OFF), (float*)(ws + SS3_OFF)};
        pg8::gemm_phase<epi::PleGate, pg8::StaticOrder, PG8_ALIGN, PG8_SP2>(lds + RING_OFF, g, S, E, wave);
    }
    SEAM(12);
    if (IN(13)) final_phase(in, ws, args.out, gw, NGW, LANE);
#undef IN
#undef SEAM
#undef LANE
}

extern "C" void kernel_launch(void* const* d_in, const int* in_sizes, int n_in, void* d_out, int out_size, void* d_ws, size_t ws_size, hipStream_t stream) {
    static int grid = 0;
    if (grid == 0) {
        if (n_in != 32 || in_sizes[0] != M * D || out_size != M * D || ws_size < WS_END) { fprintf(stderr, "kernel_launch: unexpected shapes: n_in %d in0 %d out %d ws %zu (need %zu)\n", n_in, n_in > 0 ? in_sizes[0] : -1, out_size, ws_size, (size_t)WS_END); grid = -1; return; }
        int dev = 0, cus = 0, per_cu = 0;
        if (hipGetDevice(&dev) != hipSuccess || hipDeviceGetAttribute(&cus, hipDeviceAttributeMultiprocessorCount, dev) != hipSuccess) { grid = -1; return; }
        if (hipFuncSetAttribute((const void*)hybrid_fwd, hipFuncAttributeMaxDynamicSharedMemorySize, LDS_BYTES) != hipSuccess) { fprintf(stderr, "kernel_launch: hipFuncSetAttribute failed\n"); grid = -1; return; }
        if (hipOccupancyMaxActiveBlocksPerMultiprocessor(&per_cu, (const void*)hybrid_fwd, NWAVES * 64, LDS_BYTES) != hipSuccess || per_cu < 1) fprintf(stderr, "kernel_launch: occupancy query says %d\n", per_cu);
        (void)hipGetLastError();
        grid = cus;
    }
    if (grid < 0) return;
    if (hipMemsetAsync((char*)d_ws + WS_CTL, 0, CTL_ZERO_BYTES, stream) != hipSuccess) return;
    Args a{};
    for (int i = 0; i < 32; ++i) a.in[i] = (const float*)d_in[i];
    a.out = (float*)d_out; a.ws = (unsigned char*)d_ws;
#if MK_N_LAUNCHES == 1
    a.ph_lo = 0; a.ph_hi = N_PHASES + 1;
    hipLaunchKernelGGL(hybrid_fwd, dim3(grid), dim3(NWAVES * 64), LDS_BYTES, stream, a);
#else
    for (int p = 0; p <= N_PHASES; ++p) { a.ph_lo = p; a.ph_hi = p + 1; hipLaunchKernelGGL(hybrid_fwd, dim3(grid), dim3(NWAVES * 64), LDS_BYTES, stream, a); }
#endif
}
```

```cpp
#include <hip/hip_runtime.h>
#include <cstdio>
#include <cstdint>
__device__ __forceinline__ int lane_opaque() { int l; asm volatile("v_mbcnt_lo_u32_b32 %0, -1, 0\n\tv_mbcnt_hi_u32_b32 %0, -1, %0" : "=v"(l)); return l; }

namespace pg8 {
#define PG8_LAS __attribute__((address_space(3)))
typedef unsigned short bf16_t;
typedef short bf16x8 __attribute__((ext_vector_type(8)));
typedef float f32x4 __attribute__((ext_vector_type(4)));
typedef unsigned u32x4 __attribute__((ext_vector_type(4)));
constexpr int BM = 256, BK = 64, HALF = 128, HTB = HALF * BK * 2  , STAGE_BYTES = 8 * HTB, NXCD = 8, WGM = 8;

__host__ __device__ __forceinline__ int lds_byte(int r, int c) { const int st = (r >> 4) * 2 + (c >> 5), rr = r & 15, cc = c & 31, ob = rr * 64 + cc * 2; return st * 1024 + (ob ^ (((ob >> 9) & 1) << 5)); }
__host__ __device__ __forceinline__ void stage_rc(int b, int& R, int& C) { const int st = b / 1024, sb = b % 1024, swz = sb ^ (((sb >> 9) & 1) << 5); R = (st >> 1) * 16 + swz / 64; C = (st & 1) * 32 + (swz % 64) / 2; }
__host__ __device__ __forceinline__ int perm32(int rho) { const int n = rho >> 4, i = rho & 15; return 8 * (i >> 2) + 4 * n + (i & 3); }

struct Unit { int pm, pn; };
struct Gemm { const bf16_t* A; const bf16_t* Bt; int M, N, K; };

struct StaticOrder {
    int nM, nN, nwg, G, c;
    __host__ __device__ void init(int M, int N, int G_, int c_) { nM = M / BM; nN = N / BM; nwg = nM * nN; G = G_; c = c_; }
    __host__ __device__ bool next(int i, Unit& u) const {
        const long L = (long)i * G + c; if (L >= nwg) return false;
        int wgid = (int)L; { const int q = nwg / NXCD, r = nwg % NXCD, xcd = wgid % NXCD, off = wgid / NXCD; wgid = (xcd < r ? xcd * (q + 1) : r * (q + 1) + (xcd - r) * q) + off; }
        const int nig = WGM * nN, gid = wgid / nig, fm = gid * WGM, gsz = (nM - fm) < WGM ? (nM - fm) : WGM;
        u.pm = fm + ((wgid % nig) % gsz); u.pn = (wgid % nig) / gsz; return true;
    }
    __device__ __forceinline__ void a_ready(const Unit&) const {}
    __device__ __forceinline__ void done(const Unit&) const {}
};
__device__ __forceinline__ unsigned cvt_pk_bf16(float lo, float hi) { unsigned r; asm volatile("v_cvt_pk_bf16_f32 %0, %1, %2" : "=v"(r) : "v"(lo), "v"(hi)); return r; }
template <class Epi, class Sched, bool ALIGN_EPI = false, bool SP2 = false>
__device__ __forceinline__ void gemm_phase(PG8_LAS unsigned char* lds, const Gemm g, const Sched& S, const Epi& E, const int wid) {
    const int lane = lane_opaque(), tid = wid * 64 + lane, wr = wid >> 2, wc = wid & 3, fr = lane & 15, fq = lane >> 4;
    const int K = g.K, nt = K / BK;
    unsigned voffA[2], voffB[2];
#pragma unroll
    for (int i = 0; i < 2; ++i) { int R, C; stage_rc(tid * 16 + i * 8192, R, C); const int Rb = Epi::PERM ? ((R & ~31) + perm32(R & 31)) : R;
        voffA[i] = (unsigned)(R * K + C) * 2u; voffB[i] = (unsigned)(Rb * K + C) * 2u; }
    const size_t kstep = (size_t)(BK * 2);
    const size_t hstep = (size_t)HALF * K * 2;
    const size_t tstep = 2 * hstep;
    const unsigned ldsw = (unsigned)wid * 1024u;
    const int aoff = lds_byte(wr * 64 + fr, fq * 8), boff = lds_byte(wc * 32 + fr, fq * 8);
#define PG8_SA(b, h) (((b) * 2 + (h)) * HTB)
#define PG8_SB(b, h) ((4 + (b) * 2 + (h)) * HTB)
#define PG8_STAGE(bufoff, gbase, voff) do { _Pragma("unroll") for (int _i = 0; _i < 2; ++_i) \
        __builtin_amdgcn_global_load_lds((const unsigned*)((const char*)(gbase) + (voff)[_i]), (PG8_LAS unsigned*)(lds + (bufoff) + ldsw + _i * 8192), 16, 0, 0); } while (0)
#define PG8_LDA(dst, b, h) do { _Pragma("unroll") for (int m = 0; m < 4; ++m) _Pragma("unroll") for (int k = 0; k < 2; ++k) dst[m][k] = *(const PG8_LAS bf16x8*)(lds + PG8_SA(b, h) + aoff + m * 2048 + k * 1024); } while (0)
#define PG8_LDB(dst, b, h) do { _Pragma("unroll") for (int n = 0; n < 2; ++n) _Pragma("unroll") for (int k = 0; k < 2; ++k) dst[n][k] = *(const PG8_LAS bf16x8*)(lds + PG8_SB(b, h) + boff + n * 2048 + k * 1024); } while (0)
#define PG8_MMA(ai, bj, At, Bt) do { __builtin_amdgcn_s_setprio(1); _Pragma("unroll") for (int m = 0; m < 4; ++m) _Pragma("unroll") for (int n = 0; n < 2; ++n) _Pragma("unroll") for (int k = 0; k < 2; ++k) \
        acc[ai][bj][m][n] = __builtin_amdgcn_mfma_f32_16x16x32_bf16(Bt[n][k], At[m][k], acc[ai][bj][m][n], 0, 0, 0); __builtin_amdgcn_s_setprio(0); } while (0)
#define PG8_WAIT_V(n) asm volatile("s_waitcnt vmcnt(" #n ")" ::: "memory")
#define PG8_WAIT_L(n) asm volatile("s_waitcnt lgkmcnt(" #n ")" ::: "memory")
#define PG8_BAR __builtin_amdgcn_s_barrier()
#define PG8_SCHED __builtin_amdgcn_sched_barrier(0)
    Unit cur, nxt; int ui = 0;
    if (!S.next(0, cur)) return;
    f32x4 acc[2][2][4][2];
#pragma unroll
    for (int a = 0; a < 2; ++a)
#pragma unroll
        for (int b = 0; b < 2; ++b)
#pragma unroll
            for (int m = 0; m < 4; ++m)
#pragma unroll
                for (int n = 0; n < 2; ++n) acc[a][b][m][n] = (f32x4){0.f, 0.f, 0.f, 0.f};
    bf16x8 At[4][2], B0[2][2], B1[2][2];
    const char* cA = (const char*)g.A + (size_t)cur.pm * tstep; const char* cB = (const char*)g.Bt + (size_t)cur.pn * tstep;
    S.a_ready(cur);
    if constexpr (SP2) {
        PG8_STAGE(PG8_SB(0, 0), cB, voffB); PG8_STAGE(PG8_SB(0, 1), cB + hstep, voffB); PG8_STAGE(PG8_SA(0, 0), cA, voffA); PG8_STAGE(PG8_SA(0, 1), cA + hstep, voffA);
        if (wr == 1) PG8_BAR;
        PG8_WAIT_V(2); PG8_BAR;
        PG8_STAGE(PG8_SB(1, 0), cB + kstep, voffB); PG8_STAGE(PG8_SA(1, 0), cA + kstep, voffA); PG8_STAGE(PG8_SB(1, 1), cB + hstep + kstep, voffB);
        PG8_WAIT_V(6); PG8_BAR;
    } else {
        PG8_STAGE(PG8_SB(0, 0), cB, voffB); PG8_STAGE(PG8_SA(0, 0), cA, voffA); PG8_STAGE(PG8_SB(0, 1), cB + hstep, voffB); PG8_STAGE(PG8_SA(0, 1), cA + hstep, voffA);
        if (wr == 1) PG8_BAR;
        PG8_WAIT_V(4); PG8_BAR;
        PG8_STAGE(PG8_SB(1, 0), cB + kstep, voffB); PG8_STAGE(PG8_SA(1, 0), cA + kstep, voffA); PG8_STAGE(PG8_SB(1, 1), cB + hstep + kstep, voffB);
        PG8_WAIT_V(6); PG8_BAR;
    }
    for (;;) {
        const bool has_next = S.next(ui + 1, nxt);
        const char* nA = has_next ? (const char*)g.A + (size_t)nxt.pm * tstep : cA; const char* nB = has_next ? (const char*)g.Bt + (size_t)nxt.pn * tstep : cB;
        for (int t = 0; t < nt; t += 2) {
            const bool last = (t == nt - 2);
            const char* a1 = cA + (size_t)(t + 1) * kstep;
            const char* a2 = last ? nA : cA + (size_t)(t + 2) * kstep; const char* b2 = last ? nB : cB + (size_t)(t + 2) * kstep;
            const char* a3 = a2 + kstep; const char* b3 = b2 + kstep;
            if (last && has_next) S.a_ready(nxt);
            if constexpr (SP2) {
            PG8_LDB(B0, 0, 0); PG8_LDB(B1, 0, 1); PG8_SCHED; PG8_LDA(At, 0, 0); PG8_STAGE(PG8_SA(1, 1), a1 + hstep, voffA);
            PG8_WAIT_V(8); PG8_WAIT_L(0); PG8_BAR; PG8_MMA(0, 0, At, B0); PG8_MMA(0, 1, At, B1); PG8_BAR; PG8_SCHED;
            PG8_LDA(At, 0, 1); PG8_STAGE(PG8_SB(0, 0), b2, voffB); PG8_STAGE(PG8_SB(0, 1), b2 + hstep, voffB); PG8_STAGE(PG8_SA(0, 0), a2, voffA);
            PG8_WAIT_V(8); PG8_WAIT_L(0); PG8_BAR; PG8_MMA(1, 0, At, B0); PG8_MMA(1, 1, At, B1); PG8_BAR; PG8_SCHED;
            PG8_LDB(B0, 1, 0); PG8_LDB(B1, 1, 1); PG8_SCHED; PG8_LDA(At, 1, 0); PG8_STAGE(PG8_SA(0, 1), a2 + hstep, voffA);
            PG8_WAIT_V(8); PG8_WAIT_L(0); PG8_BAR; PG8_MMA(0, 0, At, B0); PG8_MMA(0, 1, At, B1); PG8_BAR; PG8_SCHED;
            PG8_LDA(At, 1, 1); PG8_STAGE(PG8_SB(1, 0), b3, voffB); PG8_STAGE(PG8_SB(1, 1), b3 + hstep, voffB); PG8_STAGE(PG8_SA(1, 0), a3, voffA);
            PG8_WAIT_V(8); PG8_WAIT_L(0); PG8_BAR; PG8_MMA(1, 0, At, B0); PG8_MMA(1, 1, At, B1); PG8_BAR; PG8_SCHED;
            } else {
            PG8_LDB(B0, 0, 0); PG8_SCHED; PG8_LDA(At, 0, 0); PG8_STAGE(PG8_SA(1, 1), a1 + hstep, voffA);
            PG8_WAIT_L(8); PG8_BAR; PG8_WAIT_L(0); PG8_MMA(0, 0, At, B0); PG8_BAR; PG8_SCHED;
            PG8_LDB(B1, 0, 1); PG8_STAGE(PG8_SB(0, 0), b2, voffB);
            PG8_BAR; PG8_WAIT_L(0); PG8_MMA(0, 1, At, B1); PG8_BAR;
            PG8_LDA(At, 0, 1); PG8_STAGE(PG8_SA(0, 0), a2, voffA);
            PG8_BAR; PG8_WAIT_L(0); PG8_MMA(1, 0, At, B0); PG8_BAR; PG8_SCHED;
            PG8_STAGE(PG8_SB(0, 1), b2 + hstep, voffB);
            PG8_WAIT_V(6); PG8_BAR; PG8_MMA(1, 1, At, B1); PG8_BAR;
            PG8_LDB(B0, 1, 0); PG8_SCHED; PG8_LDA(At, 1, 0); PG8_STAGE(PG8_SA(0, 1), a2 + hstep, voffA);
            PG8_WAIT_L(8); PG8_BAR; PG8_WAIT_L(0); PG8_MMA(0, 0, At, B0); PG8_BAR; PG8_SCHED;
            PG8_LDB(B1, 1, 1); PG8_STAGE(PG8_SB(1, 0), b3, voffB);
            PG8_BAR; PG8_WAIT_L(0); PG8_MMA(0, 1, At, B1); PG8_BAR;
            PG8_LDA(At, 1, 1); PG8_STAGE(PG8_SA(1, 0), a3, voffA);
            PG8_BAR; PG8_WAIT_L(0); PG8_MMA(1, 0, At, B0); PG8_BAR; PG8_SCHED;
            PG8_STAGE(PG8_SB(1, 1), b3 + hstep, voffB);
            PG8_WAIT_V(6); PG8_BAR; PG8_MMA(1, 1, At, B1); PG8_BAR;
            }
        }
        if constexpr (ALIGN_EPI) { if (wr == 0) PG8_BAR; }
        if constexpr (!Epi::AFTER_DRAIN) { E(acc, cur, wr, wc, fr, fq); S.done(cur); }
        if (!has_next) break;
        if (!Epi::CHAIN || !E.keep(cur)) {
#pragma unroll
        for (int a = 0; a < 2; ++a)
#pragma unroll
            for (int b = 0; b < 2; ++b)
#pragma unroll
                for (int m = 0; m < 4; ++m)
#pragma unroll
                    for (int n = 0; n < 2; ++n) acc[a][b][m][n] = (f32x4){0.f, 0.f, 0.f, 0.f};
        }
        cur = nxt; cA = nA; cB = nB; ++ui;
        if constexpr (ALIGN_EPI) { if (wr == 1) PG8_BAR; }
    }
    PG8_WAIT_V(0);
    if constexpr (!ALIGN_EPI) { if (wr == 0) PG8_BAR; }
    PG8_BAR;
    if constexpr (Epi::AFTER_DRAIN) { E.fused(acc, cur, wr, wc, fr, fq, lds, wid, lane); S.done(cur); }
#undef PG8_SA
#undef PG8_SB
#undef PG8_STAGE
#undef PG8_LDA
#undef PG8_LDB
#undef PG8_MMA
#undef PG8_WAIT_V
#undef PG8_WAIT_L
#undef PG8_BAR
#undef PG8_SCHED
}
}

#define LAS __attribute__((address_space(3)))
#define XB_TMO      128
#define XB_XCNT(j)  (256  + 64 * (j))
#define XB_XSUB(j)  (1280 + 64 * (j))
#define XB_XGEN(j)  (2304 + 64 * (j))
#define XB_TOP      3328
#define XB_TOPGEN   3392
#define XCD_BAR_WORDS 3456
#define XB_SPIN_CAP (1u << 18)

__device__ __forceinline__ unsigned xb_ld(unsigned* p)              { return __hip_atomic_load(p, __ATOMIC_RELAXED, __HIP_MEMORY_SCOPE_AGENT); }
__device__ __forceinline__ unsigned xb_add(unsigned* p, unsigned v) { return __hip_atomic_fetch_add(p, v, __ATOMIC_RELAXED, __HIP_MEMORY_SCOPE_AGENT); }
__device__ __forceinline__ unsigned xb_xcc_id() { return (unsigned)__builtin_amdgcn_s_getreg((3 << 11) | 20) & 0xFu; }
#define XB_SPIN(cond, bar) do { unsigned _sp = 0; while (cond) { __builtin_amdgcn_s_sleep(1); \
    if ((++_sp & 255u) == 0u) { if (xb_ld(&(bar)[XB_TMO])) break; if (_sp > XB_SPIN_CAP) { atomicAdd(&(bar)[XB_TMO], 1u); break; } } } } while (0)

struct XcdBarrier {
    unsigned* bar; unsigned x;
    volatile LAS unsigned* st;
};

__device__ __forceinline__ XcdBarrier xcd_barrier_post(unsigned* bar, volatile LAS unsigned* st, const bool leader  ) {
    XcdBarrier b; b.bar = bar; b.x = xb_xcc_id(); b.st = st;
    if (leader) (void)xb_add(&bar[XB_XCNT(b.x)], 1u);
    return b;
}
__device__ __forceinline__ void xcd_barrier_complete(unsigned* bar, unsigned x, unsigned& nloc, unsigned& nx) {
    const unsigned G = gridDim.x * gridDim.y * gridDim.z;
    unsigned sum, cnt, mine, sp = 0u;
    for (;;) {
        sum = 0u; cnt = 0u; mine = 0u;
#pragma unroll
        for (unsigned j = 0; j < 16; ++j) { const unsigned c = xb_ld(&bar[XB_XCNT(j)]); sum += c; cnt += (c > 0u) ? 1u : 0u; mine = (j == x) ? c : mine; }
        if (sum == G) break;
        __builtin_amdgcn_s_sleep(1);
        if ((++sp & 255u) == 0u) { if (xb_ld(&bar[XB_TMO])) break; if (sp > XB_SPIN_CAP) { atomicAdd(&bar[XB_TMO], 1u); break; } }
    }
    nloc = mine > 0u ? mine : 1u; nx = cnt > 0u ? cnt : 1u;
}

__device__ __forceinline__ void xcd_barrier(const XcdBarrier& b, const bool leader  ) {
    asm volatile("s_waitcnt vmcnt(0)" ::: "memory");
    __syncthreads();
    if (leader) {
        unsigned* bar = b.bar;
        __builtin_amdgcn_s_waitcnt(0);
        unsigned nloc = b.st[0], nx = b.st[1];
        if (nloc == 0u) { xcd_barrier_complete(bar, b.x, nloc, nx); b.st[0] = nloc; b.st[1] = nx; }
        const unsigned old = xb_add(&bar[XB_XSUB(b.x)], 1u);
        const unsigned gen = old / nloc;
        if (old + 1u == (gen + 1u) * nloc) {
            __builtin_amdgcn_fence(__ATOMIC_RELEASE, "agent");
            asm volatile("s_waitcnt vmcnt(0)" ::: "memory");
            const unsigned og = xb_add(&bar[XB_TOP], 1u);
            const unsigned tg = og / nx;
            if (og + 1u == (tg + 1u) * nx) xb_add(&bar[XB_TOPGEN], 1u);
            else XB_SPIN(xb_ld(&bar[XB_TOPGEN]) == tg, bar);
            __builtin_amdgcn_fence(__ATOMIC_ACQUIRE, "agent");
            xb_add(&bar[XB_XGEN(b.x)], 1u);
            asm volatile("s_waitcnt vmcnt(0)" ::: "memory");
        } else {
            XB_SPIN(xb_ld(&bar[XB_XGEN(b.x)]) == gen, bar);
            __builtin_amdgcn_fence(__ATOMIC_ACQUIRE, "agent");
            asm volatile("s_waitcnt vmcnt(0)" ::: "memory");
        }
    }
    __syncthreads();
}

constexpr int BATCH = 2, SEQ = 8192, M = BATCH * SEQ, D = 4096;
constexpr int DA = 2048, KVD = 512, DIQ = 2048, HDI = 128, NHI = 16, DB = 2048, NHB = 32, HDB = 64;
constexpr int DIN = 11408, DFF = 11008, DPLE = 256, TOPK = 256;
constexpr int NCAT = 81 * 256;
constexpr int N13 = 2 * DFF;
constexpr int LORA_LD = 1024;
constexpr float RMS_EPS = 1e-6f, GN_EPS = 64e-5f;

#define GAS __attribute__((address_space(1)))
typedef unsigned short bf16;
typedef unsigned v4u __attribute__((ext_vector_type(4)));
typedef unsigned v2u __attribute__((ext_vector_type(2)));
typedef float f32x4 __attribute__((ext_vector_type(4)));
typedef float f32x16 __attribute__((ext_vector_type(16)));
typedef float f32x2 __attribute__((ext_vector_type(2)));
typedef short bf16x8 __attribute__((ext_vector_type(8)));
typedef GAS unsigned gu32;
#define RLX_AGENT __ATOMIC_RELAXED, __HIP_MEMORY_SCOPE_AGENT
#define LDS_WAIT() asm volatile("s_waitcnt lgkmcnt(0)" ::: "memory")
#define VM_WAIT() asm volatile("s_waitcnt vmcnt(0)" ::: "memory")
#define DI __device__ __forceinline__

DI unsigned f2bf(float f) { unsigned u = __builtin_bit_cast(unsigned, f); return (u + 0x7fffu + ((u >> 16) & 1u)) >> 16; }
DI unsigned pk2(float lo, float hi) { return f2bf(lo) | (f2bf(hi) << 16); }
DI float bf_lo(unsigned w) { return __builtin_bit_cast(float, w << 16); }
DI float bf_hi(unsigned w) { return __builtin_bit_cast(float, w & 0xffff0000u); }
DI float bf2f(bf16 h) { return __builtin_bit_cast(float, ((unsigned)h) << 16); }
DI float sigmoidf_(float z) { return 1.0f / (1.0f + __expf(-z)); }
DI float wave_sum(float v) {
#pragma unroll
    for (int o = 1; o < 64; o <<= 1) v += __shfl_xor(v, o);
    return v;
}

namespace epi {
using pg8::Unit; using pg8::BM; using pg8::HALF; using pg8::cvt_pk_bf16;
typedef pg8::f32x4 f4;
DI v4u pack8(const f4& a, const f4& b) { v4u w; w.x = cvt_pk_bf16(a[0], a[1]); w.y = cvt_pk_bf16(a[2], a[3]); w.z = cvt_pk_bf16(b[0], b[1]); w.w = cvt_pk_bf16(b[2], b[3]); return w; }
DI void unpack8(const v4u& w, f4& a, f4& b) { a[0] = bf_lo(w.x); a[1] = bf_hi(w.x); a[2] = bf_lo(w.y); a[3] = bf_hi(w.y); b[0] = bf_lo(w.z); b[1] = bf_hi(w.z); b[2] = bf_lo(w.w); b[3] = bf_hi(w.w); }

struct InProj {
    static constexpr bool PERM = true, AFTER_DRAIN = false, CHAIN = false;
    bf16 *q, *k, *v, *qi, *ki, *rb, *kb, *vb, *lora, *gates; float* wi;
    const float *rstd, *rcos, *rsin;
    DI bool keep(const Unit&) const { return false; }
    DI void operator()(f4 (&acc)[2][2][4][2], const Unit& u, int wr, int wc, int fr, int fq) const {
        { const int ln_ = lane_opaque(); fr = ln_ & 15; fq = ln_ >> 4; }
        const int pn = u.pn, row0 = u.pm * BM + wr * 64 + fr;
        int kind = 0, ld, cb; bf16* dst;
        float rsv[2][4];
#pragma unroll
        for (int ai = 0; ai < 2; ++ai)
#pragma unroll
            for (int m = 0; m < 4; ++m) rsv[ai][m] = rstd[row0 + ai * HALF + m * 16];
        if (pn < 8)       { kind = 1; dst = q;  ld = DA;  cb = pn * 256; }
        else if (pn < 10) { kind = 1; dst = k;  ld = KVD; cb = (pn - 8) * 256; }
        else if (pn < 12) { dst = v;  ld = KVD; cb = (pn - 10) * 256; }
        else if (pn < 20) { kind = 1; dst = qi; ld = DIQ; cb = (pn - 12) * 256; }
        else if (pn == 20){ kind = 2; dst = ki; ld = HDI; cb = 0; }
        else if (pn < 29) { dst = rb; ld = DB; cb = (pn - 21) * 256; }
        else if (pn < 37) { dst = kb; ld = DB; cb = (pn - 29) * 256; }
        else if (pn < 45) { dst = vb; ld = DB; cb = (pn - 37) * 256; }
        else if (pn < 49) { dst = lora; ld = LORA_LD; cb = (pn - 45) * 256; }
        else              { dst = gates; ld = 2 * D; cb = (pn - 49) * 256; }
        if (kind == 0) {
#pragma unroll
            for (int ai = 0; ai < 2; ++ai)
#pragma unroll
                for (int m = 0; m < 4; ++m) { const int row = row0 + ai * HALF + m * 16; const float rs = rsv[ai][m];
#pragma unroll
                    for (int bj = 0; bj < 2; ++bj) *(v4u*)(dst + (size_t)row * ld + cb + bj * HALF + wc * 32 + 8 * fq) = pack8(acc[ai][bj][m][0] * rs, acc[ai][bj][m][1] * rs); }
        } else if (kind == 1 || wc < 2) {
            const int hb = cb + (wc >> 1) * 128, dd0 = (wc & 1) * 32 + 8 * fq;
#pragma unroll
            for (int ai = 0; ai < 2; ++ai)
#pragma unroll
              for (int mp = 0; mp < 2; ++mp) {
                f4 cv[2][2], sv[2][2];
#pragma unroll
                for (int mm = 0; mm < 2; ++mm) { const size_t to = (size_t)(row0 + ai * HALF + (2 * mp + mm) * 16) * 64 + dd0; cv[mm][0] = *(const f4*)(rcos + to); cv[mm][1] = *(const f4*)(rcos + to + 4); sv[mm][0] = *(const f4*)(rsin + to); sv[mm][1] = *(const f4*)(rsin + to + 4); }
                asm volatile("" ::: "memory");
#pragma unroll
                for (int mm = 0; mm < 2; ++mm) { const int m = 2 * mp + mm, row = row0 + ai * HALF + m * 16; const float rs = rsv[ai][m];
                    const f4 c0 = cv[mm][0], c1 = cv[mm][1], s0 = sv[mm][0], s1 = sv[mm][1];
                    const f4 a0 = acc[ai][0][m][0] * rs, a1 = acc[ai][0][m][1] * rs, b0 = acc[ai][1][m][0] * rs, b1 = acc[ai][1][m][1] * rs;
                    bf16* p = dst + (size_t)row * ld + hb + dd0;
                    *(v4u*)(p)      = pack8(a0 * c0 - b0 * s0, a1 * c1 - b1 * s1);
                    *(v4u*)(p + 64) = pack8(a0 * s0 + b0 * c0, a1 * s1 + b1 * c1); }
                asm volatile("" ::: "memory"); }
        } else if (wc == 2 && fq < 2) {
#pragma unroll
            for (int ai = 0; ai < 2; ++ai)
#pragma unroll
                for (int m = 0; m < 4; ++m) { const int row = row0 + ai * HALF + m * 16; const float rs = rsv[ai][m] * 0.25f;
                    *(f4*)(wi + (size_t)row * 16 + 8 * fq) = acc[ai][0][m][0] * rs; *(f4*)(wi + (size_t)row * 16 + 8 * fq + 4) = acc[ai][0][m][1] * rs; }
        }
    }
};

struct LoraUp {
    static constexpr bool PERM = true, AFTER_DRAIN = false, CHAIN = false;
    float* decay; bf16 *aout, *gout; const float *w0, *a0;
    DI bool keep(const Unit&) const { return false; }
    DI void operator()(f4 (&acc)[2][2][4][2], const Unit& u, int wr, int wc, int fr, int fq) const {
        { const int ln_ = lane_opaque(); fr = ln_ & 15; fq = ln_ >> 4; }
        const int which = u.pm >> 6, row0 = (u.pm & 63) * BM + wr * 64 + fr, col0 = (u.pn & 7) * BM + wc * 32 + 8 * fq;
        if (which == 0) {
#pragma unroll
            for (int bj = 0; bj < 2; ++bj) { const int col = col0 + bj * HALF; const f4 z0 = *(const f4*)(w0 + col), z1 = *(const f4*)(w0 + col + 4);
#pragma unroll
                for (int ai = 0; ai < 2; ++ai)
#pragma unroll
                    for (int m = 0; m < 4; ++m) { const size_t off = (size_t)(row0 + ai * HALF + m * 16) * DB + col;
                        f4 x0 = acc[ai][bj][m][0] + z0, x1 = acc[ai][bj][m][1] + z1;
#pragma unroll
                        for (int e = 0; e < 4; ++e) { x0[e] = __expf(-0.6065306597126334f * sigmoidf_(x0[e])); x1[e] = __expf(-0.6065306597126334f * sigmoidf_(x1[e])); }
                        *(f4*)(decay + off) = x0; *(f4*)(decay + off + 4) = x1;
                        asm volatile("" ::: "memory"); } }
        } else if (which == 1) {
#pragma unroll
            for (int bj = 0; bj < 2; ++bj) { const int col = col0 + bj * HALF; const f4 z0 = *(const f4*)(a0 + col), z1 = *(const f4*)(a0 + col + 4);
#pragma unroll
                for (int ai = 0; ai < 2; ++ai)
#pragma unroll
                    for (int m = 0; m < 4; ++m) { const size_t off = (size_t)(row0 + ai * HALF + m * 16) * DB + col;
                        f4 x0 = acc[ai][bj][m][0] + z0, x1 = acc[ai][bj][m][1] + z1;
#pragma unroll
                        for (int e = 0; e < 4; ++e) { x0[e] = sigmoidf_(x0[e]); x1[e] = sigmoidf_(x1[e]); }
                        *(v4u*)(aout + off) = pack8(x0, x1);
                        asm volatile("" ::: "memory"); } }
        } else {
#pragma unroll
            for (int bj = 0; bj < 2; ++bj)
#pragma unroll
                for (int ai = 0; ai < 2; ++ai)
#pragma unroll
                    for (int m = 0; m < 4; ++m) *(v4u*)(gout + (size_t)(row0 + ai * HALF + m * 16) * DB + col0 + bj * HALF) = pack8(acc[ai][bj][m][0], acc[ai][bj][m][1]);
        }
    }
};

struct GateMix {
    static constexpr bool PERM = true, AFTER_DRAIN = false, CHAIN = true;
    const bf16* gates; const float* bgate; bf16* mout;
    DI bool keep(const Unit& u) const { return u.pm < 64; }
    DI void operator()(f4 (&acc)[2][2][4][2], const Unit& u, int wr, int wc, int fr, int fq) const {
        { const int ln_ = lane_opaque(); fr = ln_ & 15; fq = ln_ >> 4; }
        const int which = u.pm >> 6, row0 = (u.pm & 63) * BM + wr * 64 + fr, col0 = (u.pn & 15) * BM + wc * 32 + 8 * fq;
        f4 ba[2][2], bb[2][2];
#pragma unroll
        for (int bj = 0; bj < 2; ++bj) { const int col = col0 + bj * HALF; ba[bj][0] = *(const f4*)(bgate + col); ba[bj][1] = *(const f4*)(bgate + col + 4); bb[bj][0] = *(const f4*)(bgate + D + col); bb[bj][1] = *(const f4*)(bgate + D + col + 4); }
#pragma unroll
        for (int ai = 0; ai < 2; ++ai)
#pragma unroll
          for (int mp = 0; mp < 2; ++mp) {
            v4u zbv[2][2], zav[2][2];
#pragma unroll
            for (int mm = 0; mm < 2; ++mm)
#pragma unroll
                for (int bj = 0; bj < 2; ++bj) { const size_t go = (size_t)(row0 + ai * HALF + (2 * mp + mm) * 16) * (2 * D) + col0 + bj * HALF;
                    zbv[mm][bj] = *(const v4u*)(gates + go + D); if (which == 0) zav[mm][bj] = *(const v4u*)(gates + go); else zav[mm][bj] = (v4u){0u, 0u, 0u, 0u}; }
            asm volatile("" ::: "memory");
#pragma unroll
            for (int mm = 0; mm < 2; ++mm) { const int m = 2 * mp + mm, row = row0 + ai * HALF + m * 16;
#pragma unroll
                for (int bj = 0; bj < 2; ++bj) { const int col = col0 + bj * HALF;
                    f4 zb0, zb1; unpack8(zbv[mm][bj], zb0, zb1); zb0 += bb[bj][0]; zb1 += bb[bj][1];
                    if (which == 0) {
                        f4 za0, za1; unpack8(zav[mm][bj], za0, za1); za0 += ba[bj][0]; za1 += ba[bj][1];
#pragma unroll
                        for (int t = 0; t < 4; ++t) {
                            acc[ai][bj][m][0][t] *= (1.0f + __expf(-zb0[t])) / (1.0f + __expf(-za0[t]));
                            acc[ai][bj][m][1][t] *= (1.0f + __expf(-zb1[t])) / (1.0f + __expf(-za1[t])); }
                    } else {
                        f4 o0, o1;
#pragma unroll
                        for (int t = 0; t < 4; ++t) { o0[t] = acc[ai][bj][m][0][t] * sigmoidf_(zb0[t]); o1[t] = acc[ai][bj][m][1][t] * sigmoidf_(zb1[t]); }
                        *(v4u*)(mout + (size_t)row * D + col) = pack8(o0, o1);
                    } } }
            asm volatile("" ::: "memory");
          }
    }
};

struct Resid {
    static constexpr bool PERM = true, AFTER_DRAIN = false, CHAIN = false;
    const float* base; float* out; bf16* outb; float* ss;
    DI bool keep(const Unit&) const { return false; }
    DI void operator()(f4 (&acc)[2][2][4][2], const Unit& u, int wr, int wc, int fr, int fq) const {
        { const int ln_ = lane_opaque(); fr = ln_ & 15; fq = ln_ >> 4; }
        const int row0 = u.pm * BM + wr * 64 + fr, col0 = u.pn * BM + wc * 32 + 8 * fq;
#pragma unroll
        for (int ai = 0; ai < 2; ++ai) {
            f4 b0[4][2], b1[4][2];
#pragma unroll
            for (int m = 0; m < 4; ++m)
#pragma unroll
                for (int bj = 0; bj < 2; ++bj) { const size_t off = (size_t)(row0 + ai * HALF + m * 16) * D + col0 + bj * HALF; b0[m][bj] = *(const f4*)(base + off); b1[m][bj] = *(const f4*)(base + off + 4); }
            asm volatile("" ::: "memory");
#pragma unroll
            for (int m = 0; m < 4; ++m) { const int row = row0 + ai * HALF + m * 16; float s = 0.f;
#pragma unroll
                for (int bj = 0; bj < 2; ++bj) { const size_t off = (size_t)row * D + col0 + bj * HALF;
                    const f4 h0 = b0[m][bj] + acc[ai][bj][m][0], h1 = b1[m][bj] + acc[ai][bj][m][1];
                    *(f4*)(out + off) = h0; *(f4*)(out + off + 4) = h1; *(v4u*)(outb + off) = pack8(h0, h1);
                    s += (h0[0] * h0[0] + h0[1] * h0[1]) + (h0[2] * h0[2] + h0[3] * h0[3]) + (h1[0] * h1[0] + h1[1] * h1[1]) + (h1[2] * h1[2] + h1[3] * h1[3]); }
                s += __shfl_xor(s, 16); s += __shfl_xor(s, 32);
                if (fq == 0) atomicAdd(ss + row, s); }
            asm volatile("" ::: "memory");
        }
    }
};

struct FfnUp {
    static constexpr bool PERM = true, AFTER_DRAIN = false, CHAIN = false;
    const float* ss; bf16* uout;
    DI bool keep(const Unit&) const { return false; }
    DI void operator()(f4 (&acc)[2][2][4][2], const Unit& u, int wr, int wc, int fr, int fq) const {
        { const int ln_ = lane_opaque(); fr = ln_ & 15; fq = ln_ >> 4; }
        const int row0 = u.pm * BM + wr * 64 + fr, col0 = u.pn * HALF + wc * 32 + 8 * fq;
        float rr[2][4];
#pragma unroll
        for (int ai = 0; ai < 2; ++ai)
#pragma unroll
            for (int m = 0; m < 4; ++m) rr[ai][m] = ss[row0 + ai * HALF + m * 16];
#pragma unroll
        for (int ai = 0; ai < 2; ++ai)
#pragma unroll
            for (int m = 0; m < 4; ++m) { const int row = row0 + ai * HALF + m * 16; const float r = __builtin_amdgcn_rsqf(rr[ai][m] * (1.0f / D) + RMS_EPS);
                f4 o0, o1;
#pragma unroll
                for (int e = 0; e < 4; ++e) { const float a0 = acc[ai][0][m][0][e] * r, a1 = acc[ai][0][m][1][e] * r;
                    o0[e] = a0 * sigmoidf_(a0) * (acc[ai][1][m][0][e] * r); o1[e] = a1 * sigmoidf_(a1) * (acc[ai][1][m][1][e] * r); }
                *(v4u*)(uout + (size_t)row * DFF + col0) = pack8(o0, o1); }
    }
};

struct StoreBf {
    static constexpr bool PERM = true, AFTER_DRAIN = false, CHAIN = false;
    bf16* o; int ld;
    DI bool keep(const Unit&) const { return false; }
    DI void operator()(f4 (&acc)[2][2][4][2], const Unit& u, int wr, int wc, int fr, int fq) const {
        { const int ln_ = lane_opaque(); fr = ln_ & 15; fq = ln_ >> 4; }
        const int row0 = u.pm * BM + wr * 64 + fr, col0 = u.pn * BM + wc * 32 + 8 * fq;
#pragma unroll
        for (int ai = 0; ai < 2; ++ai)
#pragma unroll
            for (int m = 0; m < 4; ++m)
#pragma unroll
                for (int bj = 0; bj < 2; ++bj) *(v4u*)(o + (size_t)(row0 + ai * HALF + m * 16) * ld + col0 + bj * HALF) = pack8(acc[ai][bj][m][0], acc[ai][bj][m][1]);
    }
};

struct PleGate {
    static constexpr bool PERM = true, AFTER_DRAIN = false, CHAIN = false;
    float* h; const bf16* pp; const float* ss_in; float* ss_out;
    DI bool keep(const Unit&) const { return false; }
    DI void operator()(f4 (&acc)[2][2][4][2], const Unit& u, int wr, int wc, int fr, int fq) const {
        { const int ln_ = lane_opaque(); fr = ln_ & 15; fq = ln_ >> 4; }
        const int row0 = u.pm * BM + wr * 64 + fr, col0 = u.pn * BM + wc * 32 + 8 * fq;
        float rr[2][4];
#pragma unroll
        for (int ai = 0; ai < 2; ++ai)
#pragma unroll
            for (int m = 0; m < 4; ++m) rr[ai][m] = ss_in[row0 + ai * HALF + m * 16];
#pragma unroll
        for (int ai = 0; ai < 2; ++ai)
#pragma unroll
            for (int mp = 0; mp < 2; ++mp) {
                v4u pv[2][2]; f4 h0v[2][2], h1v[2][2];
#pragma unroll
                for (int mm = 0; mm < 2; ++mm)
#pragma unroll
                    for (int bj = 0; bj < 2; ++bj) { const size_t off = (size_t)(row0 + ai * HALF + (2 * mp + mm) * 16) * D + col0 + bj * HALF;
                        pv[mm][bj] = *(const v4u*)(pp + off); h0v[mm][bj] = *(const f4*)(h + off); h1v[mm][bj] = *(const f4*)(h + off + 4); }
                asm volatile("" ::: "memory");
#pragma unroll
                for (int mm = 0; mm < 2; ++mm) { const int m = 2 * mp + mm, row = row0 + ai * HALF + m * 16; const float r = __builtin_amdgcn_rsqf(rr[ai][m] * (1.0f / D) + RMS_EPS); float s = 0.f;
#pragma unroll
                    for (int bj = 0; bj < 2; ++bj) { const size_t off = (size_t)row * D + col0 + bj * HALF;
                        f4 p0, p1; unpack8(pv[mm][bj], p0, p1);
                        f4 h0 = h0v[mm][bj], h1 = h1v[mm][bj];
#pragma unroll
                        for (int t = 0; t < 4; ++t) { h0[t] += sigmoidf_(acc[ai][bj][m][0][t] * r) * p0[t]; h1[t] += sigmoidf_(acc[ai][bj][m][1][t] * r) * p1[t]; }
                        *(f4*)(h + off) = h0; *(f4*)(h + off + 4) = h1;
                        s += (h0[0] * h0[0] + h0[1] * h0[1]) + (h0[2] * h0[2] + h0[3] * h0[3]) + (h1[0] * h1[0] + h1[1] * h1[1]) + (h1[2] * h1[2] + h1[3] * h1[3]); }
                    s += __shfl_xor(s, 16); s += __shfl_xor(s, 32);
                    if (fq == 0) atomicAdd(ss_out + row, s); }
                asm volatile("" ::: "memory");
            }
    }
};

struct Stack3Order {
    int G, c;
    DI bool next(int i, Unit& u) const { const int L = i * G + c; if (L >= 1536) return false; const int which = L >> 9, r = L & 511; u.pm = which * 64 + (r & 63); u.pn = which * 8 + (r >> 6); return true; }
    DI void a_ready(const Unit&) const {}
    DI void done(const Unit&) const {}
};
struct ChainOrder {
    pg8::StaticOrder so;
    DI bool next(int i, Unit& u) const { Unit t; if (!so.next(i >> 1, t)) return false; const int which = i & 1; u.pm = which * 64 + t.pm; u.pn = which * 16 + t.pn; return true; }
    DI void a_ready(const Unit&) const {}
    DI void done(const Unit&) const {}
};
}

constexpr size_t MiB = 1u << 20;
constexpr size_t WS_CTL = 0, CTL_ZERO_BYTES = 1 * MiB;
constexpr int CW_TMO = 0, CW_BAR = 4096, CW_ATTQ = 8192;
constexpr size_t SS1_OFF = 256 * 1024, SS2_OFF = 320 * 1024, SS3_OFF = 384 * 1024;
constexpr size_t WS_RSTDX = 1 * MiB;
constexpr size_t WS_BONUS = 2 * MiB;
constexpr size_t WS_RCOS = 4 * MiB, WS_RSIN = 8 * MiB;
constexpr size_t WS_WI = 12 * MiB;
constexpr size_t WS_PB = 13 * MiB;
constexpr size_t WS_WPAB = 24 * MiB;
constexpr size_t WS_WO = 56 * MiB, WS_WPG = 88 * MiB;
constexpr size_t WS_WPLE = 120 * MiB;
constexpr size_t WS_WL2 = 122 * MiB;
constexpr size_t WS_R1 = 126 * MiB;
constexpr size_t WS_WCAT = 126 * MiB;
constexpr size_t WS_XB = 288 * MiB;
constexpr size_t WS_SCORE = 126 * MiB;
constexpr size_t WS_IDX = 1252 * MiB;
constexpr size_t WS_DECAY = 126 * MiB;
constexpr size_t WS_AOUT = 254 * MiB;
constexpr size_t WS_ALORA = 318 * MiB;
constexpr size_t WS_W13 = 126 * MiB;
constexpr size_t WS_W2 = 318 * MiB;
constexpr size_t WS_Q = 416 * MiB, WS_K = 480 * MiB, WS_V = 496 * MiB, WS_QI = 512 * MiB, WS_KI = 576 * MiB;
constexpr size_t WS_RB = 580 * MiB, WS_KB = 644 * MiB, WS_VB = 708 * MiB, WS_LORA = 772 * MiB, WS_GATES = 804 * MiB;
constexpr size_t WS_Y = 416 * MiB;
constexpr size_t WS_MIX = 416 * MiB;
constexpr size_t WS_H1B = 544 * MiB;
constexpr size_t WS_U = 672 * MiB;
constexpr size_t WS_H2B = 416 * MiB;
constexpr size_t WS_PP = 544 * MiB;
constexpr size_t WS_AO = 1060 * MiB;
constexpr size_t WS_GOUT = 1188 * MiB;
constexpr size_t WS_END = 1268 * MiB;

constexpr int RING_OFF = 0, RING_BYTES = 131072;
constexpr int LDS_BYTES = 163840;
constexpr int LDSCTL_OFF = LDS_BYTES - 1024, MISC_OFF = LDSCTL_OFF + 320;
constexpr int NWAVES = 8;

struct Args {
    const float* in[32]; float* out; unsigned char* ws; int ph_lo, ph_hi;
};
enum { I_X = 0, I_P, I_POS, I_NORM_MIX, I_W_IN, I_MU_RKV, I_MU_WAG, I_W0, I_W1, I_W2, I_A0, I_A1, I_A2, I_G1, I_G2, I_KK, I_KA, I_RK, I_LNW, I_LNB,
       I_WPA, I_WPB, I_WGATE, I_BGATE, I_WO, I_NORM_FFN, I_WFFN1, I_WFFN3, I_WFFN2, I_WPLEG, I_WPLE, I_NORM_FINAL };

struct TrSrc { const float* p; int ld, col0, nvalid, kvalid; const float* ksc; const float* mu; int mumode; };
DI void tr_item(const TrSrc& s, bf16* WT, int dK, int n0, int k0, LAS unsigned* T, int lane) {
    const int ng = lane & 15, kq = lane >> 4;
    f32x4 v[8][2]; f32x2 sc[8];
    const bool nok = 4 * ng < s.nvalid;
#pragma unroll
    for (int st = 0; st < 8; ++st) { const int k = k0 + 8 * st + 2 * kq;
#pragma unroll
        for (int j = 0; j < 2; ++j) v[st][j] = (nok && k + j < s.kvalid) ? *(const f32x4*)(s.p + (size_t)(k + j) * s.ld + s.col0 + 4 * ng) : (f32x4){0.f, 0.f, 0.f, 0.f};
        f32x2 c = {1.f, 1.f};
        if (s.ksc) c = *(const f32x2*)(s.ksc + k);
        if (s.mumode == 1) { const f32x2 m = *(const f32x2*)(s.mu + k); c = c * (1.0f - m); } else if (s.mumode == 2) { const f32x2 m = *(const f32x2*)(s.mu + k); c = c * m; }
        sc[st] = c; }
#pragma unroll
    for (int st = 0; st < 8; ++st) { const int kp = 4 * st + kq;
#pragma unroll
        for (int i = 0; i < 4; ++i) T[(4 * ng + i) * 32 + (kp ^ (4 * (ng & 7)))] = pk2(v[st][0][i] * sc[st][0], v[st][1][i] * sc[st][1]); }
    LDS_WAIT(); asm volatile("" ::: "memory");
#pragma unroll
    for (int j = 0; j < 8; ++j) { const int n = (lane >> 3) + 8 * j, c = lane & 7;
        *(GAS v4u*)(WT + (size_t)(n0 + n) * dK + k0 + 8 * c) = *(const LAS v4u*)(T + n * 32 + 4 * (c ^ ((n >> 2) & 7))); }
    LDS_WAIT(); asm volatile("" ::: "memory");
}
DI TrSrc src_wcat(const float* const* in, int n0) {
    TrSrc s; s.p = in[I_W_IN]; s.ld = DIN; s.col0 = 0; s.nvalid = 64; s.kvalid = D; s.ksc = in[I_NORM_MIX]; s.mu = nullptr; s.mumode = 0;
    const int tile = n0 >> 8, p = n0 & 255, bj = p >> 7, hh = (p >> 6) & 1;
    if (tile < 8)        s.col0 = 0    + (2 * tile + hh) * 128 + 64 * bj;
    else if (tile < 10)  s.col0 = 2048 + (2 * (tile - 8) + hh) * 128 + 64 * bj;
    else if (tile < 12)  s.col0 = 2560 + (tile - 10) * 256 + p;
    else if (tile < 20)  s.col0 = 3072 + (2 * (tile - 12) + hh) * 128 + 64 * bj;
    else if (tile == 20) { if (hh == 0) s.col0 = 5120 + 64 * bj; else if (bj == 0) { s.col0 = 5248; s.nvalid = 16; } else s.nvalid = 0; }
    else if (tile < 45)  s.col0 = 5264 + (tile - 21) * 256 + p;
    else if (tile < 49)  { const int c = (tile - 45) * 256 + p;
        const int seg = c < 128 ? 0 : c < 256 ? 1 : c < 512 ? 2 : c < 640 ? 3 : c < 768 ? 4 : 5, sbeg = seg == 0 ? 0 : seg == 1 ? 128 : seg == 2 ? 256 : seg == 3 ? 512 : seg == 4 ? 640 : 768;
        const int kind = seg % 3;
        s.p = in[kind == 0 ? I_W1 : (kind == 1 ? I_A1 : I_G1)]; s.ld = kind == 2 ? 256 : 96; s.col0 = c - sbeg; s.mu = in[I_MU_WAG] + kind * D; s.mumode = seg < 3 ? 1 : 2;
        if (kind != 2) s.nvalid = (s.col0 == 0) ? 64 : 32; }
    else { s.p = in[I_WGATE]; s.ld = 2 * D; s.col0 = (tile - 49) * 256 + p; }
    return s;
}
DI TrSrc src_plain(const float* p, int ld, int col0, int kvalid, const float* ksc) { TrSrc s; s.p = p; s.ld = ld; s.col0 = col0; s.nvalid = 64; s.kvalid = kvalid; s.ksc = ksc; s.mu = nullptr; s.mumode = 0; return s; }

DI void convert_set_a(const float* const* in, unsigned char* ws, LAS unsigned* scr, int gw, int NGW, int lane) {
    constexpr int I0 = (NCAT / 64) * (D / 64);
    constexpr int I6 = (DB / 64) * (256 / 64);
    constexpr int NITEMS = I0 + 3 * I6;
    for (int it = gw; it < NITEMS; it += NGW) {
        int r = it;
        if (r < I0) { const int nblk = NCAT / 64, kb = r / nblk, nb = r % nblk; tr_item(src_wcat(in, 64 * nb), (bf16*)(ws + WS_WCAT), D, 64 * nb, 64 * kb, scr, lane); continue; } r -= I0;
        { const int w = r / I6; r -= w * I6; const int nblk = DB / 64, kb = r / nblk, nb = r % nblk;
          tr_item(src_plain(in[w == 0 ? I_W2 : (w == 1 ? I_A2 : I_G2)], DB, 64 * nb, w == 2 ? 256 : 96, nullptr), (bf16*)(ws + WS_WL2) + (size_t)w * DB * 256, 256, 64 * nb, 64 * kb, scr, lane); }
    }
}
constexpr int A1_I1 = (D / 64) * (DA / 64), A1_I3 = (D / 64) * (D / 64), A1_I5 = (D / 64) * (DPLE / 64), A1_NITEMS = 2 * A1_I1 + 2 * A1_I3 + A1_I5;
DI void convert_a1_item(const float* const* in, unsigned char* ws, LAS unsigned* scr, int it, int lane) {
    int r = it;
    if (r < 2 * A1_I1) { const int w = r / A1_I1; r -= w * A1_I1; const int nblk = D / 64, kb = r / nblk, nb = r % nblk;
        tr_item(src_plain(in[w ? I_WPB : I_WPA], D, 64 * nb, DA, nullptr), (bf16*)(ws + WS_WPAB) + (size_t)w * D * DA, DA, 64 * nb, 64 * kb, scr, lane); return; } r -= 2 * A1_I1;
    if (r < 2 * A1_I3) { const int w = r / A1_I3; r -= w * A1_I3; const int nblk = D / 64, kb = r / nblk, nb = r % nblk;
        tr_item(src_plain(in[w ? I_WPLEG : I_WO], D, 64 * nb, D, nullptr), (bf16*)(ws + (w ? WS_WPG : WS_WO)), D, 64 * nb, 64 * kb, scr, lane); return; } r -= 2 * A1_I3;
    { const int nblk = D / 64, kb = r / nblk, nb = r % nblk; tr_item(src_plain(in[I_WPLE], D, 64 * nb, DPLE, nullptr), (bf16*)(ws + WS_WPLE), DPLE, 64 * nb, 64 * kb, scr, lane); }
}
DI void convert_set_b(const float* const* in, unsigned char* ws, LAS unsigned* scr, int gw, int NGW, int lane) {
    constexpr int I0 = (N13 / 64) * (D / 64);
    for (int it = gw; it < I0; it += NGW) {
        const int nblk = N13 / 64, kb = it / nblk, nb = it % nblk, n0 = 64 * nb, tile = n0 >> 8, p = n0 & 255;
        tr_item(src_plain(in[(p >> 7) ? I_WFFN3 : I_WFFN1], DFF, tile * 128 + (p & 127), D, in[I_NORM_FFN]), (bf16*)(ws + WS_W13), D, n0, 64 * kb, scr, lane);
    }
}
constexpr int W2_NITEMS = (D / 64) * (DFF / 64);
DI void convert_w2_item(const float* const* in, unsigned char* ws, LAS unsigned* scr, int it, int lane) {
    const int nblk = D / 64, kb = it / nblk, nb = it % nblk; tr_item(src_plain(in[I_WFFN2], D, 64 * nb, DFF, nullptr), (bf16*)(ws + WS_W2), DFF, 64 * nb, 64 * kb, scr, lane);
}
DI void prologue_rows(const float* const* in, unsigned char* ws, int gw, int NGW, int lane) {
    const float* x = in[I_X]; bf16* xb = (bf16*)(ws + WS_XB); float* rstd = (float*)(ws + WS_RSTDX);
    for (int m = gw; m < M; m += NGW) {
        const GAS f32x4* xr = (const GAS f32x4*)(x + (size_t)m * D) + lane; GAS v2u* o = (GAS v2u*)(xb + (size_t)m * D) + lane; float s = 0.f;
f32x4 xv[16];
#pragma unroll
        for (int j = 0; j < 16; ++j) xv[j] = xr[64 * j];
#pragma unroll
        for (int j = 0; j < 16; ++j) { const f32x4 v = xv[j]; s += (v.x * v.x + v.y * v.y) + (v.z * v.z + v.w * v.w); v2u w; w.x = pk2(v.x, v.y); w.y = pk2(v.z, v.w); o[64 * j] = w; }
        s = wave_sum(s);
        if (lane == 0) rstd[m] = 1.0f / sqrtf(s * (1.0f / D) + RMS_EPS);
    }
    const int* pos = (const int*)in[I_POS]; float* rc = (float*)(ws + WS_RCOS); float* rsn = (float*)(ws + WS_RSIN);
    for (int e = gw * 64 + lane; e < M * 64; e += NGW * 64) {
        const int m = e >> 6, i = e & 63; double inv = 1.0; for (int j = 0; j < i; ++j) inv *= 0.8659643233600653523;
        const double ang = (double)pos[m] * inv;
        const double qd = __builtin_rint(ang * 0.63661977236758134308); const int qi = (int)((long long)qd & 3);
        double r = __builtin_fma(-qd, 1.5707963267948965580, ang); r = __builtin_fma(-qd, 6.1232339957367658860e-17, r);
        const double r2 = r * r;
        const double sn = r * (1.0 + r2 * (-1.0 / 6 + r2 * (1.0 / 120 + r2 * (-1.0 / 5040 + r2 * (1.0 / 362880 + r2 * (-1.0 / 39916800 + r2 * (1.0 / 6227020800.0)))))));
        const double cs = 1.0 + r2 * (-0.5 + r2 * (1.0 / 24 + r2 * (-1.0 / 720 + r2 * (1.0 / 40320 + r2 * (-1.0 / 3628800 + r2 * (1.0 / 479001600.0 + r2 * (-1.0 / 87178291200.0)))))));
        const double c4 = (qi == 0) ? cs : (qi == 1) ? -sn : (qi == 2) ? -cs : sn;
        const double s4 = (qi == 0) ? sn : (qi == 1) ? cs : (qi == 2) ? -sn : -cs;
        rc[e] = (float)c4; rsn[e] = (float)s4;
    }
    const float* p = in[I_P]; bf16* pb = (bf16*)(ws + WS_PB);
    for (int e = gw * 64 + lane; e < M * DPLE / 4; e += NGW * 64) { const f32x4 v = ((const GAS f32x4*)p)[e]; v2u w; w.x = pk2(v.x, v.y); w.y = pk2(v.z, v.w); ((GAS v2u*)pb)[e] = w; }
}
DI void build_alora(unsigned char* ws, int gtid, int NT) {
    const bf16* L = (const bf16*)(ws + WS_LORA); bf16* A = (bf16*)(ws + WS_ALORA);
    for (int e = gtid; e < 3 * M * 32; e += NT) {
        const int which = e / (M * 32), r = e - which * (M * 32), m = r >> 5, j0 = (r & 31) * 8;
        f32x4 o0 = {0.f, 0.f, 0.f, 0.f}, o1 = o0;
        const int width = which == 2 ? 256 : 96, ca = which == 0 ? 0 : (which == 1 ? 128 : 256), cbb = which == 0 ? 512 : (which == 1 ? 640 : 768);
        if (j0 < width) {
            f32x4 c0, c1, p0 = {0.f, 0.f, 0.f, 0.f}, p1 = p0;
            epi::unpack8(*(const v4u*)(L + (size_t)m * LORA_LD + ca + j0), c0, c1);
            if ((m & (SEQ - 1)) != 0) epi::unpack8(*(const v4u*)(L + (size_t)(m - 1) * LORA_LD + cbb + j0), p0, p1);
            o0 = c0 + p0; o1 = c1 + p1;
            if (which == 0) {
#pragma unroll
                for (int t = 0; t < 4; ++t) { o0[t] = 1.0f - 2.0f / (__expf(2.0f * o0[t]) + 1.0f); o1[t] = 1.0f - 2.0f / (__expf(2.0f * o1[t]) + 1.0f); } }
            if (which == 2) {
#pragma unroll
                for (int t = 0; t < 4; ++t) { o0[t] = sigmoidf_(o0[t]); o1[t] = sigmoidf_(o1[t]); } }
        }
        *(v4u*)(A + ((size_t)which * M + m) * 256 + j0) = epi::pack8(o0, o1);
    }
}

constexpr int IDX_TS = 272;
constexpr int IDX_TILE_BYTES = 64 * IDX_TS;
constexpr int IDX_HIST_OFF = 2 * IDX_TILE_BYTES;

DI unsigned fkey(float f) { unsigned u = __builtin_bit_cast(unsigned, f); if (u == 0x80000000u) u = 0u; return (u & 0x80000000u) ? ~u : (u | 0x80000000u); }

DI void indexer_unit(unsigned char* ws, LAS unsigned char* lds, int b, int blk, float* scratch, int wave) {
    const int lane = lane_opaque(), tid = wave * 64 + lane;
    const bf16* qi = (const bf16*)(ws + WS_QI); const bf16* ki = (const bf16*)(ws + WS_KI); const float* wi = (const float*)(ws + WS_WI);
    const int t0 = blk * 32, mrow0 = b * SEQ + t0;
    const int r = lane & 31, kh = lane >> 5, aq = (r >> 2) & 1, ah = (r & 3) + 4 * (r >> 3);
    bf16x8 af[2][8]; f32x4 wg[2][4];
#pragma unroll
    for (int rt = 0; rt < 2; ++rt) {
        const bf16* src = qi + (size_t)(mrow0 + 4 * wave + 2 * rt + aq) * DIQ + ah * HDI + 8 * kh;
#pragma unroll
        for (int ks = 0; ks < 8; ++ks) af[rt][ks] = *(const bf16x8*)(src + 16 * ks);
        const float* wsrc = wi + (size_t)(mrow0 + 4 * wave + 2 * rt + kh) * NHI;
#pragma unroll
        for (int j = 0; j < 4; ++j) wg[rt][j] = *(const f32x4*)(wsrc + 4 * j) * 0.08838834764831845f;
    }
    const int nk = (t0 + 32 + 63) >> 6;
    const int lkey = tid >> 3, lpart = tid & 7;
    const bf16* kbase = ki + (size_t)(b * SEQ) * HDI;
    v4u st0, st1;
    { const v4u* g = (const v4u*)(kbase + (size_t)lkey * HDI + lpart * 16); st0 = g[0]; st1 = g[1]; }
    __syncthreads();
    { LAS v4u* d = (LAS v4u*)(lds + lkey * IDX_TS + lpart * 32); d[0] = st0; d[1] = st1; }
    __syncthreads();
#pragma unroll
    for (int rt = 0; rt < 2; ++rt) {
#pragma unroll
        for (int ks = 0; ks < 8; ++ks) asm volatile("; pin %0" : "+v"(af[rt][ks]));
#pragma unroll
        for (int j = 0; j < 4; ++j) asm volatile("; pin %0" : "+v"(wg[rt][j])); }
    for (int kt = 0; kt < nk; ++kt) {
        if (kt + 1 < nk) { const v4u* g = (const v4u*)(kbase + (size_t)((kt + 1) * 64 + lkey) * HDI + lpart * 16); st0 = g[0]; st1 = g[1]; }
        const LAS unsigned char* tb = lds + (kt & 1) * IDX_TILE_BYTES;
#pragma unroll
        for (int ct = 0; ct < 2; ++ct) {
            bf16x8 bfr[8];
#pragma unroll
            for (int ks = 0; ks < 8; ++ks) bfr[ks] = *(const LAS bf16x8*)(tb + (32 * ct + r) * IDX_TS + (16 * ks + 8 * kh) * 2);
#pragma unroll
            for (int rt = 0; rt < 2; ++rt) {
                f32x16 c;
#pragma unroll
                for (int j = 0; j < 16; ++j) c[j] = 0.f;
#pragma unroll
                for (int ks = 0; ks < 8; ++ks) c = __builtin_amdgcn_mfma_f32_32x32x16_bf16(af[rt][ks], bfr[ks], c, 0, 0, 0);
                float s = 0.f;
#pragma unroll
                for (int j = 0; j < 16; ++j) s += wg[rt][j >> 2][j & 3] * __builtin_amdgcn_fmed3f(c[j], 0.f, 3.0e38f);
                scratch[(size_t)(4 * wave + 2 * rt + kh) * SEQ + kt * 64 + 32 * ct + r] = s;
            }
        }
        if (kt + 1 < nk) { LAS v4u* d = (LAS v4u*)(lds + ((kt + 1) & 1) * IDX_TILE_BYTES + lkey * IDX_TS + lpart * 32); d[0] = st0; d[1] = st1; }
        asm volatile("s_waitcnt lgkmcnt(0)" ::: "memory"); __builtin_amdgcn_s_barrier(); asm volatile("" ::: "memory");
    }
}

DI void select_unit(unsigned char* ws, LAS unsigned char* lds, int b, int blk, const float* scratch, int wave) {
    int* idx = (int*)(ws + WS_IDX);
    LAS unsigned* hist = (LAS unsigned*)(lds + IDX_HIST_OFF + wave * 8192);
    for (int qq = 0; qq < 4; ++qq) {
        const int lane = lane_opaque(); const unsigned long long lt_mask = (1ull << lane) - 1ull;
        const int ql = wave * 4 + qq, t = blk * 32 + ql, n = t + 1;
        const float* sc = scratch + (size_t)ql * SEQ; int* out = idx + (size_t)(b * SEQ + t) * TOPK;
        if (n <= TOPK) { for (int e = lane; e < TOPK; e += 64) out[e] = (e < n) ? e : 0; continue; }
        const int n4 = (n + 3) >> 2;
        v4u key[32];
#pragma unroll
        for (int j = 0; j < 32; ++j) { key[j] = (v4u){0u, 0u, 0u, 0u};
            if (64 * j < n4) { const int gi = 64 * j + lane; if (gi < n4) { const f32x4 v = *(const f32x4*)(sc + 4 * gi); const int e0 = 4 * gi;
                key[j].x = fkey(v[0]); key[j].y = (e0 + 1 < n) ? fkey(v[1]) : 0u; key[j].z = (e0 + 2 < n) ? fkey(v[2]) : 0u; key[j].w = (e0 + 3 < n) ? fkey(v[3]) : 0u; } } }
        unsigned prefix = 0u, pmask = 0u; int kk = TOPK;
        for (int pass = 0; pass < 4; ++pass) {
            const int shift = 24 - 8 * pass;
#pragma unroll
            for (int z = 0; z < 8; ++z) *(LAS v4u*)(hist + 4 * (lane + 64 * z)) = (v4u){0u, 0u, 0u, 0u};
            LAS unsigned* hc = hist + 256 * (lane & 7);
#pragma unroll
            for (int j = 0; j < 32; ++j) if (64 * j < n4) {
#pragma unroll
                for (int c = 0; c < 4; ++c) { const unsigned u = key[j][c]; if ((u & pmask) == prefix) __hip_atomic_fetch_add(hc + ((u >> shift) & 255u), 1u, __ATOMIC_RELAXED, __HIP_MEMORY_SCOPE_WORKGROUP); } }
            LDS_WAIT(); asm volatile("" ::: "memory");
            v4u hs = {0u, 0u, 0u, 0u};
#pragma unroll
            for (int z = 0; z < 8; ++z) hs += *(const LAS v4u*)(hist + 256 * z + 4 * lane);
            const int c0 = (int)hs.x, c1 = (int)hs.y, c2 = (int)hs.z, c3 = (int)hs.w;
            const int T = c0 + c1 + c2 + c3; int S = T;
#pragma unroll
            for (int o = 1; o < 64; o <<= 1) { const int v = __shfl_down(S, o); if (lane + o < 64) S += v; }
            const int E = S - T;
            const bool found = (E < kk) && (kk <= S);
            int d = 0, knew = 0;
            if (found) { int run = E;
                if (run + c3 >= kk) { d = 4 * lane + 3; knew = kk - run; } else { run += c3;
                if (run + c2 >= kk) { d = 4 * lane + 2; knew = kk - run; } else { run += c2;
                if (run + c1 >= kk) { d = 4 * lane + 1; knew = kk - run; } else { run += c1; d = 4 * lane; knew = kk - run; } } } }
            const unsigned long long fm = __ballot(found); const int src = fm ? (int)__builtin_ctzll(fm) : 0;
            d = __shfl(d, src); knew = __shfl(knew, src);
            prefix |= ((unsigned)d) << shift; pmask |= 0xffu << shift; kk = knew;
            asm volatile("" ::: "memory");
        }
        int pos = 0, eqt = 0;
#pragma unroll
        for (int j = 0; j < 32; ++j) if (64 * j < n4) {
            bool eq[4], gt[4]; unsigned long long em[4]; int eq_before = eqt;
#pragma unroll
            for (int c = 0; c < 4; ++c) { const unsigned u = key[j][c]; eq[c] = (u == prefix); gt[c] = (u > prefix); em[c] = __ballot(eq[c]); eq_before += __builtin_popcountll(em[c] & lt_mask); }
            bool take[4]; unsigned long long tm[4]; int tk_before = pos, run_eq = eq_before;
#pragma unroll
            for (int c = 0; c < 4; ++c) { take[c] = gt[c] || (eq[c] && run_eq < kk); run_eq += eq[c] ? 1 : 0; tm[c] = __ballot(take[c]); tk_before += __builtin_popcountll(tm[c] & lt_mask); }
            int slot = tk_before;
#pragma unroll
            for (int c = 0; c < 4; ++c) { if (take[c]) { if (slot < TOPK) out[slot] = 256 * j + 4 * lane + c; ++slot; } }
#pragma unroll
            for (int c = 0; c < 4; ++c) { pos += __builtin_popcountll(tm[c]); eqt += __builtin_popcountll(em[c]); }
        }
    }
}

DI void indexer_phase(unsigned char* ws, LAS unsigned char* lds, int wave) {
    float* scratch = (float*)(ws + WS_SCORE) + (size_t)blockIdx.x * 32 * SEQ;
    for (int pr = blockIdx.x; pr < 256; pr += gridDim.x) {
        const int b = pr >> 7, j = pr & 127;
        for (int half = 0; half < 2; ++half) { const int blk = half ? 255 - j : j;
            indexer_unit(ws, lds, b, blk, scratch, wave);
            VM_WAIT(); __syncthreads();
#ifndef REP_SEL
#define REP_SEL 1
#endif
            for (int rs_ = 0; rs_ < REP_SEL; ++rs_) select_unit(ws, lds, b, blk, scratch, wave);
            VM_WAIT(); __syncthreads(); }
    }
}

typedef int v4i __attribute__((ext_vector_type(4)));
#define ATT_FENCE() asm volatile("" ::: "memory")
DI void attn_worker(unsigned char* ws, LAS unsigned char* lds, LAS unsigned* qctr, int wave) {
    const int lane = lane_opaque();
    const bf16* q = (const bf16*)(ws + WS_Q); const bf16* kbuf = (const bf16*)(ws + WS_K); const bf16* vbuf = (const bf16*)(ws + WS_V);
    const int* idx = (const int*)(ws + WS_IDX); bf16* ao = (bf16*)(ws + WS_AO);
    LAS int* idl = (LAS int*)(lds); LAS float* pl = (LAS float*)(lds + 1024);
    const int G = gridDim.x, bg = blockIdx.x & 7, b = bg >> 2, g = bg & 3;
    unsigned* gq = (unsigned*)(ws + WS_CTL) + CW_ATTQ + 64 * bg;
    (void)G;
    const int kr = lane & 15, kq = lane >> 4;
    const int kg = lane >> 4, dg = lane & 15;
    const bf16* kbase = kbuf + (size_t)(b * SEQ) * KVD + g * 128 + 8 * kq;
    const bf16* vbase = vbuf + (size_t)(b * SEQ) * KVD + g * 128 + 8 * dg;
    int qn; { unsigned v_ = 0u; if (lane == 0) v_ = __hip_atomic_fetch_add(gq, 1u, __ATOMIC_RELAXED, __HIP_MEMORY_SCOPE_AGENT); qn = __builtin_amdgcn_readfirstlane((int)v_); }
    int ixg[4]; bf16x8 qf[4];
    if (qn < SEQ) { const int mq = b * SEQ + qn;
#pragma unroll
        for (int c = 0; c < 4; ++c) ixg[c] = idx[(size_t)mq * TOPK + lane + 64 * c];
#pragma unroll
        for (int ks = 0; ks < 4; ++ks) { if (kr < 4) qf[ks] = *(const bf16x8*)(q + (size_t)mq * DA + (4 * g + kr) * 128 + 32 * ks + 8 * kq); else qf[ks] = (bf16x8){0, 0, 0, 0, 0, 0, 0, 0}; } }
    while (qn < SEQ) {
        const int t = qn, mq = b * SEQ + t, nvalid = (t + 1 < TOPK) ? t + 1 : TOPK;
#pragma unroll
        for (int c = 0; c < 4; ++c) idl[lane + 64 * c] = ixg[c];
        LDS_WAIT(); ATT_FENCE();
        int qn2; { unsigned v_ = 0u; if (lane == 0) v_ = __hip_atomic_fetch_add(gq, 1u, __ATOMIC_RELAXED, __HIP_MEMORY_SCOPE_AGENT); qn2 = __builtin_amdgcn_readfirstlane((int)v_); }
        if (qn2 < SEQ) { const int mq2 = b * SEQ + qn2;
#pragma unroll
            for (int c = 0; c < 4; ++c) ixg[c] = idx[(size_t)mq2 * TOPK + lane + 64 * c]; }
        ATT_FENCE();
        int kidx[16];
#pragma unroll
        for (int kt = 0; kt < 16; ++kt) kidx[kt] = idl[64 * (kr >> 2) + 4 * kt + (kr & 3)];
        f32x4 s[16]; bf16x8 kf[3][2][4];
#pragma unroll
        for (int hg = 0; hg < 2; ++hg) {
#pragma unroll
            for (int j = 0; j < 2; ++j) { const bf16* kp = kbase + (size_t)kidx[2 * hg + j] * KVD;
#pragma unroll
                for (int ks = 0; ks < 4; ++ks) kf[hg][j][ks] = *(const bf16x8*)(kp + 32 * ks); }
            ATT_FENCE(); }
#pragma unroll
        for (int hg = 0; hg < 8; ++hg) {
            if (hg + 2 < 8) {
#pragma unroll
                for (int j = 0; j < 2; ++j) { const bf16* kp = kbase + (size_t)kidx[2 * (hg + 2) + j] * KVD;
#pragma unroll
                    for (int ks = 0; ks < 4; ++ks) kf[(hg + 2) % 3][j][ks] = *(const bf16x8*)(kp + 32 * ks); }
                ATT_FENCE(); }
#pragma unroll
            for (int j = 0; j < 2; ++j) { f32x4 a = {0.f, 0.f, 0.f, 0.f};
#pragma unroll
                for (int ks = 0; ks < 4; ++ks) a = __builtin_amdgcn_mfma_f32_16x16x32_bf16(kf[hg % 3][j][ks], qf[ks], a, 0, 0, 0);
                s[2 * hg + j] = a; }
        }
        if (qn2 < SEQ && kr < 4) { const int mq2 = b * SEQ + qn2;
#pragma unroll
            for (int ks = 0; ks < 4; ++ks) qf[ks] = *(const bf16x8*)(q + (size_t)mq2 * DA + (4 * g + kr) * 128 + 32 * ks + 8 * kq); }
        ATT_FENCE();
        v4i ix[3][2]; v4u vv[3][8];
#pragma unroll
        for (int ch = 0; ch < 2; ++ch) {
            ix[ch][0] = *(const LAS v4i*)(idl + 64 * kg + 8 * ch); ix[ch][1] = *(const LAS v4i*)(idl + 64 * kg + 8 * ch + 4);
#pragma unroll
            for (int j = 0; j < 8; ++j) vv[ch][j] = *(const v4u*)(vbase + (size_t)ix[ch][j >> 2][j & 3] * KVD);
            ATT_FENCE(); }
        float mx = -3.0e38f;
#pragma unroll
        for (int kt = 0; kt < 16; ++kt)
#pragma unroll
            for (int e = 0; e < 4; ++e) { const bool ok = (64 * kq + 4 * kt + e) < nvalid; s[kt][e] = ok ? s[kt][e] * 0.08838834764831845f : -3.0e38f; mx = fmaxf(mx, s[kt][e]); }
        mx = fmaxf(mx, __shfl_xor(mx, 16)); mx = fmaxf(mx, __shfl_xor(mx, 32));
        float sum = 0.f;
#pragma unroll
        for (int kt = 0; kt < 16; ++kt)
#pragma unroll
            for (int e = 0; e < 4; ++e) { const bool ok = (64 * kq + 4 * kt + e) < nvalid; const float p = ok ? __expf(s[kt][e] - mx) : 0.f; s[kt][e] = p; sum += p; }
        sum += __shfl_xor(sum, 16); sum += __shfl_xor(sum, 32);
        const float inv = 1.0f / sum;
        if (kr < 4) {
#pragma unroll
            for (int kt = 0; kt < 16; ++kt) *(LAS f32x4*)(pl + kr * 256 + 64 * kq + 4 * kt) = s[kt] * inv; }
        LDS_WAIT(); ATT_FENCE();
        f32x2 acc[4][4];
#pragma unroll
        for (int h = 0; h < 4; ++h)
#pragma unroll
            for (int d = 0; d < 4; ++d) acc[h][d] = (f32x2){0.f, 0.f};
#pragma unroll
        for (int ch = 0; ch < 8; ++ch) {
            if (ch + 2 < 8) { const int c2 = (ch + 2) % 3;
                ix[c2][0] = *(const LAS v4i*)(idl + 64 * kg + 8 * (ch + 2)); ix[c2][1] = *(const LAS v4i*)(idl + 64 * kg + 8 * (ch + 2) + 4);
#pragma unroll
                for (int j = 0; j < 8; ++j) vv[c2][j] = *(const v4u*)(vbase + (size_t)ix[c2][j >> 2][j & 3] * KVD);
                ATT_FENCE(); }
            f32x4 pp[4][2];
#pragma unroll
            for (int h = 0; h < 4; ++h) { pp[h][0] = *(const LAS f32x4*)(pl + h * 256 + 64 * kg + 8 * ch); pp[h][1] = *(const LAS f32x4*)(pl + h * 256 + 64 * kg + 8 * ch + 4); }
#pragma unroll
            for (int j = 0; j < 8; ++j) { const v4u w = vv[ch % 3][j];
                const f32x2 v0 = {bf_lo(w.x), bf_hi(w.x)}, v1 = {bf_lo(w.y), bf_hi(w.y)}, v2 = {bf_lo(w.z), bf_hi(w.z)}, v3 = {bf_lo(w.w), bf_hi(w.w)};
#pragma unroll
                for (int h = 0; h < 4; ++h) { const float p = pp[h][j >> 2][j & 3]; const f32x2 p2 = {p, p};
                    acc[h][0] += p2 * v0; acc[h][1] += p2 * v1; acc[h][2] += p2 * v2; acc[h][3] += p2 * v3; }
            }
        }
#pragma unroll
        for (int h = 0; h < 4; ++h)
#pragma unroll
            for (int d = 0; d < 4; ++d) {
                acc[h][d][0] += __shfl_xor(acc[h][d][0], 16); acc[h][d][1] += __shfl_xor(acc[h][d][1], 16);
                acc[h][d][0] += __shfl_xor(acc[h][d][0], 32); acc[h][d][1] += __shfl_xor(acc[h][d][1], 32); }
        if (kg == 0) {
#pragma unroll
            for (int h = 0; h < 4; ++h) { v4u w; w.x = pk2(acc[h][0][0], acc[h][0][1]); w.y = pk2(acc[h][1][0], acc[h][1][1]); w.z = pk2(acc[h][2][0], acc[h][2][1]); w.w = pk2(acc[h][3][0], acc[h][3][1]);
                *(v4u*)(ao + (size_t)mq * DA + (4 * g + h) * 128 + 8 * dg) = w; } }
        LDS_WAIT(); ATT_FENCE();
        qn = qn2;
    }
}

constexpr int SC_STEPS = 32, SC_PAIRS = SC_STEPS / 2;
constexpr int SC_PAIR_FLOATS = 616, SC_PAIR_BYTES = SC_PAIR_FLOATS * 4;
constexpr int SC_BUF_BYTES = SC_PAIRS * SC_PAIR_BYTES;
constexpr int PV_D1 = 0, PV_D2 = 64, PV_E1 = 128, PV_W12 = 192, PV_B1P = 256, PV_K1P = 320, PV_B2 = 384, PV_K2 = 448, PV_R2 = 512, PV_SC = 576, PV_V = 580;

template <int CTRL> DI float dpp_add(float x) { return x + __builtin_bit_cast(float, __builtin_amdgcn_update_dpp(0, __builtin_bit_cast(int, x), CTRL, 0xf, 0xf, false)); }
DI float red16(float x) { x = dpp_add<0xB1>(x); x = dpp_add<0x4E>(x); x = dpp_add<0x141>(x); x = dpp_add<0x140>(x); return x; }
DI float red8(float x) { x = dpp_add<0xB1>(x); x = dpp_add<0x4E>(x); x = dpp_add<0x141>(x); return x; }
DI float hsum4(const f32x4& p) { return (p[0] + p[1]) + (p[2] + p[3]); }

struct ScanRaw { v2u rc, rp, kc, kp, vc, vp, ac; f32x4 dc; };
struct ScanConst { f32x4 mu_r, mu_k, mu_v, kkw, kaw, rkw; };
DI f32x4 bf4(const v2u& w) { f32x4 r; r[0] = bf_lo(w.x); r[1] = bf_hi(w.x); r[2] = bf_lo(w.y); r[3] = bf_hi(w.y); return r; }

DI void scan_issue_pair(ScanRaw& R1, ScanRaw& R2, const unsigned char* ws, int b, int h, int t, int cg) {
    const bf16* rb = (const bf16*)(ws + WS_RB); const bf16* kb = (const bf16*)(ws + WS_KB); const bf16* vb = (const bf16*)(ws + WS_VB);
    const float* decay = (const float*)(ws + WS_DECAY); const bf16* av = (const bf16*)(ws + WS_AOUT);
    const size_t o = (size_t)(b * SEQ + t) * DB + h * HDB + 4 * cg;
    R1.rc = *(const v2u*)(rb + o); R1.kc = *(const v2u*)(kb + o); R1.vc = *(const v2u*)(vb + o); R1.dc = *(const f32x4*)(decay + o); R1.ac = *(const v2u*)(av + o);
    R2.rc = *(const v2u*)(rb + o + DB); R2.kc = *(const v2u*)(kb + o + DB); R2.vc = *(const v2u*)(vb + o + DB); R2.dc = *(const f32x4*)(decay + o + DB); R2.ac = *(const v2u*)(av + o + DB);
    if (t > 0) { R1.rp = *(const v2u*)(rb + o - DB); R1.kp = *(const v2u*)(kb + o - DB); R1.vp = *(const v2u*)(vb + o - DB); }
    else { R1.rp = (v2u){0u, 0u}; R1.kp = (v2u){0u, 0u}; R1.vp = (v2u){0u, 0u}; }
}
struct StepVec { f32x4 w, a, b, k, r, v; float bonus; };
DI void scan_stepvec(StepVec& o, const f32x4& rc, const f32x4& rp, const f32x4& kc, const f32x4& kp, const f32x4& vc, const f32x4& vp, const f32x4& a, const f32x4& dc, const ScanConst& C) {
    const f32x4 r1 = rc + (rp - rc) * C.mu_r, k0 = kc + (kp - kc) * C.mu_k, v1 = vc + (vp - vc) * C.mu_v;
    const f32x4 kkv = k0 * C.kkw;
    const float nrm = sqrtf(red16(hsum4(kkv * kkv)));
    const f32x4 kkn = kkv * (1.0f / fmaxf(nrm, 1e-12f));
    const f32x4 k1 = k0 * (1.0f + (a - 1.0f) * C.kaw);
    o.w = dc; o.a = -kkn; o.b = kkn * a; o.k = k1; o.r = r1; o.v = v1; o.bonus = red16(hsum4(r1 * k1 * C.rkw));
}
DI void scan_emit_pair(const ScanRaw& R1, const ScanRaw& R2, const ScanConst& C, LAS float* pb, int cg, int qr, float* bonus_dst) {
    const f32x4 rc1 = bf4(R1.rc), kc1 = bf4(R1.kc), vc1 = bf4(R1.vc);
    StepVec s1, s2;
    scan_stepvec(s1, rc1, bf4(R1.rp), kc1, bf4(R1.kp), vc1, bf4(R1.vp), bf4(R1.ac), R1.dc, C);
    scan_stepvec(s2, bf4(R2.rc), rc1, bf4(R2.kc), kc1, bf4(R2.vc), vc1, bf4(R2.ac), R2.dc, C);
    const float beta = red16(hsum4(s1.b * s2.a)), kappa = red16(hsum4(s1.k * s2.a)), betar = red16(hsum4(s1.b * s1.r)), kappar = red16(hsum4(s1.k * s1.r));
    *(LAS f32x4*)(pb + PV_D1 + 4 * cg) = s1.a; *(LAS f32x4*)(pb + PV_D2 + 4 * cg) = s1.w * s2.a; *(LAS f32x4*)(pb + PV_E1 + 4 * cg) = s1.w * s1.r;
    *(LAS f32x4*)(pb + PV_W12 + 4 * cg) = s1.w * s2.w; *(LAS f32x4*)(pb + PV_B1P + 4 * cg) = s1.b * s2.w; *(LAS f32x4*)(pb + PV_K1P + 4 * cg) = s1.k * s2.w;
    *(LAS f32x4*)(pb + PV_B2 + 4 * cg) = s2.b; *(LAS f32x4*)(pb + PV_K2 + 4 * cg) = s2.k; *(LAS f32x4*)(pb + PV_R2 + 4 * cg) = s2.r;
    if (cg == 0) *(LAS f32x4*)(pb + PV_SC) = (f32x4){beta, kappa, betar, kappar};
    if ((cg >> 2) == qr) { LAS float* vd = pb + PV_V + 8 * (cg & 3);
        *(LAS f32x4*)(vd) = (f32x4){s1.v[0], s2.v[0], s1.v[1], s2.v[1]}; *(LAS f32x4*)(vd + 4) = (f32x4){s1.v[2], s2.v[2], s1.v[3], s2.v[3]}; }
    if (bonus_dst != nullptr && cg == 0) { bonus_dst[0] = s1.bonus; bonus_dst[NHB] = s2.bonus; }
}
struct PairVec { f32x4 d1[2], d2[2], e1[2], w12[2], b1p[2], k1p[2], b2[2], k2[2], r2[2], sc; f32x2 v; };
DI void pair_ld(PairVec& P, const LAS float* pb, int cg, int vrow) {
#pragma unroll
    for (int i = 0; i < 2; ++i) { const int o = 8 * cg + 4 * i;
        P.d1[i] = *(const LAS f32x4*)(pb + PV_D1 + o); P.d2[i] = *(const LAS f32x4*)(pb + PV_D2 + o); P.e1[i] = *(const LAS f32x4*)(pb + PV_E1 + o);
        P.w12[i] = *(const LAS f32x4*)(pb + PV_W12 + o); P.b1p[i] = *(const LAS f32x4*)(pb + PV_B1P + o); P.k1p[i] = *(const LAS f32x4*)(pb + PV_K1P + o);
        P.b2[i] = *(const LAS f32x4*)(pb + PV_B2 + o); P.k2[i] = *(const LAS f32x4*)(pb + PV_K2 + o); P.r2[i] = *(const LAS f32x4*)(pb + PV_R2 + o); }
    P.sc = *(const LAS f32x4*)(pb + PV_SC); P.v = *(const LAS f32x2*)(pb + PV_V + 2 * vrow);
}
DI void pair_step(f32x4& s0, f32x4& s1, const PairVec& P, float& y1, float& y2) {
    const float d1 = red8(hsum4(s0 * P.d1[0] + s1 * P.d1[1])), d2 = red8(hsum4(s0 * P.d2[0] + s1 * P.d2[1])), e1 = red8(hsum4(s0 * P.e1[0] + s1 * P.e1[1]));
    const float v1 = P.v[0], v2 = P.v[1];
    const float sa2 = d2 + d1 * P.sc[0] + v1 * P.sc[1];
    y1 = e1 + d1 * P.sc[2] + v1 * P.sc[3];
    s0 = s0 * P.w12[0] + P.b1p[0] * d1 + P.k1p[0] * v1 + P.b2[0] * sa2 + P.k2[0] * v2;
    s1 = s1 * P.w12[1] + P.b1p[1] * d1 + P.k1p[1] * v1 + P.b2[1] * sa2 + P.k2[1] * v2;
    y2 = red8(hsum4(s0 * P.r2[0] + s1 * P.r2[1]));
}
DI void lds_signal(LAS unsigned* p, int lane) { asm volatile("s_waitcnt lgkmcnt(0)" ::: "memory"); if (lane == 0) __hip_atomic_fetch_add(p, 1u, __ATOMIC_RELAXED, __HIP_MEMORY_SCOPE_WORKGROUP); }
DI void lds_wait_ge(LAS unsigned* p, unsigned v) {
    unsigned spins = 0;
    while ((unsigned)__builtin_amdgcn_readfirstlane(__hip_atomic_load(p, __ATOMIC_RELAXED, __HIP_MEMORY_SCOPE_WORKGROUP)) < v) { __builtin_amdgcn_s_sleep(1); if (++spins > (1u << 24)) break; }
    asm volatile("" ::: "memory");
}
constexpr int SC_YW_OFF = 2 * SC_BUF_BYTES;
constexpr int SC_NSCAN = 2, SC_NLOAD = 2;

DI void scan_task(const float* const* in, unsigned char* ws, float* y, LAS unsigned char* lds, LAS unsigned* ctr, int task, int wave) {
    const int lane = lane_opaque();
    float* bonus = (float*)(ws + WS_BONUS);
#ifndef SC_REP
#define SC_REP 1
#endif
    constexpr int NCHUNK = SEQ / SC_STEPS, NCH2 = SC_REP * NCHUNK;
    const int bh = task >> 2, qr = task & 3, b = bh >> 5, h = bh & 31;
    if (wave < SC_NSCAN) {
        const int rl = lane >> 3, cg = lane & 7, vrow = 8 * wave + rl;
        f32x4 s0 = {0.f, 0.f, 0.f, 0.f}, s1 = s0;
        LAS float* yb = (LAS float*)(lds + SC_YW_OFF + wave * 1024);
        for (int c2 = 0; c2 < NCH2; ++c2) { const int c = c2 & (NCHUNK - 1); if (SC_REP > 1 && c == 0) { s0 = (f32x4){0.f, 0.f, 0.f, 0.f}; s1 = s0; }
            lds_wait_ge(ctr, (unsigned)(c2 + 1)); lds_wait_ge(ctr + 1, (unsigned)(c2 + 1));
            const LAS unsigned char* buf = lds + (c2 & 1) * SC_BUF_BYTES;
            PairVec A, B; pair_ld(A, (const LAS float*)buf, cg, vrow);
#pragma unroll 1
            for (int p = 0; p < SC_PAIRS; p += 2) {
                pair_ld(B, (const LAS float*)(buf + (p + 1) * SC_PAIR_BYTES), cg, vrow);
                float ya, yb_, yc, yd;
                pair_step(s0, s1, A, ya, yb_);
                if (p + 2 < SC_PAIRS) pair_ld(A, (const LAS float*)(buf + (p + 2) * SC_PAIR_BYTES), cg, vrow);
                pair_step(s0, s1, B, yc, yd);
                if (cg == 0) { yb[(2 * p) * 8 + rl] = ya; yb[(2 * p + 1) * 8 + rl] = yb_; yb[(2 * p + 2) * 8 + rl] = yc; yb[(2 * p + 3) * 8 + rl] = yd; }
            }
            lds_signal(ctr + 2 + wave, lane);
            { const int s = lane >> 1, hf = lane & 1, t = c * SC_STEPS + s;
              *(f32x4*)(y + (size_t)(b * SEQ + t) * DB + h * HDB + 16 * qr + 8 * wave + 4 * hf) = *(const LAS f32x4*)(yb + s * 8 + 4 * hf); }
            asm volatile("s_waitcnt lgkmcnt(0)" ::: "memory");
        }
    } else if (wave < SC_NSCAN + SC_NLOAD) {
        const int lw = wave - SC_NSCAN, pl_ = lane >> 4, cg = lane & 15, col0 = h * HDB + 4 * cg;
        ScanConst C; C.mu_r = *(const f32x4*)(in[I_MU_RKV] + col0); C.mu_k = *(const f32x4*)(in[I_MU_RKV] + DB + col0); C.mu_v = *(const f32x4*)(in[I_MU_RKV] + 2 * DB + col0);
        C.kkw = *(const f32x4*)(in[I_KK] + col0); C.kaw = *(const f32x4*)(in[I_KA] + col0); C.rkw = *(const f32x4*)(in[I_RK] + col0);
        ScanRaw R1[2], R2[2];
#pragma unroll
        for (int q = 0; q < 2; ++q) scan_issue_pair(R1[q], R2[q], ws, b, h, 2 * (4 * (lw + 2 * q) + pl_), cg);
        for (int c2 = 0; c2 < NCH2; ++c2) { const int c = c2 & (NCHUNK - 1);
            if (c2 >= 2) { lds_wait_ge(ctr + 2, (unsigned)(c2 - 1)); lds_wait_ge(ctr + 3, (unsigned)(c2 - 1)); }
            LAS float* base = (LAS float*)(lds + (c2 & 1) * SC_BUF_BYTES); const int t0 = c * SC_STEPS;
#pragma unroll
            for (int q = 0; q < 2; ++q) { const int pr = 4 * (lw + 2 * q) + pl_;
                scan_emit_pair(R1[q], R2[q], C, base + pr * SC_PAIR_FLOATS, cg, qr, qr == 0 ? bonus + (size_t)(b * SEQ + t0 + 2 * pr) * NHB + h : nullptr);
                if (c2 + 1 < NCH2) scan_issue_pair(R1[q], R2[q], ws, b, h, ((c + 1) & (NCHUNK - 1)) * SC_STEPS + 2 * pr, cg); }
            lds_signal(ctr + lw, lane);
        }
    }
}


typedef __bf16 hbf2 __attribute__((ext_vector_type(2)));
DI unsigned cvtpk2(float lo, float hi) { const f32x2 v = {lo, hi}; const hbf2 b = __builtin_convertvector(v, hbf2); return __builtin_bit_cast(unsigned, b); }
DI bf16x8 pack_acc8(const f32x16& x, const int s) { v4u w; w.x = cvtpk2(x[8 * s], x[8 * s + 1]); w.y = cvtpk2(x[8 * s + 2], x[8 * s + 3]); w.z = cvtpk2(x[8 * s + 4], x[8 * s + 5]); w.w = cvtpk2(x[8 * s + 6], x[8 * s + 7]); return __builtin_bit_cast(bf16x8, w); }
DI bf16x8 ld_perm(const LAS unsigned char* rowk0, int h) { const v2u lo = *(const LAS v2u*)(rowk0 + 8 * h), hi = *(const LAS v2u*)(rowk0 + 16 + 8 * h); const v4u w = {lo.x, lo.y, hi.x, hi.y}; return __builtin_bit_cast(bf16x8, w); }
DI bf16x8 ld_frag(const LAS unsigned char* p) { return *(const LAS bf16x8*)p; }
DI float wave_sum64(float x) { x = red16(x); const int xi = __builtin_bit_cast(int, x);
    return (__builtin_bit_cast(float, __builtin_amdgcn_readlane(xi, 0)) + __builtin_bit_cast(float, __builtin_amdgcn_readlane(xi, 16))) + (__builtin_bit_cast(float, __builtin_amdgcn_readlane(xi, 32)) + __builtin_bit_cast(float, __builtin_amdgcn_readlane(xi, 48))); }

constexpr int CK = 16, CS_NCHUNK = SEQ / CK;
constexpr int CS_RA = 0, CS_BK = 4608, CS_XG = 9728, CS_MM = 11008, CS_VT = 12288, CS_PC = 15360, CS_SLOT = 15616;
constexpr int CS_P_RA = 144, CS_P_BK = 80, CS_P_XG = 80, CS_P_VT = 48;
constexpr int CS_NPREP = 6, CS_SCR_OFF = CS_NPREP * CS_SLOT;
constexpr int CS_S_BKROW = 0, CS_S_LAB = 4608, CS_S_LAK = 5632, CS_S_PT = 6400, CS_SCR_BYTES = 10496;
static_assert(CS_SCR_OFF + CS_NPREP * CS_SCR_BYTES <= 162816, "chunk-scan LDS map");

DI void chunk_scan(const float* const* in, unsigned char* ws, float* y, LAS unsigned char* lds, LAS unsigned* ctr  , int b, int hd, int wave) {
    const int lane = lane_opaque();
    if (wave < 2) {
        const int Ib = wave, n = lane & 31, h = lane >> 5;
        f32x16 acc0, acc1;
#pragma unroll
        for (int i = 0; i < 16; ++i) { acc0[i] = 0.f; acc1[i] = 0.f; }
        int pw = 0, nn = 0;
        for (int c = 0; c < CS_NCHUNK; ++c, ++pw) {
            if (pw == CS_NPREP) { pw = 0; ++nn; }
            lds_wait_ge(ctr + pw, (unsigned)(nn + 1));
            const LAS unsigned char* sl = lds + pw * CS_SLOT;
            const LAS unsigned char* ra = sl + CS_RA + n * CS_P_RA; const LAS unsigned char* xg = sl + CS_XG + (n & 15) * CS_P_XG; const LAS unsigned char* mm = sl + CS_MM + (n & 15) * CS_P_XG;
            const bf16x8 vfrag = ld_frag(sl + CS_VT + (32 * Ib + n) * CS_P_VT + 16 * h);
            f32x16 U;
#pragma unroll
            for (int i = 0; i < 16; ++i) U[i] = 0.f;
            U = __builtin_amdgcn_mfma_f32_32x32x16_bf16(ld_perm(ra + 0, h),  pack_acc8(acc0, 0), U, 0, 0, 0);
            U = __builtin_amdgcn_mfma_f32_32x32x16_bf16(ld_perm(ra + 32, h), pack_acc8(acc0, 1), U, 0, 0, 0);
            U = __builtin_amdgcn_mfma_f32_32x32x16_bf16(ld_perm(ra + 64, h), pack_acc8(acc1, 0), U, 0, 0, 0);
            U = __builtin_amdgcn_mfma_f32_32x32x16_bf16(ld_perm(ra + 96, h), pack_acc8(acc1, 1), U, 0, 0, 0);
            f32x16 SA;
#pragma unroll
            for (int i = 0; i < 16; ++i) SA[i] = 0.f;
            SA = __builtin_amdgcn_mfma_f32_32x32x16_bf16(ld_perm(xg, h), pack_acc8(U, 1), SA, 0, 0, 0);
            SA = __builtin_amdgcn_mfma_f32_32x32x16_bf16(ld_frag(xg + 32 + 16 * h), vfrag, SA, 0, 0, 0);
            const bf16x8 sab = pack_acc8(SA, 0);
            U = __builtin_amdgcn_mfma_f32_32x32x16_bf16(ld_perm(mm, h), sab, U, 0, 0, 0);
            U = __builtin_amdgcn_mfma_f32_32x32x16_bf16(ld_frag(mm + 32 + 16 * h), vfrag, U, 0, 0, 0);
            { const LAS unsigned char* bk = sl + CS_BK + n * CS_P_BK;
              acc0 = __builtin_amdgcn_mfma_f32_32x32x16_bf16(ld_perm(bk, h), sab, acc0, 0, 0, 0);
              acc0 = __builtin_amdgcn_mfma_f32_32x32x16_bf16(ld_frag(bk + 32 + 16 * h), vfrag, acc0, 0, 0, 0);
              acc1 = __builtin_amdgcn_mfma_f32_32x32x16_bf16(ld_perm(bk + 32 * CS_P_BK, h), sab, acc1, 0, 0, 0);
              acc1 = __builtin_amdgcn_mfma_f32_32x32x16_bf16(ld_frag(bk + 32 * CS_P_BK + 32 + 16 * h), vfrag, acc1, 0, 0, 0);
              const LAS float* pc = (const LAS float*)(sl + CS_PC);
#pragma unroll
              for (int g = 0; g < 4; ++g) { const f32x4 p0 = *(const LAS f32x4*)(pc + 8 * g + 4 * h), p1 = *(const LAS f32x4*)(pc + 32 + 8 * g + 4 * h);
#pragma unroll
                  for (int e = 0; e < 4; ++e) { acc0[4 * g + e] *= p0[e]; acc1[4 * g + e] *= p1[e]; } } }
            { float* yb = y + (size_t)(b * SEQ + c * CK) * DB + hd * HDB + 32 * Ib + n;
#pragma unroll
              for (int rho = 0; rho < 8; ++rho) yb[(size_t)((rho & 3) + 8 * (rho >> 2) + 4 * h) * DB] = U[rho]; }
            lds_signal(ctr + 6 + wave, lane);
        }
    } else if (wave < 2 + CS_NPREP) {
        const int pw = wave - 2, j = lane, col = hd * HDB + j, st = lane >> 4, cg = lane & 15, col4 = hd * HDB + 4 * cg;
        const bf16* rb = (const bf16*)(ws + WS_RB); const bf16* kb = (const bf16*)(ws + WS_KB); const bf16* vb = (const bf16*)(ws + WS_VB);
        const float* decay = (const float*)(ws + WS_DECAY); const bf16* av = (const bf16*)(ws + WS_AOUT); float* bonus = (float*)(ws + WS_BONUS);
        ScanConst Cc; Cc.mu_r = *(const f32x4*)(in[I_MU_RKV] + col4); Cc.mu_k = *(const f32x4*)(in[I_MU_RKV] + DB + col4); Cc.mu_v = *(const f32x4*)(in[I_MU_RKV] + 2 * DB + col4);
        Cc.kkw = *(const f32x4*)(in[I_KK] + col4); Cc.kaw = *(const f32x4*)(in[I_KA] + col4); Cc.rkw = *(const f32x4*)(in[I_RK] + col4);
        LAS unsigned char* scr = lds + CS_SCR_OFF + pw * CS_SCR_BYTES; LAS unsigned char* sl = lds + pw * CS_SLOT;
        const int n32 = lane & 31, h = lane >> 5;
        float dcol[16]; ScanRaw R[4];
#define CS_ISSUE(cc) do { const size_t ob_ = (size_t)(b * SEQ + (cc) * CK) * DB; \
            _Pragma("unroll") for (int t_ = 0; t_ < 16; ++t_) dcol[t_] = decay[ob_ + (size_t)t_ * DB + col]; \
            _Pragma("unroll") for (int p_ = 0; p_ < 4; ++p_) { const int tt_ = (cc) * CK + 4 * p_ + st; const size_t o_ = (size_t)(b * SEQ + tt_) * DB + col4; \
                R[p_].rc = *(const v2u*)(rb + o_); R[p_].kc = *(const v2u*)(kb + o_); R[p_].vc = *(const v2u*)(vb + o_); R[p_].ac = *(const v2u*)(av + o_); \
                if (tt_ > 0) { R[p_].rp = *(const v2u*)(rb + o_ - DB); R[p_].kp = *(const v2u*)(kb + o_ - DB); R[p_].vp = *(const v2u*)(vb + o_ - DB); } \
                else { R[p_].rp = (v2u){0u, 0u}; R[p_].kp = (v2u){0u, 0u}; R[p_].vp = (v2u){0u, 0u}; } } } while (0)
        CS_ISSUE(pw);
        for (int nn = 0; pw + CS_NPREP * nn < CS_NCHUNK; ++nn) {
            const int c = pw + CS_NPREP * nn, t0 = c * CK;
            { float P = 1.0f; LAS float* pt = (LAS float*)(scr + CS_S_PT);
#pragma unroll
              for (int t = 0; t < 16; ++t) { P *= dcol[t]; pt[t * 64 + j] = P; } }
            if (nn >= 1) { lds_wait_ge(ctr + 6, (unsigned)(c - CS_NPREP + 1)); lds_wait_ge(ctr + 7, (unsigned)(c - CS_NPREP + 1)); }
            LDS_WAIT(); asm volatile("" ::: "memory");
            ((LAS float*)(sl + CS_PC))[j] = ((const LAS float*)(scr + CS_S_PT))[15 * 64 + j];
#pragma unroll
            for (int p = 0; p < 4; ++p) { const int t = 4 * p + st;
                const f32x4 rc = bf4(R[p].rc), kc = bf4(R[p].kc), vc = bf4(R[p].vc), a_ = bf4(R[p].ac);
                const f32x4 r1 = rc + (bf4(R[p].rp) - rc) * Cc.mu_r, k0 = kc + (bf4(R[p].kp) - kc) * Cc.mu_k, v1 = vc + (bf4(R[p].vp) - vc) * Cc.mu_v;
                const f32x4 kkv = k0 * Cc.kkw;
                const float nrm = sqrtf(red16(hsum4(kkv * kkv)));
                const f32x4 kkn = kkv * (1.0f / fmaxf(nrm, 1e-12f));
                const f32x4 k1 = k0 * (1.0f + (a_ - 1.0f) * Cc.kaw);
                const float bc = red16(hsum4(r1 * k1 * Cc.rkw));
                if (cg == 0) bonus[(size_t)(b * SEQ + t0 + t) * NHB + hd] = bc;
                const f32x4 P4 = *(const LAS f32x4*)(scr + CS_S_PT + (t * 64 + 4 * cg) * 4);
                f32x4 Pm = {1.f, 1.f, 1.f, 1.f}; if (t > 0) Pm = *(const LAS f32x4*)(scr + CS_S_PT + ((t - 1) * 64 + 4 * cg) * 4);
                f32x4 iP; iP[0] = 1.0f / P4[0]; iP[1] = 1.0f / P4[1]; iP[2] = 1.0f / P4[2]; iP[3] = 1.0f / P4[3];
                const f32x4 Rt = r1 * P4, At = -kkn * Pm, Bt = kkn * a_ * iP, Kt = k1 * iP;
                *(LAS v2u*)(sl + CS_RA + t * CS_P_RA + 8 * cg) = (v2u){pk2(Rt[0], Rt[1]), pk2(Rt[2], Rt[3])};
                *(LAS v2u*)(sl + CS_RA + (16 + t) * CS_P_RA + 8 * cg) = (v2u){pk2(At[0], At[1]), pk2(At[2], At[3])};
                *(LAS v2u*)(scr + CS_S_BKROW + t * CS_P_RA + 8 * cg) = (v2u){pk2(Bt[0], Bt[1]), pk2(Bt[2], Bt[3])};
                *(LAS v2u*)(scr + CS_S_BKROW + (16 + t) * CS_P_RA + 8 * cg) = (v2u){pk2(Kt[0], Kt[1]), pk2(Kt[2], Kt[3])};
#pragma unroll
                for (int i = 0; i < 4; ++i) { LAS bf16* bkr = (LAS bf16*)(sl + CS_BK + (4 * cg + i) * CS_P_BK); bkr[t] = (bf16)f2bf(Bt[i]); bkr[16 + t] = (bf16)f2bf(Kt[i]);
                    ((LAS bf16*)(sl + CS_VT + (4 * cg + i) * CS_P_VT))[t] = (bf16)f2bf(v1[i]); }
            }
            if (c + CS_NPREP < CS_NCHUNK) CS_ISSUE(c + CS_NPREP);
            LDS_WAIT(); asm volatile("" ::: "memory");
            f32x16 C;
#pragma unroll
            for (int i = 0; i < 16; ++i) C[i] = 0.f;
#pragma unroll
            for (int s = 0; s < 4; ++s) C = __builtin_amdgcn_mfma_f32_32x32x16_bf16(ld_frag(scr + CS_S_BKROW + n32 * CS_P_RA + (16 * s + 8 * h) * 2), ld_frag(sl + CS_RA + n32 * CS_P_RA + (16 * s + 8 * h) * 2), C, 0, 0, 0);
            if (n32 < 16) {
                const int t = n32; LAS unsigned char* mrow = sl + CS_MM + t * CS_P_XG;
#pragma unroll
                for (int g = 0; g < 2; ++g) { float m0[4], m1[4];
#pragma unroll
                    for (int e = 0; e < 4; ++e) { const int tau = e + 8 * g + 4 * h; m0[e] = (tau <= t) ? C[4 * g + e] : 0.f; m1[e] = (tau <= t) ? C[8 + 4 * g + e] : 0.f; }
                    *(LAS v2u*)(mrow + 16 * g + 8 * h) = (v2u){pk2(m0[0], m0[1]), pk2(m0[2], m0[3])}; *(LAS v2u*)(mrow + 32 + 16 * g + 8 * h) = (v2u){pk2(m1[0], m1[1]), pk2(m1[2], m1[3])}; }
            } else {
                const int t = n32 - 16;
#pragma unroll
                for (int g = 0; g < 2; ++g)
#pragma unroll
                    for (int e = 0; e < 4; ++e) { const int tau = e + 8 * g + 4 * h;
                        ((LAS float*)(scr + CS_S_LAB))[tau * 16 + t] = (tau < t) ? C[4 * g + e] : 0.f;
                        ((LAS bf16*)(scr + CS_S_LAK + tau * 48))[t] = (bf16)f2bf((tau < t) ? C[8 + 4 * g + e] : 0.f); }
            }
            LDS_WAIT(); asm volatile("" ::: "memory");
            float x[16]; const int tx = lane & 15;
#pragma unroll
            for (int i = 0; i < 16; ++i) x[i] = (i == tx) ? 1.0f : 0.0f;
#pragma unroll
            for (int tau = 14; tau >= 0; --tau) { const LAS f32x4* lr = (const LAS f32x4*)(scr + CS_S_LAB + tau * 64); float a2 = x[tau];
#pragma unroll
                for (int q = (tau + 1) >> 2; q < 4; ++q) { const f32x4 L = lr[q];
#pragma unroll
                    for (int e = 0; e < 4; ++e) { const int s2 = 4 * q + e; if (s2 > tau) a2 += L[e] * x[s2]; } }
                x[tau] = a2; }
            if (lane < 16) { LAS v4u* xr = (LAS v4u*)(sl + CS_XG + lane * CS_P_XG);
                xr[0] = (v4u){pk2(x[0], x[1]), pk2(x[2], x[3]), pk2(x[4], x[5]), pk2(x[6], x[7])}; xr[1] = (v4u){pk2(x[8], x[9]), pk2(x[10], x[11]), pk2(x[12], x[13]), pk2(x[14], x[15])}; }
            { v4u xb;
              xb.x = h ? pk2(x[8], x[9]) : pk2(x[0], x[1]); xb.y = h ? pk2(x[10], x[11]) : pk2(x[2], x[3]); xb.z = h ? pk2(x[12], x[13]) : pk2(x[4], x[5]); xb.w = h ? pk2(x[14], x[15]) : pk2(x[6], x[7]);
              if (n32 >= 16) xb = (v4u){0u, 0u, 0u, 0u};
              f32x16 Gm;
#pragma unroll
              for (int i = 0; i < 16; ++i) Gm[i] = 0.f;
              Gm = __builtin_amdgcn_mfma_f32_32x32x16_bf16(ld_frag(scr + CS_S_LAK + (n32 & 15) * 48 + 16 * h), __builtin_bit_cast(bf16x8, xb), Gm, 0, 0, 0);
              if (n32 < 16) { LAS unsigned char* grow = sl + CS_XG + n32 * CS_P_XG + 32;
#pragma unroll
                  for (int g = 0; g < 2; ++g) *(LAS v2u*)(grow + 16 * g + 8 * h) = (v2u){pk2(Gm[4 * g], Gm[4 * g + 1]), pk2(Gm[4 * g + 2], Gm[4 * g + 3])}; } }
            lds_signal(ctr + pw, lane);
        }
#undef CS_ISSUE
    }
}

constexpr int ATT_LDS_OFF = 90112;
constexpr int ATT_LDS_OFF2 = 132096;
DI void scan_attn_phase(const float* const* in, unsigned char* ws, float* y, LAS unsigned char* lds, LAS unsigned char* lds_all, LAS unsigned* ctr, int wave) {
    const bool is_scan = ((blockIdx.x >> 3) & 3) == 0 && gridDim.x == 256; const int sb = (int)(blockIdx.x & 7) + 8 * (int)(blockIdx.x >> 5);
    __syncthreads();
    if (wave == 0 && lane_opaque() == 0) { ((LAS v4u*)ctr)[0] = (v4u){0u, 0u, 0u, 0u}; ((LAS v4u*)ctr)[1] = (v4u){0u, 0u, 0u, 0u}; ((LAS v4u*)ctr)[2] = (v4u){0u, 0u, 0u, 0u}; }
    __syncthreads();
#ifndef REP_CS
#define REP_CS 1
#endif
    if (is_scan) { for (int rep = 0; rep < REP_CS; ++rep) {
            if (rep) { if (wave == 0 && lane_opaque() == 0) { ((LAS v4u*)ctr)[0] = (v4u){0u, 0u, 0u, 0u}; ((LAS v4u*)ctr)[1] = (v4u){0u, 0u, 0u, 0u}; } __syncthreads(); }
            chunk_scan(in, ws, y, lds, ctr, sb >> 5, sb & 31, wave); __syncthreads(); } }
    LAS unsigned char* mine = wave >= 3 ? lds + ATT_LDS_OFF + (wave - 3) * 8192 : lds_all + ATT_LDS_OFF2 + wave * 5120;
    attn_worker(ws, mine, ctr + 4, wave);
    if (wave >= 3) { const int lane = lane_opaque(); constexpr int NSIDE = A1_NITEMS + W2_NITEMS; const int nmine = (NSIDE - (int)blockIdx.x + (int)gridDim.x - 1) / (int)gridDim.x;
        for (;;) { unsigned v_ = 0u; if (lane == 0) v_ = __hip_atomic_fetch_add(ctr + 8, 1u, __ATOMIC_RELAXED, __HIP_MEMORY_SCOPE_WORKGROUP);
            const int i = __builtin_amdgcn_readfirstlane((int)v_); if (i >= nmine) break;
            const int it = (int)blockIdx.x + i * (int)gridDim.x;
            if (it < A1_NITEMS) convert_a1_item(in, ws, (LAS unsigned*)mine, it, lane); else convert_w2_item(in, ws, (LAS unsigned*)mine, it - A1_NITEMS, lane); } }
}

DI void gn_phase(const float* const* in, unsigned char* ws, const float* y, int gw, int NGW, int lane) {
    const bf16* vb = (const bf16*)(ws + WS_VB); const bf16* gout = (const bf16*)(ws + WS_GOUT);
    const float* bonus = (const float*)(ws + WS_BONUS); bf16* ro = (bf16*)(ws + WS_AO) + (size_t)M * DB;
    const int per = (M * 8 + NGW - 1) / NGW, it0 = gw * per, it1 = (it0 + per < M * 8) ? it0 + per : M * 8;
    const int hh = lane >> 4, cg = lane & 15;
#pragma unroll 2
    for (int it = it0; it < it1; ++it) {
        const int m = it >> 3, h = (it & 7) * 4 + hh, col = h * HDB + 4 * cg; const size_t o = (size_t)m * DB + col;
        const f32x4 yv = *(const f32x4*)(y + o);
        const f32x4 vc = bf4(*(const v2u*)(vb + o)), g4 = bf4(*(const v2u*)(gout + o));
        f32x4 vp = {0.f, 0.f, 0.f, 0.f}; if (m & (SEQ - 1)) vp = bf4(*(const v2u*)(vb + o - DB));
        const float bc = bonus[(size_t)m * NHB + h];
        const f32x4 lw = *(const f32x4*)(in[I_LNW] + col), lb = *(const f32x4*)(in[I_LNB] + col), muv = *(const f32x4*)(in[I_MU_RKV] + 2 * DB + col);
        const float mean = red16((yv[0] + yv[1]) + (yv[2] + yv[3])) * (1.0f / 64.0f); const f32x4 d = yv - mean;
        const float var = red16((d[0] * d[0] + d[1] * d[1]) + (d[2] * d[2] + d[3] * d[3])) * (1.0f / 64.0f);
        const f32x4 yn = d * (1.0f / sqrtf(var + GN_EPS)) * lw + lb;
        const f32x4 v1 = vc + (vp - vc) * muv;
        const f32x4 res = (yn + v1 * bc) * g4;
        v2u w; w.x = pk2(res[0], res[1]); w.y = pk2(res[2], res[3]);
        *(v2u*)(ro + o) = w;
    }
}

DI void final_phase(const float* const* in, unsigned char* ws, float* out, int gw, int NGW, int lane) {
    const float* ss3 = (const float*)(ws + SS3_OFF); const float* nf = in[I_NORM_FINAL];
    for (int m = gw; m < M; m += NGW) { const float r = 1.0f / sqrtf(ss3[m] * (1.0f / D) + RMS_EPS);
        GAS f32x4* o = (GAS f32x4*)(out + (size_t)m * D) + lane; const GAS f32x4* g = (const GAS f32x4*)nf + lane;
#pragma unroll 4
        for (int j = 0; j < 16; ++j) { f32x4 v = o[64 * j]; const f32x4 gg = g[64 * j]; v = v * r * gg; o[64 * j] = v; } }
}

#ifndef MK_N_LAUNCHES
#define MK_N_LAUNCHES 1
#endif
constexpr int N_PHASES = 13;
#ifndef REP_P2
#define REP_P2 1
#endif
#ifndef REP_P3
#define REP_P3 1
#endif
#ifndef REP_P6
#define REP_P6 1
#endif
#ifndef REP_P7
#define REP_P7 1
#endif
#ifndef REP_P10
#define REP_P10 1
#endif
#ifndef REP_C
#define REP_C 1
#endif
#ifndef PG8_SP2
#define PG8_SP2 true
#endif
#ifndef PG8_ALIGN
#define PG8_ALIGN true
#endif

__global__ void __launch_bounds__(NWAVES * 64, 2) hybrid_fwd(Args args) {
    extern __shared__ __attribute__((aligned(16))) unsigned char lds_raw[];
    LAS unsigned char* lds = (LAS unsigned char*)lds_raw;
    volatile LAS unsigned* MISC = (volatile LAS unsigned*)(lds + MISC_OFF);
    const int wave = __builtin_amdgcn_readfirstlane(threadIdx.x >> 6);
    const int G = gridDim.x, gw = blockIdx.x * NWAVES + wave, NGW = G * NWAVES;
    unsigned char* ws = args.ws; const float* const* in = args.in;
    { const int tid0 = wave * 64 + lane_opaque(); for (int u = tid0; u < (LDS_BYTES - LDSCTL_OFF) / 4; u += NWAVES * 64) ((LAS unsigned*)(lds + LDSCTL_OFF))[u] = 0u; }
    __syncthreads();
    unsigned* ctl = (unsigned*)(ws + WS_CTL);
    XcdBarrier bar; bar.bar = ctl + CW_BAR; bar.x = 0; bar.st = nullptr;
    const bool multi = (args.ph_hi - args.ph_lo) > 1;
    if (multi) bar = xcd_barrier_post(ctl + CW_BAR, MISC + 8, wave == 0 && lane_opaque() == 0);
    const int lo = args.ph_lo, hi = args.ph_hi;
#ifndef PHASE_MASK
#define PHASE_MASK 0x3fff
#endif
#define IN(k) ((((PHASE_MASK) >> (k)) & 1) && lo <= (k) && (k) < hi)
#define SEAM(k) do { if (IN(k) && IN((k) + 1)) xcd_barrier(bar, wave == 0 && lane_opaque() == 0); } while (0)
#define LANE lane_opaque()
    LAS unsigned* scr = (LAS unsigned*)(lds + RING_OFF + wave * 16384);

    if (IN(0)) { const int lane = LANE; for (int rep = 0; rep < REP_C; ++rep) { convert_set_a(in, ws, scr, gw, NGW, lane); prologue_rows(in, ws, gw, NGW, lane); } }
    SEAM(0);
    if (IN(1)) {
        pg8::Gemm g{(const bf16*)(ws + WS_XB), (const bf16*)(ws + WS_WCAT), M, NCAT, D}; pg8::StaticOrder S; S.init(M, NCAT, G, (int)blockIdx.x);
        epi::InProj E{(bf16*)(ws + WS_Q), (bf16*)(ws + WS_K), (bf16*)(ws + WS_V), (bf16*)(ws + WS_QI), (bf16*)(ws + WS_KI), (bf16*)(ws + WS_RB), (bf16*)(ws + WS_KB), (bf16*)(ws + WS_VB),
                      (bf16*)(ws + WS_LORA), (bf16*)(ws + WS_GATES), (float*)(ws + WS_WI), (const float*)(ws + WS_RSTDX), (const float*)(ws + WS_RCOS), (const float*)(ws + WS_RSIN)};
        pg8::gemm_phase<epi::InProj, pg8::StaticOrder, PG8_ALIGN, PG8_SP2>(lds + RING_OFF, g, S, E, wave);
#if defined(REP_P1)
        pg8::gemm_phase<epi::InProj, pg8::StaticOrder, PG8_ALIGN, PG8_SP2>(lds + RING_OFF, g, S, E, wave);
#endif
    }
    SEAM(1);
    if (IN(2)) { for (int rep = 0; rep < REP_P2; ++rep) indexer_phase(ws, lds + RING_OFF, wave); }
    SEAM(2);
    if (IN(4)) build_alora(ws, blockIdx.x * (NWAVES * 64) + wave * 64 + LANE, G * NWAVES * 64);
    SEAM(4);
    if (IN(5)) {
        int k256 = 256; asm volatile("" : "+s"(k256));
        pg8::Gemm g{(const bf16*)(ws + WS_ALORA), (const bf16*)(ws + WS_WL2), 3 * M, 3 * DB, k256}; epi::Stack3Order S{G, (int)blockIdx.x};
        epi::LoraUp E{(float*)(ws + WS_DECAY), (bf16*)(ws + WS_AOUT), (bf16*)(ws + WS_GOUT), in[I_W0], in[I_A0]};
        pg8::gemm_phase<epi::LoraUp, epi::Stack3Order, PG8_ALIGN, PG8_SP2>(lds + RING_OFF, g, S, E, wave);
    }
    SEAM(5);
    if (IN(6)) { for (int rep = 0; rep < REP_P6; ++rep) scan_attn_phase(in, ws, args.out, lds + RING_OFF, lds, (LAS unsigned*)(lds + MISC_OFF + 64), wave); }
    SEAM(6);
    if (IN(7)) { for (int rep = 0; rep < REP_P7; ++rep) gn_phase(in, ws, args.out, gw, NGW, LANE); }
    if (IN(7)) { const int lane = LANE; __syncthreads(); for (int rep = 0; rep < REP_C; ++rep) convert_set_b(in, ws, scr, gw, NGW, lane); }
    SEAM(7);
    if (IN(8)) {
        pg8::Gemm g{(const bf16*)(ws + WS_AO), (const bf16*)(ws + WS_WPAB), 2 * M, 2 * D, DA}; epi::ChainOrder S; S.so.init(M, D, G, (int)blockIdx.x);
        epi::GateMix E{(const bf16*)(ws + WS_GATES), in[I_BGATE], (bf16*)(ws + WS_MIX)};
        pg8::gemm_phase<epi::GateMix, epi::ChainOrder, PG8_ALIGN, PG8_SP2>(lds + RING_OFF, g, S, E, wave);
#if defined(REP_P8)
        pg8::gemm_phase<epi::GateMix, epi::ChainOrder, PG8_ALIGN, PG8_SP2>(lds + RING_OFF, g, S, E, wave);
#endif
    }
    SEAM(8);
    if (IN(9)) {
        pg8::Gemm g{(const bf16*)(ws + WS_MIX), (const bf16*)(ws + WS_WO), M, D, D}; pg8::StaticOrder S; S.init(M, D, G, (int)blockIdx.x);
        epi::Resid E{in[I_X], args.out, (bf16*)(ws + WS_H1B), (float*)(ws + SS1_OFF)};
        pg8::gemm_phase<epi::Resid, pg8::StaticOrder, PG8_ALIGN, PG8_SP2>(lds + RING_OFF, g, S, E, wave);
    }
    SEAM(9);
    if (IN(10)) {
        pg8::Gemm g{(const bf16*)(ws + WS_H1B), (const bf16*)(ws + WS_W13), M, N13, D}; pg8::StaticOrder S; S.init(M, N13, G, (int)blockIdx.x);
        epi::FfnUp E{(const float*)(ws + SS1_OFF), (bf16*)(ws + WS_U)};
        pg8::gemm_phase<epi::FfnUp, pg8::StaticOrder, PG8_ALIGN, PG8_SP2>(lds + RING_OFF, g, S, E, wave);
#if REP_P10 > 1
        pg8::gemm_phase<epi::FfnUp, pg8::StaticOrder, PG8_ALIGN, PG8_SP2>(lds + RING_OFF, g, S, E, wave);
#endif
    }
    SEAM(10);
    if (IN(11)) {
        { pg8::Gemm g{(const bf16*)(ws + WS_U), (const bf16*)(ws + WS_W2), M, D, DFF}; pg8::StaticOrder S; S.init(M, D, G, (int)blockIdx.x);
          epi::Resid E{args.out, args.out, (bf16*)(ws + WS_H2B), (float*)(ws + SS2_OFF)};
          pg8::gemm_phase<epi::Resid, pg8::StaticOrder, PG8_ALIGN, PG8_SP2>(lds + RING_OFF, g, S, E, wave); }
        { int k256 = 256; asm volatile("" : "+s"(k256));
          pg8::Gemm g{(const bf16*)(ws + WS_PB), (const bf16*)(ws + WS_WPLE), M, D, k256}; pg8::StaticOrder S; S.init(M, D, G, (int)blockIdx.x);
          epi::StoreBf E{(bf16*)(ws + WS_PP), D};
          pg8::gemm_phase<epi::StoreBf, pg8::StaticOrder, PG8_ALIGN, PG8_SP2>(lds + RING_OFF, g, S, E, wave); }
    }
    SEAM(11);
    if (IN(12)) {
        pg8::Gemm g{(const bf16*)(ws + WS_H2B), (const bf16*)(ws + WS_WPG), M, D, D}; pg8::StaticOrder S; S.init(M, D, G, (int)blockIdx.x);
        epi::PleGate E{args.out, (const bf16*)(ws + WS_PP), (const float*)(ws + SS2_OFF), (float*)(ws + SS3_OFF)};
        pg8::gemm_phase<epi::PleGate, pg8::StaticOrder, PG8_ALIGN, PG8_SP2>(lds + RING_OFF, g, S, E, wave);
    }
    SEAM(12);
    if (IN(13)) final_phase(in, ws, args.out, gw, NGW, LANE);
#undef IN
#undef SEAM
#undef LANE
}

extern "C" void kernel_launch(void* const* d_in, const int* in_sizes, int n_in, void* d_out, int out_size, void* d_ws, size_t ws_size, hipStream_t stream) {
    static int grid = 0;
    if (grid == 0) {
        if (n_in != 32 || in_sizes[0] != M * D || out_size != M * D || ws_size < WS_END) { fprintf(stderr, "kernel_launch: unexpected shapes: n_in %d in0 %d out %d ws %zu (need %zu)\n", n_in, n_in > 0 ? in_sizes[0] : -1, out_size, ws_size, (size_t)WS_END); grid = -1; return; }
        int dev = 0, cus = 0, per_cu = 0;
        if (hipGetDevice(&dev) != hipSuccess || hipDeviceGetAttribute(&cus, hipDeviceAttributeMultiprocessorCount, dev) != hipSuccess) { grid = -1; return; }
        if (hipFuncSetAttribute((const void*)hybrid_fwd, hipFuncAttributeMaxDynamicSharedMemorySize, LDS_BYTES) != hipSuccess) { fprintf(stderr, "kernel_launch: hipFuncSetAttribute failed\n"); grid = -1; return; }
        if (hipOccupancyMaxActiveBlocksPerMultiprocessor(&per_cu, (const void*)hybrid_fwd, NWAVES * 64, LDS_BYTES) != hipSuccess || per_cu < 1) fprintf(stderr, "kernel_launch: occupancy query says %d\n", per_cu);
        (void)hipGetLastError();
        grid = cus;
    }
    if (grid < 0) return;
    if (hipMemsetAsync((char*)d_ws + WS_CTL, 0, CTL_ZERO_BYTES, stream) != hipSuccess) return;
    Args a{};
    for (int i = 0; i < 32; ++i) a.in[i] = (const float*)d_in[i];
    a.out = (float*)d_out; a.ws = (unsigned char*)d_ws;
#if MK_N_LAUNCHES == 1
    a.ph_lo = 0; a.ph_hi = N_PHASES + 1;
    hipLaunchKernelGGL(hybrid_fwd, dim3(grid), dim3(NWAVES * 64), LDS_BYTES, stream, a);
#else
    for (int p = 0; p <= N_PHASES; ++p) { a.ph_lo = p; a.ph_hi = p + 1; hipLaunchKernelGGL(hybrid_fwd, dim3(grid), dim3(NWAVES * 64), LDS_BYTES, stream, a); }
#endif
}
```

```cpp
#include <hip/hip_runtime.h>
#include <cstdio>
#include <cstdint>
__device__ __forceinline__ int lane_opaque() { int l; asm volatile("v_mbcnt_lo_u32_b32 %0, -1, 0\n\tv_mbcnt_hi_u32_b32 %0, -1, %0" : "=v"(l)); return l; }

namespace pg8 {
#define PG8_LAS __attribute__((address_space(3)))
typedef unsigned short bf16_t;
typedef short bf16x8 __attribute__((ext_vector_type(8)));
typedef float f32x4 __attribute__((ext_vector_type(4)));
typedef unsigned u32x4 __attribute__((ext_vector_type(4)));
constexpr int BM = 256, BK = 64, HALF = 128, HTB = HALF * BK * 2  , STAGE_BYTES = 8 * HTB, NXCD = 8, WGM = 8;

__host__ __device__ __forceinline__ int lds_byte(int r, int c) { const int st = (r >> 4) * 2 + (c >> 5), rr = r & 15, cc = c & 31, ob = rr * 64 + cc * 2; return st * 1024 + (ob ^ (((ob >> 9) & 1) << 5)); }
__host__ __device__ __forceinline__ void stage_rc(int b, int& R, int& C) { const int st = b / 1024, sb = b % 1024, swz = sb ^ (((sb >> 9) & 1) << 5); R = (st >> 1) * 16 + swz / 64; C = (st & 1) * 32 + (swz % 64) / 2; }
__host__ __device__ __forceinline__ int perm32(int rho) { const int n = rho >> 4, i = rho & 15; return 8 * (i >> 2) + 4 * n + (i & 3); }

struct Unit { int pm, pn; };
struct Gemm { const bf16_t* A; const bf16_t* Bt; int M, N, K; };

struct StaticOrder {
    int nM, nN, nwg, G, c;
    __host__ __device__ void init(int M, int N, int G_, int c_) { nM = M / BM; nN = N / BM; nwg = nM * nN; G = G_; c = c_; }
    __host__ __device__ bool next(int i, Unit& u) const {
        const long L = (long)i * G + c; if (L >= nwg) return false;
        int wgid = (int)L; { const int q = nwg / NXCD, r = nwg % NXCD, xcd = wgid % NXCD, off = wgid / NXCD; wgid = (xcd < r ? xcd * (q + 1) : r * (q + 1) + (xcd - r) * q) + off; }
        const int nig = WGM * nN, gid = wgid / nig, fm = gid * WGM, gsz = (nM - fm) < WGM ? (nM - fm) : WGM;
        u.pm = fm + ((wgid % nig) % gsz); u.pn = (wgid % nig) / gsz; return true;
    }
    __device__ __forceinline__ void a_ready(const Unit&) const {}
    __device__ __forceinline__ void done(const Unit&) const {}
};
__device__ __forceinline__ unsigned cvt_pk_bf16(float lo, float hi) { unsigned r; asm volatile("v_cvt_pk_bf16_f32 %0, %1, %2" : "=v"(r) : "v"(lo), "v"(hi)); return r; }
template <class Epi, class Sched, bool ALIGN_EPI = false, bool SP2 = false>
__device__ __forceinline__ void gemm_phase(PG8_LAS unsigned char* lds, const Gemm g, const Sched& S, const Epi& E, const int wid) {
    const int lane = lane_opaque(), tid = wid * 64 + lane, wr = wid >> 2, wc = wid & 3, fr = lane & 15, fq = lane >> 4;
    const int K = g.K, nt = K / BK;
    unsigned voffA[2], voffB[2];
#pragma unroll
    for (int i = 0; i < 2; ++i) { int R, C; stage_rc(tid * 16 + i * 8192, R, C); const int Rb = Epi::PERM ? ((R & ~31) + perm32(R & 31)) : R;
        voffA[i] = (unsigned)(R * K + C) * 2u; voffB[i] = (unsigned)(Rb * K + C) * 2u; }
    const size_t kstep = (size_t)(BK * 2);
    const size_t hstep = (size_t)HALF * K * 2;
    const size_t tstep = 2 * hstep;
    const unsigned ldsw = (unsigned)wid * 1024u;
    const int aoff = lds_byte(wr * 64 + fr, fq * 8), boff = lds_byte(wc * 32 + fr, fq * 8);
#define PG8_SA(b, h) (((b) * 2 + (h)) * HTB)
#define PG8_SB(b, h) ((4 + (b) * 2 + (h)) * HTB)
#define PG8_STAGE(bufoff, gbase, voff) do { _Pragma("unroll") for (int _i = 0; _i < 2; ++_i) \
        __builtin_amdgcn_global_load_lds((const unsigned*)((const char*)(gbase) + (voff)[_i]), (PG8_LAS unsigned*)(lds + (bufoff) + ldsw + _i * 8192), 16, 0, 0); } while (0)
#define PG8_LDA(dst, b, h) do { _Pragma("unroll") for (int m = 0; m < 4; ++m) _Pragma("unroll") for (int k = 0; k < 2; ++k) dst[m][k] = *(const PG8_LAS bf16x8*)(lds + PG8_SA(b, h) + aoff + m * 2048 + k * 1024); } while (0)
#define PG8_LDB(dst, b, h) do { _Pragma("unroll") for (int n = 0; n < 2; ++n) _Pragma("unroll") for (int k = 0; k < 2; ++k) dst[n][k] = *(const PG8_LAS bf16x8*)(lds + PG8_SB(b, h) + boff + n * 2048 + k * 1024); } while (0)
#define PG8_MMA(ai, bj, At, Bt) do { __builtin_amdgcn_s_setprio(1); _Pragma("unroll") for (int m = 0; m < 4; ++m) _Pragma("unroll") for (int n = 0; n < 2; ++n) _Pragma("unroll") for (int k = 0; k < 2; ++k) \
        acc[ai][bj][m][n] = __builtin_amdgcn_mfma_f32_16x16x32_bf16(Bt[n][k], At[m][k], acc[ai][bj][m][n], 0, 0, 0); __builtin_amdgcn_s_setprio(0); } while (0)
#define PG8_WAIT_V(n) asm volatile("s_waitcnt vmcnt(" #n ")" ::: "memory")
#define PG8_WAIT_L(n) asm volatile("s_waitcnt lgkmcnt(" #n ")" ::: "memory")
#define PG8_BAR __builtin_amdgcn_s_barrier()
#define PG8_SCHED __builtin_amdgcn_sched_barrier(0)
    Unit cur, nxt; int ui = 0;
    if (!S.next(0, cur)) return;
    f32x4 acc[2][2][4][2];
#pragma unroll
    for (int a = 0; a < 2; ++a)
#pragma unroll
        for (int b = 0; b < 2; ++b)
#pragma unroll
            for (int m = 0; m < 4; ++m)
#pragma unroll
                for (int n = 0; n < 2; ++n) acc[a][b][m][n] = (f32x4){0.f, 0.f, 0.f, 0.f};
    bf16x8 At[4][2], B0[2][2], B1[2][2];
    const char* cA = (const char*)g.A + (size_t)cur.pm * tstep; const char* cB = (const char*)g.Bt + (size_t)cur.pn * tstep;
    S.a_ready(cur);
    if constexpr (SP2) {
        PG8_STAGE(PG8_SB(0, 0), cB, voffB); PG8_STAGE(PG8_SB(0, 1), cB + hstep, voffB); PG8_STAGE(PG8_SA(0, 0), cA, voffA); PG8_STAGE(PG8_SA(0, 1), cA + hstep, voffA);
        if (wr == 1) PG8_BAR;
        PG8_WAIT_V(2); PG8_BAR;
        PG8_STAGE(PG8_SB(1, 0), cB + kstep, voffB); PG8_STAGE(PG8_SA(1, 0), cA + kstep, voffA); PG8_STAGE(PG8_SB(1, 1), cB + hstep + kstep, voffB);
        PG8_WAIT_V(6); PG8_BAR;
    } else {
        PG8_STAGE(PG8_SB(0, 0), cB, voffB); PG8_STAGE(PG8_SA(0, 0), cA, voffA); PG8_STAGE(PG8_SB(0, 1), cB + hstep, voffB); PG8_STAGE(PG8_SA(0, 1), cA + hstep, voffA);
        if (wr == 1) PG8_BAR;
        PG8_WAIT_V(4); PG8_BAR;
        PG8_STAGE(PG8_SB(1, 0), cB + kstep, voffB); PG8_STAGE(PG8_SA(1, 0), cA + kstep, voffA); PG8_STAGE(PG8_SB(1, 1), cB + hstep + kstep, voffB);
        PG8_WAIT_V(6); PG8_BAR;
    }
    for (;;) {
        const bool has_next = S.next(ui + 1, nxt);
        const char* nA = has_next ? (const char*)g.A + (size_t)nxt.pm * tstep : cA; const char* nB = has_next ? (const char*)g.Bt + (size_t)nxt.pn * tstep : cB;
        for (int t = 0; t < nt; t += 2) {
            const bool last = (t == nt - 2);
            const char* a1 = cA + (size_t)(t + 1) * kstep;
            const char* a2 = last ? nA : cA + (size_t)(t + 2) * kstep; const char* b2 = last ? nB : cB + (size_t)(t + 2) * kstep;
            const char* a3 = a2 + kstep; const char* b3 = b2 + kstep;
            if (last && has_next) S.a_ready(nxt);
            if constexpr (SP2) {
            PG8_LDB(B0, 0, 0); PG8_LDB(B1, 0, 1); PG8_SCHED; PG8_LDA(At, 0, 0); PG8_STAGE(PG8_SA(1, 1), a1 + hstep, voffA);
            PG8_WAIT_V(8); PG8_WAIT_L(0); PG8_BAR; PG8_MMA(0, 0, At, B0); PG8_MMA(0, 1, At, B1); PG8_BAR; PG8_SCHED;
            PG8_LDA(At, 0, 1); PG8_STAGE(PG8_SB(0, 0), b2, voffB); PG8_STAGE(PG8_SB(0, 1), b2 + hstep, voffB); PG8_STAGE(PG8_SA(0, 0), a2, voffA);
            PG8_WAIT_V(8); PG8_WAIT_L(0); PG8_BAR; PG8_MMA(1, 0, At, B0); PG8_MMA(1, 1, At, B1); PG8_BAR; PG8_SCHED;
            PG8_LDB(B0, 1, 0); PG8_LDB(B1, 1, 1); PG8_SCHED; PG8_LDA(At, 1, 0); PG8_STAGE(PG8_SA(0, 1), a2 + hstep, voffA);
            PG8_WAIT_V(8); PG8_WAIT_L(0); PG8_BAR; PG8_MMA(0, 0, At, B0); PG8_MMA(0, 1, At, B1); PG8_BAR; PG8_SCHED;
            PG8_LDA(At, 1, 1); PG8_STAGE(PG8_SB(1, 0), b3, voffB); PG8_STAGE(PG8_SB(1, 1), b3 + hstep, voffB); PG8_STAGE(PG8_SA(1, 0), a3, voffA);
            PG8_WAIT_V(8); PG8_WAIT_L(0); PG8_BAR; PG8_MMA(1, 0, At, B0); PG8_MMA(1, 1, At, B1); PG8_BAR; PG8_SCHED;
            } else {
            PG8_LDB(B0, 0, 0); PG8_SCHED; PG8_LDA(At, 0, 0); PG8_STAGE(PG8_SA(1, 1), a1 + hstep, voffA);
            PG8_WAIT_L(8); PG8_BAR; PG8_WAIT_L(0); PG8_MMA(0, 0, At, B0); PG8_BAR; PG8_SCHED;
            PG8_LDB(B1, 0, 1); PG8_STAGE(PG8_SB(0, 0), b2, voffB);
            PG8_BAR; PG8_WAIT_L(0); PG8_MMA(0, 1, At, B1); PG8_BAR;
            PG8_LDA(At, 0, 1); PG8_STAGE(PG8_SA(0, 0), a2, voffA);
            PG8_BAR; PG8_WAIT_L(0); PG8_MMA(1, 0, At, B0); PG8_BAR; PG8_SCHED;
            PG8_STAGE(PG8_SB(0, 1), b2 + hstep, voffB);
            PG8_WAIT_V(6); PG8_BAR; PG8_MMA(1, 1, At, B1); PG8_BAR;
            PG8_LDB(B0, 1, 0); PG8_SCHED; PG8_LDA(At, 1, 0); PG8_STAGE(PG8_SA(0, 1), a2 + hstep, voffA);
            PG8_WAIT_L(8); PG8_BAR; PG8_WAIT_L(0); PG8_MMA(0, 0, At, B0); PG8_BAR; PG8_SCHED;
            PG8_LDB(B1, 1, 1); PG8_STAGE(PG8_SB(1, 0), b3, voffB);
            PG8_BAR; PG8_WAIT_L(0); PG8_MMA(0, 1, At, B1); PG8_BAR;
            PG8_LDA(At, 1, 1); PG8_STAGE(PG8_SA(1, 0), a3, voffA);
            PG8_BAR; PG8_WAIT_L(0); PG8_MMA(1, 0, At, B0); PG8_BAR; PG8_SCHED;
            PG8_STAGE(PG8_SB(1, 1), b3 + hstep, voffB);
            PG8_WAIT_V(6); PG8_BAR; PG8_MMA(1, 1, At, B1); PG8_BAR;
            }
        }
        if constexpr (ALIGN_EPI) { if (wr == 0) PG8_BAR; }
        if constexpr (!Epi::AFTER_DRAIN) { E(acc, cur, wr, wc, fr, fq); S.done(cur); }
        if (!has_next) break;
        if (!Epi::CHAIN || !E.keep(cur)) {
#pragma unroll
        for (int a = 0; a < 2; ++a)
#pragma unroll
            for (int b = 0; b < 2; ++b)
#pragma unroll
                for (int m = 0; m < 4; ++m)
#pragma unroll
                    for (int n = 0; n < 2; ++n) acc[a][b][m][n] = (f32x4){0.f, 0.f, 0.f, 0.f};
        }
        cur = nxt; cA = nA; cB = nB; ++ui;
        if constexpr (ALIGN_EPI) { if (wr == 1) PG8_BAR; }
    }
    PG8_WAIT_V(0);
    if constexpr (!ALIGN_EPI) { if (wr == 0) PG8_BAR; }
    PG8_BAR;
    if constexpr (Epi::AFTER_DRAIN) { E.fused(acc, cur, wr, wc, fr, fq, lds, wid, lane); S.done(cur); }
#undef PG8_SA
#undef PG8_SB
#undef PG8_STAGE
#undef PG8_LDA
#undef PG8_LDB
#undef PG8_MMA
#undef PG8_WAIT_V
#undef PG8_WAIT_L
#undef PG8_BAR
#undef PG8_SCHED
}
}

#define LAS __attribute__((address_space(3)))
#define XB_TMO      128
#define XB_XCNT(j)  (256  + 64 * (j))
#define XB_XSUB(j)  (1280 + 64 * (j))
#define XB_XGEN(j)  (2304 + 64 * (j))
#define XB_TOP      3328
#define XB_TOPGEN   3392
#define XCD_BAR_WORDS 3456
#define XB_SPIN_CAP (1u << 18)

__device__ __forceinline__ unsigned xb_ld(unsigned* p)              { return __hip_atomic_load(p, __ATOMIC_RELAXED, __HIP_MEMORY_SCOPE_AGENT); }
__device__ __forceinline__ unsigned xb_add(unsigned* p, unsigned v) { return __hip_atomic_fetch_add(p, v, __ATOMIC_RELAXED, __HIP_MEMORY_SCOPE_AGENT); }
__device__ __forceinline__ unsigned xb_xcc_id() { return (unsigned)__builtin_amdgcn_s_getreg((3 << 11) | 20) & 0xFu; }
#define XB_SPIN(cond, bar) do { unsigned _sp = 0; while (cond) { __builtin_amdgcn_s_sleep(1); \
    if ((++_sp & 255u) == 0u) { if (xb_ld(&(bar)[XB_TMO])) break; if (_sp > XB_SPIN_CAP) { atomicAdd(&(bar)[XB_TMO], 1u); break; } } } } while (0)

struct XcdBarrier {
    unsigned* bar; unsigned x;
    volatile LAS unsigned* st;
};

__device__ __forceinline__ XcdBarrier xcd_barrier_post(unsigned* bar, volatile LAS unsigned* st, const bool leader  ) {
    XcdBarrier b; b.bar = bar; b.x = xb_xcc_id(); b.st = st;
    if (leader) (void)xb_add(&bar[XB_XCNT(b.x)], 1u);
    return b;
}
__device__ __forceinline__ void xcd_barrier_complete(unsigned* bar, unsigned x, unsigned& nloc, unsigned& nx) {
    const unsigned G = gridDim.x * gridDim.y * gridDim.z;
    unsigned sum, cnt, mine, sp = 0u;
    for (;;) {
        sum = 0u; cnt = 0u; mine = 0u;
#pragma unroll
        for (unsigned j = 0; j < 16; ++j) { const unsigned c = xb_ld(&bar[XB_XCNT(j)]); sum += c; cnt += (c > 0u) ? 1u : 0u; mine = (j == x) ? c : mine; }
        if (sum == G) break;
        __builtin_amdgcn_s_sleep(1);
        if ((++sp & 255u) == 0u) { if (xb_ld(&bar[XB_TMO])) break; if (sp > XB_SPIN_CAP) { atomicAdd(&bar[XB_TMO], 1u); break; } }
    }
    nloc = mine > 0u ? mine : 1u; nx = cnt > 0u ? cnt : 1u;
}

__device__ __forceinline__ void xcd_barrier(const XcdBarrier& b, const bool leader  ) {
    asm volatile("s_waitcnt vmcnt(0)" ::: "memory");
    __syncthreads();
    if (leader) {
        unsigned* bar = b.bar;
        __builtin_amdgcn_s_waitcnt(0);
        unsigned nloc = b.st[0], nx = b.st[1];
        if (nloc == 0u) { xcd_barrier_complete(bar, b.x, nloc, nx); b.st[0] = nloc; b.st[1] = nx; }
        const unsigned old = xb_add(&bar[XB_XSUB(b.x)], 1u);
        const unsigned gen = old / nloc;
        if (old + 1u == (gen + 1u) * nloc) {
            __builtin_amdgcn_fence(__ATOMIC_RELEASE, "agent");
            asm volatile("s_waitcnt vmcnt(0)" ::: "memory");
            const unsigned og = xb_add(&bar[XB_TOP], 1u);
            const unsigned tg = og / nx;
            if (og + 1u == (tg + 1u) * nx) xb_add(&bar[XB_TOPGEN], 1u);
            else XB_SPIN(xb_ld(&bar[XB_TOPGEN]) == tg, bar);
            __builtin_amdgcn_fence(__ATOMIC_ACQUIRE, "agent");
            xb_add(&bar[XB_XGEN(b.x)], 1u);
            asm volatile("s_waitcnt vmcnt(0)" ::: "memory");
        } else {
            XB_SPIN(xb_ld(&bar[XB_XGEN(b.x)]) == gen, bar);
            __builtin_amdgcn_fence(__ATOMIC_ACQUIRE, "agent");
            asm volatile("s_waitcnt vmcnt(0)" ::: "memory");
        }
    }
    __syncthreads();
}

constexpr int BATCH = 2, SEQ = 8192, M = BATCH * SEQ, D = 4096;
constexpr int DA = 2048, KVD = 512, DIQ = 2048, HDI = 128, NHI = 16, DB = 2048, NHB = 32, HDB = 64;
constexpr int DIN = 11408, DFF = 11008, DPLE = 256, TOPK = 256;
constexpr int NCAT = 81 * 256;
constexpr int N13 = 2 * DFF;
constexpr int LORA_LD = 1024;
constexpr float RMS_EPS = 1e-6f, GN_EPS = 64e-5f;

#define GAS __attribute__((address_space(1)))
typedef unsigned short bf16;
typedef unsigned v4u __attribute__((ext_vector_type(4)));
typedef unsigned v2u __attribute__((ext_vector_type(2)));
typedef float f32x4 __attribute__((ext_vector_type(4)));
typedef float f32x16 __attribute__((ext_vector_type(16)));
typedef float f32x2 __attribute__((ext_vector_type(2)));
typedef short bf16x8 __attribute__((ext_vector_type(8)));
typedef GAS unsigned gu32;
#define RLX_AGENT __ATOMIC_RELAXED, __HIP_MEMORY_SCOPE_AGENT
#define LDS_WAIT() asm volatile("s_waitcnt lgkmcnt(0)" ::: "memory")
#define VM_WAIT() asm volatile("s_waitcnt vmcnt(0)" ::: "memory")
#define DI __device__ __forceinline__

DI unsigned f2bf(float f) { unsigned u = __builtin_bit_cast(unsigned, f); return (u + 0x7fffu + ((u >> 16) & 1u)) >> 16; }
DI unsigned pk2(float lo, float hi) { return f2bf(lo) | (f2bf(hi) << 16); }
DI float bf_lo(unsigned w) { return __builtin_bit_cast(float, w << 16); }
DI float bf_hi(unsigned w) { return __builtin_bit_cast(float, w & 0xffff0000u); }
DI float bf2f(bf16 h) { return __builtin_bit_cast(float, ((unsigned)h) << 16); }
DI float sigmoidf_(float z) { return 1.0f / (1.0f + __expf(-z)); }
DI float wave_sum(float v) {
#pragma unroll
    for (int o = 1; o < 64; o <<= 1) v += __shfl_xor(v, o);
    return v;
}

namespace epi {
using pg8::Unit; using pg8::BM; using pg8::HALF; using pg8::cvt_pk_bf16;
typedef pg8::f32x4 f4;
DI v4u pack8(const f4& a, const f4& b) { v4u w; w.x = cvt_pk_bf16(a[0], a[1]); w.y = cvt_pk_bf16(a[2], a[3]); w.z = cvt_pk_bf16(b[0], b[1]); w.w = cvt_pk_bf16(b[2], b[3]); return w; }
DI void unpack8(const v4u& w, f4& a, f4& b) { a[0] = bf_lo(w.x); a[1] = bf_hi(w.x); a[2] = bf_lo(w.y); a[3] = bf_hi(w.y); b[0] = bf_lo(w.z); b[1] = bf_hi(w.z); b[2] = bf_lo(w.w); b[3] = bf_hi(w.w); }

struct InProj {
    static constexpr bool PERM = true, AFTER_DRAIN = false, CHAIN = false;
    bf16 *q, *k, *v, *qi, *ki, *rb, *kb, *vb, *lora, *gates; float* wi;
    const float *rstd, *rcos, *rsin, *bgate;
    DI bool keep(const Unit&) const { return false; }
    DI void operator()(f4 (&acc)[2][2][4][2], const Unit& u, int wr, int wc, int fr, int fq) const {
        { const int ln_ = lane_opaque(); fr = ln_ & 15; fq = ln_ >> 4; }
        const int pn = u.pn, row0 = u.pm * BM + wr * 64 + fr;
        int kind = 0, ld, cb; bf16* dst;
        float rsv[2][4];
#pragma unroll
        for (int ai = 0; ai < 2; ++ai)
#pragma unroll
            for (int m = 0; m < 4; ++m) rsv[ai][m] = rstd[row0 + ai * HALF + m * 16];
        if (pn < 8)       { kind = 1; dst = q;  ld = DA;  cb = pn * 256; }
        else if (pn < 10) { kind = 1; dst = k;  ld = KVD; cb = (pn - 8) * 256; }
        else if (pn < 12) { dst = v;  ld = KVD; cb = (pn - 10) * 256; }
        else if (pn < 20) { kind = 1; dst = qi; ld = DIQ; cb = (pn - 12) * 256; }
        else if (pn == 20){ kind = 2; dst = ki; ld = HDI; cb = 0; }
        else if (pn < 29) { dst = rb; ld = DB; cb = (pn - 21) * 256; }
        else if (pn < 37) { dst = kb; ld = DB; cb = (pn - 29) * 256; }
        else if (pn < 45) { dst = vb; ld = DB; cb = (pn - 37) * 256; }
        else if (pn < 49) { dst = lora; ld = LORA_LD; cb = (pn - 45) * 256; }
        else              { kind = 3; dst = gates; ld = D; cb = (pn - 49) * 128; }
        if (kind == 3) {
            const int col = cb + wc * 32 + 8 * fq;
            const f4 ba0 = *(const f4*)(bgate + col), ba1 = *(const f4*)(bgate + col + 4), bb0 = *(const f4*)(bgate + D + col), bb1 = *(const f4*)(bgate + D + col + 4);
#pragma unroll
            for (int ai = 0; ai < 2; ++ai)
#pragma unroll
                for (int m = 0; m < 4; ++m) { const int row = row0 + ai * HALF + m * 16; const float rs = rsv[ai][m];
                    const f4 za0 = acc[ai][0][m][0] * rs + ba0, za1 = acc[ai][0][m][1] * rs + ba1, zb0 = acc[ai][1][m][0] * rs + bb0, zb1 = acc[ai][1][m][1] * rs + bb1;
                    f4 r0, r1, g0, g1;
#pragma unroll
                    for (int t = 0; t < 4; ++t) { const float eb0 = 1.0f + __expf(-zb0[t]), eb1 = 1.0f + __expf(-zb1[t]);
                        r0[t] = eb0 * __builtin_amdgcn_rcpf(1.0f + __expf(-za0[t])); r1[t] = eb1 * __builtin_amdgcn_rcpf(1.0f + __expf(-za1[t]));
                        g0[t] = __builtin_amdgcn_rcpf(eb0); g1[t] = __builtin_amdgcn_rcpf(eb1); }
                    *(v4u*)(dst + (size_t)row * D + col) = pack8(r0, r1); *(v4u*)(dst + (size_t)M * D + (size_t)row * D + col) = pack8(g0, g1); }
        } else if (kind == 0) {
#pragma unroll
            for (int ai = 0; ai < 2; ++ai)
#pragma unroll
                for (int m = 0; m < 4; ++m) { const int row = row0 + ai * HALF + m * 16; const float rs = rsv[ai][m];
#pragma unroll
                    for (int bj = 0; bj < 2; ++bj) *(v4u*)(dst + (size_t)row * ld + cb + bj * HALF + wc * 32 + 8 * fq) = pack8(acc[ai][bj][m][0] * rs, acc[ai][bj][m][1] * rs); }
        } else if (kind == 1 || wc < 2) {
            const int hb = cb + (wc >> 1) * 128, dd0 = (wc & 1) * 32 + 8 * fq;
#pragma unroll
            for (int ai = 0; ai < 2; ++ai)
#pragma unroll
              for (int mp = 0; mp < 2; ++mp) {
                f4 cv[2][2], sv[2][2];
#pragma unroll
                for (int mm = 0; mm < 2; ++mm) { const size_t to = (size_t)(row0 + ai * HALF + (2 * mp + mm) * 16) * 64 + dd0; cv[mm][0] = *(const f4*)(rcos + to); cv[mm][1] = *(const f4*)(rcos + to + 4); sv[mm][0] = *(const f4*)(rsin + to); sv[mm][1] = *(const f4*)(rsin + to + 4); }
                asm volatile("" ::: "memory");
#pragma unroll
                for (int mm = 0; mm < 2; ++mm) { const int m = 2 * mp + mm, row = row0 + ai * HALF + m * 16; const float rs = rsv[ai][m];
                    const f4 c0 = cv[mm][0], c1 = cv[mm][1], s0 = sv[mm][0], s1 = sv[mm][1];
                    const f4 a0 = acc[ai][0][m][0] * rs, a1 = acc[ai][0][m][1] * rs, b0 = acc[ai][1][m][0] * rs, b1 = acc[ai][1][m][1] * rs;
                    bf16* p = dst + (size_t)row * ld + hb + dd0;
                    *(v4u*)(p)      = pack8(a0 * c0 - b0 * s0, a1 * c1 - b1 * s1);
                    *(v4u*)(p + 64) = pack8(a0 * s0 + b0 * c0, a1 * s1 + b1 * c1); }
                asm volatile("" ::: "memory"); }
        } else if (wc == 2 && fq < 2) {
#pragma unroll
            for (int ai = 0; ai < 2; ++ai)
#pragma unroll
                for (int m = 0; m < 4; ++m) { const int row = row0 + ai * HALF + m * 16; const float rs = rsv[ai][m] * 0.25f;
                    *(f4*)(wi + (size_t)row * 16 + 8 * fq) = acc[ai][0][m][0] * rs; *(f4*)(wi + (size_t)row * 16 + 8 * fq + 4) = acc[ai][0][m][1] * rs; }
        }
    }
};

struct LoraUp {
    static constexpr bool PERM = true, AFTER_DRAIN = false, CHAIN = false;
    float* decay; bf16 *aout, *gout; const float *w0, *a0;
    DI bool keep(const Unit&) const { return false; }
    DI void operator()(f4 (&acc)[2][2][4][2], const Unit& u, int wr, int wc, int fr, int fq) const {
        { const int ln_ = lane_opaque(); fr = ln_ & 15; fq = ln_ >> 4; }
        const int which = u.pm >> 6, row0 = (u.pm & 63) * BM + wr * 64 + fr, col0 = (u.pn & 7) * BM + wc * 32 + 8 * fq;
        if (which == 0) {
#pragma unroll
            for (int bj = 0; bj < 2; ++bj) { const int col = col0 + bj * HALF; const f4 z0 = *(const f4*)(w0 + col), z1 = *(const f4*)(w0 + col + 4);
#pragma unroll
                for (int ai = 0; ai < 2; ++ai)
#pragma unroll
                    for (int m = 0; m < 4; ++m) { const size_t off = (size_t)(row0 + ai * HALF + m * 16) * DB + col;
                        f4 x0 = acc[ai][bj][m][0] + z0, x1 = acc[ai][bj][m][1] + z1;
#pragma unroll
                        for (int e = 0; e < 4; ++e) { x0[e] = __expf(-0.6065306597126334f * sigmoidf_(x0[e])); x1[e] = __expf(-0.6065306597126334f * sigmoidf_(x1[e])); }
                        { typedef _Float16 h2_ __attribute__((ext_vector_type(2)));
                          const h2_ q0 = {(_Float16)x0[0], (_Float16)x0[1]}, q1 = {(_Float16)x0[2], (_Float16)x0[3]}, q2 = {(_Float16)x1[0], (_Float16)x1[1]}, q3 = {(_Float16)x1[2], (_Float16)x1[3]};
                          v4u w_; w_.x = __builtin_bit_cast(unsigned, q0); w_.y = __builtin_bit_cast(unsigned, q1); w_.z = __builtin_bit_cast(unsigned, q2); w_.w = __builtin_bit_cast(unsigned, q3);
                          *(v4u*)((_Float16*)decay + off) = w_; }
                        asm volatile("" ::: "memory"); } }
        } else if (which == 1) {
#pragma unroll
            for (int bj = 0; bj < 2; ++bj) { const int col = col0 + bj * HALF; const f4 z0 = *(const f4*)(a0 + col), z1 = *(const f4*)(a0 + col + 4);
#pragma unroll
                for (int ai = 0; ai < 2; ++ai)
#pragma unroll
                    for (int m = 0; m < 4; ++m) { const size_t off = (size_t)(row0 + ai * HALF + m * 16) * DB + col;
                        f4 x0 = acc[ai][bj][m][0] + z0, x1 = acc[ai][bj][m][1] + z1;
#pragma unroll
                        for (int e = 0; e < 4; ++e) { x0[e] = sigmoidf_(x0[e]); x1[e] = sigmoidf_(x1[e]); }
                        *(v4u*)(aout + off) = pack8(x0, x1);
                        asm volatile("" ::: "memory"); } }
        } else {
#pragma unroll
            for (int bj = 0; bj < 2; ++bj)
#pragma unroll
                for (int ai = 0; ai < 2; ++ai)
#pragma unroll
                    for (int m = 0; m < 4; ++m) *(v4u*)(gout + (size_t)(row0 + ai * HALF + m * 16) * DB + col0 + bj * HALF) = pack8(acc[ai][bj][m][0], acc[ai][bj][m][1]);
        }
    }
};

struct GateMix {
    static constexpr bool PERM = true, AFTER_DRAIN = false, CHAIN = true;
    const bf16* gates; const float* bgate; bf16* mout;
    DI bool keep(const Unit& u) const { return u.pm < 64; }
    DI void operator()(f4 (&acc)[2][2][4][2], const Unit& u, int wr, int wc, int fr, int fq) const {
        { const int ln_ = lane_opaque(); fr = ln_ & 15; fq = ln_ >> 4; }
        const int which = u.pm >> 6, row0 = (u.pm & 63) * BM + wr * 64 + fr, col0 = (u.pn & 15) * BM + wc * 32 + 8 * fq;
        const bf16* gsrc = gates + (which ? (size_t)M * D : (size_t)0);
#pragma unroll
        for (int ai = 0; ai < 2; ++ai) {
            v4u gv[4][2];
#pragma unroll
            for (int m = 0; m < 4; ++m)
#pragma unroll
                for (int bj = 0; bj < 2; ++bj) gv[m][bj] = *(const v4u*)(gsrc + (size_t)(row0 + ai * HALF + m * 16) * D + col0 + bj * HALF);
            asm volatile("" ::: "memory");
#pragma unroll
            for (int m = 0; m < 4; ++m) { const int row = row0 + ai * HALF + m * 16;
#pragma unroll
                for (int bj = 0; bj < 2; ++bj) { f4 g0, g1; unpack8(gv[m][bj], g0, g1);
                    if (which == 0) { acc[ai][bj][m][0] = acc[ai][bj][m][0] * g0; acc[ai][bj][m][1] = acc[ai][bj][m][1] * g1; }
                    else *(v4u*)(mout + (size_t)row * D + col0 + bj * HALF) = pack8(acc[ai][bj][m][0] * g0, acc[ai][bj][m][1] * g1); } }
            asm volatile("" ::: "memory");
        }
    }
};

template <bool SRCB>
struct ResidT {
    static constexpr bool PERM = true, AFTER_DRAIN = false, CHAIN = false;
    const float* base; const bf16* baseb; bf16* outb; float* ss;
    DI bool keep(const Unit&) const { return false; }
    DI void operator()(f4 (&acc)[2][2][4][2], const Unit& u, int wr, int wc, int fr, int fq) const {
        { const int ln_ = lane_opaque(); fr = ln_ & 15; fq = ln_ >> 4; }
        const int row0 = u.pm * BM + wr * 64 + fr, col0 = u.pn * BM + wc * 32 + 8 * fq;
#pragma unroll
        for (int ai = 0; ai < 2; ++ai) {
            f4 b0[4][2], b1[4][2];
            if constexpr (SRCB) {
                v4u bb[4][2];
#pragma unroll
                for (int m = 0; m < 4; ++m)
#pragma unroll
                    for (int bj = 0; bj < 2; ++bj) bb[m][bj] = *(const v4u*)(baseb + (size_t)(row0 + ai * HALF + m * 16) * D + col0 + bj * HALF);
                asm volatile("" ::: "memory");
#pragma unroll
                for (int m = 0; m < 4; ++m)
#pragma unroll
                    for (int bj = 0; bj < 2; ++bj) unpack8(bb[m][bj], b0[m][bj], b1[m][bj]);
            } else {
#pragma unroll
                for (int m = 0; m < 4; ++m)
#pragma unroll
                    for (int bj = 0; bj < 2; ++bj) { const size_t off = (size_t)(row0 + ai * HALF + m * 16) * D + col0 + bj * HALF; b0[m][bj] = *(const f4*)(base + off); b1[m][bj] = *(const f4*)(base + off + 4); }
                asm volatile("" ::: "memory");
            }
#pragma unroll
            for (int m = 0; m < 4; ++m) { const int row = row0 + ai * HALF + m * 16; float s = 0.f;
#pragma unroll
                for (int bj = 0; bj < 2; ++bj) { const size_t off = (size_t)row * D + col0 + bj * HALF;
                    const f4 h0 = b0[m][bj] + acc[ai][bj][m][0], h1 = b1[m][bj] + acc[ai][bj][m][1];
                    *(v4u*)(outb + off) = pack8(h0, h1);
                    s += (h0[0] * h0[0] + h0[1] * h0[1]) + (h0[2] * h0[2] + h0[3] * h0[3]) + (h1[0] * h1[0] + h1[1] * h1[1]) + (h1[2] * h1[2] + h1[3] * h1[3]); }
                s += __shfl_xor(s, 16); s += __shfl_xor(s, 32);
                if (fq == 0) atomicAdd(ss + row, s); }
            asm volatile("" ::: "memory");
        }
    }
};

struct FfnUp {
    static constexpr bool PERM = true, AFTER_DRAIN = false, CHAIN = false;
    const float* ss; bf16* uout;
    DI bool keep(const Unit&) const { return false; }
    DI void operator()(f4 (&acc)[2][2][4][2], const Unit& u, int wr, int wc, int fr, int fq) const {
        { const int ln_ = lane_opaque(); fr = ln_ & 15; fq = ln_ >> 4; }
        const int row0 = u.pm * BM + wr * 64 + fr, col0 = u.pn * HALF + wc * 32 + 8 * fq;
        float rr[2][4];
#pragma unroll
        for (int ai = 0; ai < 2; ++ai)
#pragma unroll
            for (int m = 0; m < 4; ++m) rr[ai][m] = ss[row0 + ai * HALF + m * 16];
#pragma unroll
        for (int ai = 0; ai < 2; ++ai)
#pragma unroll
            for (int m = 0; m < 4; ++m) { const int row = row0 + ai * HALF + m * 16; const float r = __builtin_amdgcn_rsqf(rr[ai][m] * (1.0f / D) + RMS_EPS);
                f4 o0, o1;
#pragma unroll
                for (int e = 0; e < 4; ++e) { const float a0 = acc[ai][0][m][0][e] * r, a1 = acc[ai][0][m][1][e] * r;
                    o0[e] = a0 * sigmoidf_(a0) * (acc[ai][1][m][0][e] * r); o1[e] = a1 * sigmoidf_(a1) * (acc[ai][1][m][1][e] * r); }
                *(v4u*)(uout + (size_t)row * DFF + col0) = pack8(o0, o1); }
    }
};

struct StoreBf {
    static constexpr bool PERM = true, AFTER_DRAIN = false, CHAIN = false;
    bf16* o; int ld;
    DI bool keep(const Unit&) const { return false; }
    DI void operator()(f4 (&acc)[2][2][4][2], const Unit& u, int wr, int wc, int fr, int fq) const {
        { const int ln_ = lane_opaque(); fr = ln_ & 15; fq = ln_ >> 4; }
        const int row0 = u.pm * BM + wr * 64 + fr, col0 = u.pn * BM + wc * 32 + 8 * fq;
#pragma unroll
        for (int ai = 0; ai < 2; ++ai)
#pragma unroll
            for (int m = 0; m < 4; ++m)
#pragma unroll
                for (int bj = 0; bj < 2; ++bj) *(v4u*)(o + (size_t)(row0 + ai * HALF + m * 16) * ld + col0 + bj * HALF) = pack8(acc[ai][bj][m][0], acc[ai][bj][m][1]);
    }
};

struct PleGate {
    static constexpr bool PERM = true, AFTER_DRAIN = false, CHAIN = false;
    bf16* h3b; const bf16* hb; const bf16* pp; const float* ss_in; float* ss_out;
    DI bool keep(const Unit&) const { return false; }
    DI void operator()(f4 (&acc)[2][2][4][2], const Unit& u, int wr, int wc, int fr, int fq) const {
        { const int ln_ = lane_opaque(); fr = ln_ & 15; fq = ln_ >> 4; }
        const int row0 = u.pm * BM + wr * 64 + fr, col0 = u.pn * BM + wc * 32 + 8 * fq;
        float rr[2][4];
#pragma unroll
        for (int ai = 0; ai < 2; ++ai)
#pragma unroll
            for (int m = 0; m < 4; ++m) rr[ai][m] = ss_in[row0 + ai * HALF + m * 16];
#pragma unroll
        for (int ai = 0; ai < 2; ++ai)
#pragma unroll
            for (int mp = 0; mp < 2; ++mp) {
                v4u pv[2][2], hv[2][2];
#pragma unroll
                for (int mm = 0; mm < 2; ++mm)
#pragma unroll
                    for (int bj = 0; bj < 2; ++bj) { const size_t off = (size_t)(row0 + ai * HALF + (2 * mp + mm) * 16) * D + col0 + bj * HALF;
                        pv[mm][bj] = *(const v4u*)(pp + off); hv[mm][bj] = *(const v4u*)(hb + off); }
                asm volatile("" ::: "memory");
#pragma unroll
                for (int mm = 0; mm < 2; ++mm) { const int m = 2 * mp + mm, row = row0 + ai * HALF + m * 16; const float r = __builtin_amdgcn_rsqf(rr[ai][m] * (1.0f / D) + RMS_EPS); float s = 0.f;
#pragma unroll
                    for (int bj = 0; bj < 2; ++bj) { const size_t off = (size_t)row * D + col0 + bj * HALF;
                        f4 p0, p1; unpack8(pv[mm][bj], p0, p1);
                        f4 h0, h1; unpack8(hv[mm][bj], h0, h1);
#pragma unroll
                        for (int t = 0; t < 4; ++t) { h0[t] += sigmoidf_(acc[ai][bj][m][0][t] * r) * p0[t]; h1[t] += sigmoidf_(acc[ai][bj][m][1][t] * r) * p1[t]; }
                        *(v4u*)(h3b + off) = pack8(h0, h1);
                        s += (h0[0] * h0[0] + h0[1] * h0[1]) + (h0[2] * h0[2] + h0[3] * h0[3]) + (h1[0] * h1[0] + h1[1] * h1[1]) + (h1[2] * h1[2] + h1[3] * h1[3]); }
                    s += __shfl_xor(s, 16); s += __shfl_xor(s, 32);
                    if (fq == 0) atomicAdd(ss_out + row, s); }
                asm volatile("" ::: "memory");
            }
    }
};

struct Stack3Order {
    int G, c;
    DI bool next(int i, Unit& u) const { const int L = i * G + c; if (L >= 1536) return false; const int which = L >> 9, r = L & 511; u.pm = which * 64 + (r & 63); u.pn = which * 8 + (r >> 6); return true; }
    DI void a_ready(const Unit&) const {}
    DI void done(const Unit&) const {}
};
struct ChainOrder {
    pg8::StaticOrder so;
    DI bool next(int i, Unit& u) const { Unit t; if (!so.next(i >> 1, t)) return false; const int which = i & 1; u.pm = which * 64 + t.pm; u.pn = which * 16 + t.pn; return true; }
    DI void a_ready(const Unit&) const {}
    DI void done(const Unit&) const {}
};
}

constexpr size_t MiB = 1u << 20;
constexpr size_t WS_CTL = 0, CTL_ZERO_BYTES = 1 * MiB;
constexpr int CW_TMO = 0, CW_BAR = 4096, CW_ATTQ = 8192;
constexpr size_t SS1_OFF = 256 * 1024, SS2_OFF = 320 * 1024, SS3_OFF = 384 * 1024;
constexpr size_t WS_RSTDX = 1 * MiB;
constexpr size_t WS_BONUS = 2 * MiB;
constexpr size_t WS_RCOS = 4 * MiB, WS_RSIN = 8 * MiB;
constexpr size_t WS_WI = 12 * MiB;
constexpr size_t WS_PB = 13 * MiB;
constexpr size_t WS_WPAB = 24 * MiB;
constexpr size_t WS_WO = 56 * MiB, WS_WPG = 88 * MiB;
constexpr size_t WS_WPLE = 120 * MiB;
constexpr size_t WS_WL2 = 122 * MiB;
constexpr size_t WS_R1 = 126 * MiB;
constexpr size_t WS_WCAT = 126 * MiB;
constexpr size_t WS_XB = 288 * MiB;
constexpr size_t WS_SCORE = 126 * MiB;
constexpr size_t WS_IDX = 1252 * MiB;
constexpr size_t WS_DECAY = 126 * MiB;
constexpr size_t WS_AOUT = 254 * MiB;
constexpr size_t WS_ALORA = 1268 * MiB;
constexpr size_t WS_W13 = 126 * MiB;
constexpr size_t WS_W2 = 318 * MiB;
constexpr size_t WS_Q = 416 * MiB, WS_K = 480 * MiB, WS_V = 496 * MiB, WS_QI = 512 * MiB, WS_KI = 576 * MiB;
constexpr size_t WS_RB = 580 * MiB, WS_KB = 644 * MiB, WS_VB = 708 * MiB, WS_LORA = 772 * MiB, WS_GATES = 804 * MiB;
constexpr size_t WS_Y = 416 * MiB;
constexpr size_t WS_MIX = 416 * MiB;
constexpr size_t WS_H1B = 544 * MiB;
constexpr size_t WS_U = 672 * MiB;
constexpr size_t WS_H2B = 416 * MiB;
constexpr size_t WS_PP = 1060 * MiB;
constexpr size_t WS_H3B = 544 * MiB;
constexpr size_t WS_AO = 1060 * MiB;
constexpr size_t WS_GOUT = 1188 * MiB;
constexpr size_t WS_END = 1292 * MiB;

constexpr int RING_OFF = 0, RING_BYTES = 131072;
constexpr int LDS_BYTES = 163840;
constexpr int LDSCTL_OFF = LDS_BYTES - 1024, MISC_OFF = LDSCTL_OFF + 320;
constexpr int NWAVES = 8;

struct Args {
    const float* in[32]; float* out; unsigned char* ws; int ph_lo, ph_hi;
};
enum { I_X = 0, I_P, I_POS, I_NORM_MIX, I_W_IN, I_MU_RKV, I_MU_WAG, I_W0, I_W1, I_W2, I_A0, I_A1, I_A2, I_G1, I_G2, I_KK, I_KA, I_RK, I_LNW, I_LNB,
       I_WPA, I_WPB, I_WGATE, I_BGATE, I_WO, I_NORM_FFN, I_WFFN1, I_WFFN3, I_WFFN2, I_WPLEG, I_WPLE, I_NORM_FINAL };

struct TrSrc { const float* p; int ld, col0, nvalid, kvalid; const float* ksc; const float* mu; int mumode; };
DI void tr_item(const TrSrc& s, bf16* WT, int dK, int n0, int k0, LAS unsigned* T, int lane) {
    const int ng = lane & 15, kq = lane >> 4;
    f32x4 v[8][2]; f32x2 sc[8];
    const bool nok = 4 * ng < s.nvalid;
#pragma unroll
    for (int st = 0; st < 8; ++st) { const int k = k0 + 8 * st + 2 * kq;
#pragma unroll
        for (int j = 0; j < 2; ++j) v[st][j] = (nok && k + j < s.kvalid) ? __builtin_nontemporal_load((const f32x4*)(s.p + (size_t)(k + j) * s.ld + s.col0 + 4 * ng)) : (f32x4){0.f, 0.f, 0.f, 0.f};
        f32x2 c = {1.f, 1.f};
        if (s.ksc) c = *(const f32x2*)(s.ksc + k);
        if (s.mumode == 1) { const f32x2 m = *(const f32x2*)(s.mu + k); c = c * (1.0f - m); } else if (s.mumode == 2) { const f32x2 m = *(const f32x2*)(s.mu + k); c = c * m; }
        sc[st] = c; }
#pragma unroll
    for (int st = 0; st < 8; ++st) { const int kp = 4 * st + kq;
#pragma unroll
        for (int i = 0; i < 4; ++i) T[(4 * ng + i) * 32 + (kp ^ (4 * (ng & 7)))] = pk2(v[st][0][i] * sc[st][0], v[st][1][i] * sc[st][1]); }
    LDS_WAIT(); asm volatile("" ::: "memory");
#pragma unroll
    for (int j = 0; j < 8; ++j) { const int n = (lane >> 3) + 8 * j, c = lane & 7;
        __builtin_nontemporal_store(*(const LAS v4u*)(T + n * 32 + 4 * (c ^ ((n >> 2) & 7))), (v4u*)(WT + (size_t)(n0 + n) * dK + k0 + 8 * c)); }
    LDS_WAIT(); asm volatile("" ::: "memory");
}
DI TrSrc src_wcat(const float* const* in, int n0) {
    TrSrc s; s.p = in[I_W_IN]; s.ld = DIN; s.col0 = 0; s.nvalid = 64; s.kvalid = D; s.ksc = in[I_NORM_MIX]; s.mu = nullptr; s.mumode = 0;
    const int tile = n0 >> 8, p = n0 & 255, bj = p >> 7, hh = (p >> 6) & 1;
    if (tile < 8)        s.col0 = 0    + (2 * tile + hh) * 128 + 64 * bj;
    else if (tile < 10)  s.col0 = 2048 + (2 * (tile - 8) + hh) * 128 + 64 * bj;
    else if (tile < 12)  s.col0 = 2560 + (tile - 10) * 256 + p;
    else if (tile < 20)  s.col0 = 3072 + (2 * (tile - 12) + hh) * 128 + 64 * bj;
    else if (tile == 20) { if (hh == 0) s.col0 = 5120 + 64 * bj; else if (bj == 0) { s.col0 = 5248; s.nvalid = 16; } else s.nvalid = 0; }
    else if (tile < 45)  s.col0 = 5264 + (tile - 21) * 256 + p;
    else if (tile < 49)  { const int c = (tile - 45) * 256 + p;
        const int seg = c < 128 ? 0 : c < 256 ? 1 : c < 512 ? 2 : c < 640 ? 3 : c < 768 ? 4 : 5, sbeg = seg == 0 ? 0 : seg == 1 ? 128 : seg == 2 ? 256 : seg == 3 ? 512 : seg == 4 ? 640 : 768;
        const int kind = seg % 3;
        s.p = in[kind == 0 ? I_W1 : (kind == 1 ? I_A1 : I_G1)]; s.ld = kind == 2 ? 256 : 96; s.col0 = c - sbeg; s.mu = in[I_MU_WAG] + kind * D; s.mumode = seg < 3 ? 1 : 2;
        if (kind != 2) s.nvalid = (s.col0 == 0) ? 64 : 32; }
    else { s.p = in[I_WGATE]; s.ld = 2 * D; s.col0 = (p >> 7) * D + (tile - 49) * 128 + (p & 127); }
    return s;
}
DI TrSrc src_plain(const float* p, int ld, int col0, int kvalid, const float* ksc) { TrSrc s; s.p = p; s.ld = ld; s.col0 = col0; s.nvalid = 64; s.kvalid = kvalid; s.ksc = ksc; s.mu = nullptr; s.mumode = 0; return s; }

DI void convert_set_a(const float* const* in, unsigned char* ws, LAS unsigned* scr, int gw, int NGW, int lane) {
    constexpr int I0 = (NCAT / 64) * (D / 64);
    constexpr int I6 = (DB / 64) * (256 / 64);
    constexpr int NITEMS = I0 + 3 * I6;
    for (int it = gw; it < NITEMS; it += NGW) {
        int r = it;
        if (r < I0) { const int nblk = NCAT / 64, kb = r / nblk, nb = r % nblk; tr_item(src_wcat(in, 64 * nb), (bf16*)(ws + WS_WCAT), D, 64 * nb, 64 * kb, scr, lane); continue; } r -= I0;
        { const int w = r / I6; r -= w * I6; const int nblk = DB / 64, kb = r / nblk, nb = r % nblk;
          tr_item(src_plain(in[w == 0 ? I_W2 : (w == 1 ? I_A2 : I_G2)], DB, 64 * nb, w == 2 ? 256 : 96, nullptr), (bf16*)(ws + WS_WL2) + (size_t)w * DB * 256, 256, 64 * nb, 64 * kb, scr, lane); }
    }
}
constexpr int A1_I1 = (D / 64) * (DA / 64), A1_I3 = (D / 64) * (D / 64), A1_I5 = (D / 64) * (DPLE / 64), A1_NITEMS = 2 * A1_I1 + 2 * A1_I3 + A1_I5;
DI void convert_a1_item(const float* const* in, unsigned char* ws, LAS unsigned* scr, int it, int lane) {
    int r = it;
    if (r < 2 * A1_I1) { const int w = r / A1_I1; r -= w * A1_I1; const int nblk = D / 64, kb = r / nblk, nb = r % nblk;
        tr_item(src_plain(in[w ? I_WPB : I_WPA], D, 64 * nb, DA, nullptr), (bf16*)(ws + WS_WPAB) + (size_t)w * D * DA, DA, 64 * nb, 64 * kb, scr, lane); return; } r -= 2 * A1_I1;
    if (r < 2 * A1_I3) { const int w = r / A1_I3; r -= w * A1_I3; const int nblk = D / 64, kb = r / nblk, nb = r % nblk;
        tr_item(src_plain(in[w ? I_WPLEG : I_WO], D, 64 * nb, D, nullptr), (bf16*)(ws + (w ? WS_WPG : WS_WO)), D, 64 * nb, 64 * kb, scr, lane); return; } r -= 2 * A1_I3;
    { const int nblk = D / 64, kb = r / nblk, nb = r % nblk; tr_item(src_plain(in[I_WPLE], D, 64 * nb, DPLE, nullptr), (bf16*)(ws + WS_WPLE), DPLE, 64 * nb, 64 * kb, scr, lane); }
}
constexpr int W13_SPLIT = 16384, W13A_NITEMS = (W13_SPLIT / 64) * (D / 64), W13B_NB = (N13 - W13_SPLIT) / 64, W13B_NITEMS = W13B_NB * (D / 64);
constexpr size_t WS_W13B = 126 * MiB;
DI void convert_w13_item(const float* const* in, unsigned char* ws, bf16* w13a, LAS unsigned* scr, int kb, int nb, int lane) {
    const int n0 = 64 * nb, tile = n0 >> 8, p = n0 & 255;
    bf16* dst = (n0 < W13_SPLIT) ? w13a : (bf16*)(ws + WS_W13B) - (size_t)W13_SPLIT * D;
    tr_item(src_plain(in[(p >> 7) ? I_WFFN3 : I_WFFN1], DFF, tile * 128 + (p & 127), D, in[I_NORM_FFN]), dst, D, n0, 64 * kb, scr, lane);
}
constexpr int W2_NITEMS = (D / 64) * (DFF / 64);
DI void convert_w2_item(const float* const* in, unsigned char* ws, LAS unsigned* scr, int it, int lane) {
    const int nblk = D / 64, kb = it / nblk, nb = it % nblk; tr_item(src_plain(in[I_WFFN2], D, 64 * nb, DFF, nullptr), (bf16*)(ws + WS_W2), DFF, 64 * nb, 64 * kb, scr, lane);
}
DI void prologue_rows(const float* const* in, unsigned char* ws, bf16* xb  , int gw, int NGW, int lane) {
    const float* x = in[I_X]; float* rstd = (float*)(ws + WS_RSTDX);
    for (int m = gw; m < M; m += NGW) {
        const GAS f32x4* xr = (const GAS f32x4*)(x + (size_t)m * D) + lane; GAS v2u* o = (GAS v2u*)(xb + (size_t)m * D) + lane; float s = 0.f;
f32x4 xv[16];
#pragma unroll
        for (int j = 0; j < 16; ++j) xv[j] = xr[64 * j];
#pragma unroll
        for (int j = 0; j < 16; ++j) { const f32x4 v = xv[j]; s += (v.x * v.x + v.y * v.y) + (v.z * v.z + v.w * v.w); v2u w; w.x = pk2(v.x, v.y); w.y = pk2(v.z, v.w); o[64 * j] = w; }
        s = wave_sum(s);
        if (lane == 0) rstd[m] = 1.0f / sqrtf(s * (1.0f / D) + RMS_EPS);
    }
    const int* pos = (const int*)in[I_POS]; float* rc = (float*)(ws + WS_RCOS); float* rsn = (float*)(ws + WS_RSIN);
    for (int e = gw * 64 + lane; e < M * 64; e += NGW * 64) {
        const int m = e >> 6, i = e & 63; double inv = 1.0; for (int j = 0; j < i; ++j) inv *= 0.8659643233600653523;
        const double ang = (double)pos[m] * inv;
        const double qd = __builtin_rint(ang * 0.63661977236758134308); const int qi = (int)((long long)qd & 3);
        double r = __builtin_fma(-qd, 1.5707963267948965580, ang); r = __builtin_fma(-qd, 6.1232339957367658860e-17, r);
        const double r2 = r * r;
        const double sn = r * (1.0 + r2 * (-1.0 / 6 + r2 * (1.0 / 120 + r2 * (-1.0 / 5040 + r2 * (1.0 / 362880 + r2 * (-1.0 / 39916800 + r2 * (1.0 / 6227020800.0)))))));
        const double cs = 1.0 + r2 * (-0.5 + r2 * (1.0 / 24 + r2 * (-1.0 / 720 + r2 * (1.0 / 40320 + r2 * (-1.0 / 3628800 + r2 * (1.0 / 479001600.0 + r2 * (-1.0 / 87178291200.0)))))));
        const double c4 = (qi == 0) ? cs : (qi == 1) ? -sn : (qi == 2) ? -cs : sn;
        const double s4 = (qi == 0) ? sn : (qi == 1) ? cs : (qi == 2) ? -sn : -cs;
        rc[e] = (float)c4; rsn[e] = (float)s4;
    }
    const float* p = in[I_P]; bf16* pb = (bf16*)(ws + WS_PB);
    for (int e = gw * 64 + lane; e < M * DPLE / 4; e += NGW * 64) { const f32x4 v = ((const GAS f32x4*)p)[e]; v2u w; w.x = pk2(v.x, v.y); w.y = pk2(v.z, v.w); ((GAS v2u*)pb)[e] = w; }
}
DI void build_alora(unsigned char* ws, int gtid, int NT) {
    const bf16* L = (const bf16*)(ws + WS_LORA); bf16* A = (bf16*)(ws + WS_ALORA);
    for (int e = gtid; e < 3 * M * 32; e += NT) {
        const int which = e / (M * 32), r = e - which * (M * 32), m = r >> 5, j0 = (r & 31) * 8;
        f32x4 o0 = {0.f, 0.f, 0.f, 0.f}, o1 = o0;
        const int width = which == 2 ? 256 : 96, ca = which == 0 ? 0 : (which == 1 ? 128 : 256), cbb = which == 0 ? 512 : (which == 1 ? 640 : 768);
        if (j0 < width) {
            f32x4 c0, c1, p0 = {0.f, 0.f, 0.f, 0.f}, p1 = p0;
            epi::unpack8(*(const v4u*)(L + (size_t)m * LORA_LD + ca + j0), c0, c1);
            if ((m & (SEQ - 1)) != 0) epi::unpack8(*(const v4u*)(L + (size_t)(m - 1) * LORA_LD + cbb + j0), p0, p1);
            o0 = c0 + p0; o1 = c1 + p1;
            if (which == 0) {
#pragma unroll
                for (int t = 0; t < 4; ++t) { o0[t] = 1.0f - 2.0f / (__expf(2.0f * o0[t]) + 1.0f); o1[t] = 1.0f - 2.0f / (__expf(2.0f * o1[t]) + 1.0f); } }
            if (which == 2) {
#pragma unroll
                for (int t = 0; t < 4; ++t) { o0[t] = sigmoidf_(o0[t]); o1[t] = sigmoidf_(o1[t]); } }
        }
        *(v4u*)(A + ((size_t)which * M + m) * 256 + j0) = epi::pack8(o0, o1);
    }
}

constexpr int IDX_TS = 272;
constexpr int IDX_TILE_BYTES = 64 * IDX_TS;
constexpr int IDX_HIST_OFF = 2 * IDX_TILE_BYTES;

DI unsigned fkey(float f) { unsigned u = __builtin_bit_cast(unsigned, f); if (u == 0x80000000u) u = 0u; return (u & 0x80000000u) ? ~u : (u | 0x80000000u); }

DI void indexer_unit(unsigned char* ws, LAS unsigned char* lds, int b, int blk, float* scratch, int wave) {
    const int lane = lane_opaque(), tid = wave * 64 + lane;
    const bf16* qi = (const bf16*)(ws + WS_QI); const bf16* ki = (const bf16*)(ws + WS_KI); const float* wi = (const float*)(ws + WS_WI);
    const int t0 = blk * 32, mrow0 = b * SEQ + t0;
    const int r = lane & 31, kh = lane >> 5, aq = (r >> 2) & 1, ah = (r & 3) + 4 * (r >> 3);
    bf16x8 af[2][8]; f32x4 wg[2][4];
#pragma unroll
    for (int rt = 0; rt < 2; ++rt) {
        const bf16* src = qi + (size_t)(mrow0 + 4 * wave + 2 * rt + aq) * DIQ + ah * HDI + 8 * kh;
#pragma unroll
        for (int ks = 0; ks < 8; ++ks) af[rt][ks] = *(const bf16x8*)(src + 16 * ks);
        const float* wsrc = wi + (size_t)(mrow0 + 4 * wave + 2 * rt + kh) * NHI;
#pragma unroll
        for (int j = 0; j < 4; ++j) wg[rt][j] = *(const f32x4*)(wsrc + 4 * j) * 0.08838834764831845f;
    }
    const int nk = (t0 + 32 + 63) >> 6;
    const int lkey = tid >> 3, lpart = tid & 7;
    const bf16* kbase = ki + (size_t)(b * SEQ) * HDI;
    v4u st0, st1, su0, su1;
    { const v4u* g = (const v4u*)(kbase + (size_t)lkey * HDI + lpart * 16); st0 = g[0]; st1 = g[1]; }
    if (1 < nk) { const v4u* g = (const v4u*)(kbase + (size_t)(64 + lkey) * HDI + lpart * 16); su0 = g[0]; su1 = g[1]; }
    __syncthreads();
    { LAS v4u* d = (LAS v4u*)(lds + lkey * IDX_TS + lpart * 32); d[0] = st0; d[1] = st1; }
    __syncthreads();
#pragma unroll
    for (int rt = 0; rt < 2; ++rt) {
#pragma unroll
        for (int ks = 0; ks < 8; ++ks) asm volatile("; pin %0" : "+v"(af[rt][ks]));
#pragma unroll
        for (int j = 0; j < 4; ++j) asm volatile("; pin %0" : "+v"(wg[rt][j])); }
#define IDX_TILE(kt, L0, L1, W0, W1) do { \
        if ((kt) + 2 < nk) { const v4u* g = (const v4u*)(kbase + (size_t)(((kt) + 2) * 64 + lkey) * HDI + lpart * 16); L0 = g[0]; L1 = g[1]; } \
        const LAS unsigned char* tb = lds + ((kt) & 1) * IDX_TILE_BYTES; \
        _Pragma("unroll") for (int ct = 0; ct < 2; ++ct) { \
            bf16x8 bfr[8]; \
            _Pragma("unroll") for (int ks = 0; ks < 8; ++ks) bfr[ks] = *(const LAS bf16x8*)(tb + (32 * ct + r) * IDX_TS + (16 * ks + 8 * kh) * 2); \
            _Pragma("unroll") for (int rt = 0; rt < 2; ++rt) { \
                f32x16 c; \
                _Pragma("unroll") for (int j = 0; j < 16; ++j) c[j] = 0.f; \
                _Pragma("unroll") for (int ks = 0; ks < 8; ++ks) c = __builtin_amdgcn_mfma_f32_32x32x16_bf16(af[rt][ks], bfr[ks], c, 0, 0, 0); \
                float s = 0.f; \
                _Pragma("unroll") for (int j = 0; j < 16; ++j) s += wg[rt][j >> 2][j & 3] * __builtin_amdgcn_fmed3f(c[j], 0.f, 3.0e38f);     \
                scratch[(size_t)(4 * wave + 2 * rt + kh) * SEQ + (kt) * 64 + 32 * ct + r] = s; \
            } \
        } \
        if ((kt) + 1 < nk) { LAS v4u* d = (LAS v4u*)(lds + (((kt) + 1) & 1) * IDX_TILE_BYTES + lkey * IDX_TS + lpart * 32); d[0] = W0; d[1] = W1; } \
        asm volatile("s_waitcnt lgkmcnt(0)" ::: "memory"); __builtin_amdgcn_s_barrier(); asm volatile("" ::: "memory");     \
    } while (0)
    for (int kt = 0; kt < nk; kt += 2) {
        IDX_TILE(kt, st0, st1, su0, su1);
        if (kt + 1 < nk) IDX_TILE(kt + 1, su0, su1, st0, st1);
    }
#undef IDX_TILE
}

DI void select_unit(unsigned char* ws, LAS unsigned char* lds, int b, int blk, const float* scratch, int wave) {
    int* idx = (int*)(ws + WS_IDX);
    LAS unsigned* hist = (LAS unsigned*)(lds + IDX_HIST_OFF + wave * 8192);
    for (int qq = 0; qq < 4; ++qq) {
        const int lane = lane_opaque(); const unsigned long long lt_mask = (1ull << lane) - 1ull;
        const int ql = wave * 4 + qq, t = blk * 32 + ql, n = t + 1;
        const float* sc = scratch + (size_t)ql * SEQ; int* out = idx + (size_t)(b * SEQ + t) * TOPK;
        if (n <= TOPK) { for (int e = lane; e < TOPK; e += 64) out[e] = (e < n) ? e : 0; continue; }
        const int n4 = (n + 3) >> 2;
        v4u key[32];
#pragma unroll
        for (int j = 0; j < 32; ++j) { key[j] = (v4u){0u, 0u, 0u, 0u};
            if (64 * j < n4) { const int gi = 64 * j + lane; if (gi < n4) { const f32x4 v = *(const f32x4*)(sc + 4 * gi); const int e0 = 4 * gi;
                key[j].x = fkey(v[0]); key[j].y = (e0 + 1 < n) ? fkey(v[1]) : 0u; key[j].z = (e0 + 2 < n) ? fkey(v[2]) : 0u; key[j].w = (e0 + 3 < n) ? fkey(v[3]) : 0u; } } }
        unsigned prefix = 0u, pmask = 0u; int kk = TOPK; bool simple = false;
        for (int pass = 0; pass < 4; ++pass) {
            const int shift = 24 - 8 * pass;
#pragma unroll
            for (int z = 0; z < 8; ++z) *(LAS v4u*)(hist + 4 * (lane + 64 * z)) = (v4u){0u, 0u, 0u, 0u};
            LAS unsigned* hc = hist + 256 * (lane & 7);
#pragma unroll
            for (int j = 0; j < 32; ++j) if (64 * j < n4) {
#pragma unroll
                for (int c = 0; c < 4; ++c) { const unsigned u = key[j][c]; if ((u & pmask) == prefix) __hip_atomic_fetch_add(hc + ((u >> shift) & 255u), 1u, __ATOMIC_RELAXED, __HIP_MEMORY_SCOPE_WORKGROUP); } }
            LDS_WAIT(); asm volatile("" ::: "memory");
            v4u hs = {0u, 0u, 0u, 0u};
#pragma unroll
            for (int z = 0; z < 8; ++z) hs += *(const LAS v4u*)(hist + 256 * z + 4 * lane);
            const int c0 = (int)hs.x, c1 = (int)hs.y, c2 = (int)hs.z, c3 = (int)hs.w;
            const int T = c0 + c1 + c2 + c3; int S = T;
#pragma unroll
            for (int o = 1; o < 64; o <<= 1) { const int v = __shfl_down(S, o); if (lane + o < 64) S += v; }
            const int E = S - T;
            const bool found = (E < kk) && (kk <= S);
            int d = 0, knew = 0, cd = 0;
            if (found) { int run = E;
                if (run + c3 >= kk) { d = 4 * lane + 3; knew = kk - run; cd = c3; } else { run += c3;
                if (run + c2 >= kk) { d = 4 * lane + 2; knew = kk - run; cd = c2; } else { run += c2;
                if (run + c1 >= kk) { d = 4 * lane + 1; knew = kk - run; cd = c1; } else { run += c1; d = 4 * lane; knew = kk - run; cd = c0; } } } }
            const unsigned long long fm = __ballot(found); const int src = fm ? (int)__builtin_ctzll(fm) : 0;
            d = __shfl(d, src); knew = __shfl(knew, src); cd = __shfl(cd, src);
            prefix |= ((unsigned)d) << shift; pmask |= 0xffu << shift; kk = knew;
            asm volatile("" ::: "memory");
            if (kk == cd) { simple = true; break; }
        }
        if (simple) {
            int pos = 0;
#pragma unroll
            for (int j = 0; j < 32; ++j) if (64 * j < n4) {
                bool take[4]; unsigned long long tm[4]; int slot = pos;
#pragma unroll
                for (int c = 0; c < 4; ++c) { take[c] = (key[j][c] & pmask) >= prefix; tm[c] = __ballot(take[c]); slot += __builtin_popcountll(tm[c] & lt_mask); }
#pragma unroll
                for (int c = 0; c < 4; ++c) { if (take[c]) { if (slot < TOPK) out[slot] = 256 * j + 4 * lane + c; ++slot; } }
#pragma unroll
                for (int c = 0; c < 4; ++c) pos += __builtin_popcountll(tm[c]);
            }
        } else {
        int pos = 0, eqt = 0;
#pragma unroll
        for (int j = 0; j < 32; ++j) if (64 * j < n4) {
            bool eq[4], gt[4]; unsigned long long em[4]; int eq_before = eqt;
#pragma unroll
            for (int c = 0; c < 4; ++c) { const unsigned u = key[j][c] & pmask; eq[c] = (u == prefix); gt[c] = (u > prefix); em[c] = __ballot(eq[c]); eq_before += __builtin_popcountll(em[c] & lt_mask); }
            bool take[4]; unsigned long long tm[4]; int tk_before = pos, run_eq = eq_before;
#pragma unroll
            for (int c = 0; c < 4; ++c) { take[c] = gt[c] || (eq[c] && run_eq < kk); run_eq += eq[c] ? 1 : 0; tm[c] = __ballot(take[c]); tk_before += __builtin_popcountll(tm[c] & lt_mask); }
            int slot = tk_before;
#pragma unroll
            for (int c = 0; c < 4; ++c) { if (take[c]) { if (slot < TOPK) out[slot] = 256 * j + 4 * lane + c; ++slot; } }
#pragma unroll
            for (int c = 0; c < 4; ++c) { pos += __builtin_popcountll(tm[c]); eqt += __builtin_popcountll(em[c]); }
        }
        }
    }
}

DI void indexer_phase(unsigned char* ws, LAS unsigned char* lds, int wave) {
    float* scratch = (float*)(ws + WS_SCORE) + (size_t)blockIdx.x * 32 * SEQ;
    for (int pr = blockIdx.x; pr < 256; pr += gridDim.x) {
        const int b = pr >> 7, j = pr & 127;
        for (int half = 0; half < 2; ++half) { const int blk = half ? 255 - j : j;
#ifndef REP_IDX
#define REP_IDX 1
#endif
            for (int ri_ = 0; ri_ < REP_IDX; ++ri_) indexer_unit(ws, lds, b, blk, scratch, wave);
            VM_WAIT(); __syncthreads();
#ifndef REP_SEL
#define REP_SEL 1
#endif
            for (int rs_ = 0; rs_ < REP_SEL; ++rs_) select_unit(ws, lds, b, blk, scratch, wave);
            VM_WAIT(); __syncthreads(); }
    }
}

typedef int v4i __attribute__((ext_vector_type(4)));
typedef int v2i __attribute__((ext_vector_type(2)));
#define ATT_FENCE() asm volatile("" ::: "memory")
DI void attn_worker(unsigned char* ws, LAS unsigned char* lds, LAS unsigned* qctr, int wave) {
    const int lane = lane_opaque();
    const bf16* q = (const bf16*)(ws + WS_Q); const bf16* kbuf = (const bf16*)(ws + WS_K); const bf16* vbuf = (const bf16*)(ws + WS_V);
    const int* idx = (const int*)(ws + WS_IDX); bf16* ao = (bf16*)(ws + WS_AO);
    LAS int* idl = (LAS int*)(lds); LAS int* idl2 = (LAS int*)(lds + 1024); LAS float* pl = (LAS float*)(lds + 2048);
    LAS unsigned char* stg = lds + 6144;
    const int G = gridDim.x, bg = blockIdx.x & 7, b = bg >> 2, g = bg & 3;
    unsigned* gq = (unsigned*)(ws + WS_CTL) + CW_ATTQ + 64 * bg;
    (void)G;
    const int kr = lane & 15, kq = lane >> 4;
    const int kg = lane >> 4, dg = lane & 15;
    const int rg = lane >> 4, cc = lane & 15;
    const bf16* kvb = kbuf + (size_t)(b * SEQ) * KVD + g * 128 + 8 * cc;
    int woff[4], roff[4];
#pragma unroll
    for (int i = 0; i < 4; ++i) { const int row = 4 * i + rg; woff[i] = row * 256 + ((cc ^ row) & 15) * 16; roff[i] = cc * 256 + (((4 * i + rg) ^ cc) & 15) * 16; }
    unsigned vwb[2], vtb[2][2];
    { const int q4 = (lane & 15) >> 2, p4 = lane & 3;
#pragma unroll
      for (int h2 = 0; h2 < 2; ++h2) { vwb[h2] = (unsigned)(size_t)stg + 2048 * rg + 512 * (cc >> 2) + 16 * ((cc & 3) ^ ((2 * rg + h2) & 3));
#pragma unroll
        for (int par = 0; par < 2; ++par) vtb[h2][par] = (unsigned)(size_t)stg + 2048 * rg + 64 * (4 * h2 + q4) + 16 * ((2 * par + (p4 >> 1)) ^ ((2 * rg + h2) & 3)) + 8 * (p4 & 1); } }
    const bf16* vbase = vbuf + (size_t)(b * SEQ) * KVD + g * 128 + 8 * dg;
    int qn; { unsigned v_ = 0u; if (lane == 0) v_ = __hip_atomic_fetch_add(gq, 1u, __ATOMIC_RELAXED, __HIP_MEMORY_SCOPE_AGENT); qn = __builtin_amdgcn_readfirstlane((int)v_); }
    int ixg[4]; bf16x8 qf[4];
    if (qn < SEQ) { const int mq = b * SEQ + qn;
#pragma unroll
        for (int c = 0; c < 4; ++c) ixg[c] = __builtin_nontemporal_load(idx + (size_t)mq * TOPK + lane + 64 * c);
#pragma unroll
        for (int ks = 0; ks < 4; ++ks) { if (kr < 4) qf[ks] = *(const bf16x8*)(q + (size_t)mq * DA + (4 * g + kr) * 128 + 32 * ks + 8 * kq); else qf[ks] = (bf16x8){0, 0, 0, 0, 0, 0, 0, 0}; } }
    while (qn < SEQ) {
        const int t = qn, mq = b * SEQ + t, nvalid = (t + 1 < TOPK) ? t + 1 : TOPK;
#pragma unroll
        for (int c = 0; c < 4; ++c) { idl[lane + 64 * c] = ixg[c]; idl2[(lane & 3) * 64 + 16 * c + (lane >> 2)] = ixg[c]; }
        LDS_WAIT(); ATT_FENCE();
        int qn2; { unsigned v_ = 0u; if (lane == 0) v_ = __hip_atomic_fetch_add(gq, 1u, __ATOMIC_RELAXED, __HIP_MEMORY_SCOPE_AGENT); qn2 = __builtin_amdgcn_readfirstlane((int)v_); }
#if defined(PROBE_T)
        if (bg == 0 && lane == 0) { if (qn2 == SEQ / 2) __hip_atomic_store((unsigned*)(ws + WS_CTL) + 9100 + 24, (unsigned)__builtin_amdgcn_s_memrealtime(), __ATOMIC_RELAXED, __HIP_MEMORY_SCOPE_AGENT);
                                    if (qn2 == SEQ - 1) __hip_atomic_store((unsigned*)(ws + WS_CTL) + 9100 + 25, (unsigned)__builtin_amdgcn_s_memrealtime(), __ATOMIC_RELAXED, __HIP_MEMORY_SCOPE_AGENT);
                                    if (qn2 == 512) __hip_atomic_store((unsigned*)(ws + WS_CTL) + 9100 + 23, (unsigned)__builtin_amdgcn_s_memrealtime(), __ATOMIC_RELAXED, __HIP_MEMORY_SCOPE_AGENT); }
#endif
        if (qn2 < SEQ) { const int mq2 = b * SEQ + qn2;
#pragma unroll
            for (int c = 0; c < 4; ++c) ixg[c] = __builtin_nontemporal_load(idx + (size_t)mq2 * TOPK + lane + 64 * c); }
        ATT_FENCE();
        f32x4 s[16]; v4u kf[3][2][4];
#define ATT_KISSUE(slot_, hg_) do { v2i kx_[4]; \
            _Pragma("unroll") for (int i = 0; i < 4; ++i) kx_[i] = *(const LAS v2i*)(idl2 + rg * 64 + 16 * i + 2 * (hg_)); \
            _Pragma("unroll") for (int j = 0; j < 2; ++j) _Pragma("unroll") for (int i = 0; i < 4; ++i) kf[slot_][j][i] = *(const v4u*)(kvb + (size_t)kx_[i][j] * KVD); \
            ATT_FENCE(); } while (0)
        ATT_KISSUE(0, 0); ATT_KISSUE(1, 1);
#pragma unroll
        for (int hg = 0; hg < 8; ++hg) {
            if (hg + 2 < 8) ATT_KISSUE((hg + 2) % 3, hg + 2);
#pragma unroll
            for (int j = 0; j < 2; ++j) {
#pragma unroll
                for (int i = 0; i < 4; ++i) *(LAS v4u*)(stg + j * 4096 + woff[i]) = kf[hg % 3][j][i];
                bf16x8 ka[4];
#pragma unroll
                for (int ks = 0; ks < 4; ++ks) ka[ks] = *(const LAS bf16x8*)(stg + j * 4096 + roff[ks]);
                f32x4 a = {0.f, 0.f, 0.f, 0.f};
#pragma unroll
                for (int ks = 0; ks < 4; ++ks) a = __builtin_amdgcn_mfma_f32_16x16x32_bf16(ka[ks], qf[ks], a, 0, 0, 0);
                s[2 * hg + j] = a; }
        }
#undef ATT_KISSUE
        if (qn2 < SEQ && kr < 4) { const int mq2 = b * SEQ + qn2;
#pragma unroll
            for (int ks = 0; ks < 4; ++ks) qf[ks] = *(const bf16x8*)(q + (size_t)mq2 * DA + (4 * g + kr) * 128 + 32 * ks + 8 * kq); }
        ATT_FENCE();
        v4i ix[3][2]; v4u vv[3][8];
#pragma unroll
        for (int ch = 0; ch < 2; ++ch) {
            ix[ch][0] = *(const LAS v4i*)(idl + 64 * kg + 8 * ch); ix[ch][1] = *(const LAS v4i*)(idl + 64 * kg + 8 * ch + 4);
#pragma unroll
            for (int j = 0; j < 8; ++j) vv[ch][j] = *(const v4u*)(vbase + (size_t)ix[ch][j >> 2][j & 3] * KVD);
            ATT_FENCE(); }
        float mx = -3.0e38f;
#pragma unroll
        for (int kt = 0; kt < 16; ++kt)
#pragma unroll
            for (int e = 0; e < 4; ++e) { const bool ok = (64 * kq + 4 * kt + e) < nvalid; s[kt][e] = ok ? s[kt][e] * 0.08838834764831845f : -3.0e38f; mx = fmaxf(mx, s[kt][e]); }
        mx = fmaxf(mx, __shfl_xor(mx, 16)); mx = fmaxf(mx, __shfl_xor(mx, 32));
        float sum = 0.f;
#pragma unroll
        for (int kt = 0; kt < 16; ++kt)
#pragma unroll
            for (int e = 0; e < 4; ++e) { const bool ok = (64 * kq + 4 * kt + e) < nvalid; const float p = ok ? __expf(s[kt][e] - mx) : 0.f; s[kt][e] = p; sum += p; }
        sum += __shfl_xor(sum, 16); sum += __shfl_xor(sum, 32);
        const float inv = 1.0f / sum;
        bf16x8 pa[8];
#pragma unroll
        for (int sg = 0; sg < 8; ++sg) pa[sg] = __builtin_bit_cast(bf16x8, epi::pack8(s[2 * sg] * inv, s[2 * sg + 1] * inv));
        f32x4 acc[8];
#pragma unroll
        for (int nt = 0; nt < 8; ++nt) acc[nt] = (f32x4){0.f, 0.f, 0.f, 0.f};
#pragma unroll
        for (int ch = 0; ch < 8; ++ch) {
            if (ch + 2 < 8) { const int c2 = (ch + 2) % 3;
                ix[c2][0] = *(const LAS v4i*)(idl + 64 * kg + 8 * (ch + 2)); ix[c2][1] = *(const LAS v4i*)(idl + 64 * kg + 8 * (ch + 2) + 4);
#pragma unroll
                for (int j = 0; j < 8; ++j) vv[c2][j] = *(const v4u*)(vbase + (size_t)ix[c2][j >> 2][j & 3] * KVD);
                ATT_FENCE(); }
#pragma unroll
            for (int j = 0; j < 8; ++j) *(LAS v4u*)(size_t)(vwb[j >> 2] + 64 * j) = vv[ch % 3][j];
            v2u r0, r1, r2, r3, r4, r5, r6, r7, r8, r9, r10, r11, r12, r13, r14, r15;
            asm volatile("ds_read_b64_tr_b16 %0, %16\n\tds_read_b64_tr_b16 %1, %18\n\tds_read_b64_tr_b16 %2, %17\n\tds_read_b64_tr_b16 %3, %19\n\t"
                         "ds_read_b64_tr_b16 %4, %16 offset:512\n\tds_read_b64_tr_b16 %5, %18 offset:512\n\tds_read_b64_tr_b16 %6, %17 offset:512\n\tds_read_b64_tr_b16 %7, %19 offset:512\n\t"
                         "ds_read_b64_tr_b16 %8, %16 offset:1024\n\tds_read_b64_tr_b16 %9, %18 offset:1024\n\tds_read_b64_tr_b16 %10, %17 offset:1024\n\tds_read_b64_tr_b16 %11, %19 offset:1024\n\t"
                         "ds_read_b64_tr_b16 %12, %16 offset:1536\n\tds_read_b64_tr_b16 %13, %18 offset:1536\n\tds_read_b64_tr_b16 %14, %17 offset:1536\n\tds_read_b64_tr_b16 %15, %19 offset:1536\n\ts_waitcnt lgkmcnt(0)"
                         : "=&v"(r0), "=&v"(r1), "=&v"(r2), "=&v"(r3), "=&v"(r4), "=&v"(r5), "=&v"(r6), "=&v"(r7), "=&v"(r8), "=&v"(r9), "=&v"(r10), "=&v"(r11), "=&v"(r12), "=&v"(r13), "=&v"(r14), "=&v"(r15)
                         : "v"(vtb[0][0]), "v"(vtb[0][1]), "v"(vtb[1][0]), "v"(vtb[1][1]) : "memory");
#define ATT_PV(nt_, ra_, rb_) acc[nt_] = __builtin_amdgcn_mfma_f32_16x16x32_bf16(pa[ch], __builtin_bit_cast(bf16x8, (v4u){ra_.x, ra_.y, rb_.x, rb_.y}), acc[nt_], 0, 0, 0)
            ATT_PV(0, r0, r1); ATT_PV(1, r2, r3); ATT_PV(2, r4, r5); ATT_PV(3, r6, r7); ATT_PV(4, r8, r9); ATT_PV(5, r10, r11); ATT_PV(6, r12, r13); ATT_PV(7, r14, r15);
#undef ATT_PV
        }
        { LAS unsigned short* ob = (LAS unsigned short*)(lds + 2048);
          if (lane < 16) {
#pragma unroll
            for (int nt = 0; nt < 8; ++nt)
#pragma unroll
                for (int e = 0; e < 4; ++e) ob[e * 128 + 16 * nt + lane] = f2bf(acc[nt][e]); }
          LDS_WAIT(); ATT_FENCE();
          const v4u w = *(const LAS v4u*)(ob + kg * 128 + 8 * dg);
          __builtin_nontemporal_store(w, (v4u*)(ao + (size_t)mq * DA + (4 * g + kg) * 128 + 8 * dg)); }
        LDS_WAIT(); ATT_FENCE();
        qn = qn2;
    }
}

constexpr int SC_STEPS = 32, SC_PAIRS = SC_STEPS / 2;
constexpr int SC_PAIR_FLOATS = 616, SC_PAIR_BYTES = SC_PAIR_FLOATS * 4;
constexpr int SC_BUF_BYTES = SC_PAIRS * SC_PAIR_BYTES;
constexpr int PV_D1 = 0, PV_D2 = 64, PV_E1 = 128, PV_W12 = 192, PV_B1P = 256, PV_K1P = 320, PV_B2 = 384, PV_K2 = 448, PV_R2 = 512, PV_SC = 576, PV_V = 580;

template <int CTRL> DI float dpp_add(float x) { return x + __builtin_bit_cast(float, __builtin_amdgcn_update_dpp(0, __builtin_bit_cast(int, x), CTRL, 0xf, 0xf, false)); }
DI float red16(float x) { x = dpp_add<0xB1>(x); x = dpp_add<0x4E>(x); x = dpp_add<0x141>(x); x = dpp_add<0x140>(x); return x; }
DI float red8(float x) { x = dpp_add<0xB1>(x); x = dpp_add<0x4E>(x); x = dpp_add<0x141>(x); return x; }
DI float hsum4(const f32x4& p) { return (p[0] + p[1]) + (p[2] + p[3]); }

struct ScanRaw { v2u rc, rp, kc, kp, vc, vp, ac; f32x4 dc; };
struct ScanConst { f32x4 mu_r, mu_k, mu_v, kkw, kaw, rkw; };
DI f32x4 bf4(const v2u& w) { f32x4 r; r[0] = bf_lo(w.x); r[1] = bf_hi(w.x); r[2] = bf_lo(w.y); r[3] = bf_hi(w.y); return r; }

DI void scan_issue_pair(ScanRaw& R1, ScanRaw& R2, const unsigned char* ws, int b, int h, int t, int cg) {
    const bf16* rb = (const bf16*)(ws + WS_RB); const bf16* kb = (const bf16*)(ws + WS_KB); const bf16* vb = (const bf16*)(ws + WS_VB);
    const float* decay = (const float*)(ws + WS_DECAY); const bf16* av = (const bf16*)(ws + WS_AOUT);
    const size_t o = (size_t)(b * SEQ + t) * DB + h * HDB + 4 * cg;
    R1.rc = *(const v2u*)(rb + o); R1.kc = *(const v2u*)(kb + o); R1.vc = *(const v2u*)(vb + o); R1.dc = *(const f32x4*)(decay + o); R1.ac = *(const v2u*)(av + o);
    R2.rc = *(const v2u*)(rb + o + DB); R2.kc = *(const v2u*)(kb + o + DB); R2.vc = *(const v2u*)(vb + o + DB); R2.dc = *(const f32x4*)(decay + o + DB); R2.ac = *(const v2u*)(av + o + DB);
    if (t > 0) { R1.rp = *(const v2u*)(rb + o - DB); R1.kp = *(const v2u*)(kb + o - DB); R1.vp = *(const v2u*)(vb + o - DB); }
    else { R1.rp = (v2u){0u, 0u}; R1.kp = (v2u){0u, 0u}; R1.vp = (v2u){0u, 0u}; }
}
struct StepVec { f32x4 w, a, b, k, r, v; float bonus; };
DI void scan_stepvec(StepVec& o, const f32x4& rc, const f32x4& rp, const f32x4& kc, const f32x4& kp, const f32x4& vc, const f32x4& vp, const f32x4& a, const f32x4& dc, const ScanConst& C) {
    const f32x4 r1 = rc + (rp - rc) * C.mu_r, k0 = kc + (kp - kc) * C.mu_k, v1 = vc + (vp - vc) * C.mu_v;
    const f32x4 kkv = k0 * C.kkw;
    const float nrm = sqrtf(red16(hsum4(kkv * kkv)));
    const f32x4 kkn = kkv * (1.0f / fmaxf(nrm, 1e-12f));
    const f32x4 k1 = k0 * (1.0f + (a - 1.0f) * C.kaw);
    o.w = dc; o.a = -kkn; o.b = kkn * a; o.k = k1; o.r = r1; o.v = v1; o.bonus = red16(hsum4(r1 * k1 * C.rkw));
}
DI void scan_emit_pair(const ScanRaw& R1, const ScanRaw& R2, const ScanConst& C, LAS float* pb, int cg, int qr, float* bonus_dst) {
    const f32x4 rc1 = bf4(R1.rc), kc1 = bf4(R1.kc), vc1 = bf4(R1.vc);
    StepVec s1, s2;
    scan_stepvec(s1, rc1, bf4(R1.rp), kc1, bf4(R1.kp), vc1, bf4(R1.vp), bf4(R1.ac), R1.dc, C);
    scan_stepvec(s2, bf4(R2.rc), rc1, bf4(R2.kc), kc1, bf4(R2.vc), vc1, bf4(R2.ac), R2.dc, C);
    const float beta = red16(hsum4(s1.b * s2.a)), kappa = red16(hsum4(s1.k * s2.a)), betar = red16(hsum4(s1.b * s1.r)), kappar = red16(hsum4(s1.k * s1.r));
    *(LAS f32x4*)(pb + PV_D1 + 4 * cg) = s1.a; *(LAS f32x4*)(pb + PV_D2 + 4 * cg) = s1.w * s2.a; *(LAS f32x4*)(pb + PV_E1 + 4 * cg) = s1.w * s1.r;
    *(LAS f32x4*)(pb + PV_W12 + 4 * cg) = s1.w * s2.w; *(LAS f32x4*)(pb + PV_B1P + 4 * cg) = s1.b * s2.w; *(LAS f32x4*)(pb + PV_K1P + 4 * cg) = s1.k * s2.w;
    *(LAS f32x4*)(pb + PV_B2 + 4 * cg) = s2.b; *(LAS f32x4*)(pb + PV_K2 + 4 * cg) = s2.k; *(LAS f32x4*)(pb + PV_R2 + 4 * cg) = s2.r;
    if (cg == 0) *(LAS f32x4*)(pb + PV_SC) = (f32x4){beta, kappa, betar, kappar};
    if ((cg >> 2) == qr) { LAS float* vd = pb + PV_V + 8 * (cg & 3);
        *(LAS f32x4*)(vd) = (f32x4){s1.v[0], s2.v[0], s1.v[1], s2.v[1]}; *(LAS f32x4*)(vd + 4) = (f32x4){s1.v[2], s2.v[2], s1.v[3], s2.v[3]}; }
    if (bonus_dst != nullptr && cg == 0) { bonus_dst[0] = s1.bonus; bonus_dst[NHB] = s2.bonus; }
}
struct PairVec { f32x4 d1[2], d2[2], e1[2], w12[2], b1p[2], k1p[2], b2[2], k2[2], r2[2], sc; f32x2 v; };
DI void pair_ld(PairVec& P, const LAS float* pb, int cg, int vrow) {
#pragma unroll
    for (int i = 0; i < 2; ++i) { const int o = 8 * cg + 4 * i;
        P.d1[i] = *(const LAS f32x4*)(pb + PV_D1 + o); P.d2[i] = *(const LAS f32x4*)(pb + PV_D2 + o); P.e1[i] = *(const LAS f32x4*)(pb + PV_E1 + o);
        P.w12[i] = *(const LAS f32x4*)(pb + PV_W12 + o); P.b1p[i] = *(const LAS f32x4*)(pb + PV_B1P + o); P.k1p[i] = *(const LAS f32x4*)(pb + PV_K1P + o);
        P.b2[i] = *(const LAS f32x4*)(pb + PV_B2 + o); P.k2[i] = *(const LAS f32x4*)(pb + PV_K2 + o); P.r2[i] = *(const LAS f32x4*)(pb + PV_R2 + o); }
    P.sc = *(const LAS f32x4*)(pb + PV_SC); P.v = *(const LAS f32x2*)(pb + PV_V + 2 * vrow);
}
DI void pair_step(f32x4& s0, f32x4& s1, const PairVec& P, float& y1, float& y2) {
    const float d1 = red8(hsum4(s0 * P.d1[0] + s1 * P.d1[1])), d2 = red8(hsum4(s0 * P.d2[0] + s1 * P.d2[1])), e1 = red8(hsum4(s0 * P.e1[0] + s1 * P.e1[1]));
    const float v1 = P.v[0], v2 = P.v[1];
    const float sa2 = d2 + d1 * P.sc[0] + v1 * P.sc[1];
    y1 = e1 + d1 * P.sc[2] + v1 * P.sc[3];
    s0 = s0 * P.w12[0] + P.b1p[0] * d1 + P.k1p[0] * v1 + P.b2[0] * sa2 + P.k2[0] * v2;
    s1 = s1 * P.w12[1] + P.b1p[1] * d1 + P.k1p[1] * v1 + P.b2[1] * sa2 + P.k2[1] * v2;
    y2 = red8(hsum4(s0 * P.r2[0] + s1 * P.r2[1]));
}
DI void lds_signal(LAS unsigned* p, int lane) { asm volatile("s_waitcnt lgkmcnt(0)" ::: "memory"); if (lane == 0) __hip_atomic_fetch_add(p, 1u, __ATOMIC_RELAXED, __HIP_MEMORY_SCOPE_WORKGROUP); }
DI void lds_wait_ge(LAS unsigned* p, unsigned v) {
    unsigned spins = 0;
    while ((unsigned)__builtin_amdgcn_readfirstlane(__hip_atomic_load(p, __ATOMIC_RELAXED, __HIP_MEMORY_SCOPE_WORKGROUP)) < v) { __builtin_amdgcn_s_sleep(1); if (++spins > (1u << 24)) break; }
    asm volatile("" ::: "memory");
}
constexpr int SC_YW_OFF = 2 * SC_BUF_BYTES;
constexpr int SC_NSCAN = 2, SC_NLOAD = 2;

DI void scan_task(const float* const* in, unsigned char* ws, float* y, LAS unsigned char* lds, LAS unsigned* ctr, int task, int wave) {
    const int lane = lane_opaque();
    float* bonus = (float*)(ws + WS_BONUS);
#ifndef SC_REP
#define SC_REP 1
#endif
    constexpr int NCHUNK = SEQ / SC_STEPS, NCH2 = SC_REP * NCHUNK;
    const int bh = task >> 2, qr = task & 3, b = bh >> 5, h = bh & 31;
    if (wave < SC_NSCAN) {
        const int rl = lane >> 3, cg = lane & 7, vrow = 8 * wave + rl;
        f32x4 s0 = {0.f, 0.f, 0.f, 0.f}, s1 = s0;
        LAS float* yb = (LAS float*)(lds + SC_YW_OFF + wave * 1024);
        for (int c2 = 0; c2 < NCH2; ++c2) { const int c = c2 & (NCHUNK - 1); if (SC_REP > 1 && c == 0) { s0 = (f32x4){0.f, 0.f, 0.f, 0.f}; s1 = s0; }
            lds_wait_ge(ctr, (unsigned)(c2 + 1)); lds_wait_ge(ctr + 1, (unsigned)(c2 + 1));
            const LAS unsigned char* buf = lds + (c2 & 1) * SC_BUF_BYTES;
            PairVec A, B; pair_ld(A, (const LAS float*)buf, cg, vrow);
#pragma unroll 1
            for (int p = 0; p < SC_PAIRS; p += 2) {
                pair_ld(B, (const LAS float*)(buf + (p + 1) * SC_PAIR_BYTES), cg, vrow);
                float ya, yb_, yc, yd;
                pair_step(s0, s1, A, ya, yb_);
                if (p + 2 < SC_PAIRS) pair_ld(A, (const LAS float*)(buf + (p + 2) * SC_PAIR_BYTES), cg, vrow);
                pair_step(s0, s1, B, yc, yd);
                if (cg == 0) { yb[(2 * p) * 8 + rl] = ya; yb[(2 * p + 1) * 8 + rl] = yb_; yb[(2 * p + 2) * 8 + rl] = yc; yb[(2 * p + 3) * 8 + rl] = yd; }
            }
            lds_signal(ctr + 2 + wave, lane);
            { const int s = lane >> 1, hf = lane & 1, t = c * SC_STEPS + s;
              *(f32x4*)(y + (size_t)(b * SEQ + t) * DB + h * HDB + 16 * qr + 8 * wave + 4 * hf) = *(const LAS f32x4*)(yb + s * 8 + 4 * hf); }
            asm volatile("s_waitcnt lgkmcnt(0)" ::: "memory");
        }
    } else if (wave < SC_NSCAN + SC_NLOAD) {
        const int lw = wave - SC_NSCAN, pl_ = lane >> 4, cg = lane & 15, col0 = h * HDB + 4 * cg;
        ScanConst C; C.mu_r = *(const f32x4*)(in[I_MU_RKV] + col0); C.mu_k = *(const f32x4*)(in[I_MU_RKV] + DB + col0); C.mu_v = *(const f32x4*)(in[I_MU_RKV] + 2 * DB + col0);
        C.kkw = *(const f32x4*)(in[I_KK] + col0); C.kaw = *(const f32x4*)(in[I_KA] + col0); C.rkw = *(const f32x4*)(in[I_RK] + col0);
        ScanRaw R1[2], R2[2];
#pragma unroll
        for (int q = 0; q < 2; ++q) scan_issue_pair(R1[q], R2[q], ws, b, h, 2 * (4 * (lw + 2 * q) + pl_), cg);
        for (int c2 = 0; c2 < NCH2; ++c2) { const int c = c2 & (NCHUNK - 1);
            if (c2 >= 2) { lds_wait_ge(ctr + 2, (unsigned)(c2 - 1)); lds_wait_ge(ctr + 3, (unsigned)(c2 - 1)); }
            LAS float* base = (LAS float*)(lds + (c2 & 1) * SC_BUF_BYTES); const int t0 = c * SC_STEPS;
#pragma unroll
            for (int q = 0; q < 2; ++q) { const int pr = 4 * (lw + 2 * q) + pl_;
                scan_emit_pair(R1[q], R2[q], C, base + pr * SC_PAIR_FLOATS, cg, qr, qr == 0 ? bonus + (size_t)(b * SEQ + t0 + 2 * pr) * NHB + h : nullptr);
                if (c2 + 1 < NCH2) scan_issue_pair(R1[q], R2[q], ws, b, h, ((c + 1) & (NCHUNK - 1)) * SC_STEPS + 2 * pr, cg); }
            lds_signal(ctr + lw, lane);
        }
    }
}


typedef __bf16 hbf2 __attribute__((ext_vector_type(2)));
DI unsigned cvtpk2(float lo, float hi) { const f32x2 v = {lo, hi}; const hbf2 b = __builtin_convertvector(v, hbf2); return __builtin_bit_cast(unsigned, b); }
DI bf16x8 pack_acc8(const f32x16& x, const int s) { v4u w; w.x = cvtpk2(x[8 * s], x[8 * s + 1]); w.y = cvtpk2(x[8 * s + 2], x[8 * s + 3]); w.z = cvtpk2(x[8 * s + 4], x[8 * s + 5]); w.w = cvtpk2(x[8 * s + 6], x[8 * s + 7]); return __builtin_bit_cast(bf16x8, w); }
DI bf16x8 ld_perm(const LAS unsigned char* rowk0, int h) { const v2u lo = *(const LAS v2u*)(rowk0 + 8 * h), hi = *(const LAS v2u*)(rowk0 + 16 + 8 * h); const v4u w = {lo.x, lo.y, hi.x, hi.y}; return __builtin_bit_cast(bf16x8, w); }
DI bf16x8 ld_frag(const LAS unsigned char* p) { return *(const LAS bf16x8*)p; }
DI float wave_sum64(float x) { x = red16(x); const int xi = __builtin_bit_cast(int, x);
    return (__builtin_bit_cast(float, __builtin_amdgcn_readlane(xi, 0)) + __builtin_bit_cast(float, __builtin_amdgcn_readlane(xi, 16))) + (__builtin_bit_cast(float, __builtin_amdgcn_readlane(xi, 32)) + __builtin_bit_cast(float, __builtin_amdgcn_readlane(xi, 48))); }

constexpr int CK = 16, CS_NCHUNK = SEQ / CK;
constexpr int CS_RA = 0, CS_BKROW = 4608, CS_XG = 9216, CS_MM = 10496, CS_VROW = 11776, CS_PC = 14080, CS_BON = 14336, CS_SLOT = 14400;
constexpr int CS_P_RA = 144, CS_P_XG = 80;
constexpr int CS_NPREP = 5, CS_SCR_OFF = CS_NPREP * CS_SLOT;
constexpr int CS_S_LAB = 0, CS_S_LAK = 1024, CS_S_PT = 1792, CS_SCR_BYTES = 5888;
constexpr int CS_YST_OFF = CS_SCR_OFF + CS_NPREP * CS_SCR_BYTES, CS_YST_BYTES = 4096 + 64;
static_assert(CS_YST_OFF + 2 * CS_YST_BYTES <= 162816, "chunk-scan LDS map");

DI void chunk_scan(const float* const* in, unsigned char* ws, float* y, LAS unsigned char* lds, LAS unsigned* ctr  , int b, int hd, int wave) {
    const int lane = lane_opaque();
    if (wave < 2) {
        const int Ib = wave, n = lane & 31, h = lane >> 5;
        f32x16 acc0, acc1;
#pragma unroll
        for (int i = 0; i < 16; ++i) { acc0[i] = 0.f; acc1[i] = 0.f; }
        int pw = 0, nn = 0;
        for (int c = 0; c < CS_NCHUNK; ++c, ++pw) {
            if (pw == CS_NPREP) { pw = 0; ++nn; }
            lds_wait_ge(ctr + pw, (unsigned)(nn + 1));
            const LAS unsigned char* sl = lds + pw * CS_SLOT;
            const LAS unsigned char* ra = sl + CS_RA + n * CS_P_RA; const LAS unsigned char* xg = sl + CS_XG + (n & 15) * CS_P_XG; const LAS unsigned char* mm = sl + CS_MM + (n & 15) * CS_P_XG;
            bf16x8 bk00, bk01, bk10, bk11, vfrag;
            { const unsigned q4 = (lane & 15) >> 2, p4 = lane & 3, blk = (lane >> 4) & 1;
              const unsigned a_perm = (unsigned)(size_t)(sl + CS_BKROW) + (4 * h + q4) * CS_P_RA + (16 * blk + 4 * p4) * 2, a_norm = (unsigned)(size_t)(sl + CS_BKROW) + (8 * h + q4) * CS_P_RA + (16 * blk + 4 * p4) * 2, a_v = a_norm + 64 * Ib;
              v2u r0, r1, r2, r3, r4, r5, r6, r7, r8, r9;
              asm volatile("ds_read_b64_tr_b16 %0, %10\n\tds_read_b64_tr_b16 %1, %10 offset:1152\n\tds_read_b64_tr_b16 %2, %10 offset:64\n\tds_read_b64_tr_b16 %3, %10 offset:1216\n\t"
                           "ds_read_b64_tr_b16 %4, %11 offset:2304\n\tds_read_b64_tr_b16 %5, %11 offset:2880\n\tds_read_b64_tr_b16 %6, %11 offset:2368\n\tds_read_b64_tr_b16 %7, %11 offset:2944\n\t"
                           "ds_read_b64_tr_b16 %8, %12 offset:7168\n\tds_read_b64_tr_b16 %9, %12 offset:7744\n\ts_waitcnt lgkmcnt(0)"
                           : "=&v"(r0), "=&v"(r1), "=&v"(r2), "=&v"(r3), "=&v"(r4), "=&v"(r5), "=&v"(r6), "=&v"(r7), "=&v"(r8), "=&v"(r9) : "v"(a_perm), "v"(a_norm), "v"(a_v) : "memory");
              bk00 = __builtin_bit_cast(bf16x8, (v4u){r0.x, r0.y, r1.x, r1.y}); bk10 = __builtin_bit_cast(bf16x8, (v4u){r2.x, r2.y, r3.x, r3.y});
              bk01 = __builtin_bit_cast(bf16x8, (v4u){r4.x, r4.y, r5.x, r5.y}); bk11 = __builtin_bit_cast(bf16x8, (v4u){r6.x, r6.y, r7.x, r7.y});
              vfrag = __builtin_bit_cast(bf16x8, (v4u){r8.x, r8.y, r9.x, r9.y}); }
            f32x16 U;
#pragma unroll
            for (int i = 0; i < 16; ++i) U[i] = 0.f;
            U = __builtin_amdgcn_mfma_f32_32x32x16_bf16(ld_perm(ra + 0, h),  pack_acc8(acc0, 0), U, 0, 0, 0);
            U = __builtin_amdgcn_mfma_f32_32x32x16_bf16(ld_perm(ra + 32, h), pack_acc8(acc0, 1), U, 0, 0, 0);
            U = __builtin_amdgcn_mfma_f32_32x32x16_bf16(ld_perm(ra + 64, h), pack_acc8(acc1, 0), U, 0, 0, 0);
            U = __builtin_amdgcn_mfma_f32_32x32x16_bf16(ld_perm(ra + 96, h), pack_acc8(acc1, 1), U, 0, 0, 0);
            f32x16 SA;
#pragma unroll
            for (int i = 0; i < 16; ++i) SA[i] = 0.f;
            SA = __builtin_amdgcn_mfma_f32_32x32x16_bf16(ld_perm(xg, h), pack_acc8(U, 1), SA, 0, 0, 0);
            SA = __builtin_amdgcn_mfma_f32_32x32x16_bf16(ld_frag(xg + 32 + 16 * h), vfrag, SA, 0, 0, 0);
            const bf16x8 sab = pack_acc8(SA, 0);
            U = __builtin_amdgcn_mfma_f32_32x32x16_bf16(ld_perm(mm, h), sab, U, 0, 0, 0);
            U = __builtin_amdgcn_mfma_f32_32x32x16_bf16(ld_frag(mm + 32 + 16 * h), vfrag, U, 0, 0, 0);
            { acc0 = __builtin_amdgcn_mfma_f32_32x32x16_bf16(bk00, sab, acc0, 0, 0, 0);
              acc0 = __builtin_amdgcn_mfma_f32_32x32x16_bf16(bk01, vfrag, acc0, 0, 0, 0);
              acc1 = __builtin_amdgcn_mfma_f32_32x32x16_bf16(bk10, sab, acc1, 0, 0, 0);
              acc1 = __builtin_amdgcn_mfma_f32_32x32x16_bf16(bk11, vfrag, acc1, 0, 0, 0);
              const LAS float* pc = (const LAS float*)(sl + CS_PC);
#pragma unroll
              for (int g = 0; g < 4; ++g) { const f32x4 p0 = *(const LAS f32x4*)(pc + 8 * g + 4 * h), p1 = *(const LAS f32x4*)(pc + 32 + 8 * g + 4 * h);
#pragma unroll
                  for (int e = 0; e < 4; ++e) { acc0[4 * g + e] *= p0[e]; acc1[4 * g + e] *= p1[e]; } } }
            { if (c >= 2) lds_wait_ge(ctr + 10, (unsigned)(c - 1));
              LAS float* ys = (LAS float*)(lds + CS_YST_OFF + (c & 1) * CS_YST_BYTES);
#pragma unroll
              for (int rho = 0; rho < 8; ++rho) ys[((rho & 3) + 8 * (rho >> 2) + 4 * h) * 64 + 32 * Ib + n] = U[rho];
              if (Ib == 0 && lane < 16) ys[1024 + lane] = ((const LAS float*)(sl + CS_BON))[lane];
              lds_signal(ctr + (wave ? 11 : 9), lane); }
            lds_signal(ctr + 6 + wave, lane);
        }
    } else if (wave < 2 + CS_NPREP) {
        const int pw = wave - 2, j = lane, col = hd * HDB + j, st = lane >> 4, cg = lane & 15, col4 = hd * HDB + 4 * cg;
        const bf16* rb = (const bf16*)(ws + WS_RB); const bf16* kb = (const bf16*)(ws + WS_KB); const bf16* vb = (const bf16*)(ws + WS_VB);
        const _Float16* decay = (const _Float16*)(ws + WS_DECAY); const bf16* av = (const bf16*)(ws + WS_AOUT); float* bonus = (float*)(ws + WS_BONUS);
        ScanConst Cc; Cc.mu_r = *(const f32x4*)(in[I_MU_RKV] + col4); Cc.mu_k = *(const f32x4*)(in[I_MU_RKV] + DB + col4); Cc.mu_v = *(const f32x4*)(in[I_MU_RKV] + 2 * DB + col4);
        Cc.kkw = *(const f32x4*)(in[I_KK] + col4); Cc.kaw = *(const f32x4*)(in[I_KA] + col4); Cc.rkw = *(const f32x4*)(in[I_RK] + col4);
        LAS unsigned char* scr = lds + CS_SCR_OFF + pw * CS_SCR_BYTES; LAS unsigned char* sl = lds + pw * CS_SLOT;
        const int n32 = lane & 31, h = lane >> 5;
        float dcol[16]; ScanRaw R[4];
#define CS_ISSUE(cc) do { const size_t ob_ = (size_t)(b * SEQ + (cc) * CK) * DB; \
            _Pragma("unroll") for (int t_ = 0; t_ < 16; ++t_) dcol[t_] = (float)__builtin_nontemporal_load(decay + ob_ + (size_t)t_ * DB + col); \
            _Pragma("unroll") for (int p_ = 0; p_ < 4; ++p_) { const int tt_ = (cc) * CK + 4 * p_ + st; const size_t o_ = (size_t)(b * SEQ + tt_) * DB + col4; \
                R[p_].rc = __builtin_nontemporal_load((const v2u*)(rb + o_)); R[p_].kc = __builtin_nontemporal_load((const v2u*)(kb + o_)); R[p_].vc = *(const v2u*)(vb + o_); R[p_].ac = __builtin_nontemporal_load((const v2u*)(av + o_)); \
                if (tt_ > 0) { R[p_].rp = *(const v2u*)(rb + o_ - DB); R[p_].kp = *(const v2u*)(kb + o_ - DB); R[p_].vp = *(const v2u*)(vb + o_ - DB); } \
                else { R[p_].rp = (v2u){0u, 0u}; R[p_].kp = (v2u){0u, 0u}; R[p_].vp = (v2u){0u, 0u}; } } } while (0)
        CS_ISSUE(pw);
        for (int nn = 0; pw + CS_NPREP * nn < CS_NCHUNK; ++nn) {
            const int c = pw + CS_NPREP * nn, t0 = c * CK;
            { float P = 1.0f; LAS float* pt = (LAS float*)(scr + CS_S_PT);
#pragma unroll
              for (int t = 0; t < 16; ++t) { P *= dcol[t]; pt[t * 64 + j] = P; } }
            if (nn >= 1) { lds_wait_ge(ctr + 6, (unsigned)(c - CS_NPREP + 1)); lds_wait_ge(ctr + 7, (unsigned)(c - CS_NPREP + 1)); }
            LDS_WAIT(); asm volatile("" ::: "memory");
            ((LAS float*)(sl + CS_PC))[j] = ((const LAS float*)(scr + CS_S_PT))[15 * 64 + j];
            f32x4 P4v[4], Pmv[4];
#pragma unroll
            for (int p = 0; p < 4; ++p) { const int t = 4 * p + st; P4v[p] = *(const LAS f32x4*)(scr + CS_S_PT + (t * 64 + 4 * cg) * 4);
                Pmv[p] = (f32x4){1.f, 1.f, 1.f, 1.f}; if (t > 0) Pmv[p] = *(const LAS f32x4*)(scr + CS_S_PT + ((t - 1) * 64 + 4 * cg) * 4); }
#pragma unroll
            for (int p = 0; p < 4; ++p) { const int t = 4 * p + st;
                const f32x4 rc = bf4(R[p].rc), kc = bf4(R[p].kc), vc = bf4(R[p].vc), a_ = bf4(R[p].ac);
                const f32x4 r1 = rc + (bf4(R[p].rp) - rc) * Cc.mu_r, k0 = kc + (bf4(R[p].kp) - kc) * Cc.mu_k, v1 = vc + (bf4(R[p].vp) - vc) * Cc.mu_v;
                const f32x4 kkv = k0 * Cc.kkw;
                const float nrm = sqrtf(red16(hsum4(kkv * kkv)));
                const f32x4 kkn = kkv * (1.0f / fmaxf(nrm, 1e-12f));
                const f32x4 k1 = k0 * (1.0f + (a_ - 1.0f) * Cc.kaw);
                const float bc = red16(hsum4(r1 * k1 * Cc.rkw));
                if (cg == 0) ((LAS float*)(sl + CS_BON))[t] = bc;
                const f32x4 P4 = P4v[p], Pm = Pmv[p];
                f32x4 iP; iP[0] = __builtin_amdgcn_rcpf(P4[0]); iP[1] = __builtin_amdgcn_rcpf(P4[1]); iP[2] = __builtin_amdgcn_rcpf(P4[2]); iP[3] = __builtin_amdgcn_rcpf(P4[3]);
                const f32x4 Rt = r1 * P4, At = -kkn * Pm, Bt = kkn * a_ * iP, Kt = k1 * iP;
                *(LAS v2u*)(sl + CS_RA + t * CS_P_RA + 8 * cg) = (v2u){pk2(Rt[0], Rt[1]), pk2(Rt[2], Rt[3])};
                *(LAS v2u*)(sl + CS_RA + (16 + t) * CS_P_RA + 8 * cg) = (v2u){pk2(At[0], At[1]), pk2(At[2], At[3])};
                *(LAS v2u*)(sl + CS_BKROW + t * CS_P_RA + 8 * cg) = (v2u){pk2(Bt[0], Bt[1]), pk2(Bt[2], Bt[3])};
                *(LAS v2u*)(sl + CS_BKROW + (16 + t) * CS_P_RA + 8 * cg) = (v2u){pk2(Kt[0], Kt[1]), pk2(Kt[2], Kt[3])};
                *(LAS v2u*)(sl + CS_VROW + t * CS_P_RA + 8 * cg) = (v2u){pk2(v1[0], v1[1]), pk2(v1[2], v1[3])};
            }
            if (c + CS_NPREP < CS_NCHUNK) CS_ISSUE(c + CS_NPREP);
            LDS_WAIT(); asm volatile("" ::: "memory");
            f32x16 C;
#pragma unroll
            for (int i = 0; i < 16; ++i) C[i] = 0.f;
#pragma unroll
            for (int s = 0; s < 4; ++s) C = __builtin_amdgcn_mfma_f32_32x32x16_bf16(ld_frag(sl + CS_BKROW + n32 * CS_P_RA + (16 * s + 8 * h) * 2), ld_frag(sl + CS_RA + n32 * CS_P_RA + (16 * s + 8 * h) * 2), C, 0, 0, 0);
            if (n32 < 16) {
                const int t = n32; LAS unsigned char* mrow = sl + CS_MM + t * CS_P_XG;
#pragma unroll
                for (int g = 0; g < 2; ++g) { float m0[4], m1[4];
#pragma unroll
                    for (int e = 0; e < 4; ++e) { const int tau = e + 8 * g + 4 * h; m0[e] = (tau <= t) ? C[4 * g + e] : 0.f; m1[e] = (tau <= t) ? C[8 + 4 * g + e] : 0.f; }
                    *(LAS v2u*)(mrow + 16 * g + 8 * h) = (v2u){pk2(m0[0], m0[1]), pk2(m0[2], m0[3])}; *(LAS v2u*)(mrow + 32 + 16 * g + 8 * h) = (v2u){pk2(m1[0], m1[1]), pk2(m1[2], m1[3])}; }
            } else {
                const int t = n32 - 16;
#pragma unroll
                for (int g = 0; g < 2; ++g)
#pragma unroll
                    for (int e = 0; e < 4; ++e) { const int tau = e + 8 * g + 4 * h;
                        ((LAS float*)(scr + CS_S_LAB))[tau * 16 + t] = (tau < t) ? C[4 * g + e] : 0.f;
                        ((LAS bf16*)(scr + CS_S_LAK + tau * 48))[t] = (bf16)f2bf((tau < t) ? C[8 + 4 * g + e] : 0.f); }
            }
            LDS_WAIT(); asm volatile("" ::: "memory");
            float x[16]; const int tx = lane & 15;
#pragma unroll
            for (int i = 0; i < 16; ++i) x[i] = (i == tx) ? 1.0f : 0.0f;
#pragma unroll
            for (int bt = 2; bt >= 0; --bt) {
                f32x4 Lr[5][4];
#pragma unroll
                for (int r5 = 0; r5 < 5; ++r5)
#pragma unroll
                    for (int q = 0; q < 4; ++q) { const int tau = 5 * bt + r5; if (4 * q + 3 > tau) Lr[r5][q] = *(const LAS f32x4*)(scr + CS_S_LAB + tau * 64 + q * 16); else Lr[r5][q] = (f32x4){0.f, 0.f, 0.f, 0.f}; }
#pragma unroll
                for (int r5 = 4; r5 >= 0; --r5) { const int tau = 5 * bt + r5; float a2 = x[tau];
#pragma unroll
                    for (int q = 0; q < 4; ++q)
#pragma unroll
                        for (int e = 0; e < 4; ++e) { const int s2 = 4 * q + e; if (s2 > tau) a2 += Lr[r5][q][e] * x[s2]; }
                    x[tau] = a2; }
            }
            if (lane < 16) { LAS v4u* xr = (LAS v4u*)(sl + CS_XG + lane * CS_P_XG);
                xr[0] = (v4u){pk2(x[0], x[1]), pk2(x[2], x[3]), pk2(x[4], x[5]), pk2(x[6], x[7])}; xr[1] = (v4u){pk2(x[8], x[9]), pk2(x[10], x[11]), pk2(x[12], x[13]), pk2(x[14], x[15])}; }
            { v4u xb;
              xb.x = h ? pk2(x[8], x[9]) : pk2(x[0], x[1]); xb.y = h ? pk2(x[10], x[11]) : pk2(x[2], x[3]); xb.z = h ? pk2(x[12], x[13]) : pk2(x[4], x[5]); xb.w = h ? pk2(x[14], x[15]) : pk2(x[6], x[7]);
              if (n32 >= 16) xb = (v4u){0u, 0u, 0u, 0u};
              f32x16 Gm;
#pragma unroll
              for (int i = 0; i < 16; ++i) Gm[i] = 0.f;
              Gm = __builtin_amdgcn_mfma_f32_32x32x16_bf16(ld_frag(scr + CS_S_LAK + (n32 & 15) * 48 + 16 * h), __builtin_bit_cast(bf16x8, xb), Gm, 0, 0, 0);
              if (n32 < 16) { LAS unsigned char* grow = sl + CS_XG + n32 * CS_P_XG + 32;
#pragma unroll
                  for (int g = 0; g < 2; ++g) *(LAS v2u*)(grow + 16 * g + 8 * h) = (v2u){pk2(Gm[4 * g], Gm[4 * g + 1]), pk2(Gm[4 * g + 2], Gm[4 * g + 3])}; } }
            lds_signal(ctr + pw, lane);
        }
#undef CS_ISSUE
    } else if (wave == 2 + CS_NPREP) {
        const int t = lane >> 2, q = lane & 3, colq = hd * HDB + 16 * q;
        const bf16* vb = (const bf16*)(ws + WS_VB); const bf16* gout = (const bf16*)(ws + WS_GOUT); bf16* ro = (bf16*)(ws + WS_AO) + (size_t)M * DB;
        f32x4 lw[4], lb[4], muv[4];
#pragma unroll
        for (int i = 0; i < 4; ++i) { lw[i] = *(const f32x4*)(in[I_LNW] + colq + 4 * i); lb[i] = *(const f32x4*)(in[I_LNB] + colq + 4 * i); muv[i] = *(const f32x4*)(in[I_MU_RKV] + 2 * DB + colq + 4 * i); }
        v4u vcA[2], vpA[2], ggA[2], vcB[2], vpB[2], ggB[2];
#define GN_ISSUE(vcu, vpr, gg, cc) do { const int tt_ = (cc) * CK + t; const size_t o_ = (size_t)(b * SEQ + tt_) * DB + colq; \
            vcu[0] = *(const v4u*)(vb + o_); vcu[1] = *(const v4u*)(vb + o_ + 8); gg[0] = *(const v4u*)(gout + o_); gg[1] = *(const v4u*)(gout + o_ + 8); \
            if (tt_ > 0) { vpr[0] = *(const v4u*)(vb + o_ - DB); vpr[1] = *(const v4u*)(vb + o_ - DB + 8); } else { vpr[0] = (v4u){0u, 0u, 0u, 0u}; vpr[1] = (v4u){0u, 0u, 0u, 0u}; } } while (0)
#define GN_CHUNK(vcu, vpr, gg, cc) do { const int c_ = (cc); \
            lds_wait_ge(ctr + 9, (unsigned)(c_ + 1)); lds_wait_ge(ctr + 11, (unsigned)(c_ + 1)); \
            const LAS float* ys = (const LAS float*)(lds + CS_YST_OFF + (c_ & 1) * CS_YST_BYTES); \
            f32x4 yv[4]; \
            _Pragma("unroll") for (int i = 0; i < 4; ++i) yv[i] = *(const LAS f32x4*)(ys + t * 64 + 16 * q + 4 * i); \
            const float bc = ys[1024 + t]; \
            lds_signal(ctr + 10, lane); \
            float sm = (hsum4(yv[0]) + hsum4(yv[1])) + (hsum4(yv[2]) + hsum4(yv[3])); \
            sm = dpp_add<0xB1>(sm); sm = dpp_add<0x4E>(sm); \
            const float mean = sm * (1.0f / 64.0f); \
            float sq = 0.f; \
            _Pragma("unroll") for (int i = 0; i < 4; ++i) { yv[i] = yv[i] - mean; sq += hsum4(yv[i] * yv[i]); } \
            sq = dpp_add<0xB1>(sq); sq = dpp_add<0x4E>(sq); \
            const float rs = 1.0f / sqrtf(sq * (1.0f / 64.0f) + GN_EPS); \
            v4u outw[2]; \
            _Pragma("unroll") for (int i = 0; i < 4; ++i) { f32x4 vc, vp2, g4; \
                { const v4u w_ = vcu[i >> 1]; const unsigned a0 = (i & 1) ? w_.z : w_.x, a1 = (i & 1) ? w_.w : w_.y; vc = (f32x4){bf_lo(a0), bf_hi(a0), bf_lo(a1), bf_hi(a1)}; } \
                { const v4u w_ = vpr[i >> 1]; const unsigned a0 = (i & 1) ? w_.z : w_.x, a1 = (i & 1) ? w_.w : w_.y; vp2 = (f32x4){bf_lo(a0), bf_hi(a0), bf_lo(a1), bf_hi(a1)}; } \
                { const v4u w_ = gg[i >> 1]; const unsigned a0 = (i & 1) ? w_.z : w_.x, a1 = (i & 1) ? w_.w : w_.y; g4 = (f32x4){bf_lo(a0), bf_hi(a0), bf_lo(a1), bf_hi(a1)}; } \
                const f32x4 v1 = vc + (vp2 - vc) * muv[i]; \
                const f32x4 res = (yv[i] * rs * lw[i] + lb[i] + v1 * bc) * g4; \
                const unsigned p0 = pk2(res[0], res[1]), p1 = pk2(res[2], res[3]); \
                if (i == 0) { outw[0].x = p0; outw[0].y = p1; } else if (i == 1) { outw[0].z = p0; outw[0].w = p1; } else if (i == 2) { outw[1].x = p0; outw[1].y = p1; } else { outw[1].z = p0; outw[1].w = p1; } } \
            { bf16* dst = ro + (size_t)(b * SEQ + c_ * CK + t) * DB + colq; *(v4u*)dst = outw[0]; *(v4u*)(dst + 8) = outw[1]; } } while (0)
        GN_ISSUE(vcA, vpA, ggA, 0); GN_ISSUE(vcB, vpB, ggB, 1);
        for (int c = 0; c < CS_NCHUNK; c += 2) {
            GN_CHUNK(vcA, vpA, ggA, c);     if (c + 2 < CS_NCHUNK) GN_ISSUE(vcA, vpA, ggA, c + 2);
            GN_CHUNK(vcB, vpB, ggB, c + 1); if (c + 3 < CS_NCHUNK) GN_ISSUE(vcB, vpB, ggB, c + 3);
        }
#undef GN_CHUNK
#undef GN_ISSUE
    }
}

constexpr int ATT_LDS_OFF = 90112;
constexpr int ATT_LDS_OFF2 = 132096;
DI void scan_attn_phase(const float* const* in, unsigned char* ws, float* y, LAS unsigned char* lds, LAS unsigned char* lds_all, LAS unsigned* ctr, int wave) {
    const bool is_scan = ((blockIdx.x >> 3) & 3) == 0 && gridDim.x == 256; const int sb = (int)(blockIdx.x & 7) + 8 * (int)(blockIdx.x >> 5);
    __syncthreads();
    if (wave == 0 && lane_opaque() == 0) { ((LAS v4u*)ctr)[0] = (v4u){0u, 0u, 0u, 0u}; ((LAS v4u*)ctr)[1] = (v4u){0u, 0u, 0u, 0u}; ((LAS v4u*)ctr)[2] = (v4u){0u, 0u, 0u, 0u}; }
    __syncthreads();
#ifndef REP_CS
#define REP_CS 1
#endif
    if (is_scan) { for (int rep = 0; rep < REP_CS; ++rep) {
            if (rep) { if (wave == 0 && lane_opaque() == 0) { ((LAS v4u*)ctr)[0] = (v4u){0u, 0u, 0u, 0u}; ((LAS v4u*)ctr)[1] = (v4u){0u, 0u, 0u, 0u}; } __syncthreads(); }
#if defined(PROBE_X)
            const unsigned long long tp0_ = __builtin_amdgcn_s_memrealtime();
#endif
            chunk_scan(in, ws, y, lds, ctr, sb >> 5, sb & 31, wave); __syncthreads();
#if defined(PROBE_X)
            if (blockIdx.x == 0 && wave == 0 && lane_opaque() == 0) ((unsigned*)(ws + WS_CTL))[9000] = (unsigned)(__builtin_amdgcn_s_memrealtime() - tp0_);
#endif
            } }
    LAS unsigned char* mine = lds_all + wave * 16384;
    attn_worker(ws, mine, ctr + 4, wave);
    { const int lane = lane_opaque(); LAS unsigned* tile = (LAS unsigned*)mine; unsigned* cq = (unsigned*)(ws + WS_CTL) + CW_ATTQ + 64 * 8;
        bf16* w13a = (bf16*)((unsigned char*)y + (size_t)128 * MiB);
        for (;;) { unsigned v_ = 0u; if (lane == 0) v_ = __hip_atomic_fetch_add(cq, 2u, __ATOMIC_RELAXED, __HIP_MEMORY_SCOPE_AGENT);
            const int it = __builtin_amdgcn_readfirstlane((int)v_); if (it >= W2_NITEMS + W13A_NITEMS) break;
            if (it < W2_NITEMS) { convert_w2_item(in, ws, tile, it, lane); convert_w2_item(in, ws, tile, it + 1, lane); }
            else { const int i = it - W2_NITEMS; convert_w13_item(in, ws, w13a, tile, i / (W13_SPLIT / 64), i % (W13_SPLIT / 64), lane); convert_w13_item(in, ws, w13a, tile, (i + 1) / (W13_SPLIT / 64), (i + 1) % (W13_SPLIT / 64), lane); } } }
}

DI void gn_phase(const float* const* in, unsigned char* ws, const float* y, int gw, int NGW, int lane) {
    const bf16* vb = (const bf16*)(ws + WS_VB); const bf16* gout = (const bf16*)(ws + WS_GOUT);
    const float* bonus = (const float*)(ws + WS_BONUS); bf16* ro = (bf16*)(ws + WS_AO) + (size_t)M * DB;
    const int per = (M * 8 + NGW - 1) / NGW, it0 = gw * per, it1 = (it0 + per < M * 8) ? it0 + per : M * 8;
    const int hh = lane >> 4, cg = lane & 15;
#pragma unroll 2
    for (int it = it0; it < it1; ++it) {
        const int m = it >> 3, h = (it & 7) * 4 + hh, col = h * HDB + 4 * cg; const size_t o = (size_t)m * DB + col;
        const f32x4 yv = *(const f32x4*)(y + o);
        const f32x4 vc = bf4(*(const v2u*)(vb + o)), g4 = bf4(*(const v2u*)(gout + o));
        f32x4 vp = {0.f, 0.f, 0.f, 0.f}; if (m & (SEQ - 1)) vp = bf4(*(const v2u*)(vb + o - DB));
        const float bc = bonus[(size_t)m * NHB + h];
        const f32x4 lw = *(const f32x4*)(in[I_LNW] + col), lb = *(const f32x4*)(in[I_LNB] + col), muv = *(const f32x4*)(in[I_MU_RKV] + 2 * DB + col);
        const float mean = red16((yv[0] + yv[1]) + (yv[2] + yv[3])) * (1.0f / 64.0f); const f32x4 d = yv - mean;
        const float var = red16((d[0] * d[0] + d[1] * d[1]) + (d[2] * d[2] + d[3] * d[3])) * (1.0f / 64.0f);
        const f32x4 yn = d * (1.0f / sqrtf(var + GN_EPS)) * lw + lb;
        const f32x4 v1 = vc + (vp - vc) * muv;
        const f32x4 res = (yn + v1 * bc) * g4;
        v2u w; w.x = pk2(res[0], res[1]); w.y = pk2(res[2], res[3]);
        *(v2u*)(ro + o) = w;
    }
}

DI void final_phase(const float* const* in, unsigned char* ws, float* out, int gw, int NGW, int lane) {
    const float* ss3 = (const float*)(ws + SS3_OFF); const float* nf = in[I_NORM_FINAL]; const bf16* hb = (const bf16*)(ws + WS_H3B);
    for (int m = gw; m < M; m += NGW) { const float r = 1.0f / sqrtf(ss3[m] * (1.0f / D) + RMS_EPS);
        const GAS v4u* src = (const GAS v4u*)(hb + (size_t)m * D) + lane; GAS f32x4* o = (GAS f32x4*)(out + (size_t)m * D) + 2 * lane; const GAS f32x4* g = (const GAS f32x4*)nf + 2 * lane;
        v4u w[8];
#pragma unroll
        for (int j = 0; j < 8; ++j) w[j] = __builtin_nontemporal_load(src + 64 * j);
#pragma unroll
        for (int j = 0; j < 8; ++j) { f32x4 a, b; epi::unpack8(w[j], a, b); a = a * r * g[128 * j]; b = b * r * g[128 * j + 1]; __builtin_nontemporal_store(a, o + 128 * j); __builtin_nontemporal_store(b, o + 128 * j + 1); } }
}

#ifndef MK_N_LAUNCHES
#define MK_N_LAUNCHES 1
#endif
constexpr int N_PHASES = 13;
#ifndef REP_P2
#define REP_P2 1
#endif
#ifndef REP_P3
#define REP_P3 1
#endif
#ifndef REP_P6
#define REP_P6 1
#endif
#ifndef REP_P7
#define REP_P7 1
#endif
#ifndef REP_P10
#define REP_P10 1
#endif
#ifndef REP_C
#define REP_C 1
#endif
#ifndef PG8_SP2
#define PG8_SP2 true
#endif
#ifndef PG8_ALIGN
#define PG8_ALIGN true
#endif

__global__ void __launch_bounds__(NWAVES * 64, 2) hybrid_fwd(Args args) {
    extern __shared__ __attribute__((aligned(16))) unsigned char lds_raw[];
    LAS unsigned char* lds = (LAS unsigned char*)lds_raw;
    volatile LAS unsigned* MISC = (volatile LAS unsigned*)(lds + MISC_OFF);
    const int wave = __builtin_amdgcn_readfirstlane(threadIdx.x >> 6);
    const int G = gridDim.x, gw = blockIdx.x * NWAVES + wave, NGW = G * NWAVES;
    unsigned char* ws = args.ws; const float* const* in = args.in;
    { const int tid0 = wave * 64 + lane_opaque(); for (int u = tid0; u < (LDS_BYTES - LDSCTL_OFF) / 4; u += NWAVES * 64) ((LAS unsigned*)(lds + LDSCTL_OFF))[u] = 0u; }
    __syncthreads();
    unsigned* ctl = (unsigned*)(ws + WS_CTL);
    XcdBarrier bar; bar.bar = ctl + CW_BAR; bar.x = 0; bar.st = nullptr;
    const bool multi = (args.ph_hi - args.ph_lo) > 1;
    if (multi) bar = xcd_barrier_post(ctl + CW_BAR, MISC + 8, wave == 0 && lane_opaque() == 0);
    const int lo = args.ph_lo, hi = args.ph_hi;
#ifndef PHASE_MASK
#define PHASE_MASK 0x3fff
#endif
#define IN(k) ((((PHASE_MASK) >> (k)) & 1) && lo <= (k) && (k) < hi)
#define SEAM(k) do { if (IN(k) && IN((k) + 1)) xcd_barrier(bar, wave == 0 && lane_opaque() == 0); } while (0)
#define LANE lane_opaque()
#if defined(PROBE_T)
#ifndef PROBE_T2
#define PROBE_T2 (PROBE_T + 1)
#endif
#define MARK(k) do { if (blockIdx.x == 0 && wave == 0 && lane_opaque() == 0) __hip_atomic_store((unsigned*)(ws + WS_CTL) + 9100 + (k), (unsigned)__builtin_amdgcn_s_memrealtime(), __ATOMIC_RELAXED, __HIP_MEMORY_SCOPE_AGENT); } while (0)
#else
#define MARK(k) do { } while (0)
#endif
#ifndef STG_GRP
#define STG_GRP ((int)blockIdx.x & 7)
#endif
#define STAGGER(t) do { if ((t) > 0) { const unsigned long long te_ = __builtin_amdgcn_s_memrealtime() + (unsigned long long)(STG_GRP * (t)); while (__builtin_amdgcn_s_memrealtime() < te_) __builtin_amdgcn_s_sleep(4); } } while (0)
#ifndef STG_P1
#define STG_P1 0
#endif
#ifndef STG_P8
#define STG_P8 0
#endif
#ifndef STG_P9
#define STG_P9 0
#endif
#ifndef STG_P10
#define STG_P10 0
#endif
#ifndef STG_P11
#define STG_P11 0
#endif
#ifndef STG_P12
#define STG_P12 0
#endif
    LAS unsigned* scr = (LAS unsigned*)(lds + RING_OFF + wave * 16384);

    MARK(0);
    if (IN(0)) { const int lane = LANE; for (int rep = 0; rep < REP_C; ++rep) { convert_set_a(in, ws, scr, gw, NGW, lane); prologue_rows(in, ws, (bf16*)args.out, gw, NGW, lane); } }
    SEAM(0); MARK(1);
    if (IN(1)) { STAGGER(STG_P1);
        pg8::Gemm g{(const bf16*)args.out, (const bf16*)(ws + WS_WCAT), M, NCAT, D}; pg8::StaticOrder S; S.init(M, NCAT, G, (int)blockIdx.x);
        epi::InProj E{(bf16*)(ws + WS_Q), (bf16*)(ws + WS_K), (bf16*)(ws + WS_V), (bf16*)(ws + WS_QI), (bf16*)(ws + WS_KI), (bf16*)(ws + WS_RB), (bf16*)(ws + WS_KB), (bf16*)(ws + WS_VB),
                      (bf16*)(ws + WS_LORA), (bf16*)(ws + WS_GATES), (float*)(ws + WS_WI), (const float*)(ws + WS_RSTDX), (const float*)(ws + WS_RCOS), (const float*)(ws + WS_RSIN), in[I_BGATE]};
        pg8::gemm_phase<epi::InProj, pg8::StaticOrder, PG8_ALIGN, PG8_SP2>(lds + RING_OFF, g, S, E, wave);
#if defined(REP_P1)
        pg8::gemm_phase<epi::InProj, pg8::StaticOrder, PG8_ALIGN, PG8_SP2>(lds + RING_OFF, g, S, E, wave);
#endif
        { const int busy = ((M / 256) * (NCAT / 256)) % G, gi = busy ? G - busy : G, ci = busy ? (int)blockIdx.x - busy : (int)blockIdx.x;
          if (ci >= 0) { const int lane = LANE; for (int it = ci * NWAVES + wave; it < A1_NITEMS; it += gi * NWAVES) convert_a1_item(in, ws, scr, it, lane); } }
    }
    SEAM(1); MARK(2);
    if (IN(4)) build_alora(ws, blockIdx.x * (NWAVES * 64) + wave * 64 + LANE, G * NWAVES * 64);
    MARK(13);
    if (IN(2)) { for (int rep = 0; rep < REP_P2; ++rep) indexer_phase(ws, lds + RING_OFF, wave); }
    MARK(14);
    if (IN(2) && IN(5)) xcd_barrier(bar, wave == 0 && lane_opaque() == 0);
    MARK(3);
    if (IN(5)) {
        int k256 = 256; asm volatile("" : "+s"(k256));
        pg8::Gemm g{(const bf16*)(ws + WS_ALORA), (const bf16*)(ws + WS_WL2), 3 * M, 3 * DB, k256}; epi::Stack3Order S{G, (int)blockIdx.x};
        epi::LoraUp E{(float*)(ws + WS_DECAY), (bf16*)(ws + WS_AOUT), (bf16*)(ws + WS_GOUT), in[I_W0], in[I_A0]};
        pg8::gemm_phase<epi::LoraUp, epi::Stack3Order, PG8_ALIGN, PG8_SP2>(lds + RING_OFF, g, S, E, wave);
    }
    SEAM(5); MARK(4);
    if (IN(6)) { for (int rep = 0; rep < REP_P6; ++rep) scan_attn_phase(in, ws, args.out, lds + RING_OFF, lds, (LAS unsigned*)(lds + MISC_OFF + 64), wave); }
    SEAM(6); MARK(5);
    if (IN(7)) { const int lane = LANE; __syncthreads(); for (int it = gw; it < W13B_NITEMS; it += NGW) convert_w13_item(in, ws, nullptr, scr, it / W13B_NB, W13_SPLIT / 64 + it % W13B_NB, lane); }
    __syncthreads();
    MARK(6);
    if (IN(8)) { STAGGER(STG_P8);
        pg8::Gemm g{(const bf16*)(ws + WS_AO), (const bf16*)(ws + WS_WPAB), 2 * M, 2 * D, DA}; epi::ChainOrder S; S.so.init(M, D, G, (int)blockIdx.x);
        epi::GateMix E{(const bf16*)(ws + WS_GATES), in[I_BGATE], (bf16*)(ws + WS_MIX)};
        pg8::gemm_phase<epi::GateMix, epi::ChainOrder, PG8_ALIGN, PG8_SP2>(lds + RING_OFF, g, S, E, wave);
#if defined(REP_P8)
        pg8::gemm_phase<epi::GateMix, epi::ChainOrder, PG8_ALIGN, PG8_SP2>(lds + RING_OFF, g, S, E, wave);
#endif
    }
    SEAM(8); MARK(7);
    if (IN(9)) { STAGGER(STG_P9);
        pg8::Gemm g{(const bf16*)(ws + WS_MIX), (const bf16*)(ws + WS_WO), M, D, D}; pg8::StaticOrder S; S.init(M, D, G, (int)blockIdx.x);
        epi::ResidT<true> E{nullptr, (const bf16*)args.out, (bf16*)(ws + WS_H1B), (float*)(ws + SS1_OFF)};
        pg8::gemm_phase<epi::ResidT<true>, pg8::StaticOrder, PG8_ALIGN, PG8_SP2>(lds + RING_OFF, g, S, E, wave);
    }
    SEAM(9); MARK(8);
    if (IN(10)) { STAGGER(STG_P10);
        { pg8::Gemm g{(const bf16*)(ws + WS_H1B), (const bf16*)((unsigned char*)args.out + (size_t)128 * MiB), M, W13_SPLIT, D}; pg8::StaticOrder S; S.init(M, W13_SPLIT, G, (int)blockIdx.x);
          epi::FfnUp E{(const float*)(ws + SS1_OFF), (bf16*)(ws + WS_U)};
          pg8::gemm_phase<epi::FfnUp, pg8::StaticOrder, PG8_ALIGN, PG8_SP2>(lds + RING_OFF, g, S, E, wave); }
        { pg8::Gemm g{(const bf16*)(ws + WS_H1B), (const bf16*)(ws + WS_W13B), M, N13 - W13_SPLIT, D}; pg8::StaticOrder S; S.init(M, N13 - W13_SPLIT, G, (int)blockIdx.x);
          epi::FfnUp E{(const float*)(ws + SS1_OFF), (bf16*)(ws + WS_U) + W13_SPLIT / 2};
          pg8::gemm_phase<epi::FfnUp, pg8::StaticOrder, PG8_ALIGN, PG8_SP2>(lds + RING_OFF, g, S, E, wave); }
        { const int busy = ((M / 256) * ((N13 - W13_SPLIT) / 256)) % G, gi = busy ? G - busy : G, ci = busy ? (int)blockIdx.x - busy : (int)blockIdx.x;
          if (ci >= 0) { int k256 = 256; asm volatile("" : "+s"(k256));
            pg8::Gemm g2{(const bf16*)(ws + WS_PB), (const bf16*)(ws + WS_WPLE), M, D, k256}; pg8::StaticOrder S2; S2.init(M, D, gi, ci);
            epi::StoreBf E2{(bf16*)(ws + WS_PP), D};
            pg8::gemm_phase<epi::StoreBf, pg8::StaticOrder, PG8_ALIGN, PG8_SP2>(lds + RING_OFF, g2, S2, E2, wave); } }
    }
    SEAM(10); MARK(9);
    if (IN(11)) { STAGGER(STG_P11);
        { pg8::Gemm g{(const bf16*)(ws + WS_U), (const bf16*)(ws + WS_W2), M, D, DFF}; pg8::StaticOrder S; S.init(M, D, G, (int)blockIdx.x);
          epi::ResidT<true> E{nullptr, (const bf16*)(ws + WS_H1B), (bf16*)(ws + WS_H2B), (float*)(ws + SS2_OFF)};
          pg8::gemm_phase<epi::ResidT<true>, pg8::StaticOrder, PG8_ALIGN, PG8_SP2>(lds + RING_OFF, g, S, E, wave); }
    }
    SEAM(11); MARK(10);
    if (IN(12)) { STAGGER(STG_P12);
        pg8::Gemm g{(const bf16*)(ws + WS_H2B), (const bf16*)(ws + WS_WPG), M, D, D}; pg8::StaticOrder S; S.init(M, D, G, (int)blockIdx.x);
        epi::PleGate E{(bf16*)(ws + WS_H3B), (const bf16*)(ws + WS_H2B), (const bf16*)(ws + WS_PP), (const float*)(ws + SS2_OFF), (float*)(ws + SS3_OFF)};
        pg8::gemm_phase<epi::PleGate, pg8::StaticOrder, PG8_ALIGN, PG8_SP2>(lds + RING_OFF, g, S, E, wave);
    }
    SEAM(12); MARK(11);
    if (IN(13)) final_phase(in, ws, args.out, gw, NGW, LANE);
#if defined(PROBE_T)
    MARK(12);
    if (blockIdx.x == 0 && wave == 0) { const unsigned* tm_ = (const unsigned*)(ws + WS_CTL) + 9100;
        const unsigned dx_ = __hip_atomic_load(tm_ + PROBE_T2, __ATOMIC_RELAXED, __HIP_MEMORY_SCOPE_AGENT) - __hip_atomic_load(tm_ + PROBE_T, __ATOMIC_RELAXED, __HIP_MEMORY_SCOPE_AGENT);
        const unsigned long long te_ = __builtin_amdgcn_s_memrealtime() + (unsigned long long)dx_ * 4ull; while (__builtin_amdgcn_s_memrealtime() < te_) __builtin_amdgcn_s_sleep(8); }
#endif
#if defined(PROBE_X)
    if (blockIdx.x == 0 && wave == 0) { const unsigned dx_ = __hip_atomic_load((unsigned*)(ws + WS_CTL) + 9000, __ATOMIC_RELAXED, __HIP_MEMORY_SCOPE_AGENT);
        const unsigned long long te_ = __builtin_amdgcn_s_memrealtime() + (unsigned long long)dx_ * PROBE_X; while (__builtin_amdgcn_s_memrealtime() < te_) __builtin_amdgcn_s_sleep(8); }
#endif
#undef IN
#undef SEAM
#undef LANE
#undef MARK
#undef STAGGER
}

extern "C" void kernel_launch(void* const* d_in, const int* in_sizes, int n_in, void* d_out, int out_size, void* d_ws, size_t ws_size, hipStream_t stream) {
    static int grid = 0;
    if (grid == 0) {
        if (n_in != 32 || in_sizes[0] != M * D || out_size != M * D || ws_size < WS_END) { fprintf(stderr, "kernel_launch: unexpected shapes: n_in %d in0 %d out %d ws %zu (need %zu)\n", n_in, n_in > 0 ? in_sizes[0] : -1, out_size, ws_size, (size_t)WS_END); grid = -1; return; }
        int dev = 0, cus = 0, per_cu = 0;
        if (hipGetDevice(&dev) != hipSuccess || hipDeviceGetAttribute(&cus, hipDeviceAttributeMultiprocessorCount, dev) != hipSuccess) { grid = -1; return; }
        if (hipFuncSetAttribute((const void*)hybrid_fwd, hipFuncAttributeMaxDynamicSharedMemorySize, LDS_BYTES) != hipSuccess) { fprintf(stderr, "kernel_launch: hipFuncSetAttribute failed\n"); grid = -1; return; }
        if (hipOccupancyMaxActiveBlocksPerMultiprocessor(&per_cu, (const void*)hybrid_fwd, NWAVES * 64, LDS_BYTES) != hipSuccess || per_cu < 1) fprintf(stderr, "kernel_launch: occupancy query says %d\n", per_cu);
        (void)hipGetLastError();
        grid = cus;
    }
    if (grid < 0) return;
    if (hipMemsetAsync((char*)d_ws + WS_CTL, 0, CTL_ZERO_BYTES, stream) != hipSuccess) return;
    Args a{};
    for (int i = 0; i < 32; ++i) a.in[i] = (const float*)d_in[i];
    a.out = (float*)d_out; a.ws = (unsigned char*)d_ws;
#if MK_N_LAUNCHES == 1
    a.ph_lo = 0; a.ph_hi = N_PHASES + 1;
    hipLaunchKernelGGL(hybrid_fwd, dim3(grid), dim3(NWAVES * 64), LDS_BYTES, stream, a);
#else
    for (int p = 0; p <= N_PHASES; ++p) { a.ph_lo = p; a.ph_hi = p + 1; hipLaunchKernelGGL(hybrid_fwd, dim3(grid), dim3(NWAVES * 64), LDS_BYTES, stream, a); }
#endif
}
```

```cpp
#include <hip/hip_runtime.h>
#include <cstdio>
#include <cstdint>
__device__ __forceinline__ int lane_opaque() { int l; asm volatile("v_mbcnt_lo_u32_b32 %0, -1, 0\n\tv_mbcnt_hi_u32_b32 %0, -1, %0" : "=v"(l)); return l; }

namespace pg8 {
#define PG8_LAS __attribute__((address_space(3)))
typedef unsigned short bf16_t;
typedef short bf16x8 __attribute__((ext_vector_type(8)));
typedef float f32x4 __attribute__((ext_vector_type(4)));
typedef unsigned u32x4 __attribute__((ext_vector_type(4)));
constexpr int BM = 256, BK = 64, HALF = 128, HTB = HALF * BK * 2  , STAGE_BYTES = 8 * HTB, NXCD = 8, WGM = 8;

__host__ __device__ __forceinline__ int lds_byte(int r, int c) { const int st = (r >> 4) * 2 + (c >> 5), rr = r & 15, cc = c & 31, ob = rr * 64 + cc * 2; return st * 1024 + (ob ^ (((ob >> 9) & 1) << 5)); }
__host__ __device__ __forceinline__ void stage_rc(int b, int& R, int& C) { const int st = b / 1024, sb = b % 1024, swz = sb ^ (((sb >> 9) & 1) << 5); R = (st >> 1) * 16 + swz / 64; C = (st & 1) * 32 + (swz % 64) / 2; }
__host__ __device__ __forceinline__ int perm32(int rho) { const int n = rho >> 4, i = rho & 15; return 8 * (i >> 2) + 4 * n + (i & 3); }

struct Unit { int pm, pn; };
struct Gemm { const bf16_t* A; const bf16_t* Bt; int M, N, K; };

struct StaticOrder {
    int nM, nN, nwg, G, c;
    __host__ __device__ void init(int M, int N, int G_, int c_) { nM = M / BM; nN = N / BM; nwg = nM * nN; G = G_; c = c_; }
    __host__ __device__ bool next(int i, Unit& u) const {
        const long L = (long)i * G + c; if (L >= nwg) return false;
        int wgid = (int)L; { const int q = nwg / NXCD, r = nwg % NXCD, xcd = wgid % NXCD, off = wgid / NXCD; wgid = (xcd < r ? xcd * (q + 1) : r * (q + 1) + (xcd - r) * q) + off; }
        const int nig = WGM * nN, gid = wgid / nig, fm = gid * WGM, gsz = (nM - fm) < WGM ? (nM - fm) : WGM;
        u.pm = fm + ((wgid % nig) % gsz); u.pn = (wgid % nig) / gsz; return true;
    }
    __device__ __forceinline__ void a_ready(const Unit&) const {}
    __device__ __forceinline__ void done(const Unit&) const {}
};
__device__ __forceinline__ unsigned cvt_pk_bf16(float lo, float hi) { unsigned r; asm volatile("v_cvt_pk_bf16_f32 %0, %1, %2" : "=v"(r) : "v"(lo), "v"(hi)); return r; }
template <class Epi, class Sched, bool ALIGN_EPI = false, bool SP2 = false>
__device__ __forceinline__ void gemm_phase(PG8_LAS unsigned char* lds, const Gemm g, const Sched& S, const Epi& E, const int wid) {
    const int lane = lane_opaque(), tid = wid * 64 + lane, wr = wid >> 2, wc = wid & 3, fr = lane & 15, fq = lane >> 4;
    const int K = g.K, nt = K / BK;
    unsigned voffA[2], voffB[2];
#pragma unroll
    for (int i = 0; i < 2; ++i) { int R, C; stage_rc(tid * 16 + i * 8192, R, C); const int Rb = Epi::PERM ? ((R & ~31) + perm32(R & 31)) : R;
        voffA[i] = (unsigned)(R * K + C) * 2u; voffB[i] = (unsigned)(Rb * K + C) * 2u; }
    const size_t kstep = (size_t)(BK * 2);
    const size_t hstep = (size_t)HALF * K * 2;
    const size_t tstep = 2 * hstep;
    const unsigned ldsw = (unsigned)wid * 1024u;
    const int aoff = lds_byte(wr * 64 + fr, fq * 8), boff = lds_byte(wc * 32 + fr, fq * 8);
#define PG8_SA(b, h) (((b) * 2 + (h)) * HTB)
#define PG8_SB(b, h) ((4 + (b) * 2 + (h)) * HTB)
#define PG8_STAGE(bufoff, gbase, voff) do { _Pragma("unroll") for (int _i = 0; _i < 2; ++_i) \
        __builtin_amdgcn_global_load_lds((const unsigned*)((const char*)(gbase) + (voff)[_i]), (PG8_LAS unsigned*)(lds + (bufoff) + ldsw + _i * 8192), 16, 0, 0); } while (0)
#define PG8_LDA(dst, b, h) do { _Pragma("unroll") for (int m = 0; m < 4; ++m) _Pragma("unroll") for (int k = 0; k < 2; ++k) dst[m][k] = *(const PG8_LAS bf16x8*)(lds + PG8_SA(b, h) + aoff + m * 2048 + k * 1024); } while (0)
#define PG8_LDB(dst, b, h) do { _Pragma("unroll") for (int n = 0; n < 2; ++n) _Pragma("unroll") for (int k = 0; k < 2; ++k) dst[n][k] = *(const PG8_LAS bf16x8*)(lds + PG8_SB(b, h) + boff + n * 2048 + k * 1024); } while (0)
#define PG8_MMA(ai, bj, At, Bt) do { __builtin_amdgcn_s_setprio(1); _Pragma("unroll") for (int m = 0; m < 4; ++m) _Pragma("unroll") for (int n = 0; n < 2; ++n) _Pragma("unroll") for (int k = 0; k < 2; ++k) \
        acc[ai][bj][m][n] = __builtin_amdgcn_mfma_f32_16x16x32_bf16(Bt[n][k], At[m][k], acc[ai][bj][m][n], 0, 0, 0); __builtin_amdgcn_s_setprio(0); } while (0)
#define PG8_WAIT_V(n) asm volatile("s_waitcnt vmcnt(" #n ")" ::: "memory")
#define PG8_WAIT_L(n) asm volatile("s_waitcnt lgkmcnt(" #n ")" ::: "memory")
#define PG8_BAR __builtin_amdgcn_s_barrier()
#define PG8_SCHED __builtin_amdgcn_sched_barrier(0)
    Unit cur, nxt; int ui = 0;
    if (!S.next(0, cur)) return;
    f32x4 acc[2][2][4][2];
#pragma unroll
    for (int a = 0; a < 2; ++a)
#pragma unroll
        for (int b = 0; b < 2; ++b)
#pragma unroll
            for (int m = 0; m < 4; ++m)
#pragma unroll
                for (int n = 0; n < 2; ++n) acc[a][b][m][n] = (f32x4){0.f, 0.f, 0.f, 0.f};
    bf16x8 At[4][2], B0[2][2], B1[2][2];
    const char* cA = (const char*)g.A + (size_t)cur.pm * tstep; const char* cB = (const char*)g.Bt + (size_t)cur.pn * tstep;
    S.a_ready(cur);
    if constexpr (SP2) {
        PG8_STAGE(PG8_SB(0, 0), cB, voffB); PG8_STAGE(PG8_SB(0, 1), cB + hstep, voffB); PG8_STAGE(PG8_SA(0, 0), cA, voffA); PG8_STAGE(PG8_SA(0, 1), cA + hstep, voffA);
        if (wr == 1) PG8_BAR;
        PG8_WAIT_V(2); PG8_BAR;
        PG8_STAGE(PG8_SB(1, 0), cB + kstep, voffB); PG8_STAGE(PG8_SA(1, 0), cA + kstep, voffA); PG8_STAGE(PG8_SB(1, 1), cB + hstep + kstep, voffB);
        PG8_WAIT_V(6); PG8_BAR;
    } else {
        PG8_STAGE(PG8_SB(0, 0), cB, voffB); PG8_STAGE(PG8_SA(0, 0), cA, voffA); PG8_STAGE(PG8_SB(0, 1), cB + hstep, voffB); PG8_STAGE(PG8_SA(0, 1), cA + hstep, voffA);
        if (wr == 1) PG8_BAR;
        PG8_WAIT_V(4); PG8_BAR;
        PG8_STAGE(PG8_SB(1, 0), cB + kstep, voffB); PG8_STAGE(PG8_SA(1, 0), cA + kstep, voffA); PG8_STAGE(PG8_SB(1, 1), cB + hstep + kstep, voffB);
        PG8_WAIT_V(6); PG8_BAR;
    }
    for (;;) {
        const bool has_next = S.next(ui + 1, nxt);
        const char* nA = has_next ? (const char*)g.A + (size_t)nxt.pm * tstep : cA; const char* nB = has_next ? (const char*)g.Bt + (size_t)nxt.pn * tstep : cB;
        for (int t = 0; t < nt; t += 2) {
            const bool last = (t == nt - 2);
            const char* a1 = cA + (size_t)(t + 1) * kstep;
            const char* a2 = last ? nA : cA + (size_t)(t + 2) * kstep; const char* b2 = last ? nB : cB + (size_t)(t + 2) * kstep;
            const char* a3 = a2 + kstep; const char* b3 = b2 + kstep;
            if (last && has_next) S.a_ready(nxt);
            if constexpr (SP2) {
            PG8_LDB(B0, 0, 0); PG8_LDB(B1, 0, 1); PG8_SCHED; PG8_LDA(At, 0, 0); PG8_STAGE(PG8_SA(1, 1), a1 + hstep, voffA);
            PG8_WAIT_V(8); PG8_WAIT_L(0); PG8_BAR; PG8_MMA(0, 0, At, B0); PG8_MMA(0, 1, At, B1); PG8_BAR; PG8_SCHED;
            PG8_LDA(At, 0, 1); PG8_STAGE(PG8_SB(0, 0), b2, voffB); PG8_STAGE(PG8_SB(0, 1), b2 + hstep, voffB); PG8_STAGE(PG8_SA(0, 0), a2, voffA);
            PG8_WAIT_V(8); PG8_WAIT_L(0); PG8_BAR; PG8_MMA(1, 0, At, B0); PG8_MMA(1, 1, At, B1); PG8_BAR; PG8_SCHED;
            PG8_LDB(B0, 1, 0); PG8_LDB(B1, 1, 1); PG8_SCHED; PG8_LDA(At, 1, 0); PG8_STAGE(PG8_SA(0, 1), a2 + hstep, voffA);
            PG8_WAIT_V(8); PG8_WAIT_L(0); PG8_BAR; PG8_MMA(0, 0, At, B0); PG8_MMA(0, 1, At, B1); PG8_BAR; PG8_SCHED;
            PG8_LDA(At, 1, 1); PG8_STAGE(PG8_SB(1, 0), b3, voffB); PG8_STAGE(PG8_SB(1, 1), b3 + hstep, voffB); PG8_STAGE(PG8_SA(1, 0), a3, voffA);
            PG8_WAIT_V(8); PG8_WAIT_L(0); PG8_BAR; PG8_MMA(1, 0, At, B0); PG8_MMA(1, 1, At, B1); PG8_BAR; PG8_SCHED;
            } else {
            PG8_LDB(B0, 0, 0); PG8_SCHED; PG8_LDA(At, 0, 0); PG8_STAGE(PG8_SA(1, 1), a1 + hstep, voffA);
            PG8_WAIT_L(8); PG8_BAR; PG8_WAIT_L(0); PG8_MMA(0, 0, At, B0); PG8_BAR; PG8_SCHED;
            PG8_LDB(B1, 0, 1); PG8_STAGE(PG8_SB(0, 0), b2, voffB);
            PG8_BAR; PG8_WAIT_L(0); PG8_MMA(0, 1, At, B1); PG8_BAR;
            PG8_LDA(At, 0, 1); PG8_STAGE(PG8_SA(0, 0), a2, voffA);
            PG8_BAR; PG8_WAIT_L(0); PG8_MMA(1, 0, At, B0); PG8_BAR; PG8_SCHED;
            PG8_STAGE(PG8_SB(0, 1), b2 + hstep, voffB);
            PG8_WAIT_V(6); PG8_BAR; PG8_MMA(1, 1, At, B1); PG8_BAR;
            PG8_LDB(B0, 1, 0); PG8_SCHED; PG8_LDA(At, 1, 0); PG8_STAGE(PG8_SA(0, 1), a2 + hstep, voffA);
            PG8_WAIT_L(8); PG8_BAR; PG8_WAIT_L(0); PG8_MMA(0, 0, At, B0); PG8_BAR; PG8_SCHED;
            PG8_LDB(B1, 1, 1); PG8_STAGE(PG8_SB(1, 0), b3, voffB);
            PG8_BAR; PG8_WAIT_L(0); PG8_MMA(0, 1, At, B1); PG8_BAR;
            PG8_LDA(At, 1, 1); PG8_STAGE(PG8_SA(1, 0), a3, voffA);
            PG8_BAR; PG8_WAIT_L(0); PG8_MMA(1, 0, At, B0); PG8_BAR; PG8_SCHED;
            PG8_STAGE(PG8_SB(1, 1), b3 + hstep, voffB);
            PG8_WAIT_V(6); PG8_BAR; PG8_MMA(1, 1, At, B1); PG8_BAR;
            }
        }
        if constexpr (ALIGN_EPI) { if (wr == 0) PG8_BAR; }
        if constexpr (!Epi::AFTER_DRAIN) { E(acc, cur, wr, wc, fr, fq); S.done(cur); }
        if (!has_next) break;
        if (!Epi::CHAIN || !E.keep(cur)) {
#pragma unroll
        for (int a = 0; a < 2; ++a)
#pragma unroll
            for (int b = 0; b < 2; ++b)
#pragma unroll
                for (int m = 0; m < 4; ++m)
#pragma unroll
                    for (int n = 0; n < 2; ++n) acc[a][b][m][n] = (f32x4){0.f, 0.f, 0.f, 0.f};
        }
        cur = nxt; cA = nA; cB = nB; ++ui;
        if constexpr (ALIGN_EPI) { if (wr == 1) PG8_BAR; }
    }
    PG8_WAIT_V(0);
    if constexpr (!ALIGN_EPI) { if (wr == 0) PG8_BAR; }
    PG8_BAR;
    if constexpr (Epi::AFTER_DRAIN) { E.fused(acc, cur, wr, wc, fr, fq, lds, wid, lane); S.done(cur); }
#undef PG8_SA
#undef PG8_SB
#undef PG8_STAGE
#undef PG8_LDA
#undef PG8_LDB
#undef PG8_MMA
#undef PG8_WAIT_V
#undef PG8_WAIT_L
#undef PG8_BAR
#undef PG8_SCHED
}
}

#define LAS __attribute__((address_space(3)))
#define XB_TMO      128
#define XB_XCNT(j)  (256  + 64 * (j))
#define XB_XSUB(j)  (1280 + 64 * (j))
#define XB_XGEN(j)  (2304 + 64 * (j))
#define XB_TOP      3328
#define XB_TOPGEN   3392
#define XCD_BAR_WORDS 3456
#define XB_SPIN_CAP (1u << 18)

__device__ __forceinline__ unsigned xb_ld(unsigned* p)              { return __hip_atomic_load(p, __ATOMIC_RELAXED, __HIP_MEMORY_SCOPE_AGENT); }
__device__ __forceinline__ unsigned xb_add(unsigned* p, unsigned v) { return __hip_atomic_fetch_add(p, v, __ATOMIC_RELAXED, __HIP_MEMORY_SCOPE_AGENT); }
__device__ __forceinline__ unsigned xb_xcc_id() { return (unsigned)__builtin_amdgcn_s_getreg((3 << 11) | 20) & 0xFu; }
#define XB_SPIN(cond, bar) do { unsigned _sp = 0; while (cond) { __builtin_amdgcn_s_sleep(1); \
    if ((++_sp & 255u) == 0u) { if (xb_ld(&(bar)[XB_TMO])) break; if (_sp > XB_SPIN_CAP) { atomicAdd(&(bar)[XB_TMO], 1u); break; } } } } while (0)

struct XcdBarrier {
    unsigned* bar; unsigned x;
    volatile LAS unsigned* st;
};

__device__ __forceinline__ XcdBarrier xcd_barrier_post(unsigned* bar, volatile LAS unsigned* st, const bool leader  ) {
    XcdBarrier b; b.bar = bar; b.x = xb_xcc_id(); b.st = st;
    if (leader) (void)xb_add(&bar[XB_XCNT(b.x)], 1u);
    return b;
}
__device__ __forceinline__ void xcd_barrier_complete(unsigned* bar, unsigned x, unsigned& nloc, unsigned& nx) {
    const unsigned G = gridDim.x * gridDim.y * gridDim.z;
    unsigned sum, cnt, mine, sp = 0u;
    for (;;) {
        sum = 0u; cnt = 0u; mine = 0u;
#pragma unroll
        for (unsigned j = 0; j < 16; ++j) { const unsigned c = xb_ld(&bar[XB_XCNT(j)]); sum += c; cnt += (c > 0u) ? 1u : 0u; mine = (j == x) ? c : mine; }
        if (sum == G) break;
        __builtin_amdgcn_s_sleep(1);
        if ((++sp & 255u) == 0u) { if (xb_ld(&bar[XB_TMO])) break; if (sp > XB_SPIN_CAP) { atomicAdd(&bar[XB_TMO], 1u); break; } }
    }
    nloc = mine > 0u ? mine : 1u; nx = cnt > 0u ? cnt : 1u;
}

__device__ __forceinline__ void xcd_barrier(const XcdBarrier& b, const bool leader  ) {
    asm volatile("s_waitcnt vmcnt(0)" ::: "memory");
    __syncthreads();
    if (leader) {
        unsigned* bar = b.bar;
        __builtin_amdgcn_s_waitcnt(0);
        unsigned nloc = b.st[0], nx = b.st[1];
        if (nloc == 0u) { xcd_barrier_complete(bar, b.x, nloc, nx); b.st[0] = nloc; b.st[1] = nx; }
        const unsigned old = xb_add(&bar[XB_XSUB(b.x)], 1u);
        const unsigned gen = old / nloc;
        if (old + 1u == (gen + 1u) * nloc) {
            __builtin_amdgcn_fence(__ATOMIC_RELEASE, "agent");
            asm volatile("s_waitcnt vmcnt(0)" ::: "memory");
            const unsigned og = xb_add(&bar[XB_TOP], 1u);
            const unsigned tg = og / nx;
            if (og + 1u == (tg + 1u) * nx) xb_add(&bar[XB_TOPGEN], 1u);
            else XB_SPIN(xb_ld(&bar[XB_TOPGEN]) == tg, bar);
            __builtin_amdgcn_fence(__ATOMIC_ACQUIRE, "agent");
            xb_add(&bar[XB_XGEN(b.x)], 1u);
            asm volatile("s_waitcnt vmcnt(0)" ::: "memory");
        } else {
            XB_SPIN(xb_ld(&bar[XB_XGEN(b.x)]) == gen, bar);
            __builtin_amdgcn_fence(__ATOMIC_ACQUIRE, "agent");
            asm volatile("s_waitcnt vmcnt(0)" ::: "memory");
        }
    }
    __syncthreads();
}

constexpr int BATCH = 2, SEQ = 8192, M = BATCH * SEQ, D = 4096;
constexpr int DA = 2048, KVD = 512, DIQ = 2048, HDI = 128, NHI = 16, DB = 2048, NHB = 32, HDB = 64;
constexpr int DIN = 11408, DFF = 11008, DPLE = 256, TOPK = 256;
constexpr int NCAT = 81 * 256;
constexpr int N13 = 2 * DFF;
constexpr int LORA_LD = 1024;
constexpr float RMS_EPS = 1e-6f, GN_EPS = 64e-5f;

#define GAS __attribute__((address_space(1)))
typedef unsigned short bf16;
typedef unsigned v4u __attribute__((ext_vector_type(4)));
typedef unsigned v2u __attribute__((ext_vector_type(2)));
typedef float f32x4 __attribute__((ext_vector_type(4)));
typedef float f32x16 __attribute__((ext_vector_type(16)));
typedef float f32x2 __attribute__((ext_vector_type(2)));
typedef short bf16x8 __attribute__((ext_vector_type(8)));
typedef GAS unsigned gu32;
#define RLX_AGENT __ATOMIC_RELAXED, __HIP_MEMORY_SCOPE_AGENT
#define LDS_WAIT() asm volatile("s_waitcnt lgkmcnt(0)" ::: "memory")
#define VM_WAIT() asm volatile("s_waitcnt vmcnt(0)" ::: "memory")
#define DI __device__ __forceinline__

DI unsigned f2bf(float f) { unsigned u = __builtin_bit_cast(unsigned, f); return (u + 0x7fffu + ((u >> 16) & 1u)) >> 16; }
DI unsigned pk2(float lo, float hi) { return f2bf(lo) | (f2bf(hi) << 16); }
DI float bf_lo(unsigned w) { return __builtin_bit_cast(float, w << 16); }
DI float bf_hi(unsigned w) { return __builtin_bit_cast(float, w & 0xffff0000u); }
DI float bf2f(bf16 h) { return __builtin_bit_cast(float, ((unsigned)h) << 16); }
DI float sigmoidf_(float z) { return 1.0f / (1.0f + __expf(-z)); }
DI float wave_sum(float v) {
#pragma unroll
    for (int o = 1; o < 64; o <<= 1) v += __shfl_xor(v, o);
    return v;
}

namespace epi {
using pg8::Unit; using pg8::BM; using pg8::HALF; using pg8::cvt_pk_bf16;
typedef pg8::f32x4 f4;
DI v4u pack8(const f4& a, const f4& b) { v4u w; w.x = cvt_pk_bf16(a[0], a[1]); w.y = cvt_pk_bf16(a[2], a[3]); w.z = cvt_pk_bf16(b[0], b[1]); w.w = cvt_pk_bf16(b[2], b[3]); return w; }
DI void unpack8(const v4u& w, f4& a, f4& b) { a[0] = bf_lo(w.x); a[1] = bf_hi(w.x); a[2] = bf_lo(w.y); a[3] = bf_hi(w.y); b[0] = bf_lo(w.z); b[1] = bf_hi(w.z); b[2] = bf_lo(w.w); b[3] = bf_hi(w.w); }

struct InProj {
    static constexpr bool PERM = true, AFTER_DRAIN = false, CHAIN = false;
    bf16 *q, *k, *v, *qi, *ki, *rb, *kb, *vb, *lora, *gates; float* wi;
    const float *rstd, *rcos, *rsin, *bgate;
    DI bool keep(const Unit&) const { return false; }
    DI void operator()(f4 (&acc)[2][2][4][2], const Unit& u, int wr, int wc, int fr, int fq) const {
        { const int ln_ = lane_opaque(); fr = ln_ & 15; fq = ln_ >> 4; }
        const int pn = u.pn, row0 = u.pm * BM + wr * 64 + fr;
        int kind = 0, ld, cb; bf16* dst;
        float rsv[2][4];
#pragma unroll
        for (int ai = 0; ai < 2; ++ai)
#pragma unroll
            for (int m = 0; m < 4; ++m) rsv[ai][m] = rstd[row0 + ai * HALF + m * 16];
        if (pn < 8)       { kind = 1; dst = q;  ld = DA;  cb = pn * 256; }
        else if (pn < 10) { kind = 1; dst = k;  ld = KVD; cb = (pn - 8) * 256; }
        else if (pn < 12) { dst = v;  ld = KVD; cb = (pn - 10) * 256; }
        else if (pn < 20) { kind = 1; dst = qi; ld = DIQ; cb = (pn - 12) * 256; }
        else if (pn == 20){ kind = 2; dst = ki; ld = HDI; cb = 0; }
        else if (pn < 29) { dst = rb; ld = DB; cb = (pn - 21) * 256; }
        else if (pn < 37) { dst = kb; ld = DB; cb = (pn - 29) * 256; }
        else if (pn < 45) { dst = vb; ld = DB; cb = (pn - 37) * 256; }
        else if (pn < 49) { dst = lora; ld = LORA_LD; cb = (pn - 45) * 256; }
        else              { kind = 3; dst = gates; ld = D; cb = (pn - 49) * 128; }
        if (kind == 3) {
            const int col = cb + wc * 32 + 8 * fq;
            const f4 ba0 = *(const f4*)(bgate + col), ba1 = *(const f4*)(bgate + col + 4), bb0 = *(const f4*)(bgate + D + col), bb1 = *(const f4*)(bgate + D + col + 4);
#pragma unroll
            for (int ai = 0; ai < 2; ++ai)
#pragma unroll
                for (int m = 0; m < 4; ++m) { const int row = row0 + ai * HALF + m * 16; const float rs = rsv[ai][m];
                    const f4 za0 = acc[ai][0][m][0] * rs + ba0, za1 = acc[ai][0][m][1] * rs + ba1, zb0 = acc[ai][1][m][0] * rs + bb0, zb1 = acc[ai][1][m][1] * rs + bb1;
                    f4 r0, r1, g0, g1;
#pragma unroll
                    for (int t = 0; t < 4; ++t) { const float eb0 = 1.0f + __expf(-zb0[t]), eb1 = 1.0f + __expf(-zb1[t]);
                        r0[t] = eb0 * __builtin_amdgcn_rcpf(1.0f + __expf(-za0[t])); r1[t] = eb1 * __builtin_amdgcn_rcpf(1.0f + __expf(-za1[t]));
                        g0[t] = __builtin_amdgcn_rcpf(eb0); g1[t] = __builtin_amdgcn_rcpf(eb1); }
                    *(v4u*)(dst + (size_t)row * D + col) = pack8(r0, r1); *(v4u*)(dst + (size_t)M * D + (size_t)row * D + col) = pack8(g0, g1); }
        } else if (kind == 0) {
#pragma unroll
            for (int ai = 0; ai < 2; ++ai)
#pragma unroll
                for (int m = 0; m < 4; ++m) { const int row = row0 + ai * HALF + m * 16; const float rs = rsv[ai][m];
#pragma unroll
                    for (int bj = 0; bj < 2; ++bj) *(v4u*)(dst + (size_t)row * ld + cb + bj * HALF + wc * 32 + 8 * fq) = pack8(acc[ai][bj][m][0] * rs, acc[ai][bj][m][1] * rs); }
        } else if (kind == 1 || wc < 2) {
            const int hb = cb + (wc >> 1) * 128, dd0 = (wc & 1) * 32 + 8 * fq;
#pragma unroll
            for (int ai = 0; ai < 2; ++ai)
#pragma unroll
              for (int mp = 0; mp < 2; ++mp) {
                f4 cv[2][2], sv[2][2];
#pragma unroll
                for (int mm = 0; mm < 2; ++mm) { const size_t to = (size_t)(row0 + ai * HALF + (2 * mp + mm) * 16) * 64 + dd0; cv[mm][0] = *(const f4*)(rcos + to); cv[mm][1] = *(const f4*)(rcos + to + 4); sv[mm][0] = *(const f4*)(rsin + to); sv[mm][1] = *(const f4*)(rsin + to + 4); }
                asm volatile("" ::: "memory");
#pragma unroll
                for (int mm = 0; mm < 2; ++mm) { const int m = 2 * mp + mm, row = row0 + ai * HALF + m * 16; const float rs = rsv[ai][m];
                    const f4 c0 = cv[mm][0], c1 = cv[mm][1], s0 = sv[mm][0], s1 = sv[mm][1];
                    const f4 a0 = acc[ai][0][m][0] * rs, a1 = acc[ai][0][m][1] * rs, b0 = acc[ai][1][m][0] * rs, b1 = acc[ai][1][m][1] * rs;
                    bf16* p = dst + (size_t)row * ld + hb + dd0;
                    *(v4u*)(p)      = pack8(a0 * c0 - b0 * s0, a1 * c1 - b1 * s1);
                    *(v4u*)(p + 64) = pack8(a0 * s0 + b0 * c0, a1 * s1 + b1 * c1); }
                asm volatile("" ::: "memory"); }
        } else if (wc == 2 && fq < 2) {
#pragma unroll
            for (int ai = 0; ai < 2; ++ai)
#pragma unroll
                for (int m = 0; m < 4; ++m) { const int row = row0 + ai * HALF + m * 16; const float rs = rsv[ai][m] * 0.25f;
                    *(f4*)(wi + (size_t)row * 16 + 8 * fq) = acc[ai][0][m][0] * rs; *(f4*)(wi + (size_t)row * 16 + 8 * fq + 4) = acc[ai][0][m][1] * rs; }
        }
    }
};

struct LoraUp {
    static constexpr bool PERM = true, AFTER_DRAIN = false, CHAIN = false;
    float* decay; bf16 *aout, *gout; const float *w0, *a0;
    DI bool keep(const Unit&) const { return false; }
    DI void operator()(f4 (&acc)[2][2][4][2], const Unit& u, int wr, int wc, int fr, int fq) const {
        { const int ln_ = lane_opaque(); fr = ln_ & 15; fq = ln_ >> 4; }
        const int which = u.pm >> 6, row0 = (u.pm & 63) * BM + wr * 64 + fr, col0 = (u.pn & 7) * BM + wc * 32 + 8 * fq;
        if (which == 0) {
#pragma unroll
            for (int bj = 0; bj < 2; ++bj) { const int col = col0 + bj * HALF; const f4 z0 = *(const f4*)(w0 + col), z1 = *(const f4*)(w0 + col + 4);
#pragma unroll
                for (int ai = 0; ai < 2; ++ai)
#pragma unroll
                    for (int m = 0; m < 4; ++m) { const size_t off = (size_t)(row0 + ai * HALF + m * 16) * DB + col;
                        f4 x0 = acc[ai][bj][m][0] + z0, x1 = acc[ai][bj][m][1] + z1;
#pragma unroll
                        for (int e = 0; e < 4; ++e) { x0[e] = __expf(-0.6065306597126334f * sigmoidf_(x0[e])); x1[e] = __expf(-0.6065306597126334f * sigmoidf_(x1[e])); }
                        { typedef _Float16 h2_ __attribute__((ext_vector_type(2)));
                          const h2_ q0 = {(_Float16)x0[0], (_Float16)x0[1]}, q1 = {(_Float16)x0[2], (_Float16)x0[3]}, q2 = {(_Float16)x1[0], (_Float16)x1[1]}, q3 = {(_Float16)x1[2], (_Float16)x1[3]};
                          v4u w_; w_.x = __builtin_bit_cast(unsigned, q0); w_.y = __builtin_bit_cast(unsigned, q1); w_.z = __builtin_bit_cast(unsigned, q2); w_.w = __builtin_bit_cast(unsigned, q3);
                          *(v4u*)((_Float16*)decay + off) = w_; }
                        asm volatile("" ::: "memory"); } }
        } else if (which == 1) {
#pragma unroll
            for (int bj = 0; bj < 2; ++bj) { const int col = col0 + bj * HALF; const f4 z0 = *(const f4*)(a0 + col), z1 = *(const f4*)(a0 + col + 4);
#pragma unroll
                for (int ai = 0; ai < 2; ++ai)
#pragma unroll
                    for (int m = 0; m < 4; ++m) { const size_t off = (size_t)(row0 + ai * HALF + m * 16) * DB + col;
                        f4 x0 = acc[ai][bj][m][0] + z0, x1 = acc[ai][bj][m][1] + z1;
#pragma unroll
                        for (int e = 0; e < 4; ++e) { x0[e] = sigmoidf_(x0[e]); x1[e] = sigmoidf_(x1[e]); }
                        *(v4u*)(aout + off) = pack8(x0, x1);
                        asm volatile("" ::: "memory"); } }
        } else {
#pragma unroll
            for (int bj = 0; bj < 2; ++bj)
#pragma unroll
                for (int ai = 0; ai < 2; ++ai)
#pragma unroll
                    for (int m = 0; m < 4; ++m) *(v4u*)(gout + (size_t)(row0 + ai * HALF + m * 16) * DB + col0 + bj * HALF) = pack8(acc[ai][bj][m][0], acc[ai][bj][m][1]);
        }
    }
};

struct GateMix {
    static constexpr bool PERM = true, AFTER_DRAIN = false, CHAIN = true;
    const bf16* gates; const float* bgate; bf16* mout;
    DI bool keep(const Unit& u) const { return u.pm < 64; }
    DI void operator()(f4 (&acc)[2][2][4][2], const Unit& u, int wr, int wc, int fr, int fq) const {
        { const int ln_ = lane_opaque(); fr = ln_ & 15; fq = ln_ >> 4; }
        const int which = u.pm >> 6, row0 = (u.pm & 63) * BM + wr * 64 + fr, col0 = (u.pn & 15) * BM + wc * 32 + 8 * fq;
        const bf16* gsrc = gates + (which ? (size_t)M * D : (size_t)0);
#pragma unroll
        for (int ai = 0; ai < 2; ++ai) {
            v4u gv[4][2];
#pragma unroll
            for (int m = 0; m < 4; ++m)
#pragma unroll
                for (int bj = 0; bj < 2; ++bj) gv[m][bj] = *(const v4u*)(gsrc + (size_t)(row0 + ai * HALF + m * 16) * D + col0 + bj * HALF);
            asm volatile("" ::: "memory");
#pragma unroll
            for (int m = 0; m < 4; ++m) { const int row = row0 + ai * HALF + m * 16;
#pragma unroll
                for (int bj = 0; bj < 2; ++bj) { f4 g0, g1; unpack8(gv[m][bj], g0, g1);
                    if (which == 0) { acc[ai][bj][m][0] = acc[ai][bj][m][0] * g0; acc[ai][bj][m][1] = acc[ai][bj][m][1] * g1; }
                    else *(v4u*)(mout + (size_t)row * D + col0 + bj * HALF) = pack8(acc[ai][bj][m][0] * g0, acc[ai][bj][m][1] * g1); } }
            asm volatile("" ::: "memory");
        }
    }
};

template <bool SRCB>
struct ResidT {
    static constexpr bool PERM = true, AFTER_DRAIN = false, CHAIN = false;
    const float* base; const bf16* baseb; bf16* outb; float* ss;
    DI bool keep(const Unit&) const { return false; }
    DI void operator()(f4 (&acc)[2][2][4][2], const Unit& u, int wr, int wc, int fr, int fq) const {
        { const int ln_ = lane_opaque(); fr = ln_ & 15; fq = ln_ >> 4; }
        const int row0 = u.pm * BM + wr * 64 + fr, col0 = u.pn * BM + wc * 32 + 8 * fq;
#pragma unroll
        for (int ai = 0; ai < 2; ++ai) {
            f4 b0[4][2], b1[4][2];
            if constexpr (SRCB) {
                v4u bb[4][2];
#pragma unroll
                for (int m = 0; m < 4; ++m)
#pragma unroll
                    for (int bj = 0; bj < 2; ++bj) bb[m][bj] = *(const v4u*)(baseb + (size_t)(row0 + ai * HALF + m * 16) * D + col0 + bj * HALF);
                asm volatile("" ::: "memory");
#pragma unroll
                for (int m = 0; m < 4; ++m)
#pragma unroll
                    for (int bj = 0; bj < 2; ++bj) unpack8(bb[m][bj], b0[m][bj], b1[m][bj]);
            } else {
#pragma unroll
                for (int m = 0; m < 4; ++m)
#pragma unroll
                    for (int bj = 0; bj < 2; ++bj) { const size_t off = (size_t)(row0 + ai * HALF + m * 16) * D + col0 + bj * HALF; b0[m][bj] = *(const f4*)(base + off); b1[m][bj] = *(const f4*)(base + off + 4); }
                asm volatile("" ::: "memory");
            }
#pragma unroll
            for (int m = 0; m < 4; ++m) { const int row = row0 + ai * HALF + m * 16; float s = 0.f;
#pragma unroll
                for (int bj = 0; bj < 2; ++bj) { const size_t off = (size_t)row * D + col0 + bj * HALF;
                    const f4 h0 = b0[m][bj] + acc[ai][bj][m][0], h1 = b1[m][bj] + acc[ai][bj][m][1];
                    *(v4u*)(outb + off) = pack8(h0, h1);
                    s += (h0[0] * h0[0] + h0[1] * h0[1]) + (h0[2] * h0[2] + h0[3] * h0[3]) + (h1[0] * h1[0] + h1[1] * h1[1]) + (h1[2] * h1[2] + h1[3] * h1[3]); }
                s += __shfl_xor(s, 16); s += __shfl_xor(s, 32);
                if (fq == 0) atomicAdd(ss + row, s); }
            asm volatile("" ::: "memory");
        }
    }
};

struct FfnUp {
    static constexpr bool PERM = true, AFTER_DRAIN = false, CHAIN = false;
    const float* ss; bf16* uout;
    DI bool keep(const Unit&) const { return false; }
    DI void operator()(f4 (&acc)[2][2][4][2], const Unit& u, int wr, int wc, int fr, int fq) const {
        { const int ln_ = lane_opaque(); fr = ln_ & 15; fq = ln_ >> 4; }
        const int row0 = u.pm * BM + wr * 64 + fr, col0 = u.pn * HALF + wc * 32 + 8 * fq;
        float rr[2][4];
#pragma unroll
        for (int ai = 0; ai < 2; ++ai)
#pragma unroll
            for (int m = 0; m < 4; ++m) rr[ai][m] = ss[row0 + ai * HALF + m * 16];
#pragma unroll
        for (int ai = 0; ai < 2; ++ai)
#pragma unroll
            for (int m = 0; m < 4; ++m) { const int row = row0 + ai * HALF + m * 16; const float r = __builtin_amdgcn_rsqf(rr[ai][m] * (1.0f / D) + RMS_EPS);
                f4 o0, o1;
#pragma unroll
                for (int e = 0; e < 4; ++e) { const float a0 = acc[ai][0][m][0][e] * r, a1 = acc[ai][0][m][1][e] * r;
                    o0[e] = a0 * sigmoidf_(a0) * (acc[ai][1][m][0][e] * r); o1[e] = a1 * sigmoidf_(a1) * (acc[ai][1][m][1][e] * r); }
                *(v4u*)(uout + (size_t)row * DFF + col0) = pack8(o0, o1); }
    }
};

struct StoreBf {
    static constexpr bool PERM = true, AFTER_DRAIN = false, CHAIN = false;
    bf16* o; int ld;
    DI bool keep(const Unit&) const { return false; }
    DI void operator()(f4 (&acc)[2][2][4][2], const Unit& u, int wr, int wc, int fr, int fq) const {
        { const int ln_ = lane_opaque(); fr = ln_ & 15; fq = ln_ >> 4; }
        const int row0 = u.pm * BM + wr * 64 + fr, col0 = u.pn * BM + wc * 32 + 8 * fq;
#pragma unroll
        for (int ai = 0; ai < 2; ++ai)
#pragma unroll
            for (int m = 0; m < 4; ++m)
#pragma unroll
                for (int bj = 0; bj < 2; ++bj) *(v4u*)(o + (size_t)(row0 + ai * HALF + m * 16) * ld + col0 + bj * HALF) = pack8(acc[ai][bj][m][0], acc[ai][bj][m][1]);
    }
};

struct PleGate {
    static constexpr bool PERM = true, AFTER_DRAIN = false, CHAIN = false;
    bf16* h3b; const bf16* hb; const bf16* pp; const float* ss_in; float* ss_out;
    DI bool keep(const Unit&) const { return false; }
    DI void operator()(f4 (&acc)[2][2][4][2], const Unit& u, int wr, int wc, int fr, int fq) const {
        { const int ln_ = lane_opaque(); fr = ln_ & 15; fq = ln_ >> 4; }
        const int row0 = u.pm * BM + wr * 64 + fr, col0 = u.pn * BM + wc * 32 + 8 * fq;
        float rr[2][4];
#pragma unroll
        for (int ai = 0; ai < 2; ++ai)
#pragma unroll
            for (int m = 0; m < 4; ++m) rr[ai][m] = ss_in[row0 + ai * HALF + m * 16];
#pragma unroll
        for (int ai = 0; ai < 2; ++ai)
#pragma unroll
            for (int mp = 0; mp < 2; ++mp) {
                v4u pv[2][2], hv[2][2];
#pragma unroll
                for (int mm = 0; mm < 2; ++mm)
#pragma unroll
                    for (int bj = 0; bj < 2; ++bj) { const size_t off = (size_t)(row0 + ai * HALF + (2 * mp + mm) * 16) * D + col0 + bj * HALF;
                        pv[mm][bj] = *(const v4u*)(pp + off); hv[mm][bj] = *(const v4u*)(hb + off); }
                asm volatile("" ::: "memory");
#pragma unroll
                for (int mm = 0; mm < 2; ++mm) { const int m = 2 * mp + mm, row = row0 + ai * HALF + m * 16; const float r = __builtin_amdgcn_rsqf(rr[ai][m] * (1.0f / D) + RMS_EPS); float s = 0.f;
#pragma unroll
                    for (int bj = 0; bj < 2; ++bj) { const size_t off = (size_t)row * D + col0 + bj * HALF;
                        f4 p0, p1; unpack8(pv[mm][bj], p0, p1);
                        f4 h0, h1; unpack8(hv[mm][bj], h0, h1);
#pragma unroll
                        for (int t = 0; t < 4; ++t) { h0[t] += sigmoidf_(acc[ai][bj][m][0][t] * r) * p0[t]; h1[t] += sigmoidf_(acc[ai][bj][m][1][t] * r) * p1[t]; }
                        *(v4u*)(h3b + off) = pack8(h0, h1);
                        s += (h0[0] * h0[0] + h0[1] * h0[1]) + (h0[2] * h0[2] + h0[3] * h0[3]) + (h1[0] * h1[0] + h1[1] * h1[1]) + (h1[2] * h1[2] + h1[3] * h1[3]); }
                    s += __shfl_xor(s, 16); s += __shfl_xor(s, 32);
                    if (fq == 0) atomicAdd(ss_out + row, s); }
                asm volatile("" ::: "memory");
            }
    }
};

struct Stack3Order {
    int G, c;
    DI bool next(int i, Unit& u) const { const int L = i * G + c; if (L >= 1536) return false; const int which = L >> 9, r = L & 511; u.pm = which * 64 + (r & 63); u.pn = which * 8 + (r >> 6); return true; }
    DI void a_ready(const Unit&) const {}
    DI void done(const Unit&) const {}
};
struct ChainOrder {
    pg8::StaticOrder so;
    DI bool next(int i, Unit& u) const { Unit t; if (!so.next(i >> 1, t)) return false; const int which = i & 1; u.pm = which * 64 + t.pm; u.pn = which * 16 + t.pn; return true; }
    DI void a_ready(const Unit&) const {}
    DI void done(const Unit&) const {}
};
}

constexpr size_t MiB = 1u << 20;
constexpr size_t WS_CTL = 0, CTL_ZERO_BYTES = 1 * MiB;
constexpr int CW_TMO = 0, CW_BAR = 4096, CW_ATTQ = 8192;
constexpr size_t SS1_OFF = 256 * 1024, SS2_OFF = 320 * 1024, SS3_OFF = 384 * 1024;
constexpr size_t WS_RSTDX = 1 * MiB;
constexpr size_t WS_BONUS = 2 * MiB;
constexpr size_t WS_RCOS = 4 * MiB, WS_RSIN = 8 * MiB;
constexpr size_t WS_WI = 12 * MiB;
constexpr size_t WS_PB = 13 * MiB;
constexpr size_t WS_WPAB = 24 * MiB;
constexpr size_t WS_WO = 56 * MiB, WS_WPG = 88 * MiB;
constexpr size_t WS_WPLE = 120 * MiB;
constexpr size_t WS_WL2 = 122 * MiB;
constexpr size_t WS_R1 = 126 * MiB;
constexpr size_t WS_WCAT = 126 * MiB;
constexpr size_t WS_XB = 288 * MiB;
constexpr size_t WS_SCORE = 126 * MiB;
constexpr size_t WS_IDX = 1252 * MiB;
constexpr size_t WS_DECAY = 126 * MiB;
constexpr size_t WS_AOUT = 254 * MiB;
constexpr size_t WS_ALORA = 1268 * MiB;
constexpr size_t WS_W13 = 126 * MiB;
constexpr size_t WS_W2 = 318 * MiB;
constexpr size_t WS_Q = 416 * MiB, WS_K = 480 * MiB, WS_V = 496 * MiB, WS_QI = 512 * MiB, WS_KI = 576 * MiB;
constexpr size_t WS_RB = 580 * MiB, WS_KB = 644 * MiB, WS_VB = 708 * MiB, WS_LORA = 772 * MiB, WS_GATES = 804 * MiB;
constexpr size_t WS_Y = 416 * MiB;
constexpr size_t WS_MIX = 416 * MiB;
constexpr size_t WS_H1B = 544 * MiB;
constexpr size_t WS_U = 672 * MiB;
constexpr size_t WS_H2B = 416 * MiB;
constexpr size_t WS_PP = 1060 * MiB;
constexpr size_t WS_H3B = 544 * MiB;
constexpr size_t WS_AO = 1060 * MiB;
constexpr size_t WS_GOUT = 1188 * MiB;
constexpr size_t WS_END = 1292 * MiB;

constexpr int RING_OFF = 0, RING_BYTES = 131072;
constexpr int LDS_BYTES = 163840;
constexpr int LDSCTL_OFF = LDS_BYTES - 1024, MISC_OFF = LDSCTL_OFF + 320;
constexpr int NWAVES = 8;

struct Args {
    const float* in[32]; float* out; unsigned char* ws; int ph_lo, ph_hi;
};
enum { I_X = 0, I_P, I_POS, I_NORM_MIX, I_W_IN, I_MU_RKV, I_MU_WAG, I_W0, I_W1, I_W2, I_A0, I_A1, I_A2, I_G1, I_G2, I_KK, I_KA, I_RK, I_LNW, I_LNB,
       I_WPA, I_WPB, I_WGATE, I_BGATE, I_WO, I_NORM_FFN, I_WFFN1, I_WFFN3, I_WFFN2, I_WPLEG, I_WPLE, I_NORM_FINAL };

struct TrSrc { const float* p; int ld, col0, nvalid, kvalid; const float* ksc; const float* mu; int mumode; };
DI void tr_item(const TrSrc& s, bf16* WT, int dK, int n0, int k0, LAS unsigned* T, int lane) {
    const int ng = lane & 15, kq = lane >> 4;
    f32x4 v[8][2]; f32x2 sc[8];
    const bool nok = 4 * ng < s.nvalid;
#pragma unroll
    for (int st = 0; st < 8; ++st) { const int k = k0 + 8 * st + 2 * kq;
#pragma unroll
        for (int j = 0; j < 2; ++j) v[st][j] = (nok && k + j < s.kvalid) ? __builtin_nontemporal_load((const f32x4*)(s.p + (size_t)(k + j) * s.ld + s.col0 + 4 * ng)) : (f32x4){0.f, 0.f, 0.f, 0.f};
        f32x2 c = {1.f, 1.f};
        if (s.ksc) c = *(const f32x2*)(s.ksc + k);
        if (s.mumode == 1) { const f32x2 m = *(const f32x2*)(s.mu + k); c = c * (1.0f - m); } else if (s.mumode == 2) { const f32x2 m = *(const f32x2*)(s.mu + k); c = c * m; }
        sc[st] = c; }
#pragma unroll
    for (int st = 0; st < 8; ++st) { const int kp = 4 * st + kq;
#pragma unroll
        for (int i = 0; i < 4; ++i) T[(4 * ng + i) * 32 + (kp ^ (4 * (ng & 7)))] = pk2(v[st][0][i] * sc[st][0], v[st][1][i] * sc[st][1]); }
    LDS_WAIT(); asm volatile("" ::: "memory");
#pragma unroll
    for (int j = 0; j < 8; ++j) { const int n = (lane >> 3) + 8 * j, c = lane & 7;
        __builtin_nontemporal_store(*(const LAS v4u*)(T + n * 32 + 4 * (c ^ ((n >> 2) & 7))), (v4u*)(WT + (size_t)(n0 + n) * dK + k0 + 8 * c)); }
    LDS_WAIT(); asm volatile("" ::: "memory");
}
DI TrSrc src_wcat(const float* const* in, int n0) {
    TrSrc s; s.p = in[I_W_IN]; s.ld = DIN; s.col0 = 0; s.nvalid = 64; s.kvalid = D; s.ksc = in[I_NORM_MIX]; s.mu = nullptr; s.mumode = 0;
    const int tile = n0 >> 8, p = n0 & 255, bj = p >> 7, hh = (p >> 6) & 1;
    if (tile < 8)        s.col0 = 0    + (2 * tile + hh) * 128 + 64 * bj;
    else if (tile < 10)  s.col0 = 2048 + (2 * (tile - 8) + hh) * 128 + 64 * bj;
    else if (tile < 12)  s.col0 = 2560 + (tile - 10) * 256 + p;
    else if (tile < 20)  s.col0 = 3072 + (2 * (tile - 12) + hh) * 128 + 64 * bj;
    else if (tile == 20) { if (hh == 0) s.col0 = 5120 + 64 * bj; else if (bj == 0) { s.col0 = 5248; s.nvalid = 16; } else s.nvalid = 0; }
    else if (tile < 45)  s.col0 = 5264 + (tile - 21) * 256 + p;
    else if (tile < 49)  { const int c = (tile - 45) * 256 + p;
        const int seg = c < 128 ? 0 : c < 256 ? 1 : c < 512 ? 2 : c < 640 ? 3 : c < 768 ? 4 : 5, sbeg = seg == 0 ? 0 : seg == 1 ? 128 : seg == 2 ? 256 : seg == 3 ? 512 : seg == 4 ? 640 : 768;
        const int kind = seg % 3;
        s.p = in[kind == 0 ? I_W1 : (kind == 1 ? I_A1 : I_G1)]; s.ld = kind == 2 ? 256 : 96; s.col0 = c - sbeg; s.mu = in[I_MU_WAG] + kind * D; s.mumode = seg < 3 ? 1 : 2;
        if (kind != 2) s.nvalid = (s.col0 == 0) ? 64 : 32; }
    else { s.p = in[I_WGATE]; s.ld = 2 * D; s.col0 = (p >> 7) * D + (tile - 49) * 128 + (p & 127); }
    return s;
}
DI TrSrc src_plain(const float* p, int ld, int col0, int kvalid, const float* ksc) { TrSrc s; s.p = p; s.ld = ld; s.col0 = col0; s.nvalid = 64; s.kvalid = kvalid; s.ksc = ksc; s.mu = nullptr; s.mumode = 0; return s; }

DI void convert_set_a(const float* const* in, unsigned char* ws, LAS unsigned* scr, int gw, int NGW, int lane) {
    constexpr int I0 = (NCAT / 64) * (D / 64);
    constexpr int I6 = (DB / 64) * (256 / 64);
    constexpr int NITEMS = I0 + 3 * I6;
    for (int it = gw; it < NITEMS; it += NGW) {
        int r = it;
        if (r < I0) { const int nblk = NCAT / 64, kb = r / nblk, nb = r % nblk; tr_item(src_wcat(in, 64 * nb), (bf16*)(ws + WS_WCAT), D, 64 * nb, 64 * kb, scr, lane); continue; } r -= I0;
        { const int w = r / I6; r -= w * I6; const int nblk = DB / 64, kb = r / nblk, nb = r % nblk;
          tr_item(src_plain(in[w == 0 ? I_W2 : (w == 1 ? I_A2 : I_G2)], DB, 64 * nb, w == 2 ? 256 : 96, nullptr), (bf16*)(ws + WS_WL2) + (size_t)w * DB * 256, 256, 64 * nb, 64 * kb, scr, lane); }
    }
}
constexpr int A1_I1 = (D / 64) * (DA / 64), A1_I3 = (D / 64) * (D / 64), A1_I5 = (D / 64) * (DPLE / 64), A1_NITEMS = 2 * A1_I1 + 2 * A1_I3 + A1_I5;
DI void convert_a1_item(const float* const* in, unsigned char* ws, LAS unsigned* scr, int it, int lane) {
    int r = it;
    if (r < 2 * A1_I1) { const int w = r / A1_I1; r -= w * A1_I1; const int nblk = D / 64, kb = r / nblk, nb = r % nblk;
        tr_item(src_plain(in[w ? I_WPB : I_WPA], D, 64 * nb, DA, nullptr), (bf16*)(ws + WS_WPAB) + (size_t)w * D * DA, DA, 64 * nb, 64 * kb, scr, lane); return; } r -= 2 * A1_I1;
    if (r < 2 * A1_I3) { const int w = r / A1_I3; r -= w * A1_I3; const int nblk = D / 64, kb = r / nblk, nb = r % nblk;
        tr_item(src_plain(in[w ? I_WPLEG : I_WO], D, 64 * nb, D, nullptr), (bf16*)(ws + (w ? WS_WPG : WS_WO)), D, 64 * nb, 64 * kb, scr, lane); return; } r -= 2 * A1_I3;
    { const int nblk = D / 64, kb = r / nblk, nb = r % nblk; tr_item(src_plain(in[I_WPLE], D, 64 * nb, DPLE, nullptr), (bf16*)(ws + WS_WPLE), DPLE, 64 * nb, 64 * kb, scr, lane); }
}
constexpr int W13_SPLIT = 16384, W13A_NITEMS = (W13_SPLIT / 64) * (D / 64), W13B_NB = (N13 - W13_SPLIT) / 64, W13B_NITEMS = W13B_NB * (D / 64);
constexpr size_t WS_W13B = 126 * MiB;
DI void convert_w13_item(const float* const* in, unsigned char* ws, bf16* w13a, LAS unsigned* scr, int kb, int nb, int lane) {
    const int n0 = 64 * nb, tile = n0 >> 8, p = n0 & 255;
    bf16* dst = (n0 < W13_SPLIT) ? w13a : (bf16*)(ws + WS_W13B) - (size_t)W13_SPLIT * D;
    tr_item(src_plain(in[(p >> 7) ? I_WFFN3 : I_WFFN1], DFF, tile * 128 + (p & 127), D, in[I_NORM_FFN]), dst, D, n0, 64 * kb, scr, lane);
}
constexpr int W2_NITEMS = (D / 64) * (DFF / 64);
DI void convert_w2_item(const float* const* in, unsigned char* ws, LAS unsigned* scr, int it, int lane) {
    const int nblk = D / 64, kb = it / nblk, nb = it % nblk; tr_item(src_plain(in[I_WFFN2], D, 64 * nb, DFF, nullptr), (bf16*)(ws + WS_W2), DFF, 64 * nb, 64 * kb, scr, lane);
}
DI void prologue_rows(const float* const* in, unsigned char* ws, bf16* xb  , int gw, int NGW, int lane) {
    const float* x = in[I_X]; float* rstd = (float*)(ws + WS_RSTDX);
    for (int m = gw; m < M; m += NGW) {
        const GAS f32x4* xr = (const GAS f32x4*)(x + (size_t)m * D) + lane; GAS v2u* o = (GAS v2u*)(xb + (size_t)m * D) + lane; float s = 0.f;
f32x4 xv[16];
#pragma unroll
        for (int j = 0; j < 16; ++j) xv[j] = xr[64 * j];
#pragma unroll
        for (int j = 0; j < 16; ++j) { const f32x4 v = xv[j]; s += (v.x * v.x + v.y * v.y) + (v.z * v.z + v.w * v.w); v2u w; w.x = pk2(v.x, v.y); w.y = pk2(v.z, v.w); o[64 * j] = w; }
        s = wave_sum(s);
        if (lane == 0) rstd[m] = 1.0f / sqrtf(s * (1.0f / D) + RMS_EPS);
    }
    const int* pos = (const int*)in[I_POS]; float* rc = (float*)(ws + WS_RCOS); float* rsn = (float*)(ws + WS_RSIN);
    for (int e = gw * 64 + lane; e < M * 64; e += NGW * 64) {
        const int m = e >> 6, i = e & 63; double inv = 1.0; for (int j = 0; j < i; ++j) inv *= 0.8659643233600653523;
        const double ang = (double)pos[m] * inv;
        const double qd = __builtin_rint(ang * 0.63661977236758134308); const int qi = (int)((long long)qd & 3);
        double r = __builtin_fma(-qd, 1.5707963267948965580, ang); r = __builtin_fma(-qd, 6.1232339957367658860e-17, r);
        const double r2 = r * r;
        const double sn = r * (1.0 + r2 * (-1.0 / 6 + r2 * (1.0 / 120 + r2 * (-1.0 / 5040 + r2 * (1.0 / 362880 + r2 * (-1.0 / 39916800 + r2 * (1.0 / 6227020800.0)))))));
        const double cs = 1.0 + r2 * (-0.5 + r2 * (1.0 / 24 + r2 * (-1.0 / 720 + r2 * (1.0 / 40320 + r2 * (-1.0 / 3628800 + r2 * (1.0 / 479001600.0 + r2 * (-1.0 / 87178291200.0)))))));
        const double c4 = (qi == 0) ? cs : (qi == 1) ? -sn : (qi == 2) ? -cs : sn;
        const double s4 = (qi == 0) ? sn : (qi == 1) ? cs : (qi == 2) ? -sn : -cs;
        rc[e] = (float)c4; rsn[e] = (float)s4;
    }
    const float* p = in[I_P]; bf16* pb = (bf16*)(ws + WS_PB);
    for (int e = gw * 64 + lane; e < M * DPLE / 4; e += NGW * 64) { const f32x4 v = ((const GAS f32x4*)p)[e]; v2u w; w.x = pk2(v.x, v.y); w.y = pk2(v.z, v.w); ((GAS v2u*)pb)[e] = w; }
}
DI void build_alora(unsigned char* ws, int gtid, int NT) {
    const bf16* L = (const bf16*)(ws + WS_LORA); bf16* A = (bf16*)(ws + WS_ALORA);
    for (int e = gtid; e < 3 * M * 32; e += NT) {
        const int which = e / (M * 32), r = e - which * (M * 32), m = r >> 5, j0 = (r & 31) * 8;
        f32x4 o0 = {0.f, 0.f, 0.f, 0.f}, o1 = o0;
        const int width = which == 2 ? 256 : 96, ca = which == 0 ? 0 : (which == 1 ? 128 : 256), cbb = which == 0 ? 512 : (which == 1 ? 640 : 768);
        if (j0 < width) {
            f32x4 c0, c1, p0 = {0.f, 0.f, 0.f, 0.f}, p1 = p0;
            epi::unpack8(*(const v4u*)(L + (size_t)m * LORA_LD + ca + j0), c0, c1);
            if ((m & (SEQ - 1)) != 0) epi::unpack8(*(const v4u*)(L + (size_t)(m - 1) * LORA_LD + cbb + j0), p0, p1);
            o0 = c0 + p0; o1 = c1 + p1;
            if (which == 0) {
#pragma unroll
                for (int t = 0; t < 4; ++t) { o0[t] = 1.0f - 2.0f / (__expf(2.0f * o0[t]) + 1.0f); o1[t] = 1.0f - 2.0f / (__expf(2.0f * o1[t]) + 1.0f); } }
            if (which == 2) {
#pragma unroll
                for (int t = 0; t < 4; ++t) { o0[t] = sigmoidf_(o0[t]); o1[t] = sigmoidf_(o1[t]); } }
        }
        *(v4u*)(A + ((size_t)which * M + m) * 256 + j0) = epi::pack8(o0, o1);
    }
}

constexpr int IDX_TS = 272;
constexpr int IDX_TILE_BYTES = 64 * IDX_TS;
constexpr int IDX_HIST_OFF = 2 * IDX_TILE_BYTES;

DI unsigned fkey(float f) { unsigned u = __builtin_bit_cast(unsigned, f); if (u == 0x80000000u) u = 0u; return (u & 0x80000000u) ? ~u : (u | 0x80000000u); }

DI void indexer_unit(unsigned char* ws, LAS unsigned char* lds, int b, int blk, float* scratch, int wave) {
    const int lane = lane_opaque(), tid = wave * 64 + lane;
    const bf16* qi = (const bf16*)(ws + WS_QI); const bf16* ki = (const bf16*)(ws + WS_KI); const float* wi = (const float*)(ws + WS_WI);
    const int t0 = blk * 32, mrow0 = b * SEQ + t0;
    const int r = lane & 31, kh = lane >> 5, aq = (r >> 2) & 1, ah = (r & 3) + 4 * (r >> 3);
    bf16x8 af[2][8]; f32x4 wg[2][4];
#pragma unroll
    for (int rt = 0; rt < 2; ++rt) {
        const bf16* src = qi + (size_t)(mrow0 + 4 * wave + 2 * rt + aq) * DIQ + ah * HDI + 8 * kh;
#pragma unroll
        for (int ks = 0; ks < 8; ++ks) af[rt][ks] = *(const bf16x8*)(src + 16 * ks);
        const float* wsrc = wi + (size_t)(mrow0 + 4 * wave + 2 * rt + kh) * NHI;
#pragma unroll
        for (int j = 0; j < 4; ++j) wg[rt][j] = *(const f32x4*)(wsrc + 4 * j) * 0.08838834764831845f;
    }
    const int nk = (t0 + 32 + 63) >> 6;
    const int lkey = tid >> 3, lpart = tid & 7;
    const bf16* kbase = ki + (size_t)(b * SEQ) * HDI;
    v4u st0, st1, su0, su1;
    { const v4u* g = (const v4u*)(kbase + (size_t)lkey * HDI + lpart * 16); st0 = g[0]; st1 = g[1]; }
    if (1 < nk) { const v4u* g = (const v4u*)(kbase + (size_t)(64 + lkey) * HDI + lpart * 16); su0 = g[0]; su1 = g[1]; }
    __syncthreads();
    { LAS v4u* d = (LAS v4u*)(lds + lkey * IDX_TS + lpart * 32); d[0] = st0; d[1] = st1; }
    __syncthreads();
#pragma unroll
    for (int rt = 0; rt < 2; ++rt) {
#pragma unroll
        for (int ks = 0; ks < 8; ++ks) asm volatile("; pin %0" : "+v"(af[rt][ks]));
#pragma unroll
        for (int j = 0; j < 4; ++j) asm volatile("; pin %0" : "+v"(wg[rt][j])); }
#define IDX_TILE(kt, L0, L1, W0, W1) do { \
        if ((kt) + 2 < nk) { const v4u* g = (const v4u*)(kbase + (size_t)(((kt) + 2) * 64 + lkey) * HDI + lpart * 16); L0 = g[0]; L1 = g[1]; } \
        const LAS unsigned char* tb = lds + ((kt) & 1) * IDX_TILE_BYTES; \
        _Pragma("unroll") for (int ct = 0; ct < 2; ++ct) { \
            bf16x8 bfr[8]; \
            _Pragma("unroll") for (int ks = 0; ks < 8; ++ks) bfr[ks] = *(const LAS bf16x8*)(tb + (32 * ct + r) * IDX_TS + (16 * ks + 8 * kh) * 2); \
            _Pragma("unroll") for (int rt = 0; rt < 2; ++rt) { \
                f32x16 c; \
                _Pragma("unroll") for (int j = 0; j < 16; ++j) c[j] = 0.f; \
                _Pragma("unroll") for (int ks = 0; ks < 8; ++ks) c = __builtin_amdgcn_mfma_f32_32x32x16_bf16(af[rt][ks], bfr[ks], c, 0, 0, 0); \
                float s = 0.f; \
                _Pragma("unroll") for (int j = 0; j < 16; ++j) s += wg[rt][j >> 2][j & 3] * __builtin_amdgcn_fmed3f(c[j], 0.f, 3.0e38f);     \
                scratch[(size_t)(4 * wave + 2 * rt + kh) * SEQ + (kt) * 64 + 32 * ct + r] = s; \
            } \
        } \
        if ((kt) + 1 < nk) { LAS v4u* d = (LAS v4u*)(lds + (((kt) + 1) & 1) * IDX_TILE_BYTES + lkey * IDX_TS + lpart * 32); d[0] = W0; d[1] = W1; } \
        asm volatile("s_waitcnt lgkmcnt(0)" ::: "memory"); __builtin_amdgcn_s_barrier(); asm volatile("" ::: "memory");     \
    } while (0)
    for (int kt = 0; kt < nk; kt += 2) {
        IDX_TILE(kt, st0, st1, su0, su1);
        if (kt + 1 < nk) IDX_TILE(kt + 1, su0, su1, st0, st1);
    }
#undef IDX_TILE
}

DI void select_unit(unsigned char* ws, LAS unsigned char* lds, int b, int blk, const float* scratch, int wave) {
    unsigned short* idx = (unsigned short*)(ws + WS_IDX);
    LAS unsigned* hist = (LAS unsigned*)(lds + IDX_HIST_OFF + wave * 8192);
    for (int qq = 0; qq < 4; ++qq) {
        const int lane = lane_opaque(); const unsigned long long lt_mask = (1ull << lane) - 1ull;
        const int ql = wave * 4 + qq, t = blk * 32 + ql, n = t + 1;
        const float* sc = scratch + (size_t)ql * SEQ; unsigned short* out = idx + (size_t)(b * SEQ + t) * TOPK;
        if (n <= TOPK) { for (int e = lane; e < TOPK; e += 64) out[e] = (e < n) ? e : 0; continue; }
        const int n4 = (n + 3) >> 2;
        v4u key[32];
#pragma unroll
        for (int j = 0; j < 32; ++j) { key[j] = (v4u){0u, 0u, 0u, 0u};
            if (64 * j < n4) { const int gi = 64 * j + lane; if (gi < n4) { const f32x4 v = *(const f32x4*)(sc + 4 * gi); const int e0 = 4 * gi;
                key[j].x = fkey(v[0]); key[j].y = (e0 + 1 < n) ? fkey(v[1]) : 0u; key[j].z = (e0 + 2 < n) ? fkey(v[2]) : 0u; key[j].w = (e0 + 3 < n) ? fkey(v[3]) : 0u; } } }
        unsigned prefix = 0u, pmask = 0u; int kk = TOPK; bool simple = false;
        for (int pass = 0; pass < 4; ++pass) {
            const int shift = 24 - 8 * pass;
#pragma unroll
            for (int z = 0; z < 8; ++z) *(LAS v4u*)(hist + 4 * (lane + 64 * z)) = (v4u){0u, 0u, 0u, 0u};
            LAS unsigned* hc = hist + 256 * (lane & 7);
#pragma unroll
            for (int j = 0; j < 32; ++j) if (64 * j < n4) {
#pragma unroll
                for (int c = 0; c < 4; ++c) { const unsigned u = key[j][c]; if ((u & pmask) == prefix) __hip_atomic_fetch_add(hc + ((u >> shift) & 255u), 1u, __ATOMIC_RELAXED, __HIP_MEMORY_SCOPE_WORKGROUP); } }
            LDS_WAIT(); asm volatile("" ::: "memory");
            v4u hs = {0u, 0u, 0u, 0u};
#pragma unroll
            for (int z = 0; z < 8; ++z) hs += *(const LAS v4u*)(hist + 256 * z + 4 * lane);
            const int c0 = (int)hs.x, c1 = (int)hs.y, c2 = (int)hs.z, c3 = (int)hs.w;
            const int T = c0 + c1 + c2 + c3; int S = T;
#pragma unroll
            for (int o = 1; o < 64; o <<= 1) { const int v = __shfl_down(S, o); if (lane + o < 64) S += v; }
            const int E = S - T;
            const bool found = (E < kk) && (kk <= S);
            int d = 0, knew = 0, cd = 0;
            if (found) { int run = E;
                if (run + c3 >= kk) { d = 4 * lane + 3; knew = kk - run; cd = c3; } else { run += c3;
                if (run + c2 >= kk) { d = 4 * lane + 2; knew = kk - run; cd = c2; } else { run += c2;
                if (run + c1 >= kk) { d = 4 * lane + 1; knew = kk - run; cd = c1; } else { run += c1; d = 4 * lane; knew = kk - run; cd = c0; } } } }
            const unsigned long long fm = __ballot(found); const int src = fm ? (int)__builtin_ctzll(fm) : 0;
            d = __shfl(d, src); knew = __shfl(knew, src); cd = __shfl(cd, src);
            prefix |= ((unsigned)d) << shift; pmask |= 0xffu << shift; kk = knew;
            asm volatile("" ::: "memory");
            if (kk == cd) { simple = true; break; }
        }
        if (simple) {
            int pos = 0;
#pragma unroll
            for (int j = 0; j < 32; ++j) if (64 * j < n4) {
                bool take[4]; unsigned long long tm[4]; int slot = pos;
#pragma unroll
                for (int c = 0; c < 4; ++c) { take[c] = (key[j][c] & pmask) >= prefix; tm[c] = __ballot(take[c]); slot += __builtin_popcountll(tm[c] & lt_mask); }
#pragma unroll
                for (int c = 0; c < 4; ++c) { if (take[c]) { if (slot < TOPK) out[slot] = 256 * j + 4 * lane + c; ++slot; } }
#pragma unroll
                for (int c = 0; c < 4; ++c) pos += __builtin_popcountll(tm[c]);
            }
        } else {
        int pos = 0, eqt = 0;
#pragma unroll
        for (int j = 0; j < 32; ++j) if (64 * j < n4) {
            bool eq[4], gt[4]; unsigned long long em[4]; int eq_before = eqt;
#pragma unroll
            for (int c = 0; c < 4; ++c) { const unsigned u = key[j][c] & pmask; eq[c] = (u == prefix); gt[c] = (u > prefix); em[c] = __ballot(eq[c]); eq_before += __builtin_popcountll(em[c] & lt_mask); }
            bool take[4]; unsigned long long tm[4]; int tk_before = pos, run_eq = eq_before;
#pragma unroll
            for (int c = 0; c < 4; ++c) { take[c] = gt[c] || (eq[c] && run_eq < kk); run_eq += eq[c] ? 1 : 0; tm[c] = __ballot(take[c]); tk_before += __builtin_popcountll(tm[c] & lt_mask); }
            int slot = tk_before;
#pragma unroll
            for (int c = 0; c < 4; ++c) { if (take[c]) { if (slot < TOPK) out[slot] = 256 * j + 4 * lane + c; ++slot; } }
#pragma unroll
            for (int c = 0; c < 4; ++c) { pos += __builtin_popcountll(tm[c]); eqt += __builtin_popcountll(em[c]); }
        }
        }
    }
}

DI void indexer_phase(unsigned char* ws, LAS unsigned char* lds, int wave) {
    float* scratch = (float*)(ws + WS_SCORE) + (size_t)blockIdx.x * 32 * SEQ;
    for (int pr = blockIdx.x; pr < 256; pr += gridDim.x) {
        const int b = pr >> 7, j = pr & 127;
        for (int half = 0; half < 2; ++half) { const int blk = half ? 255 - j : j;
#ifndef REP_IDX
#define REP_IDX 1
#endif
            for (int ri_ = 0; ri_ < REP_IDX; ++ri_) indexer_unit(ws, lds, b, blk, scratch, wave);
            VM_WAIT(); __syncthreads();
#ifndef REP_SEL
#define REP_SEL 1
#endif
            for (int rs_ = 0; rs_ < REP_SEL; ++rs_) select_unit(ws, lds, b, blk, scratch, wave);
            VM_WAIT(); __syncthreads(); }
    }
}

typedef int v4i __attribute__((ext_vector_type(4)));
typedef int v2i __attribute__((ext_vector_type(2)));
#define ATT_FENCE() asm volatile("" ::: "memory")
DI void attn_worker(unsigned char* ws, LAS unsigned char* lds, LAS unsigned* qctr, int wave) {
    const int lane = lane_opaque();
    const bf16* q = (const bf16*)(ws + WS_Q); const bf16* kbuf = (const bf16*)(ws + WS_K); const bf16* vbuf = (const bf16*)(ws + WS_V);
    const unsigned short* idx = (const unsigned short*)(ws + WS_IDX); bf16* ao = (bf16*)(ws + WS_AO);
    LAS int* idl = (LAS int*)(lds); LAS int* idl2 = (LAS int*)(lds + 1024); LAS float* pl = (LAS float*)(lds + 2048);
    LAS unsigned char* stg = lds + 6144;
    const int G = gridDim.x, bg = blockIdx.x & 7, b = bg >> 2, g = bg & 3;
    unsigned* gq = (unsigned*)(ws + WS_CTL) + CW_ATTQ + 64 * bg;
    (void)G;
    const int kr = lane & 15, kq = lane >> 4;
    const int kg = lane >> 4, dg = lane & 15;
    const int rg = lane >> 4, cc = lane & 15;
    const bf16* kvb = kbuf + (size_t)(b * SEQ) * KVD + g * 128 + 8 * cc;
    int woff[4], roff[4];
#pragma unroll
    for (int i = 0; i < 4; ++i) { const int row = 4 * i + rg; woff[i] = row * 256 + ((cc ^ row) & 15) * 16; roff[i] = cc * 256 + (((4 * i + rg) ^ cc) & 15) * 16; }
    unsigned vwb[2], vtb[2][2];
    { const int q4 = (lane & 15) >> 2, p4 = lane & 3;
#pragma unroll
      for (int h2 = 0; h2 < 2; ++h2) { vwb[h2] = (unsigned)(size_t)stg + 2048 * rg + 512 * (cc >> 2) + 16 * ((cc & 3) ^ ((2 * rg + h2) & 3));
#pragma unroll
        for (int par = 0; par < 2; ++par) vtb[h2][par] = (unsigned)(size_t)stg + 2048 * rg + 64 * (4 * h2 + q4) + 16 * ((2 * par + (p4 >> 1)) ^ ((2 * rg + h2) & 3)) + 8 * (p4 & 1); } }
    const bf16* vbase = vbuf + (size_t)(b * SEQ) * KVD + g * 128 + 8 * dg;
    int qn; { unsigned v_ = 0u; if (lane == 0) v_ = __hip_atomic_fetch_add(gq, 1u, __ATOMIC_RELAXED, __HIP_MEMORY_SCOPE_AGENT); qn = __builtin_amdgcn_readfirstlane((int)v_); }
    int ixg[4]; bf16x8 qf[4];
    if (qn < SEQ) { const int mq = b * SEQ + qn;
#pragma unroll
        for (int c = 0; c < 4; ++c) ixg[c] = (int)__builtin_nontemporal_load(idx + (size_t)mq * TOPK + lane + 64 * c);
#pragma unroll
        for (int ks = 0; ks < 4; ++ks) { if (kr < 4) qf[ks] = *(const bf16x8*)(q + (size_t)mq * DA + (4 * g + kr) * 128 + 32 * ks + 8 * kq); else qf[ks] = (bf16x8){0, 0, 0, 0, 0, 0, 0, 0}; } }
    while (qn < SEQ) {
        const int t = qn, mq = b * SEQ + t, nvalid = (t + 1 < TOPK) ? t + 1 : TOPK;
#pragma unroll
        for (int c = 0; c < 4; ++c) { idl[lane + 64 * c] = ixg[c]; idl2[(lane & 3) * 64 + 16 * c + (lane >> 2)] = ixg[c]; }
        LDS_WAIT(); ATT_FENCE();
        int qn2; { unsigned v_ = 0u; if (lane == 0) v_ = __hip_atomic_fetch_add(gq, 1u, __ATOMIC_RELAXED, __HIP_MEMORY_SCOPE_AGENT); qn2 = __builtin_amdgcn_readfirstlane((int)v_); }
#if defined(PROBE_T)
        if (bg == 0 && lane == 0) { if (qn2 == SEQ / 2) __hip_atomic_store((unsigned*)(ws + WS_CTL) + 9100 + 24, (unsigned)__builtin_amdgcn_s_memrealtime(), __ATOMIC_RELAXED, __HIP_MEMORY_SCOPE_AGENT);
                                    if (qn2 == SEQ - 1) __hip_atomic_store((unsigned*)(ws + WS_CTL) + 9100 + 25, (unsigned)__builtin_amdgcn_s_memrealtime(), __ATOMIC_RELAXED, __HIP_MEMORY_SCOPE_AGENT);
                                    if (qn2 == 512) __hip_atomic_store((unsigned*)(ws + WS_CTL) + 9100 + 23, (unsigned)__builtin_amdgcn_s_memrealtime(), __ATOMIC_RELAXED, __HIP_MEMORY_SCOPE_AGENT); }
#endif
        if (qn2 < SEQ) { const int mq2 = b * SEQ + qn2;
#pragma unroll
            for (int c = 0; c < 4; ++c) ixg[c] = (int)__builtin_nontemporal_load(idx + (size_t)mq2 * TOPK + lane + 64 * c); }
        ATT_FENCE();
        f32x4 s[16]; v4u kf[3][2][4];
#define ATT_KISSUE(slot_, hg_) do { v2i kx_[4]; \
            _Pragma("unroll") for (int i = 0; i < 4; ++i) kx_[i] = *(const LAS v2i*)(idl2 + rg * 64 + 16 * i + 2 * (hg_)); \
            _Pragma("unroll") for (int j = 0; j < 2; ++j) _Pragma("unroll") for (int i = 0; i < 4; ++i) kf[slot_][j][i] = *(const v4u*)(kvb + (size_t)kx_[i][j] * KVD); \
            ATT_FENCE(); } while (0)
        ATT_KISSUE(0, 0); ATT_KISSUE(1, 1);
#pragma unroll
        for (int hg = 0; hg < 8; ++hg) {
            if (hg + 2 < 8) ATT_KISSUE((hg + 2) % 3, hg + 2);
#pragma unroll
            for (int j = 0; j < 2; ++j) {
#pragma unroll
                for (int i = 0; i < 4; ++i) *(LAS v4u*)(stg + j * 4096 + woff[i]) = kf[hg % 3][j][i];
                bf16x8 ka[4];
#pragma unroll
                for (int ks = 0; ks < 4; ++ks) ka[ks] = *(const LAS bf16x8*)(stg + j * 4096 + roff[ks]);
                f32x4 a = {0.f, 0.f, 0.f, 0.f};
#pragma unroll
                for (int ks = 0; ks < 4; ++ks) a = __builtin_amdgcn_mfma_f32_16x16x32_bf16(ka[ks], qf[ks], a, 0, 0, 0);
                s[2 * hg + j] = a; }
        }
#undef ATT_KISSUE
        if (qn2 < SEQ && kr < 4) { const int mq2 = b * SEQ + qn2;
#pragma unroll
            for (int ks = 0; ks < 4; ++ks) qf[ks] = *(const bf16x8*)(q + (size_t)mq2 * DA + (4 * g + kr) * 128 + 32 * ks + 8 * kq); }
        ATT_FENCE();
        v4i ix[3][2]; v4u vv[3][8];
#pragma unroll
        for (int ch = 0; ch < 2; ++ch) {
            ix[ch][0] = *(const LAS v4i*)(idl + 64 * kg + 8 * ch); ix[ch][1] = *(const LAS v4i*)(idl + 64 * kg + 8 * ch + 4);
#pragma unroll
            for (int j = 0; j < 8; ++j) vv[ch][j] = *(const v4u*)(vbase + (size_t)ix[ch][j >> 2][j & 3] * KVD);
            ATT_FENCE(); }
        float mx = -3.0e38f;
#pragma unroll
        for (int kt = 0; kt < 16; ++kt)
#pragma unroll
            for (int e = 0; e < 4; ++e) { const bool ok = (64 * kq + 4 * kt + e) < nvalid; s[kt][e] = ok ? s[kt][e] * 0.08838834764831845f : -3.0e38f; mx = fmaxf(mx, s[kt][e]); }
        mx = fmaxf(mx, __shfl_xor(mx, 16)); mx = fmaxf(mx, __shfl_xor(mx, 32));
        float sum = 0.f;
#pragma unroll
        for (int kt = 0; kt < 16; ++kt)
#pragma unroll
            for (int e = 0; e < 4; ++e) { const bool ok = (64 * kq + 4 * kt + e) < nvalid; const float p = ok ? __expf(s[kt][e] - mx) : 0.f; s[kt][e] = p; sum += p; }
        sum += __shfl_xor(sum, 16); sum += __shfl_xor(sum, 32);
        const float inv = 1.0f / sum;
        bf16x8 pa[8];
#pragma unroll
        for (int sg = 0; sg < 8; ++sg) pa[sg] = __builtin_bit_cast(bf16x8, epi::pack8(s[2 * sg] * inv, s[2 * sg + 1] * inv));
        f32x4 acc[8];
#pragma unroll
        for (int nt = 0; nt < 8; ++nt) acc[nt] = (f32x4){0.f, 0.f, 0.f, 0.f};
#pragma unroll
        for (int ch = 0; ch < 8; ++ch) {
            if (ch + 2 < 8) { const int c2 = (ch + 2) % 3;
                ix[c2][0] = *(const LAS v4i*)(idl + 64 * kg + 8 * (ch + 2)); ix[c2][1] = *(const LAS v4i*)(idl + 64 * kg + 8 * (ch + 2) + 4);
#pragma unroll
                for (int j = 0; j < 8; ++j) vv[c2][j] = *(const v4u*)(vbase + (size_t)ix[c2][j >> 2][j & 3] * KVD);
                ATT_FENCE(); }
#pragma unroll
            for (int j = 0; j < 8; ++j) *(LAS v4u*)(size_t)(vwb[j >> 2] + 64 * j) = vv[ch % 3][j];
            v2u r0, r1, r2, r3, r4, r5, r6, r7, r8, r9, r10, r11, r12, r13, r14, r15;
            asm volatile("ds_read_b64_tr_b16 %0, %16\n\tds_read_b64_tr_b16 %1, %18\n\tds_read_b64_tr_b16 %2, %17\n\tds_read_b64_tr_b16 %3, %19\n\t"
                         "ds_read_b64_tr_b16 %4, %16 offset:512\n\tds_read_b64_tr_b16 %5, %18 offset:512\n\tds_read_b64_tr_b16 %6, %17 offset:512\n\tds_read_b64_tr_b16 %7, %19 offset:512\n\t"
                         "ds_read_b64_tr_b16 %8, %16 offset:1024\n\tds_read_b64_tr_b16 %9, %18 offset:1024\n\tds_read_b64_tr_b16 %10, %17 offset:1024\n\tds_read_b64_tr_b16 %11, %19 offset:1024\n\t"
                         "ds_read_b64_tr_b16 %12, %16 offset:1536\n\tds_read_b64_tr_b16 %13, %18 offset:1536\n\tds_read_b64_tr_b16 %14, %17 offset:1536\n\tds_read_b64_tr_b16 %15, %19 offset:1536\n\ts_waitcnt lgkmcnt(0)"
                         : "=&v"(r0), "=&v"(r1), "=&v"(r2), "=&v"(r3), "=&v"(r4), "=&v"(r5), "=&v"(r6), "=&v"(r7), "=&v"(r8), "=&v"(r9), "=&v"(r10), "=&v"(r11), "=&v"(r12), "=&v"(r13), "=&v"(r14), "=&v"(r15)
                         : "v"(vtb[0][0]), "v"(vtb[0][1]), "v"(vtb[1][0]), "v"(vtb[1][1]) : "memory");
#define ATT_PV(nt_, ra_, rb_) acc[nt_] = __builtin_amdgcn_mfma_f32_16x16x32_bf16(pa[ch], __builtin_bit_cast(bf16x8, (v4u){ra_.x, ra_.y, rb_.x, rb_.y}), acc[nt_], 0, 0, 0)
            ATT_PV(0, r0, r1); ATT_PV(1, r2, r3); ATT_PV(2, r4, r5); ATT_PV(3, r6, r7); ATT_PV(4, r8, r9); ATT_PV(5, r10, r11); ATT_PV(6, r12, r13); ATT_PV(7, r14, r15);
#undef ATT_PV
        }
        { LAS unsigned short* ob = (LAS unsigned short*)(lds + 2048);
          if (lane < 16) {
#pragma unroll
            for (int nt = 0; nt < 8; ++nt)
#pragma unroll
                for (int e = 0; e < 4; ++e) ob[e * 128 + 16 * nt + lane] = f2bf(acc[nt][e]); }
          LDS_WAIT(); ATT_FENCE();
          const v4u w = *(const LAS v4u*)(ob + kg * 128 + 8 * dg);
          __builtin_nontemporal_store(w, (v4u*)(ao + (size_t)mq * DA + (4 * g + kg) * 128 + 8 * dg)); }
        LDS_WAIT(); ATT_FENCE();
        qn = qn2;
    }
}

constexpr int SC_STEPS = 32, SC_PAIRS = SC_STEPS / 2;
constexpr int SC_PAIR_FLOATS = 616, SC_PAIR_BYTES = SC_PAIR_FLOATS * 4;
constexpr int SC_BUF_BYTES = SC_PAIRS * SC_PAIR_BYTES;
constexpr int PV_D1 = 0, PV_D2 = 64, PV_E1 = 128, PV_W12 = 192, PV_B1P = 256, PV_K1P = 320, PV_B2 = 384, PV_K2 = 448, PV_R2 = 512, PV_SC = 576, PV_V = 580;

template <int CTRL> DI float dpp_add(float x) { return x + __builtin_bit_cast(float, __builtin_amdgcn_update_dpp(0, __builtin_bit_cast(int, x), CTRL, 0xf, 0xf, false)); }
DI float red16(float x) { x = dpp_add<0xB1>(x); x = dpp_add<0x4E>(x); x = dpp_add<0x141>(x); x = dpp_add<0x140>(x); return x; }
DI float red8(float x) { x = dpp_add<0xB1>(x); x = dpp_add<0x4E>(x); x = dpp_add<0x141>(x); return x; }
DI float hsum4(const f32x4& p) { return (p[0] + p[1]) + (p[2] + p[3]); }

struct ScanRaw { v2u rc, rp, kc, kp, vc, vp, ac; f32x4 dc; };
struct ScanConst { f32x4 mu_r, mu_k, mu_v, kkw, kaw, rkw; };
DI f32x4 bf4(const v2u& w) { f32x4 r; r[0] = bf_lo(w.x); r[1] = bf_hi(w.x); r[2] = bf_lo(w.y); r[3] = bf_hi(w.y); return r; }

DI void scan_issue_pair(ScanRaw& R1, ScanRaw& R2, const unsigned char* ws, int b, int h, int t, int cg) {
    const bf16* rb = (const bf16*)(ws + WS_RB); const bf16* kb = (const bf16*)(ws + WS_KB); const bf16* vb = (const bf16*)(ws + WS_VB);
    const float* decay = (const float*)(ws + WS_DECAY); const bf16* av = (const bf16*)(ws + WS_AOUT);
    const size_t o = (size_t)(b * SEQ + t) * DB + h * HDB + 4 * cg;
    R1.rc = *(const v2u*)(rb + o); R1.kc = *(const v2u*)(kb + o); R1.vc = *(const v2u*)(vb + o); R1.dc = *(const f32x4*)(decay + o); R1.ac = *(const v2u*)(av + o);
    R2.rc = *(const v2u*)(rb + o + DB); R2.kc = *(const v2u*)(kb + o + DB); R2.vc = *(const v2u*)(vb + o + DB); R2.dc = *(const f32x4*)(decay + o + DB); R2.ac = *(const v2u*)(av + o + DB);
    if (t > 0) { R1.rp = *(const v2u*)(rb + o - DB); R1.kp = *(const v2u*)(kb + o - DB); R1.vp = *(const v2u*)(vb + o - DB); }
    else { R1.rp = (v2u){0u, 0u}; R1.kp = (v2u){0u, 0u}; R1.vp = (v2u){0u, 0u}; }
}
struct StepVec { f32x4 w, a, b, k, r, v; float bonus; };
DI void scan_stepvec(StepVec& o, const f32x4& rc, const f32x4& rp, const f32x4& kc, const f32x4& kp, const f32x4& vc, const f32x4& vp, const f32x4& a, const f32x4& dc, const ScanConst& C) {
    const f32x4 r1 = rc + (rp - rc) * C.mu_r, k0 = kc + (kp - kc) * C.mu_k, v1 = vc + (vp - vc) * C.mu_v;
    const f32x4 kkv = k0 * C.kkw;
    const float nrm = sqrtf(red16(hsum4(kkv * kkv)));
    const f32x4 kkn = kkv * (1.0f / fmaxf(nrm, 1e-12f));
    const f32x4 k1 = k0 * (1.0f + (a - 1.0f) * C.kaw);
    o.w = dc; o.a = -kkn; o.b = kkn * a; o.k = k1; o.r = r1; o.v = v1; o.bonus = red16(hsum4(r1 * k1 * C.rkw));
}
DI void scan_emit_pair(const ScanRaw& R1, const ScanRaw& R2, const ScanConst& C, LAS float* pb, int cg, int qr, float* bonus_dst) {
    const f32x4 rc1 = bf4(R1.rc), kc1 = bf4(R1.kc), vc1 = bf4(R1.vc);
    StepVec s1, s2;
    scan_stepvec(s1, rc1, bf4(R1.rp), kc1, bf4(R1.kp), vc1, bf4(R1.vp), bf4(R1.ac), R1.dc, C);
    scan_stepvec(s2, bf4(R2.rc), rc1, bf4(R2.kc), kc1, bf4(R2.vc), vc1, bf4(R2.ac), R2.dc, C);
    const float beta = red16(hsum4(s1.b * s2.a)), kappa = red16(hsum4(s1.k * s2.a)), betar = red16(hsum4(s1.b * s1.r)), kappar = red16(hsum4(s1.k * s1.r));
    *(LAS f32x4*)(pb + PV_D1 + 4 * cg) = s1.a; *(LAS f32x4*)(pb + PV_D2 + 4 * cg) = s1.w * s2.a; *(LAS f32x4*)(pb + PV_E1 + 4 * cg) = s1.w * s1.r;
    *(LAS f32x4*)(pb + PV_W12 + 4 * cg) = s1.w * s2.w; *(LAS f32x4*)(pb + PV_B1P + 4 * cg) = s1.b * s2.w; *(LAS f32x4*)(pb + PV_K1P + 4 * cg) = s1.k * s2.w;
    *(LAS f32x4*)(pb + PV_B2 + 4 * cg) = s2.b; *(LAS f32x4*)(pb + PV_K2 + 4 * cg) = s2.k; *(LAS f32x4*)(pb + PV_R2 + 4 * cg) = s2.r;
    if (cg == 0) *(LAS f32x4*)(pb + PV_SC) = (f32x4){beta, kappa, betar, kappar};
    if ((cg >> 2) == qr) { LAS float* vd = pb + PV_V + 8 * (cg & 3);
        *(LAS f32x4*)(vd) = (f32x4){s1.v[0], s2.v[0], s1.v[1], s2.v[1]}; *(LAS f32x4*)(vd + 4) = (f32x4){s1.v[2], s2.v[2], s1.v[3], s2.v[3]}; }
    if (bonus_dst != nullptr && cg == 0) { bonus_dst[0] = s1.bonus; bonus_dst[NHB] = s2.bonus; }
}
struct PairVec { f32x4 d1[2], d2[2], e1[2], w12[2], b1p[2], k1p[2], b2[2], k2[2], r2[2], sc; f32x2 v; };
DI void pair_ld(PairVec& P, const LAS float* pb, int cg, int vrow) {
#pragma unroll
    for (int i = 0; i < 2; ++i) { const int o = 8 * cg + 4 * i;
        P.d1[i] = *(const LAS f32x4*)(pb + PV_D1 + o); P.d2[i] = *(const LAS f32x4*)(pb + PV_D2 + o); P.e1[i] = *(const LAS f32x4*)(pb + PV_E1 + o);
        P.w12[i] = *(const LAS f32x4*)(pb + PV_W12 + o); P.b1p[i] = *(const LAS f32x4*)(pb + PV_B1P + o); P.k1p[i] = *(const LAS f32x4*)(pb + PV_K1P + o);
        P.b2[i] = *(const LAS f32x4*)(pb + PV_B2 + o); P.k2[i] = *(const LAS f32x4*)(pb + PV_K2 + o); P.r2[i] = *(const LAS f32x4*)(pb + PV_R2 + o); }
    P.sc = *(const LAS f32x4*)(pb + PV_SC); P.v = *(const LAS f32x2*)(pb + PV_V + 2 * vrow);
}
DI void pair_step(f32x4& s0, f32x4& s1, const PairVec& P, float& y1, float& y2) {
    const float d1 = red8(hsum4(s0 * P.d1[0] + s1 * P.d1[1])), d2 = red8(hsum4(s0 * P.d2[0] + s1 * P.d2[1])), e1 = red8(hsum4(s0 * P.e1[0] + s1 * P.e1[1]));
    const float v1 = P.v[0], v2 = P.v[1];
    const float sa2 = d2 + d1 * P.sc[0] + v1 * P.sc[1];
    y1 = e1 + d1 * P.sc[2] + v1 * P.sc[3];
    s0 = s0 * P.w12[0] + P.b1p[0] * d1 + P.k1p[0] * v1 + P.b2[0] * sa2 + P.k2[0] * v2;
    s1 = s1 * P.w12[1] + P.b1p[1] * d1 + P.k1p[1] * v1 + P.b2[1] * sa2 + P.k2[1] * v2;
    y2 = red8(hsum4(s0 * P.r2[0] + s1 * P.r2[1]));
}
DI void lds_signal(LAS unsigned* p, int lane) { asm volatile("s_waitcnt lgkmcnt(0)" ::: "memory"); if (lane == 0) __hip_atomic_fetch_add(p, 1u, __ATOMIC_RELAXED, __HIP_MEMORY_SCOPE_WORKGROUP); }
DI void lds_wait_ge(LAS unsigned* p, unsigned v) {
    unsigned spins = 0;
    while ((unsigned)__builtin_amdgcn_readfirstlane(__hip_atomic_load(p, __ATOMIC_RELAXED, __HIP_MEMORY_SCOPE_WORKGROUP)) < v) { __builtin_amdgcn_s_sleep(1); if (++spins > (1u << 24)) break; }
    asm volatile("" ::: "memory");
}
constexpr int SC_YW_OFF = 2 * SC_BUF_BYTES;
constexpr int SC_NSCAN = 2, SC_NLOAD = 2;

DI void scan_task(const float* const* in, unsigned char* ws, float* y, LAS unsigned char* lds, LAS unsigned* ctr, int task, int wave) {
    const int lane = lane_opaque();
    float* bonus = (float*)(ws + WS_BONUS);
#ifndef SC_REP
#define SC_REP 1
#endif
    constexpr int NCHUNK = SEQ / SC_STEPS, NCH2 = SC_REP * NCHUNK;
    const int bh = task >> 2, qr = task & 3, b = bh >> 5, h = bh & 31;
    if (wave < SC_NSCAN) {
        const int rl = lane >> 3, cg = lane & 7, vrow = 8 * wave + rl;
        f32x4 s0 = {0.f, 0.f, 0.f, 0.f}, s1 = s0;
        LAS float* yb = (LAS float*)(lds + SC_YW_OFF + wave * 1024);
        for (int c2 = 0; c2 < NCH2; ++c2) { const int c = c2 & (NCHUNK - 1); if (SC_REP > 1 && c == 0) { s0 = (f32x4){0.f, 0.f, 0.f, 0.f}; s1 = s0; }
            lds_wait_ge(ctr, (unsigned)(c2 + 1)); lds_wait_ge(ctr + 1, (unsigned)(c2 + 1));
            const LAS unsigned char* buf = lds + (c2 & 1) * SC_BUF_BYTES;
            PairVec A, B; pair_ld(A, (const LAS float*)buf, cg, vrow);
#pragma unroll 1
            for (int p = 0; p < SC_PAIRS; p += 2) {
                pair_ld(B, (const LAS float*)(buf + (p + 1) * SC_PAIR_BYTES), cg, vrow);
                float ya, yb_, yc, yd;
                pair_step(s0, s1, A, ya, yb_);
                if (p + 2 < SC_PAIRS) pair_ld(A, (const LAS float*)(buf + (p + 2) * SC_PAIR_BYTES), cg, vrow);
                pair_step(s0, s1, B, yc, yd);
                if (cg == 0) { yb[(2 * p) * 8 + rl] = ya; yb[(2 * p + 1) * 8 + rl] = yb_; yb[(2 * p + 2) * 8 + rl] = yc; yb[(2 * p + 3) * 8 + rl] = yd; }
            }
            lds_signal(ctr + 2 + wave, lane);
            { const int s = lane >> 1, hf = lane & 1, t = c * SC_STEPS + s;
              *(f32x4*)(y + (size_t)(b * SEQ + t) * DB + h * HDB + 16 * qr + 8 * wave + 4 * hf) = *(const LAS f32x4*)(yb + s * 8 + 4 * hf); }
            asm volatile("s_waitcnt lgkmcnt(0)" ::: "memory");
        }
    } else if (wave < SC_NSCAN + SC_NLOAD) {
        const int lw = wave - SC_NSCAN, pl_ = lane >> 4, cg = lane & 15, col0 = h * HDB + 4 * cg;
        ScanConst C; C.mu_r = *(const f32x4*)(in[I_MU_RKV] + col0); C.mu_k = *(const f32x4*)(in[I_MU_RKV] + DB + col0); C.mu_v = *(const f32x4*)(in[I_MU_RKV] + 2 * DB + col0);
        C.kkw = *(const f32x4*)(in[I_KK] + col0); C.kaw = *(const f32x4*)(in[I_KA] + col0); C.rkw = *(const f32x4*)(in[I_RK] + col0);
        ScanRaw R1[2], R2[2];
#pragma unroll
        for (int q = 0; q < 2; ++q) scan_issue_pair(R1[q], R2[q], ws, b, h, 2 * (4 * (lw + 2 * q) + pl_), cg);
        for (int c2 = 0; c2 < NCH2; ++c2) { const int c = c2 & (NCHUNK - 1);
            if (c2 >= 2) { lds_wait_ge(ctr + 2, (unsigned)(c2 - 1)); lds_wait_ge(ctr + 3, (unsigned)(c2 - 1)); }
            LAS float* base = (LAS float*)(lds + (c2 & 1) * SC_BUF_BYTES); const int t0 = c * SC_STEPS;
#pragma unroll
            for (int q = 0; q < 2; ++q) { const int pr = 4 * (lw + 2 * q) + pl_;
                scan_emit_pair(R1[q], R2[q], C, base + pr * SC_PAIR_FLOATS, cg, qr, qr == 0 ? bonus + (size_t)(b * SEQ + t0 + 2 * pr) * NHB + h : nullptr);
                if (c2 + 1 < NCH2) scan_issue_pair(R1[q], R2[q], ws, b, h, ((c + 1) & (NCHUNK - 1)) * SC_STEPS + 2 * pr, cg); }
            lds_signal(ctr + lw, lane);
        }
    }
}


typedef __bf16 hbf2 __attribute__((ext_vector_type(2)));
DI unsigned cvtpk2(float lo, float hi) { const f32x2 v = {lo, hi}; const hbf2 b = __builtin_convertvector(v, hbf2); return __builtin_bit_cast(unsigned, b); }
DI bf16x8 pack_acc8(const f32x16& x, const int s) { v4u w; w.x = cvtpk2(x[8 * s], x[8 * s + 1]); w.y = cvtpk2(x[8 * s + 2], x[8 * s + 3]); w.z = cvtpk2(x[8 * s + 4], x[8 * s + 5]); w.w = cvtpk2(x[8 * s + 6], x[8 * s + 7]); return __builtin_bit_cast(bf16x8, w); }
DI bf16x8 ld_perm(const LAS unsigned char* rowk0, int h) { const v2u lo = *(const LAS v2u*)(rowk0 + 8 * h), hi = *(const LAS v2u*)(rowk0 + 16 + 8 * h); const v4u w = {lo.x, lo.y, hi.x, hi.y}; return __builtin_bit_cast(bf16x8, w); }
DI bf16x8 ld_frag(const LAS unsigned char* p) { return *(const LAS bf16x8*)p; }
DI float wave_sum64(float x) { x = red16(x); const int xi = __builtin_bit_cast(int, x);
    return (__builtin_bit_cast(float, __builtin_amdgcn_readlane(xi, 0)) + __builtin_bit_cast(float, __builtin_amdgcn_readlane(xi, 16))) + (__builtin_bit_cast(float, __builtin_amdgcn_readlane(xi, 32)) + __builtin_bit_cast(float, __builtin_amdgcn_readlane(xi, 48))); }

constexpr int CK = 16, CS_NCHUNK = SEQ / CK;
constexpr int CS_RA = 0, CS_BKROW = 4608, CS_XG = 9216, CS_MM = 10496, CS_VROW = 11776, CS_PC = 14080, CS_BON = 14336, CS_SLOT = 14400;
constexpr int CS_P_RA = 144, CS_P_XG = 80;
constexpr int CS_NPREP = 5, CS_SCR_OFF = CS_NPREP * CS_SLOT;
constexpr int CS_S_LAB = 0, CS_S_LAK = 1024, CS_S_PT = 1792, CS_SCR_BYTES = 5888;
constexpr int CS_YST_OFF = CS_SCR_OFF + CS_NPREP * CS_SCR_BYTES, CS_YST_BYTES = 4096 + 64;
static_assert(CS_YST_OFF + 2 * CS_YST_BYTES <= 162816, "chunk-scan LDS map");

DI void chunk_scan(const float* const* in, unsigned char* ws, float* y, LAS unsigned char* lds, LAS unsigned* ctr  , int b, int hd, int wave) {
    const int lane = lane_opaque();
    if (wave < 2) {
        const int Ib = wave, n = lane & 31, h = lane >> 5;
        f32x16 acc0, acc1;
#pragma unroll
        for (int i = 0; i < 16; ++i) { acc0[i] = 0.f; acc1[i] = 0.f; }
        int pw = 0, nn = 0;
        for (int c = 0; c < CS_NCHUNK; ++c, ++pw) {
            if (pw == CS_NPREP) { pw = 0; ++nn; }
            lds_wait_ge(ctr + pw, (unsigned)(nn + 1));
            const LAS unsigned char* sl = lds + pw * CS_SLOT;
            const LAS unsigned char* ra = sl + CS_RA + n * CS_P_RA; const LAS unsigned char* xg = sl + CS_XG + (n & 15) * CS_P_XG; const LAS unsigned char* mm = sl + CS_MM + (n & 15) * CS_P_XG;
            bf16x8 bk00, bk01, bk10, bk11, vfrag;
            { const unsigned q4 = (lane & 15) >> 2, p4 = lane & 3, blk = (lane >> 4) & 1;
              const unsigned a_perm = (unsigned)(size_t)(sl + CS_BKROW) + (4 * h + q4) * CS_P_RA + (16 * blk + 4 * p4) * 2, a_norm = (unsigned)(size_t)(sl + CS_BKROW) + (8 * h + q4) * CS_P_RA + (16 * blk + 4 * p4) * 2, a_v = a_norm + 64 * Ib;
              v2u r0, r1, r2, r3, r4, r5, r6, r7, r8, r9;
              asm volatile("ds_read_b64_tr_b16 %0, %10\n\tds_read_b64_tr_b16 %1, %10 offset:1152\n\tds_read_b64_tr_b16 %2, %10 offset:64\n\tds_read_b64_tr_b16 %3, %10 offset:1216\n\t"
                           "ds_read_b64_tr_b16 %4, %11 offset:2304\n\tds_read_b64_tr_b16 %5, %11 offset:2880\n\tds_read_b64_tr_b16 %6, %11 offset:2368\n\tds_read_b64_tr_b16 %7, %11 offset:2944\n\t"
                           "ds_read_b64_tr_b16 %8, %12 offset:7168\n\tds_read_b64_tr_b16 %9, %12 offset:7744\n\ts_waitcnt lgkmcnt(0)"
                           : "=&v"(r0), "=&v"(r1), "=&v"(r2), "=&v"(r3), "=&v"(r4), "=&v"(r5), "=&v"(r6), "=&v"(r7), "=&v"(r8), "=&v"(r9) : "v"(a_perm), "v"(a_norm), "v"(a_v) : "memory");
              bk00 = __builtin_bit_cast(bf16x8, (v4u){r0.x, r0.y, r1.x, r1.y}); bk10 = __builtin_bit_cast(bf16x8, (v4u){r2.x, r2.y, r3.x, r3.y});
              bk01 = __builtin_bit_cast(bf16x8, (v4u){r4.x, r4.y, r5.x, r5.y}); bk11 = __builtin_bit_cast(bf16x8, (v4u){r6.x, r6.y, r7.x, r7.y});
              vfrag = __builtin_bit_cast(bf16x8, (v4u){r8.x, r8.y, r9.x, r9.y}); }
            f32x16 U;
#pragma unroll
            for (int i = 0; i < 16; ++i) U[i] = 0.f;
            U = __builtin_amdgcn_mfma_f32_32x32x16_bf16(ld_perm(ra + 0, h),  pack_acc8(acc0, 0), U, 0, 0, 0);
            U = __builtin_amdgcn_mfma_f32_32x32x16_bf16(ld_perm(ra + 32, h), pack_acc8(acc0, 1), U, 0, 0, 0);
            U = __builtin_amdgcn_mfma_f32_32x32x16_bf16(ld_perm(ra + 64, h), pack_acc8(acc1, 0), U, 0, 0, 0);
            U = __builtin_amdgcn_mfma_f32_32x32x16_bf16(ld_perm(ra + 96, h), pack_acc8(acc1, 1), U, 0, 0, 0);
            f32x16 SA;
#pragma unroll
            for (int i = 0; i < 16; ++i) SA[i] = 0.f;
            SA = __builtin_amdgcn_mfma_f32_32x32x16_bf16(ld_perm(xg, h), pack_acc8(U, 1), SA, 0, 0, 0);
            SA = __builtin_amdgcn_mfma_f32_32x32x16_bf16(ld_frag(xg + 32 + 16 * h), vfrag, SA, 0, 0, 0);
            const bf16x8 sab = pack_acc8(SA, 0);
            U = __builtin_amdgcn_mfma_f32_32x32x16_bf16(ld_perm(mm, h), sab, U, 0, 0, 0);
            U = __builtin_amdgcn_mfma_f32_32x32x16_bf16(ld_frag(mm + 32 + 16 * h), vfrag, U, 0, 0, 0);
            { acc0 = __builtin_amdgcn_mfma_f32_32x32x16_bf16(bk00, sab, acc0, 0, 0, 0);
              acc0 = __builtin_amdgcn_mfma_f32_32x32x16_bf16(bk01, vfrag, acc0, 0, 0, 0);
              acc1 = __builtin_amdgcn_mfma_f32_32x32x16_bf16(bk10, sab, acc1, 0, 0, 0);
              acc1 = __builtin_amdgcn_mfma_f32_32x32x16_bf16(bk11, vfrag, acc1, 0, 0, 0);
              const LAS float* pc = (const LAS float*)(sl + CS_PC);
#pragma unroll
              for (int g = 0; g < 4; ++g) { const f32x4 p0 = *(const LAS f32x4*)(pc + 8 * g + 4 * h), p1 = *(const LAS f32x4*)(pc + 32 + 8 * g + 4 * h);
#pragma unroll
                  for (int e = 0; e < 4; ++e) { acc0[4 * g + e] *= p0[e]; acc1[4 * g + e] *= p1[e]; } } }
            { if (c >= 2) lds_wait_ge(ctr + 10, (unsigned)(c - 1));
              LAS float* ys = (LAS float*)(lds + CS_YST_OFF + (c & 1) * CS_YST_BYTES);
#pragma unroll
              for (int rho = 0; rho < 8; ++rho) ys[((rho & 3) + 8 * (rho >> 2) + 4 * h) * 64 + 32 * Ib + n] = U[rho];
              if (Ib == 0 && lane < 16) ys[1024 + lane] = ((const LAS float*)(sl + CS_BON))[lane];
              lds_signal(ctr + (wave ? 11 : 9), lane); }
            lds_signal(ctr + 6 + wave, lane);
        }
    } else if (wave < 2 + CS_NPREP) {
        const int pw = wave - 2, j = lane, col = hd * HDB + j, st = lane >> 4, cg = lane & 15, col4 = hd * HDB + 4 * cg;
        const bf16* rb = (const bf16*)(ws + WS_RB); const bf16* kb = (const bf16*)(ws + WS_KB); const bf16* vb = (const bf16*)(ws + WS_VB);
        const _Float16* decay = (const _Float16*)(ws + WS_DECAY); const bf16* av = (const bf16*)(ws + WS_AOUT); float* bonus = (float*)(ws + WS_BONUS);
        ScanConst Cc; Cc.mu_r = *(const f32x4*)(in[I_MU_RKV] + col4); Cc.mu_k = *(const f32x4*)(in[I_MU_RKV] + DB + col4); Cc.mu_v = *(const f32x4*)(in[I_MU_RKV] + 2 * DB + col4);
        Cc.kkw = *(const f32x4*)(in[I_KK] + col4); Cc.kaw = *(const f32x4*)(in[I_KA] + col4); Cc.rkw = *(const f32x4*)(in[I_RK] + col4);
        LAS unsigned char* scr = lds + CS_SCR_OFF + pw * CS_SCR_BYTES; LAS unsigned char* sl = lds + pw * CS_SLOT;
        const int n32 = lane & 31, h = lane >> 5;
        float dcol[16]; ScanRaw R[4];
#define CS_ISSUE(cc) do { const size_t ob_ = (size_t)(b * SEQ + (cc) * CK) * DB; \
            _Pragma("unroll") for (int t_ = 0; t_ < 16; ++t_) dcol[t_] = (float)__builtin_nontemporal_load(decay + ob_ + (size_t)t_ * DB + col); \
            _Pragma("unroll") for (int p_ = 0; p_ < 4; ++p_) { const int tt_ = (cc) * CK + 4 * p_ + st; const size_t o_ = (size_t)(b * SEQ + tt_) * DB + col4; \
                R[p_].rc = __builtin_nontemporal_load((const v2u*)(rb + o_)); R[p_].kc = __builtin_nontemporal_load((const v2u*)(kb + o_)); R[p_].vc = *(const v2u*)(vb + o_); R[p_].ac = __builtin_nontemporal_load((const v2u*)(av + o_)); \
                if (tt_ > 0) { R[p_].rp = *(const v2u*)(rb + o_ - DB); R[p_].kp = *(const v2u*)(kb + o_ - DB); R[p_].vp = *(const v2u*)(vb + o_ - DB); } \
                else { R[p_].rp = (v2u){0u, 0u}; R[p_].kp = (v2u){0u, 0u}; R[p_].vp = (v2u){0u, 0u}; } } } while (0)
        CS_ISSUE(pw);
        for (int nn = 0; pw + CS_NPREP * nn < CS_NCHUNK; ++nn) {
            const int c = pw + CS_NPREP * nn, t0 = c * CK;
            { float P = 1.0f; LAS float* pt = (LAS float*)(scr + CS_S_PT);
#pragma unroll
              for (int t = 0; t < 16; ++t) { P *= dcol[t]; pt[t * 64 + j] = P; } }
            if (nn >= 1) { lds_wait_ge(ctr + 6, (unsigned)(c - CS_NPREP + 1)); lds_wait_ge(ctr + 7, (unsigned)(c - CS_NPREP + 1)); }
            LDS_WAIT(); asm volatile("" ::: "memory");
            ((LAS float*)(sl + CS_PC))[j] = ((const LAS float*)(scr + CS_S_PT))[15 * 64 + j];
            f32x4 P4v[4], Pmv[4];
#pragma unroll
            for (int p = 0; p < 4; ++p) { const int t = 4 * p + st; P4v[p] = *(const LAS f32x4*)(scr + CS_S_PT + (t * 64 + 4 * cg) * 4);
                Pmv[p] = (f32x4){1.f, 1.f, 1.f, 1.f}; if (t > 0) Pmv[p] = *(const LAS f32x4*)(scr + CS_S_PT + ((t - 1) * 64 + 4 * cg) * 4); }
#pragma unroll
            for (int p = 0; p < 4; ++p) { const int t = 4 * p + st;
                const f32x4 rc = bf4(R[p].rc), kc = bf4(R[p].kc), vc = bf4(R[p].vc), a_ = bf4(R[p].ac);
                const f32x4 r1 = rc + (bf4(R[p].rp) - rc) * Cc.mu_r, k0 = kc + (bf4(R[p].kp) - kc) * Cc.mu_k, v1 = vc + (bf4(R[p].vp) - vc) * Cc.mu_v;
                const f32x4 kkv = k0 * Cc.kkw;
                const float nrm = sqrtf(red16(hsum4(kkv * kkv)));
                const f32x4 kkn = kkv * (1.0f / fmaxf(nrm, 1e-12f));
                const f32x4 k1 = k0 * (1.0f + (a_ - 1.0f) * Cc.kaw);
                const float bc = red16(hsum4(r1 * k1 * Cc.rkw));
                if (cg == 0) ((LAS float*)(sl + CS_BON))[t] = bc;
                const f32x4 P4 = P4v[p], Pm = Pmv[p];
                f32x4 iP; iP[0] = __builtin_amdgcn_rcpf(P4[0]); iP[1] = __builtin_amdgcn_rcpf(P4[1]); iP[2] = __builtin_amdgcn_rcpf(P4[2]); iP[3] = __builtin_amdgcn_rcpf(P4[3]);
                const f32x4 Rt = r1 * P4, At = -kkn * Pm, Bt = kkn * a_ * iP, Kt = k1 * iP;
                *(LAS v2u*)(sl + CS_RA + t * CS_P_RA + 8 * cg) = (v2u){pk2(Rt[0], Rt[1]), pk2(Rt[2], Rt[3])};
                *(LAS v2u*)(sl + CS_RA + (16 + t) * CS_P_RA + 8 * cg) = (v2u){pk2(At[0], At[1]), pk2(At[2], At[3])};
                *(LAS v2u*)(sl + CS_BKROW + t * CS_P_RA + 8 * cg) = (v2u){pk2(Bt[0], Bt[1]), pk2(Bt[2], Bt[3])};
                *(LAS v2u*)(sl + CS_BKROW + (16 + t) * CS_P_RA + 8 * cg) = (v2u){pk2(Kt[0], Kt[1]), pk2(Kt[2], Kt[3])};
                *(LAS v2u*)(sl + CS_VROW + t * CS_P_RA + 8 * cg) = (v2u){pk2(v1[0], v1[1]), pk2(v1[2], v1[3])};
            }
            if (c + CS_NPREP < CS_NCHUNK) CS_ISSUE(c + CS_NPREP);
            LDS_WAIT(); asm volatile("" ::: "memory");
            f32x16 C;
#pragma unroll
            for (int i = 0; i < 16; ++i) C[i] = 0.f;
#pragma unroll
            for (int s = 0; s < 4; ++s) C = __builtin_amdgcn_mfma_f32_32x32x16_bf16(ld_frag(sl + CS_BKROW + n32 * CS_P_RA + (16 * s + 8 * h) * 2), ld_frag(sl + CS_RA + n32 * CS_P_RA + (16 * s + 8 * h) * 2), C, 0, 0, 0);
            if (n32 < 16) {
                const int t = n32; LAS unsigned char* mrow = sl + CS_MM + t * CS_P_XG;
#pragma unroll
                for (int g = 0; g < 2; ++g) { float m0[4], m1[4];
#pragma unroll
                    for (int e = 0; e < 4; ++e) { const int tau = e + 8 * g + 4 * h; m0[e] = (tau <= t) ? C[4 * g + e] : 0.f; m1[e] = (tau <= t) ? C[8 + 4 * g + e] : 0.f; }
                    *(LAS v2u*)(mrow + 16 * g + 8 * h) = (v2u){pk2(m0[0], m0[1]), pk2(m0[2], m0[3])}; *(LAS v2u*)(mrow + 32 + 16 * g + 8 * h) = (v2u){pk2(m1[0], m1[1]), pk2(m1[2], m1[3])}; }
            } else {
                const int t = n32 - 16;
#pragma unroll
                for (int g = 0; g < 2; ++g)
#pragma unroll
                    for (int e = 0; e < 4; ++e) { const int tau = e + 8 * g + 4 * h;
                        ((LAS float*)(scr + CS_S_LAB))[tau * 16 + t] = (tau < t) ? C[4 * g + e] : 0.f;
                        ((LAS bf16*)(scr + CS_S_LAK + tau * 48))[t] = (bf16)f2bf((tau < t) ? C[8 + 4 * g + e] : 0.f); }
            }
            LDS_WAIT(); asm volatile("" ::: "memory");
            float x[16]; const int tx = lane & 15;
#pragma unroll
            for (int i = 0; i < 16; ++i) x[i] = (i == tx) ? 1.0f : 0.0f;
#pragma unroll
            for (int bt = 2; bt >= 0; --bt) {
                f32x4 Lr[5][4];
#pragma unroll
                for (int r5 = 0; r5 < 5; ++r5)
#pragma unroll
                    for (int q = 0; q < 4; ++q) { const int tau = 5 * bt + r5; if (4 * q + 3 > tau) Lr[r5][q] = *(const LAS f32x4*)(scr + CS_S_LAB + tau * 64 + q * 16); else Lr[r5][q] = (f32x4){0.f, 0.f, 0.f, 0.f}; }
#pragma unroll
                for (int r5 = 4; r5 >= 0; --r5) { const int tau = 5 * bt + r5; float a2 = x[tau];
#pragma unroll
                    for (int q = 0; q < 4; ++q)
#pragma unroll
                        for (int e = 0; e < 4; ++e) { const int s2 = 4 * q + e; if (s2 > tau) a2 += Lr[r5][q][e] * x[s2]; }
                    x[tau] = a2; }
            }
            if (lane < 16) { LAS v4u* xr = (LAS v4u*)(sl + CS_XG + lane * CS_P_XG);
                xr[0] = (v4u){pk2(x[0], x[1]), pk2(x[2], x[3]), pk2(x[4], x[5]), pk2(x[6], x[7])}; xr[1] = (v4u){pk2(x[8], x[9]), pk2(x[10], x[11]), pk2(x[12], x[13]), pk2(x[14], x[15])}; }
            { v4u xb;
              xb.x = h ? pk2(x[8], x[9]) : pk2(x[0], x[1]); xb.y = h ? pk2(x[10], x[11]) : pk2(x[2], x[3]); xb.z = h ? pk2(x[12], x[13]) : pk2(x[4], x[5]); xb.w = h ? pk2(x[14], x[15]) : pk2(x[6], x[7]);
              if (n32 >= 16) xb = (v4u){0u, 0u, 0u, 0u};
              f32x16 Gm;
#pragma unroll
              for (int i = 0; i < 16; ++i) Gm[i] = 0.f;
              Gm = __builtin_amdgcn_mfma_f32_32x32x16_bf16(ld_frag(scr + CS_S_LAK + (n32 & 15) * 48 + 16 * h), __builtin_bit_cast(bf16x8, xb), Gm, 0, 0, 0);
              if (n32 < 16) { LAS unsigned char* grow = sl + CS_XG + n32 * CS_P_XG + 32;
#pragma unroll
                  for (int g = 0; g < 2; ++g) *(LAS v2u*)(grow + 16 * g + 8 * h) = (v2u){pk2(Gm[4 * g], Gm[4 * g + 1]), pk2(Gm[4 * g + 2], Gm[4 * g + 3])}; } }
            lds_signal(ctr + pw, lane);
        }
#undef CS_ISSUE
    } else if (wave == 2 + CS_NPREP) {
        const int t = lane >> 2, q = lane & 3, colq = hd * HDB + 16 * q;
        const bf16* vb = (const bf16*)(ws + WS_VB); const bf16* gout = (const bf16*)(ws + WS_GOUT); bf16* ro = (bf16*)(ws + WS_AO) + (size_t)M * DB;
        f32x4 lw[4], lb[4], muv[4];
#pragma unroll
        for (int i = 0; i < 4; ++i) { lw[i] = *(const f32x4*)(in[I_LNW] + colq + 4 * i); lb[i] = *(const f32x4*)(in[I_LNB] + colq + 4 * i); muv[i] = *(const f32x4*)(in[I_MU_RKV] + 2 * DB + colq + 4 * i); }
        v4u vcA[2], vpA[2], ggA[2], vcB[2], vpB[2], ggB[2];
#define GN_ISSUE(vcu, vpr, gg, cc) do { const int tt_ = (cc) * CK + t; const size_t o_ = (size_t)(b * SEQ + tt_) * DB + colq; \
            vcu[0] = *(const v4u*)(vb + o_); vcu[1] = *(const v4u*)(vb + o_ + 8); gg[0] = *(const v4u*)(gout + o_); gg[1] = *(const v4u*)(gout + o_ + 8); \
            if (tt_ > 0) { vpr[0] = *(const v4u*)(vb + o_ - DB); vpr[1] = *(const v4u*)(vb + o_ - DB + 8); } else { vpr[0] = (v4u){0u, 0u, 0u, 0u}; vpr[1] = (v4u){0u, 0u, 0u, 0u}; } } while (0)
#define GN_CHUNK(vcu, vpr, gg, cc) do { const int c_ = (cc); \
            lds_wait_ge(ctr + 9, (unsigned)(c_ + 1)); lds_wait_ge(ctr + 11, (unsigned)(c_ + 1)); \
            const LAS float* ys = (const LAS float*)(lds + CS_YST_OFF + (c_ & 1) * CS_YST_BYTES); \
            f32x4 yv[4]; \
            _Pragma("unroll") for (int i = 0; i < 4; ++i) yv[i] = *(const LAS f32x4*)(ys + t * 64 + 16 * q + 4 * i); \
            const float bc = ys[1024 + t]; \
            lds_signal(ctr + 10, lane); \
            float sm = (hsum4(yv[0]) + hsum4(yv[1])) + (hsum4(yv[2]) + hsum4(yv[3])); \
            sm = dpp_add<0xB1>(sm); sm = dpp_add<0x4E>(sm); \
            const float mean = sm * (1.0f / 64.0f); \
            float sq = 0.f; \
            _Pragma("unroll") for (int i = 0; i < 4; ++i) { yv[i] = yv[i] - mean; sq += hsum4(yv[i] * yv[i]); } \
            sq = dpp_add<0xB1>(sq); sq = dpp_add<0x4E>(sq); \
            const float rs = 1.0f / sqrtf(sq * (1.0f / 64.0f) + GN_EPS); \
            v4u outw[2]; \
            _Pragma("unroll") for (int i = 0; i < 4; ++i) { f32x4 vc, vp2, g4; \
                { const v4u w_ = vcu[i >> 1]; const unsigned a0 = (i & 1) ? w_.z : w_.x, a1 = (i & 1) ? w_.w : w_.y; vc = (f32x4){bf_lo(a0), bf_hi(a0), bf_lo(a1), bf_hi(a1)}; } \
                { const v4u w_ = vpr[i >> 1]; const unsigned a0 = (i & 1) ? w_.z : w_.x, a1 = (i & 1) ? w_.w : w_.y; vp2 = (f32x4){bf_lo(a0), bf_hi(a0), bf_lo(a1), bf_hi(a1)}; } \
                { const v4u w_ = gg[i >> 1]; const unsigned a0 = (i & 1) ? w_.z : w_.x, a1 = (i & 1) ? w_.w : w_.y; g4 = (f32x4){bf_lo(a0), bf_hi(a0), bf_lo(a1), bf_hi(a1)}; } \
                const f32x4 v1 = vc + (vp2 - vc) * muv[i]; \
                const f32x4 res = (yv[i] * rs * lw[i] + lb[i] + v1 * bc) * g4; \
                const unsigned p0 = pk2(res[0], res[1]), p1 = pk2(res[2], res[3]); \
                if (i == 0) { outw[0].x = p0; outw[0].y = p1; } else if (i == 1) { outw[0].z = p0; outw[0].w = p1; } else if (i == 2) { outw[1].x = p0; outw[1].y = p1; } else { outw[1].z = p0; outw[1].w = p1; } } \
            { bf16* dst = ro + (size_t)(b * SEQ + c_ * CK + t) * DB + colq; *(v4u*)dst = outw[0]; *(v4u*)(dst + 8) = outw[1]; } } while (0)
        GN_ISSUE(vcA, vpA, ggA, 0); GN_ISSUE(vcB, vpB, ggB, 1);
        for (int c = 0; c < CS_NCHUNK; c += 2) {
            GN_CHUNK(vcA, vpA, ggA, c);     if (c + 2 < CS_NCHUNK) GN_ISSUE(vcA, vpA, ggA, c + 2);
            GN_CHUNK(vcB, vpB, ggB, c + 1); if (c + 3 < CS_NCHUNK) GN_ISSUE(vcB, vpB, ggB, c + 3);
        }
#undef GN_CHUNK
#undef GN_ISSUE
    }
}

constexpr int ATT_LDS_OFF = 90112;
constexpr int ATT_LDS_OFF2 = 132096;
DI void scan_attn_phase(const float* const* in, unsigned char* ws, float* y, LAS unsigned char* lds, LAS unsigned char* lds_all, LAS unsigned* ctr, int wave) {
    const bool is_scan = ((blockIdx.x >> 3) & 3) == 0 && gridDim.x == 256; const int sb = (int)(blockIdx.x & 7) + 8 * (int)(blockIdx.x >> 5);
    __syncthreads();
    if (wave == 0 && lane_opaque() == 0) { ((LAS v4u*)ctr)[0] = (v4u){0u, 0u, 0u, 0u}; ((LAS v4u*)ctr)[1] = (v4u){0u, 0u, 0u, 0u}; ((LAS v4u*)ctr)[2] = (v4u){0u, 0u, 0u, 0u}; }
    __syncthreads();
#ifndef REP_CS
#define REP_CS 1
#endif
    if (is_scan) { for (int rep = 0; rep < REP_CS; ++rep) {
            if (rep) { if (wave == 0 && lane_opaque() == 0) { ((LAS v4u*)ctr)[0] = (v4u){0u, 0u, 0u, 0u}; ((LAS v4u*)ctr)[1] = (v4u){0u, 0u, 0u, 0u}; } __syncthreads(); }
#if defined(PROBE_X)
            const unsigned long long tp0_ = __builtin_amdgcn_s_memrealtime();
#endif
            chunk_scan(in, ws, y, lds, ctr, sb >> 5, sb & 31, wave); __syncthreads();
#if defined(PROBE_X)
            if (blockIdx.x == 0 && wave == 0 && lane_opaque() == 0) ((unsigned*)(ws + WS_CTL))[9000] = (unsigned)(__builtin_amdgcn_s_memrealtime() - tp0_);
#endif
            } }
    LAS unsigned char* mine = lds_all + wave * 16384;
    attn_worker(ws, mine, ctr + 4, wave);
    { const int lane = lane_opaque(); LAS unsigned* tile = (LAS unsigned*)mine; unsigned* cq = (unsigned*)(ws + WS_CTL) + CW_ATTQ + 64 * 8;
        bf16* w13a = (bf16*)((unsigned char*)y + (size_t)128 * MiB);
        for (;;) { unsigned v_ = 0u; if (lane == 0) v_ = __hip_atomic_fetch_add(cq, 2u, __ATOMIC_RELAXED, __HIP_MEMORY_SCOPE_AGENT);
            const int it = __builtin_amdgcn_readfirstlane((int)v_); if (it >= W2_NITEMS + W13A_NITEMS) break;
            if (it < W2_NITEMS) { convert_w2_item(in, ws, tile, it, lane); convert_w2_item(in, ws, tile, it + 1, lane); }
            else { const int i = it - W2_NITEMS; convert_w13_item(in, ws, w13a, tile, i / (W13_SPLIT / 64), i % (W13_SPLIT / 64), lane); convert_w13_item(in, ws, w13a, tile, (i + 1) / (W13_SPLIT / 64), (i + 1) % (W13_SPLIT / 64), lane); } } }
}

DI void gn_phase(const float* const* in, unsigned char* ws, const float* y, int gw, int NGW, int lane) {
    const bf16* vb = (const bf16*)(ws + WS_VB); const bf16* gout = (const bf16*)(ws + WS_GOUT);
    const float* bonus = (const float*)(ws + WS_BONUS); bf16* ro = (bf16*)(ws + WS_AO) + (size_t)M * DB;
    const int per = (M * 8 + NGW - 1) / NGW, it0 = gw * per, it1 = (it0 + per < M * 8) ? it0 + per : M * 8;
    const int hh = lane >> 4, cg = lane & 15;
#pragma unroll 2
    for (int it = it0; it < it1; ++it) {
        const int m = it >> 3, h = (it & 7) * 4 + hh, col = h * HDB + 4 * cg; const size_t o = (size_t)m * DB + col;
        const f32x4 yv = *(const f32x4*)(y + o);
        const f32x4 vc = bf4(*(const v2u*)(vb + o)), g4 = bf4(*(const v2u*)(gout + o));
        f32x4 vp = {0.f, 0.f, 0.f, 0.f}; if (m & (SEQ - 1)) vp = bf4(*(const v2u*)(vb + o - DB));
        const float bc = bonus[(size_t)m * NHB + h];
        const f32x4 lw = *(const f32x4*)(in[I_LNW] + col), lb = *(const f32x4*)(in[I_LNB] + col), muv = *(const f32x4*)(in[I_MU_RKV] + 2 * DB + col);
        const float mean = red16((yv[0] + yv[1]) + (yv[2] + yv[3])) * (1.0f / 64.0f); const f32x4 d = yv - mean;
        const float var = red16((d[0] * d[0] + d[1] * d[1]) + (d[2] * d[2] + d[3] * d[3])) * (1.0f / 64.0f);
        const f32x4 yn = d * (1.0f / sqrtf(var + GN_EPS)) * lw + lb;
        const f32x4 v1 = vc + (vp - vc) * muv;
        const f32x4 res = (yn + v1 * bc) * g4;
        v2u w; w.x = pk2(res[0], res[1]); w.y = pk2(res[2], res[3]);
        *(v2u*)(ro + o) = w;
    }
}

DI void final_phase(const float* const* in, unsigned char* ws, float* out, int gw, int NGW, int lane) {
    const float* ss3 = (const float*)(ws + SS3_OFF); const float* nf = in[I_NORM_FINAL]; const bf16* hb = (const bf16*)(ws + WS_H3B);
    for (int m = gw; m < M; m += NGW) { const float r = 1.0f / sqrtf(ss3[m] * (1.0f / D) + RMS_EPS);
        const GAS v4u* src = (const GAS v4u*)(hb + (size_t)m * D) + lane; GAS f32x4* o = (GAS f32x4*)(out + (size_t)m * D) + 2 * lane; const GAS f32x4* g = (const GAS f32x4*)nf + 2 * lane;
        v4u w[8];
#pragma unroll
        for (int j = 0; j < 8; ++j) w[j] = __builtin_nontemporal_load(src + 64 * j);
#pragma unroll
        for (int j = 0; j < 8; ++j) { f32x4 a, b; epi::unpack8(w[j], a, b); a = a * r * g[128 * j]; b = b * r * g[128 * j + 1]; __builtin_nontemporal_store(a, o + 128 * j); __builtin_nontemporal_store(b, o + 128 * j + 1); } }
}

#ifndef MK_N_LAUNCHES
#define MK_N_LAUNCHES 1
#endif
constexpr int N_PHASES = 13;
#ifndef REP_P2
#define REP_P2 1
#endif
#ifndef REP_P3
#define REP_P3 1
#endif
#ifndef REP_P6
#define REP_P6 1
#endif
#ifndef REP_P7
#define REP_P7 1
#endif
#ifndef REP_P10
#define REP_P10 1
#endif
#ifndef REP_C
#define REP_C 1
#endif
#ifndef PG8_SP2
#define PG8_SP2 true
#endif
#ifndef PG8_ALIGN
#define PG8_ALIGN true
#endif

__global__ void __launch_bounds__(NWAVES * 64, 2) hybrid_fwd(Args args) {
    extern __shared__ __attribute__((aligned(16))) unsigned char lds_raw[];
    LAS unsigned char* lds = (LAS unsigned char*)lds_raw;
    volatile LAS unsigned* MISC = (volatile LAS unsigned*)(lds + MISC_OFF);
    const int wave = __builtin_amdgcn_readfirstlane(threadIdx.x >> 6);
    const int G = gridDim.x, gw = blockIdx.x * NWAVES + wave, NGW = G * NWAVES;
    unsigned char* ws = args.ws; const float* const* in = args.in;
    { const int tid0 = wave * 64 + lane_opaque(); for (int u = tid0; u < (LDS_BYTES - LDSCTL_OFF) / 4; u += NWAVES * 64) ((LAS unsigned*)(lds + LDSCTL_OFF))[u] = 0u; }
    __syncthreads();
    unsigned* ctl = (unsigned*)(ws + WS_CTL);
    XcdBarrier bar; bar.bar = ctl + CW_BAR; bar.x = 0; bar.st = nullptr;
    const bool multi = (args.ph_hi - args.ph_lo) > 1;
    if (multi) bar = xcd_barrier_post(ctl + CW_BAR, MISC + 8, wave == 0 && lane_opaque() == 0);
    const int lo = args.ph_lo, hi = args.ph_hi;
#ifndef PHASE_MASK
#define PHASE_MASK 0x3fff
#endif
#define IN(k) ((((PHASE_MASK) >> (k)) & 1) && lo <= (k) && (k) < hi)
#define SEAM(k) do { if (IN(k) && IN((k) + 1)) xcd_barrier(bar, wave == 0 && lane_opaque() == 0); } while (0)
#define LANE lane_opaque()
#if defined(PROBE_T)
#ifndef PROBE_T2
#define PROBE_T2 (PROBE_T + 1)
#endif
#define MARK(k) do { if (blockIdx.x == 0 && wave == 0 && lane_opaque() == 0) __hip_atomic_store((unsigned*)(ws + WS_CTL) + 9100 + (k), (unsigned)__builtin_amdgcn_s_memrealtime(), __ATOMIC_RELAXED, __HIP_MEMORY_SCOPE_AGENT); } while (0)
#else
#define MARK(k) do { } while (0)
#endif
#ifndef STG_GRP
#define STG_GRP ((int)blockIdx.x & 7)
#endif
#define STAGGER(t) do { if ((t) > 0) { const unsigned long long te_ = __builtin_amdgcn_s_memrealtime() + (unsigned long long)(STG_GRP * (t)); while (__builtin_amdgcn_s_memrealtime() < te_) __builtin_amdgcn_s_sleep(4); } } while (0)
#ifndef STG_P1
#define STG_P1 0
#endif
#ifndef STG_P8
#define STG_P8 0
#endif
#ifndef STG_P9
#define STG_P9 0
#endif
#ifndef STG_P10
#define STG_P10 0
#endif
#ifndef STG_P11
#define STG_P11 0
#endif
#ifndef STG_P12
#define STG_P12 0
#endif
    LAS unsigned* scr = (LAS unsigned*)(lds + RING_OFF + wave * 16384);

    MARK(0);
    if (IN(0)) { const int lane = LANE; for (int rep = 0; rep < REP_C; ++rep) { convert_set_a(in, ws, scr, gw, NGW, lane); prologue_rows(in, ws, (bf16*)args.out, gw, NGW, lane); } }
    SEAM(0); MARK(1);
    if (IN(1)) { STAGGER(STG_P1);
        pg8::Gemm g{(const bf16*)args.out, (const bf16*)(ws + WS_WCAT), M, NCAT, D}; pg8::StaticOrder S; S.init(M, NCAT, G, (int)blockIdx.x);
        epi::InProj E{(bf16*)(ws + WS_Q), (bf16*)(ws + WS_K), (bf16*)(ws + WS_V), (bf16*)(ws + WS_QI), (bf16*)(ws + WS_KI), (bf16*)(ws + WS_RB), (bf16*)(ws + WS_KB), (bf16*)(ws + WS_VB),
                      (bf16*)(ws + WS_LORA), (bf16*)(ws + WS_GATES), (float*)(ws + WS_WI), (const float*)(ws + WS_RSTDX), (const float*)(ws + WS_RCOS), (const float*)(ws + WS_RSIN), in[I_BGATE]};
        pg8::gemm_phase<epi::InProj, pg8::StaticOrder, PG8_ALIGN, PG8_SP2>(lds + RING_OFF, g, S, E, wave);
#if defined(REP_P1)
        pg8::gemm_phase<epi::InProj, pg8::StaticOrder, PG8_ALIGN, PG8_SP2>(lds + RING_OFF, g, S, E, wave);
#endif
        { const int busy = ((M / 256) * (NCAT / 256)) % G, gi = busy ? G - busy : G, ci = busy ? (int)blockIdx.x - busy : (int)blockIdx.x;
          if (ci >= 0) { const int lane = LANE; for (int it = ci * NWAVES + wave; it < A1_NITEMS; it += gi * NWAVES) convert_a1_item(in, ws, scr, it, lane); } }
    }
    SEAM(1); MARK(2);
    if (IN(4)) build_alora(ws, blockIdx.x * (NWAVES * 64) + wave * 64 + LANE, G * NWAVES * 64);
    MARK(13);
    if (IN(2)) { for (int rep = 0; rep < REP_P2; ++rep) indexer_phase(ws, lds + RING_OFF, wave); }
    MARK(14);
    if (IN(2) && IN(5)) xcd_barrier(bar, wave == 0 && lane_opaque() == 0);
    MARK(3);
    if (IN(5)) {
        int k256 = 256; asm volatile("" : "+s"(k256));
        pg8::Gemm g{(const bf16*)(ws + WS_ALORA), (const bf16*)(ws + WS_WL2), 3 * M, 3 * DB, k256}; epi::Stack3Order S{G, (int)blockIdx.x};
        epi::LoraUp E{(float*)(ws + WS_DECAY), (bf16*)(ws + WS_AOUT), (bf16*)(ws + WS_GOUT), in[I_W0], in[I_A0]};
        pg8::gemm_phase<epi::LoraUp, epi::Stack3Order, PG8_ALIGN, PG8_SP2>(lds + RING_OFF, g, S, E, wave);
    }
    SEAM(5); MARK(4);
    if (IN(6)) { for (int rep = 0; rep < REP_P6; ++rep) scan_attn_phase(in, ws, args.out, lds + RING_OFF, lds, (LAS unsigned*)(lds + MISC_OFF + 64), wave); }
    SEAM(6); MARK(5);
    if (IN(7)) { const int lane = LANE; __syncthreads(); for (int it = gw; it < W13B_NITEMS; it += NGW) convert_w13_item(in, ws, nullptr, scr, it / W13B_NB, W13_SPLIT / 64 + it % W13B_NB, lane); }
    __syncthreads();
    MARK(6);
    if (IN(8)) { STAGGER(STG_P8);
        pg8::Gemm g{(const bf16*)(ws + WS_AO), (const bf16*)(ws + WS_WPAB), 2 * M, 2 * D, DA}; epi::ChainOrder S; S.so.init(M, D, G, (int)blockIdx.x);
        epi::GateMix E{(const bf16*)(ws + WS_GATES), in[I_BGATE], (bf16*)(ws + WS_MIX)};
        pg8::gemm_phase<epi::GateMix, epi::ChainOrder, PG8_ALIGN, PG8_SP2>(lds + RING_OFF, g, S, E, wave);
#if defined(REP_P8)
        pg8::gemm_phase<epi::GateMix, epi::ChainOrder, PG8_ALIGN, PG8_SP2>(lds + RING_OFF, g, S, E, wave);
#endif
    }
    SEAM(8); MARK(7);
    if (IN(9)) { STAGGER(STG_P9);
        pg8::Gemm g{(const bf16*)(ws + WS_MIX), (const bf16*)(ws + WS_WO), M, D, D}; pg8::StaticOrder S; S.init(M, D, G, (int)blockIdx.x);
        epi::ResidT<true> E{nullptr, (const bf16*)args.out, (bf16*)(ws + WS_H1B), (float*)(ws + SS1_OFF)};
        pg8::gemm_phase<epi::ResidT<true>, pg8::StaticOrder, PG8_ALIGN, PG8_SP2>(lds + RING_OFF, g, S, E, wave);
    }
    SEAM(9); MARK(8);
    if (IN(10)) { STAGGER(STG_P10);
        { pg8::Gemm g{(const bf16*)(ws + WS_H1B), (const bf16*)((unsigned char*)args.out + (size_t)128 * MiB), M, W13_SPLIT, D}; pg8::StaticOrder S; S.init(M, W13_SPLIT, G, (int)blockIdx.x);
          epi::FfnUp E{(const float*)(ws + SS1_OFF), (bf16*)(ws + WS_U)};
          pg8::gemm_phase<epi::FfnUp, pg8::StaticOrder, PG8_ALIGN, PG8_SP2>(lds + RING_OFF, g, S, E, wave); }
        { pg8::Gemm g{(const bf16*)(ws + WS_H1B), (const bf16*)(ws + WS_W13B), M, N13 - W13_SPLIT, D}; pg8::StaticOrder S; S.init(M, N13 - W13_SPLIT, G, (int)blockIdx.x);
          epi::FfnUp E{(const float*)(ws + SS1_OFF), (bf16*)(ws + WS_U) + W13_SPLIT / 2};
          pg8::gemm_phase<epi::FfnUp, pg8::StaticOrder, PG8_ALIGN, PG8_SP2>(lds + RING_OFF, g, S, E, wave); }
        { const int busy = ((M / 256) * ((N13 - W13_SPLIT) / 256)) % G, gi = busy ? G - busy : G, ci = busy ? (int)blockIdx.x - busy : (int)blockIdx.x;
          if (ci >= 0) { int k256 = 256; asm volatile("" : "+s"(k256));
            pg8::Gemm g2{(const bf16*)(ws + WS_PB), (const bf16*)(ws + WS_WPLE), M, D, k256}; pg8::StaticOrder S2; S2.init(M, D, gi, ci);
            epi::StoreBf E2{(bf16*)(ws + WS_PP), D};
            pg8::gemm_phase<epi::StoreBf, pg8::StaticOrder, PG8_ALIGN, PG8_SP2>(lds + RING_OFF, g2, S2, E2, wave); } }
    }
    SEAM(10); MARK(9);
    if (IN(11)) { STAGGER(STG_P11);
        { pg8::Gemm g{(const bf16*)(ws + WS_U), (const bf16*)(ws + WS_W2), M, D, DFF}; pg8::StaticOrder S; S.init(M, D, G, (int)blockIdx.x);
          epi::ResidT<true> E{nullptr, (const bf16*)(ws + WS_H1B), (bf16*)(ws + WS_H2B), (float*)(ws + SS2_OFF)};
          pg8::gemm_phase<epi::ResidT<true>, pg8::StaticOrder, PG8_ALIGN, PG8_SP2>(lds + RING_OFF, g, S, E, wave); }
    }
    SEAM(11); MARK(10);
    if (IN(12)) { STAGGER(STG_P12);
        pg8::Gemm g{(const bf16*)(ws + WS_H2B), (const bf16*)(ws + WS_WPG), M, D, D}; pg8::StaticOrder S; S.init(M, D, G, (int)blockIdx.x);
        epi::PleGate E{(bf16*)(ws + WS_H3B), (const bf16*)(ws + WS_H2B), (const bf16*)(ws + WS_PP), (const float*)(ws + SS2_OFF), (float*)(ws + SS3_OFF)};
        pg8::gemm_phase<epi::PleGate, pg8::StaticOrder, PG8_ALIGN, PG8_SP2>(lds + RING_OFF, g, S, E, wave);
    }
    SEAM(12); MARK(11);
    if (IN(13)) final_phase(in, ws, args.out, gw, NGW, LANE);
#if defined(PROBE_T)
    MARK(12);
    if (blockIdx.x == 0 && wave == 0) { const unsigned* tm_ = (const unsigned*)(ws + WS_CTL) + 9100;
        const unsigned dx_ = __hip_atomic_load(tm_ + PROBE_T2, __ATOMIC_RELAXED, __HIP_MEMORY_SCOPE_AGENT) - __hip_atomic_load(tm_ + PROBE_T, __ATOMIC_RELAXED, __HIP_MEMORY_SCOPE_AGENT);
        const unsigned long long te_ = __builtin_amdgcn_s_memrealtime() + (unsigned long long)dx_ * 4ull; while (__builtin_amdgcn_s_memrealtime() < te_) __builtin_amdgcn_s_sleep(8); }
#endif
#if defined(PROBE_X)
    if (blockIdx.x == 0 && wave == 0) { const unsigned dx_ = __hip_atomic_load((unsigned*)(ws + WS_CTL) + 9000, __ATOMIC_RELAXED, __HIP_MEMORY_SCOPE_AGENT);
        const unsigned long long te_ = __builtin_amdgcn_s_memrealtime() + (unsigned long long)dx_ * PROBE_X; while (__builtin_amdgcn_s_memrealtime() < te_) __builtin_amdgcn_s_sleep(8); }
#endif
#undef IN
#undef SEAM
#undef LANE
#undef MARK
#undef STAGGER
}

extern "C" void kernel_launch(void* const* d_in, const int* in_sizes, int n_in, void* d_out, int out_size, void* d_ws, size_t ws_size, hipStream_t stream) {
    static int grid = 0;
    if (grid == 0) {
        if (n_in != 32 || in_sizes[0] != M * D || out_size != M * D || ws_size < WS_END) { fprintf(stderr, "kernel_launch: unexpected shapes: n_in %d in0 %d out %d ws %zu (need %zu)\n", n_in, n_in > 0 ? in_sizes[0] : -1, out_size, ws_size, (size_t)WS_END); grid = -1; return; }
        int dev = 0, cus = 0, per_cu = 0;
        if (hipGetDevice(&dev) != hipSuccess || hipDeviceGetAttribute(&cus, hipDeviceAttributeMultiprocessorCount, dev) != hipSuccess) { grid = -1; return; }
        if (hipFuncSetAttribute((const void*)hybrid_fwd, hipFuncAttributeMaxDynamicSharedMemorySize, LDS_BYTES) != hipSuccess) { fprintf(stderr, "kernel_launch: hipFuncSetAttribute failed\n"); grid = -1; return; }
        if (hipOccupancyMaxActiveBlocksPerMultiprocessor(&per_cu, (const void*)hybrid_fwd, NWAVES * 64, LDS_BYTES) != hipSuccess || per_cu < 1) fprintf(stderr, "kernel_launch: occupancy query says %d\n", per_cu);
        (void)hipGetLastError();
        grid = cus;
    }
    if (grid < 0) return;
    if (hipMemsetAsync((char*)d_ws + WS_CTL, 0, CTL_ZERO_BYTES, stream) != hipSuccess) return;
    Args a{};
    for (int i = 0; i < 32; ++i) a.in[i] = (const float*)d_in[i];
    a.out = (float*)d_out; a.ws = (unsigned char*)d_ws;
#if MK_N_LAUNCHES == 1
    a.ph_lo = 0; a.ph_hi = N_PHASES + 1;
    hipLaunchKernelGGL(hybrid_fwd, dim3(grid), dim3(NWAVES * 64), LDS_BYTES, stream, a);
#else
    for (int p = 0; p <= N_PHASES; ++p) { a.ph_lo = p; a.ph_hi = p + 1; hipLaunchKernelGGL(hybrid_fwd, dim3(grid), dim3(NWAVES * 64), LDS_BYTES, stream, a); }
#endif
}
```
